# Optimizing an MI355X kernel written in HIP

```python
import jax
import jax.numpy as jnp
from jax import lax
import numpy as np

D_MODEL = 2048
BATCH = 2
SEQ = 4096
DEPTH = 4

N_MIXERS = 3
CHUNK = 128
EPS = 1e-6

RET_HEADS = 8
RET_DK = D_MODEL // RET_HEADS
RET_DV = 2 * D_MODEL // RET_HEADS
RET_IN = 2 * RET_HEADS * RET_DK + 2 * RET_HEADS * RET_DV
ROPE_BASE = 10000.0

GMLP_DFFN = 6 * D_MODEL
GMLP_HALF = GMLP_DFFN // 2
GMLP_GROUPS = 8
GMLP_GW = GMLP_HALF // GMLP_GROUPS

FOX_HEADS = 16
FOX_HD = D_MODEL // FOX_HEADS
FOX_IN = 4 * FOX_HEADS * FOX_HD + FOX_HEADS

FFN_HIDDEN = -(-8 * D_MODEL // (3 * 256)) * 256

N_RET = (DEPTH + N_MIXERS - 1) // N_MIXERS
N_GMLP = (DEPTH + N_MIXERS - 2) // N_MIXERS
N_FOX = DEPTH // N_MIXERS

kernel_name = "hybrid_ret_gmlp_fox_trunk"


def rms_norm(x, g):
    xf = x.astype(jnp.float32)
    y = xf * lax.rsqrt(jnp.mean(xf * xf, axis=-1, keepdims=True) + EPS)
    return (y * g.astype(jnp.float32)).astype(x.dtype)


def standardize(x):
    xf = x.astype(jnp.float32)
    xc = xf - jnp.mean(xf, axis=-1, keepdims=True)
    return xc * lax.rsqrt(jnp.mean(xc * xc, axis=-1, keepdims=True) + EPS)


def rotary(t, positions):
    half = t.shape[-1] // 2
    inv_freq = ROPE_BASE ** (-jnp.arange(half, dtype=jnp.float32) / half)
    ang = positions.astype(jnp.float32)[:, :, None, None] * inv_freq
    cos, sin = jnp.cos(ang), jnp.sin(ang)
    t1, t2 = t[..., :half], t[..., half:]
    return jnp.concatenate([t1 * cos - t2 * sin, t2 * cos + t1 * sin], axis=-1)


def retention_mixer(h, positions, w_in, gn_g, w_out):
    f32 = jnp.float32
    B, S, _ = h.shape
    H, dk, dv, C = RET_HEADS, RET_DK, RET_DV, CHUNK
    nc = S // C
    proj = h @ w_in
    q, k, v, g = jnp.split(proj, [H * dk, 2 * H * dk, 2 * H * dk + H * dv], axis=-1)
    q = rotary(q.astype(f32).reshape(B, S, H, dk), positions)
    k = rotary(k.astype(f32).reshape(B, S, H, dk), positions) * (dk ** -0.5)
    v = v.astype(f32).reshape(B, S, H, dv)

    def to_chunks(t):
        return t.reshape(B, nc, C, H, t.shape[-1]).transpose(1, 0, 3, 2, 4)

    log_gamma = jnp.log1p(-jnp.exp2(-5.0 - jnp.arange(H, dtype=f32)))
    idx = jnp.arange(C, dtype=f32)
    dist = idx[:, None] - idx[None, :]
    decay_in = jnp.where(dist >= 0,
                         jnp.exp(jnp.maximum(dist, 0.0)[None] * log_gamma[:, None, None]),
                         0.0)
    q_decay = jnp.exp((idx + 1.0)[None, :] * log_gamma[:, None])[..., None]
    k_decay = jnp.exp((C - 1.0 - idx)[None, :] * log_gamma[:, None])[..., None]
    chunk_decay = jnp.exp(C * log_gamma)[:, None, None]

    def step(state, xs):
        qi, ki, vi = xs
        scores = jnp.einsum('bhnd,bhmd->bhnm', qi, ki) * decay_in
        inner = jnp.einsum('bhnm,bhme->bhne', scores, vi)
        cross = jnp.einsum('bhnd,bhde->bhne', qi, state) * q_decay
        state = state * chunk_decay + jnp.einsum('bhmd,bhme->bhde', ki * k_decay, vi)
        return state, inner + cross

    state0 = jnp.zeros((B, H, dk, dv), f32)
    _, o = lax.scan(step, state0, (to_chunks(q), to_chunks(k), to_chunks(v)))
    o = o.transpose(1, 0, 3, 2, 4).reshape(B, S, H, dv)
    o = standardize(o).reshape(B, S, H * dv) * gn_g.astype(f32)
    y = jax.nn.silu(g.astype(f32)) * o
    return y.astype(h.dtype) @ w_out


def gmlp_mixer(h, w_in, ln_g, ln_b, w_s, b_s, w_out):
    f32 = jnp.float32
    B, S, _ = h.shape
    G, gw, C = GMLP_GROUPS, GMLP_GW, CHUNK
    nc = S // C
    z = jax.nn.gelu(h @ w_in, approximate=False)
    u, v = jnp.split(z, 2, axis=-1)
    v = (standardize(v) * ln_g.astype(f32) + ln_b.astype(f32)).astype(h.dtype)
    v = v.reshape(B, nc, C, G, gw)
    w_causal = jnp.tril(w_s)
    mixed = jnp.einsum('gts,bnsgc->bntgc', w_causal, v) + b_s.T[None, None, :, :, None]
    y = u * mixed.reshape(B, S, GMLP_HALF)
    return y @ w_out


def fox_mixer(h, w_in, b_f, qn_g, kn_g, w_out):
    f32 = jnp.float32
    B, S, _ = h.shape
    H, hd, C = FOX_HEADS, FOX_HD, CHUNK
    D = H * hd
    nb = S // C
    proj = h @ w_in
    q, k, v, g, f_logit = jnp.split(proj, [D, 2 * D, 3 * D, 4 * D], axis=-1)
    q = rms_norm(q.reshape(B, S, H, hd), qn_g).astype(f32)
    k = rms_norm(k.reshape(B, S, H, hd), kn_g).astype(f32)
    v = v.reshape(B, S, H, hd).astype(f32)
    log_f = jax.nn.log_sigmoid(f_logit.astype(f32) + b_f.astype(f32))
    c = jnp.cumsum(log_f, axis=1)
    scale = hd ** -0.5
    q_blocks = q.reshape(B, nb, C, H, hd).transpose(1, 0, 3, 2, 4)
    c_blocks = c.reshape(B, nb, C, H).transpose(1, 0, 3, 2)
    k_all = k.transpose(0, 2, 1, 3)
    v_all = v.transpose(0, 2, 1, 3)
    c_keys = c.transpose(0, 2, 1)
    key_pos = jnp.arange(S)

    def attend_block(args):
        qi, ci, bi = args
        q_pos = bi * C + jnp.arange(C)
        logits = (jnp.einsum('bhqd,bhkd->bhqk', qi, k_all) * scale
                  + (ci[..., :, None] - c_keys[:, :, None, :]))
        logits = jnp.where(key_pos[None, :] <= q_pos[:, None], logits, -jnp.inf)
        p = jax.nn.softmax(logits, axis=-1)
        return jnp.einsum('bhqk,bhkd->bhqd', p, v_all)

    o = lax.map(attend_block, (q_blocks, c_blocks, jnp.arange(nb)))
    o = o.transpose(1, 0, 3, 2, 4).reshape(B, S, D)
    y = jax.nn.sigmoid(g.astype(f32)) * o
    return y.astype(h.dtype) @ w_out


def swiglu(h, w_gate, w_up, w_down):
    return (jax.nn.silu(h @ w_gate) * (h @ w_up)) @ w_down


def _normal(key, shape, scale):
    return jax.random.normal(key, shape, jnp.float32) * scale


def setup_inputs(seed: int = 0) -> dict:
    key = jax.random.key(seed)
    ks = jax.random.split(key, 24)
    D = D_MODEL
    out_scale = (2.0 * DEPTH) ** -0.5
    return {
        "x": _normal(ks[0], (BATCH, SEQ, D), 1.0),
        "positions": jnp.broadcast_to(jnp.arange(SEQ, dtype=jnp.int32), (BATCH, SEQ)),
        "mix_norm_g": 1.0 + _normal(ks[1], (DEPTH, D), 0.1),
        "ffn_norm_g": 1.0 + _normal(ks[2], (DEPTH, D), 0.1),
        "ret_w_in": _normal(ks[3], (N_RET, D, RET_IN), D ** -0.5),
        "ret_gn_g": 1.0 + _normal(ks[4], (N_RET, RET_HEADS * RET_DV), 0.1),
        "ret_w_out": _normal(ks[5], (N_RET, RET_HEADS * RET_DV, D), (RET_HEADS * RET_DV) ** -0.5 * out_scale),
        "gmlp_w_in": _normal(ks[6], (N_GMLP, D, GMLP_DFFN), D ** -0.5),
        "gmlp_ln_g": 1.0 + _normal(ks[7], (N_GMLP, GMLP_HALF), 0.1),
        "gmlp_ln_b": _normal(ks[8], (N_GMLP, GMLP_HALF), 0.1),
        "gmlp_w_s": _normal(ks[9], (N_GMLP, GMLP_GROUPS, CHUNK, CHUNK), 0.5 * CHUNK ** -0.5),
        "gmlp_b_s": 1.0 + _normal(ks[10], (N_GMLP, GMLP_GROUPS, CHUNK), 0.1),
        "gmlp_w_out": _normal(ks[11], (N_GMLP, GMLP_HALF, D), GMLP_HALF ** -0.5 * out_scale),
        "fox_w_in": _normal(ks[12], (N_FOX, D, FOX_IN), D ** -0.5),
        "fox_b_f": jax.random.uniform(ks[13], (N_FOX, FOX_HEADS), jnp.float32, 1.0, 5.0),
        "fox_qn_g": 1.0 + _normal(ks[14], (N_FOX, FOX_HD), 0.1),
        "fox_kn_g": 1.0 + _normal(ks[15], (N_FOX, FOX_HD), 0.1),
        "fox_w_out": _normal(ks[16], (N_FOX, D, D), D ** -0.5 * out_scale),
        "ffn_w_gate": _normal(ks[17], (DEPTH, D, FFN_HIDDEN), D ** -0.5),
        "ffn_w_up": _normal(ks[18], (DEPTH, D, FFN_HIDDEN), D ** -0.5),
        "ffn_w_down": _normal(ks[19], (DEPTH, FFN_HIDDEN, D), FFN_HIDDEN ** -0.5 * out_scale),
    }


def reference(x, positions, mix_norm_g, ffn_norm_g,
              ret_w_in, ret_gn_g, ret_w_out,
              gmlp_w_in, gmlp_ln_g, gmlp_ln_b, gmlp_w_s, gmlp_b_s, gmlp_w_out,
              fox_w_in, fox_b_f, fox_qn_g, fox_kn_g, fox_w_out,
              ffn_w_gate, ffn_w_up, ffn_w_down):
    for i in range(DEPTH):
        kind, j = i % N_MIXERS, i // N_MIXERS
        h = rms_norm(x, mix_norm_g[i])
        if kind == 0:
            y = retention_mixer(h, positions, ret_w_in[j], ret_gn_g[j], ret_w_out[j])
        elif kind == 1:
            y = gmlp_mixer(h, gmlp_w_in[j], gmlp_ln_g[j], gmlp_ln_b[j],
                           gmlp_w_s[j], gmlp_b_s[j], gmlp_w_out[j])
        else:
            y = fox_mixer(h, fox_w_in[j], fox_b_f[j], fox_qn_g[j], fox_kn_g[j], fox_w_out[j])
        x = x + y
        h = rms_norm(x, ffn_norm_g[i])
        x = x + swiglu(h, ffn_w_gate[i], ffn_w_up[i], ffn_w_down[i])
    return x
```

```cpp
#include <hip/hip_runtime.h>
#include <cstdio>
#include <cstdint>
#include <cmath>
namespace pg8 {
#define PG8_LAS __attribute__((address_space(3)))
typedef unsigned short bf16_t;
typedef short bf16x8 __attribute__((ext_vector_type(8)));
typedef float f32x4 __attribute__((ext_vector_type(4)));
typedef unsigned u32x4 __attribute__((ext_vector_type(4)));
constexpr int BM = 256, BK = 64, HALF = 128, HTB = HALF * BK * 2  , STAGE_BYTES = 8 * HTB, NXCD = 8, WGM = 8;

__host__ __device__ __forceinline__ int lds_byte(int r, int c) { const int st = (r >> 4) * 2 + (c >> 5), rr = r & 15, cc = c & 31, ob = rr * 64 + cc * 2; return st * 1024 + (ob ^ (((ob >> 9) & 1) << 5)); }
__host__ __device__ __forceinline__ void stage_rc(int b, int& R, int& C) { const int st = b / 1024, sb = b % 1024, swz = sb ^ (((sb >> 9) & 1) << 5); R = (st >> 1) * 16 + swz / 64; C = (st & 1) * 32 + (swz % 64) / 2; }
__host__ __device__ __forceinline__ int perm32(int rho) { const int n = rho >> 4, i = rho & 15; return 8 * (i >> 2) + 4 * n + (i & 3); }

struct Unit { int pm, pn, hf; };
struct Gemm { const bf16_t* A; const bf16_t* Bt; int M, N, K; };

struct StaticOrder {
    int nM, nN, nwg, G, c;
    __host__ __device__ void init(int M, int N, int G_, int c_) { nM = M / BM; nN = N / BM; nwg = nM * nN; G = G_; c = c_; }
    __host__ __device__ bool next(int i, Unit& u) const {
        const long L = (long)i * G + c; if (L >= nwg) return false;
        int wgid = (int)L; { const int q = nwg / NXCD, r = nwg % NXCD, xcd = wgid % NXCD, off = wgid / NXCD; wgid = (xcd < r ? xcd * (q + 1) : r * (q + 1) + (xcd - r) * q) + off; }
        const int nig = WGM * nN, gid = wgid / nig, fm = gid * WGM, gsz = (nM - fm) < WGM ? (nM - fm) : WGM;
        u.pm = fm + ((wgid % nig) % gsz); u.pn = (wgid % nig) / gsz; u.hf = 0; return true;
    }
    __device__ __forceinline__ void a_ready(const Unit&) const {}
    __device__ __forceinline__ void done(const Unit&) const {}
};

__device__ __forceinline__ unsigned cvt_pk_bf16(float lo, float hi) { unsigned r; asm volatile("v_cvt_pk_bf16_f32 %0, %1, %2" : "=v"(r) : "v"(lo), "v"(hi)); return r; }
typedef float f32x2 __attribute__((ext_vector_type(2)));
__device__ __forceinline__ f32x2 gelu_pk(f32x2 v) {
    const f32x2 av = __builtin_elementwise_abs(v), d = av * 0.2316418882f + 1.0f;
    f32x2 t; t.x = __builtin_amdgcn_rcpf(d.x); t.y = __builtin_amdgcn_rcpf(d.y);
    f32x2 q = t * 0.5307027145f + (-0.7265760135f); q = q * t + 0.7107068705f; q = q * t + (-0.142248368f); q = q * t + 0.127414796f; q = q * t;
    const f32x2 s = (v * v) * (-0.72134752044f);
    f32x2 e; e.x = __builtin_amdgcn_exp2f(s.x); e.y = __builtin_amdgcn_exp2f(s.y);
    const f32x2 m = v * (q * e), r = v - m;
    f32x2 o; o.x = v.x < 0.f ? m.x : r.x; o.y = v.y < 0.f ? m.y : r.y; return o;
}

typedef float f32x2v __attribute__((ext_vector_type(2)));
typedef __bf16 bf16x2v __attribute__((ext_vector_type(2)));
__device__ __forceinline__ unsigned cvtpk(float lo, float hi) { f32x2v v = {lo, hi}; bf16x2v b = __builtin_convertvector(v, bf16x2v); return __builtin_bit_cast(unsigned, b); }
__device__ __forceinline__ u32x4 pack8(const f32x4 a, const f32x4 b) { u32x4 w; w.x = cvtpk(a[0], a[1]); w.y = cvtpk(a[2], a[3]); w.z = cvtpk(b[0], b[1]); w.w = cvtpk(b[2], b[3]); return w; }
#ifndef EPI_WT
#define EPI_WT 0
#endif
__device__ __forceinline__ void st16(void* p, const u32x4 v) {
#if EPI_WT
    asm volatile("global_store_dwordx4 %0, %1, off sc1\n\ts_nop 2" :: "v"(p), "v"(v) : "memory");
#else
    *(u32x4*)p = v;
#endif
}
__device__ __forceinline__ float fast_sigmoid(float x) { return __builtin_amdgcn_rcpf(1.0f + __builtin_amdgcn_exp2f(-1.44269504f * x)); }

template <bool BASE_F32, bool OUT_F32> struct EpiRes {
    static constexpr bool PERM = true, AFTER_DRAIN = false;
    const float* base; float* out; bf16_t* xb; float* rs; int ldc;
    __device__ __forceinline__ void operator()(const f32x4 (&acc)[2][2][4][2], const Unit& u, int wr, int wc, int fr, int fq) const {
        const int row0 = u.pm * BM + wr * 64 + fr, col0 = u.pn * BM + wc * 32 + 8 * fq;
#pragma unroll
        for (int ai = 0; ai < 2; ++ai)
#pragma unroll
            for (int m = 0; m < 4; ++m) { const int row = row0 + ai * HALF + m * 16; const size_t off = (size_t)row * ldc + col0; float ss = 0.f;
#pragma unroll
                for (int bj = 0; bj < 2; ++bj) { f32x4 b0, b1;
                    if (BASE_F32) { b0 = *(const f32x4*)(base + off + bj * HALF); b1 = *(const f32x4*)(base + off + bj * HALF + 4); }
                    else { const u32x4 w = *(const u32x4*)(xb + off + bj * HALF);
                        b0 = (f32x4){__uint_as_float(w.x << 16), __uint_as_float(w.x & 0xffff0000u), __uint_as_float(w.y << 16), __uint_as_float(w.y & 0xffff0000u)};
                        b1 = (f32x4){__uint_as_float(w.z << 16), __uint_as_float(w.z & 0xffff0000u), __uint_as_float(w.w << 16), __uint_as_float(w.w & 0xffff0000u)}; }
                    const f32x4 x0 = b0 + acc[ai][bj][m][0], x1 = b1 + acc[ai][bj][m][1];
                    if (OUT_F32) { *(f32x4*)(out + off + bj * HALF) = x0; *(f32x4*)(out + off + bj * HALF + 4) = x1; }
                    else st16(xb + off + bj * HALF, pack8(x0, x1));
                    ss += (x0[0] * x0[0] + x0[1] * x0[1]) + (x0[2] * x0[2] + x0[3] * x0[3]) + (x1[0] * x1[0] + x1[1] * x1[1]) + (x1[2] * x1[2] + x1[3] * x1[3]); }
                if (!OUT_F32) { ss += __shfl_xor(ss, 16); ss += __shfl_xor(ss, 32);
                    if (fq == 0) rs[(size_t)row * 32 + u.pn * 4 + wc] = ss; }
                if (m & 1) asm volatile("" ::: "memory"); }
    }
};
__device__ __forceinline__ float row_sumsq(const float* rs, int row) {
    const f32x4* p = (const f32x4*)(rs + (size_t)row * 32); f32x4 t = p[0];
#pragma unroll
    for (int i = 1; i < 8; ++i) t += p[i];
    return (t[0] + t[1]) + (t[2] + t[3]);
}
__device__ __forceinline__ float row_rstd(const float* rs, int row) { return 1.0f / sqrtf(row_sumsq(rs, row) * (1.0f / 2048.0f) + 1e-6f); }
struct RsOrder : StaticOrder {
    const float* rs; PG8_LAS float* tab; mutable float pend; mutable int nready;
    __device__ __forceinline__ void a_ready(const Unit& u) const {
        if (threadIdx.x < 256) pend = row_sumsq(rs, u.pm * BM + u.hf * HALF + threadIdx.x);
        ++nready;
    }
    __device__ __forceinline__ bool next(int i, Unit& u) const {
        if (i == 1 && threadIdx.x < 256) tab[threadIdx.x] = 1.0f / sqrtf(pend * (1.0f / 2048.0f) + 1e-6f);
        return StaticOrder::next(i, u);
    }
    __device__ __forceinline__ void done(const Unit&) const {
        if (threadIdx.x < 256) tab[((nready - 1) & 1) * 256 + threadIdx.x] = 1.0f / sqrtf(pend * (1.0f / 2048.0f) + 1e-6f);
    }
};
struct TailOrder : RsOrder {
    int pn0;
    __device__ __forceinline__ bool next(int i, Unit& u) const {
        if (i == 1 && threadIdx.x < 256) tab[threadIdx.x] = 1.0f / sqrtf(pend * (1.0f / 2048.0f) + 1e-6f);
        if (i != 0 || G != 256) return false;
        const int x = c & 7, l = c >> 3; u.pm = 4 * x + (l & 3); u.hf = (l >> 2) & 1; u.pn = pn0 + (l >> 3); return true;
    }
};
template <bool HALF_M> struct EpiSwiglu {
    static constexpr bool PERM = true, AFTER_DRAIN = false;
    bf16_t* O; int ldc; const PG8_LAS float* tab; mutable int ui;
    __device__ __forceinline__ void operator()(const f32x4 (&acc)[2][2][4][2], const Unit& u, int wr, int wc, int fr, int fq) const {
        const int row0 = u.pm * BM + (HALF_M ? u.hf * HALF : 0) + wr * 64 + fr, col0 = u.pn * HALF + wc * 32 + 8 * fq;
#pragma unroll
        for (int ai = 0; ai < (HALF_M ? 1 : 2); ++ai)
#pragma unroll
            for (int m = 0; m < 4; ++m) { bf16_t* rowp = O + (size_t)(row0 + ai * HALF + m * 16) * ldc + col0; const float r = tab[(ui & 1) * 256 + wr * 64 + fr + ai * HALF + m * 16];
                f32x4 v0, v1;
#pragma unroll
                for (int j = 0; j < 4; ++j) { const float g0 = acc[ai][0][m][0][j] * r, g1 = acc[ai][0][m][1][j] * r;
                    v0[j] = g0 * fast_sigmoid(g0) * (acc[ai][1][m][0][j] * r); v1[j] = g1 * fast_sigmoid(g1) * (acc[ai][1][m][1][j] * r); }
                st16(rowp, pack8(v0, v1)); }
        ++ui;
    }
};

struct EpiSwigluProbe {
    static constexpr bool PERM = true, AFTER_DRAIN = false;
    bf16_t* O; int never;
    __device__ __forceinline__ void operator()(const f32x4 (&acc)[2][2][4][2], const Unit& u, int wr, int wc, int fr, int fq) const {
        if (never) {
#pragma unroll
        for (int ai = 0; ai < 2; ++ai)
#pragma unroll
            for (int m = 0; m < 4; ++m) { bf16_t* rowp = O + (size_t)(u.pm * BM + wr * 64 + fr + ai * HALF + m * 16) * 5632 + u.pn * HALF + wc * 32 + 8 * fq;
                st16(rowp, pack8(acc[ai][0][m][0] + acc[ai][1][m][0], acc[ai][0][m][1] + acc[ai][1][m][1])); } }
    }
};
struct EpiRetIn {
    static constexpr bool PERM = true, AFTER_DRAIN = false;
    bf16_t *q, *k, *v, *g; const float *cs, *sn; const PG8_LAS float* tab; mutable int ui;
    __device__ __forceinline__ void operator()(const f32x4 (&acc)[2][2][4][2], const Unit& u, int wr, int wc, int fr, int fq) const {
        const int pn = u.pn, ci = wc * 32 + 8 * fq;
#pragma unroll
        for (int ai = 0; ai < 2; ++ai)
#pragma unroll
            for (int m = 0; m < 4; ++m) {
                const int row = u.pm * BM + ai * HALF + wr * 64 + m * 16 + fr, b = row >> 12, s = row & 4095; const float rr = tab[(ui & 1) * 256 + ai * HALF + wr * 64 + m * 16 + fr];
                if (pn < 16) {
                    const int h = pn & 7; const float sc = (pn < 8 ? 1.0f : 0.0625f) * rr;
                    bf16_t* dst = (pn < 8 ? q : k) + ((size_t)((b * 8 + h) * 4096 + s)) * 256 + ci;
                    f32x4 o1[2], o2[2];
#pragma unroll
                    for (int n = 0; n < 2; ++n) { const f32x4 c4 = *(const f32x4*)(cs + (size_t)row * 128 + ci + 4 * n), s4 = *(const f32x4*)(sn + (size_t)row * 128 + ci + 4 * n);
                        const f32x4 x1 = acc[ai][0][m][n], x2 = acc[ai][1][m][n];
                        o1[n] = (x1 * c4 - x2 * s4) * sc; o2[n] = (x2 * c4 + x1 * s4) * sc; }
                    st16(dst, pack8(o1[0], o1[1])); st16(dst + 128, pack8(o2[0], o2[1]));
                } else if (pn < 32) {
                    const int t = pn - 16, h = t >> 1, hf = t & 1;
                    bf16_t* dst = v + ((size_t)((b * 8 + h) * 4096 + s)) * 512 + hf * 256 + ci;
                    st16(dst, pack8(acc[ai][0][m][0] * rr, acc[ai][0][m][1] * rr)); st16(dst + 128, pack8(acc[ai][1][m][0] * rr, acc[ai][1][m][1] * rr));
                } else {
                    bf16_t* dst = g + (size_t)row * 4096 + (pn - 32) * 256 + ci;
                    st16(dst, pack8(acc[ai][0][m][0] * rr, acc[ai][0][m][1] * rr)); st16(dst + 128, pack8(acc[ai][1][m][0] * rr, acc[ai][1][m][1] * rr));
                }
            }
        ++ui;
    }
};
struct EpiGeluUV {
    static constexpr bool PERM = true, AFTER_DRAIN = false;
    bf16_t *uo, *vo; f32x2v* part; const PG8_LAS float* tab; mutable int ui;
    __device__ __forceinline__ void operator()(const f32x4 (&acc)[2][2][4][2], const Unit& u, int wr, int wc, int fr, int fq) const {
        const bool isv = u.pn >= 24; const int ct = isv ? u.pn - 24 : u.pn; bf16_t* dstb = isv ? vo : uo;
#pragma unroll
        for (int ai = 0; ai < 2; ++ai)
#pragma unroll
            for (int m = 0; m < 4; ++m) {
                const int row = u.pm * BM + ai * HALF + wr * 64 + m * 16 + fr;
                bf16_t* dst = dstb + (size_t)row * 6144 + ct * 256 + wc * 32 + 8 * fq;
                float s = 0.f, ss = 0.f; const float rr = tab[(ui & 1) * 256 + ai * HALF + wr * 64 + m * 16 + fr];
#pragma unroll
                for (int bj = 0; bj < 2; ++bj) { const f32x4 v0 = acc[ai][bj][m][0] * rr, v1 = acc[ai][bj][m][1] * rr;
                    const f32x2 a = gelu_pk((f32x2){v0[0], v0[1]}), b = gelu_pk((f32x2){v0[2], v0[3]}), c = gelu_pk((f32x2){v1[0], v1[1]}), d = gelu_pk((f32x2){v1[2], v1[3]});
                    const f32x4 z0 = {a.x, a.y, b.x, b.y}, z1 = {c.x, c.y, d.x, d.y};
                    st16(dst + bj * HALF, pack8(z0, z1));
                    s += (z0[0] + z0[1]) + (z0[2] + z0[3]) + (z1[0] + z1[1]) + (z1[2] + z1[3]);
                    ss += (z0[0] * z0[0] + z0[1] * z0[1]) + (z0[2] * z0[2] + z0[3] * z0[3]) + (z1[0] * z1[0] + z1[1] * z1[1]) + (z1[2] * z1[2] + z1[3] * z1[3]); }
                if (isv) { s += __shfl_xor(s, 16); s += __shfl_xor(s, 32); ss += __shfl_xor(ss, 16); ss += __shfl_xor(ss, 32);
                    if (fq == 0) part[((size_t)row * 24 + ct) * 4 + wc] = (f32x2v){s, ss}; }
            }
        ++ui;
    }
};
struct EpiFoxIn {
    static constexpr bool PERM = true, AFTER_DRAIN = false;
    bf16_t* O; size_t stride; const PG8_LAS float* tab; mutable int ui;
    __device__ __forceinline__ void operator()(const f32x4 (&acc)[2][2][4][2], const Unit& u, int wr, int wc, int fr, int fq) const {
        const int t = u.pn >> 3; bf16_t* base = O + (size_t)t * stride + (u.pn & 7) * 256 + wc * 32 + 8 * fq;
#pragma unroll
        for (int ai = 0; ai < 2; ++ai)
#pragma unroll
            for (int m = 0; m < 4; ++m) { const int row = u.pm * BM + ai * HALF + wr * 64 + m * 16 + fr; bf16_t* dst = base + (size_t)row * 2048; const float rr = tab[(ui & 1) * 256 + ai * HALF + wr * 64 + m * 16 + fr];
#pragma unroll
                for (int bj = 0; bj < 2; ++bj) { f32x4 v0 = acc[ai][bj][m][0] * rr, v1 = acc[ai][bj][m][1] * rr;
                    if (t == 3) {
#pragma unroll
                        for (int j = 0; j < 4; ++j) { v0[j] = fast_sigmoid(v0[j]); v1[j] = fast_sigmoid(v1[j]); } }
                    st16(dst + bj * HALF, pack8(v0, v1)); } }
        ++ui;
    }
};

template <class Epi, class Sched, bool ALIGN_EPI = false, bool SP2 = false, bool HALF_M = false>
__device__ __forceinline__ void gemm_phase(PG8_LAS unsigned char* lds, const Gemm g, const Sched& S, const Epi& E) {
    const int tid = threadIdx.x, wid = __builtin_amdgcn_readfirstlane(tid >> 6), lane = tid & 63, wr = wid >> 2, wc = wid & 3, fr = lane & 15, fq = lane >> 4;
    static_assert(!HALF_M || SP2, "HALF_M is written for the SP2 loop");
    const int K = g.K, nt = K / BK;
    unsigned voffA[2], voffB[2];
#pragma unroll
    for (int i = 0; i < 2; ++i) { int R, C; stage_rc(tid * 16 + i * 8192, R, C); const int Rb = Epi::PERM ? ((R & ~31) + perm32(R & 31)) : R;
        voffA[i] = (unsigned)(R * K + C) * 2u; voffB[i] = (unsigned)(Rb * K + C) * 2u; }
    const size_t kstep = (size_t)(BK * 2);
    const size_t hstep = (size_t)HALF * K * 2;
    const size_t tstep = 2 * hstep;
    const unsigned ldsw = (unsigned)wid * 1024u;
    const int aoff = lds_byte(wr * 64 + fr, fq * 8), boff = lds_byte(wc * 32 + fr, fq * 8);
#define PG8_SA(b, h) (((b) * 2 + (h)) * HTB)
#define PG8_SB(b, h) ((4 + (b) * 2 + (h)) * HTB)
#define PG8_STAGE(bufoff, gbase, voff) do { _Pragma("unroll") for (int _i = 0; _i < 2; ++_i) \
        __builtin_amdgcn_global_load_lds((const unsigned*)((const char*)(gbase) + (voff)[_i]), (PG8_LAS unsigned*)(lds + (bufoff) + ldsw + _i * 8192), 16, 0, 0); } while (0)
#define PG8_LDA(dst, b, h) do { _Pragma("unroll") for (int m = 0; m < 4; ++m) _Pragma("unroll") for (int k = 0; k < 2; ++k) dst[m][k] = *(const PG8_LAS bf16x8*)(lds + PG8_SA(b, h) + aoff + m * 2048 + k * 1024); } while (0)
#define PG8_LDB(dst, b, h) do { _Pragma("unroll") for (int n = 0; n < 2; ++n) _Pragma("unroll") for (int k = 0; k < 2; ++k) dst[n][k] = *(const PG8_LAS bf16x8*)(lds + PG8_SB(b, h) + boff + n * 2048 + k * 1024); } while (0)
#define PG8_MMA(ai, bj, At, Bt) do { __builtin_amdgcn_s_setprio(1); _Pragma("unroll") for (int m = 0; m < 4; ++m) _Pragma("unroll") for (int n = 0; n < 2; ++n) _Pragma("unroll") for (int k = 0; k < 2; ++k) \
        acc[ai][bj][m][n] = __builtin_amdgcn_mfma_f32_16x16x32_bf16(Bt[n][k], At[m][k], acc[ai][bj][m][n], 0, 0, 0); __builtin_amdgcn_s_setprio(0); } while (0)
#define PG8_WAIT_V(n) asm volatile("s_waitcnt vmcnt(" #n ")" ::: "memory")
#define PG8_WAIT_L(n) asm volatile("s_waitcnt lgkmcnt(" #n ")" ::: "memory")
#define PG8_BAR __builtin_amdgcn_s_barrier()
#define PG8_SCHED __builtin_amdgcn_sched_barrier(0)
    Unit cur, nxt; int ui = 0;
    if (!S.next(0, cur)) return;
    f32x4 acc[2][2][4][2];
#pragma unroll
    for (int a = 0; a < 2; ++a)
#pragma unroll
        for (int b = 0; b < 2; ++b)
#pragma unroll
            for (int m = 0; m < 4; ++m)
#pragma unroll
                for (int n = 0; n < 2; ++n) acc[a][b][m][n] = (f32x4){0.f, 0.f, 0.f, 0.f};
    bf16x8 At[4][2], B0[2][2], B1[2][2];
    const char* cA = (const char*)g.A + (size_t)cur.pm * tstep + (HALF_M ? (size_t)cur.hf * hstep : (size_t)0); const char* cB = (const char*)g.Bt + (size_t)cur.pn * tstep;
    S.a_ready(cur);
    if constexpr (SP2) {
        PG8_STAGE(PG8_SB(0, 0), cB, voffB); PG8_STAGE(PG8_SB(0, 1), cB + hstep, voffB); PG8_STAGE(PG8_SA(0, 0), cA, voffA); PG8_STAGE(PG8_SA(0, 1), cA + hstep, voffA);
        if (wr == 1) PG8_BAR;
        PG8_WAIT_V(2); PG8_BAR;
        PG8_STAGE(PG8_SB(1, 0), cB + kstep, voffB); PG8_STAGE(PG8_SA(1, 0), cA + kstep, voffA); PG8_STAGE(PG8_SB(1, 1), cB + hstep + kstep, voffB);
        PG8_WAIT_V(6); PG8_BAR;
    } else {
        PG8_STAGE(PG8_SB(0, 0), cB, voffB); PG8_STAGE(PG8_SA(0, 0), cA, voffA); PG8_STAGE(PG8_SB(0, 1), cB + hstep, voffB); PG8_STAGE(PG8_SA(0, 1), cA + hstep, voffA);
        if (wr == 1) PG8_BAR;
        PG8_WAIT_V(4); PG8_BAR;
        PG8_STAGE(PG8_SB(1, 0), cB + kstep, voffB); PG8_STAGE(PG8_SA(1, 0), cA + kstep, voffA); PG8_STAGE(PG8_SB(1, 1), cB + hstep + kstep, voffB);
        PG8_WAIT_V(6); PG8_BAR;
    }
    for (;;) {
        const bool has_next = S.next(ui + 1, nxt);
        const char* nA = has_next ? (const char*)g.A + (size_t)nxt.pm * tstep + (HALF_M ? (size_t)nxt.hf * hstep : (size_t)0) : cA; const char* nB = has_next ? (const char*)g.Bt + (size_t)nxt.pn * tstep : cB;
        for (int t = 0; t < nt; t += 2) {
            const bool last = (t == nt - 2);
            const char* a1 = cA + (size_t)(t + 1) * kstep;
            const char* a2 = last ? nA : cA + (size_t)(t + 2) * kstep; const char* b2 = last ? nB : cB + (size_t)(t + 2) * kstep;
            const char* a3 = a2 + kstep; const char* b3 = b2 + kstep;
            if (last && has_next) S.a_ready(nxt);
            if constexpr (SP2) {
            PG8_LDB(B0, 0, 0); PG8_LDB(B1, 0, 1); PG8_SCHED; PG8_LDA(At, 0, 0); PG8_STAGE(PG8_SA(1, 1), a1 + hstep, voffA);
            PG8_WAIT_V(8); PG8_WAIT_L(0); PG8_BAR; PG8_MMA(0, 0, At, B0); PG8_MMA(0, 1, At, B1); PG8_BAR; PG8_SCHED;
            if constexpr (!HALF_M) { PG8_LDA(At, 0, 1); } PG8_STAGE(PG8_SB(0, 0), b2, voffB); PG8_STAGE(PG8_SB(0, 1), b2 + hstep, voffB); PG8_STAGE(PG8_SA(0, 0), a2, voffA);
            PG8_WAIT_V(8); PG8_WAIT_L(0); PG8_BAR; if constexpr (!HALF_M) { PG8_MMA(1, 0, At, B0); PG8_MMA(1, 1, At, B1); } PG8_BAR; PG8_SCHED;
            PG8_LDB(B0, 1, 0); PG8_LDB(B1, 1, 1); PG8_SCHED; PG8_LDA(At, 1, 0); PG8_STAGE(PG8_SA(0, 1), a2 + hstep, voffA);
            PG8_WAIT_V(8); PG8_WAIT_L(0); PG8_BAR; PG8_MMA(0, 0, At, B0); PG8_MMA(0, 1, At, B1); PG8_BAR; PG8_SCHED;
            if constexpr (!HALF_M) { PG8_LDA(At, 1, 1); } PG8_STAGE(PG8_SB(1, 0), b3, voffB); PG8_STAGE(PG8_SB(1, 1), b3 + hstep, voffB); PG8_STAGE(PG8_SA(1, 0), a3, voffA);
            PG8_WAIT_V(8); PG8_WAIT_L(0); PG8_BAR; if constexpr (!HALF_M) { PG8_MMA(1, 0, At, B0); PG8_MMA(1, 1, At, B1); } PG8_BAR; PG8_SCHED;
            } else {
            PG8_LDB(B0, 0, 0); PG8_SCHED; PG8_LDA(At, 0, 0); PG8_STAGE(PG8_SA(1, 1), a1 + hstep, voffA);
            PG8_WAIT_L(8); PG8_BAR; PG8_WAIT_L(0); PG8_MMA(0, 0, At, B0); PG8_BAR; PG8_SCHED;
            PG8_LDB(B1, 0, 1); PG8_STAGE(PG8_SB(0, 0), b2, voffB);
            PG8_BAR; PG8_WAIT_L(0); PG8_MMA(0, 1, At, B1); PG8_BAR;
            PG8_LDA(At, 0, 1); PG8_STAGE(PG8_SA(0, 0), a2, voffA);
            PG8_BAR; PG8_WAIT_L(0); PG8_MMA(1, 0, At, B0); PG8_BAR; PG8_SCHED;
            PG8_STAGE(PG8_SB(0, 1), b2 + hstep, voffB);
            PG8_WAIT_V(6); PG8_BAR; PG8_MMA(1, 1, At, B1); PG8_BAR;
            PG8_LDB(B0, 1, 0); PG8_SCHED; PG8_LDA(At, 1, 0); PG8_STAGE(PG8_SA(0, 1), a2 + hstep, voffA);
            PG8_WAIT_L(8); PG8_BAR; PG8_WAIT_L(0); PG8_MMA(0, 0, At, B0); PG8_BAR; PG8_SCHED;
            PG8_LDB(B1, 1, 1); PG8_STAGE(PG8_SB(1, 0), b3, voffB);
            PG8_BAR; PG8_WAIT_L(0); PG8_MMA(0, 1, At, B1); PG8_BAR;
            PG8_LDA(At, 1, 1); PG8_STAGE(PG8_SA(1, 0), a3, voffA);
            PG8_BAR; PG8_WAIT_L(0); PG8_MMA(1, 0, At, B0); PG8_BAR; PG8_SCHED;
            PG8_STAGE(PG8_SB(1, 1), b3 + hstep, voffB);
            PG8_WAIT_V(6); PG8_BAR; PG8_MMA(1, 1, At, B1); PG8_BAR;
            }
        }
        if constexpr (ALIGN_EPI) { if (wr == 0) PG8_BAR; }
        if constexpr (!Epi::AFTER_DRAIN) { E(acc, cur, wr, wc, fr, fq); S.done(cur); }
        if (!has_next) break;
#pragma unroll
        for (int a = 0; a < 2; ++a)
#pragma unroll
            for (int b = 0; b < 2; ++b)
#pragma unroll
                for (int m = 0; m < 4; ++m)
#pragma unroll
                    for (int n = 0; n < 2; ++n) acc[a][b][m][n] = (f32x4){0.f, 0.f, 0.f, 0.f};
        cur = nxt; cA = nA; cB = nB; ++ui;
        if constexpr (ALIGN_EPI) { if (wr == 1) PG8_BAR; }
    }
    PG8_WAIT_V(0);
    if constexpr (!ALIGN_EPI) { if (wr == 0) PG8_BAR; }
    PG8_BAR;
    if constexpr (Epi::AFTER_DRAIN) { E.fused(acc, cur, wr, wc, fr, fq, lds, wid, lane); S.done(cur); }
#undef PG8_SA
#undef PG8_SB
#undef PG8_STAGE
#undef PG8_LDA
#undef PG8_LDB
#undef PG8_MMA
#undef PG8_WAIT_V
#undef PG8_WAIT_L
#undef PG8_BAR
#undef PG8_SCHED
}
}

#ifndef PG8_SP2
#define PG8_SP2 true
#endif
#ifndef PG8_ALIGN
#define PG8_ALIGN true
#endif
constexpr int NWAVES = 8, NTHR = 512;
#ifndef MK_N_LAUNCHES
#define MK_N_LAUNCHES 1
#endif
constexpr int N_PHASES = 25;
constexpr int N_LAUNCHES = MK_N_LAUNCHES;
static_assert(N_LAUNCHES == 1, "this build runs as ONE launch (the retention mixer has a grid barrier inside its phase)");

constexpr int BATCH = 2, SEQ = 4096, DM = 2048, M = BATCH * SEQ, DEPTH = 4;
constexpr int RET_N = 12288, GM_N = 12288, GM_HALF = 6144, FOX_LD = 8208, FOX_N = 8192, FFN_H = 5632, FFN_N2 = 2 * FFN_H;
constexpr float EPS = 1e-6f;
constexpr float LOG2E = 1.4426950408889634f;

constexpr size_t MiB = (size_t)1 << 20;
constexpr size_t WS_CTL = 0, CTL_ZERO_BYTES = 1 * MiB;
constexpr size_t WS_W_RET_IN = 1 * MiB, SZ_W_RET_IN = 48 * MiB;
constexpr size_t WS_W_RET_OUT = 97 * MiB, SZ_W_RET_OUT = 16 * MiB;
constexpr size_t WS_W_GM_IN = 129 * MiB, WS_W_GM_OUT = 177 * MiB, WS_W_FOX_IN = 201 * MiB, WS_W_FOX_OUT = 233 * MiB;
constexpr size_t WS_W_GU = 241 * MiB, SZ_W_GU = 44 * MiB;
constexpr size_t WS_W_DN = 417 * MiB, SZ_W_DN = 22 * MiB;
constexpr size_t WS_ROPE_C = 505 * MiB, WS_ROPE_S = 509 * MiB;
constexpr size_t WS_H = 513 * MiB;
constexpr size_t WS_A = 545 * MiB;
constexpr size_t WS_B = 737 * MiB;
constexpr size_t WS_C = 833 * MiB;
constexpr size_t WS_MISC = 897 * MiB, WS_RSP = 913 * MiB, WS_END = 921 * MiB;
constexpr size_t MISC_PART = 0, MISC_RSTAT = 8 * MiB, MISC_LF = 9 * MiB;
constexpr int CW_BAR = 4096;

constexpr int RING_OFF = 0, RING_BYTES = 131072;
constexpr int LDSCTL_OFF = RING_BYTES, MISC_OFF = LDSCTL_OFF + 320;
constexpr int RSTAB_OFF = LDSCTL_OFF + 1024;
constexpr int LDS_BYTES = 147456;
static_assert(MISC_OFF + 128 <= LDS_BYTES, "LDS map");

#define GAS __attribute__((address_space(1)))
#define LAS __attribute__((address_space(3)))
typedef unsigned short bf16;
typedef unsigned v4u __attribute__((ext_vector_type(4)));
typedef unsigned v2u __attribute__((ext_vector_type(2)));
typedef float f32x4 __attribute__((ext_vector_type(4)));
typedef float f32x2 __attribute__((ext_vector_type(2)));
typedef short bf16x8 __attribute__((ext_vector_type(8)));
typedef short s16x4 __attribute__((ext_vector_type(4)));
typedef GAS unsigned gu32;
typedef LAS unsigned char* ldsp;
#define RLX_AGENT __ATOMIC_RELAXED, __HIP_MEMORY_SCOPE_AGENT
#define LDS_WAIT() asm volatile("s_waitcnt lgkmcnt(0)" ::: "memory")
using pg8::cvtpk;
__device__ __forceinline__ float bflo(unsigned w) { return __uint_as_float(w << 16); }
__device__ __forceinline__ float bfhi(unsigned w) { return __uint_as_float(w & 0xffff0000u); }
#define MFMA16(a, b, c) __builtin_amdgcn_mfma_f32_16x16x32_bf16((a), (b), (c), 0, 0, 0)
__device__ __forceinline__ bf16x8 frag_row(const ldsp tile, int RS, int lane) { return *(const LAS bf16x8*)(tile + (lane & 15) * RS + (lane >> 4) * 16); }
typedef short v4i16_t __attribute__((ext_vector_type(4)));
__device__ __forceinline__ s16x4 vtr(const ldsp p) { return __builtin_bit_cast(s16x4, __builtin_amdgcn_ds_read_tr16_b64_v4i16((LAS v4i16_t*)p)); }
__device__ __forceinline__ bf16x8 frag_tr(const ldsp tile, int RS, int lane) {
    const ldsp a = tile + (8 * (lane >> 4) + ((lane & 15) >> 2)) * RS + 8 * (lane & 3);
    const s16x4 lo = vtr(a), hi = vtr(a + 4 * RS);
    return (bf16x8){lo[0], lo[1], lo[2], lo[3], hi[0], hi[1], hi[2], hi[3]};
}

#define XB_TMO      128
#define XB_XCNT(j)  (256  + 64 * (j))
#define XB_XSUB(j)  (1280 + 64 * (j))
#define XB_XGEN(j)  (2304 + 64 * (j))
#define XB_TOP      3328
#define XB_TOPGEN   3392
#define XCD_BAR_WORDS 3456
#define XB_SPIN_CAP (1u << 18)

__device__ __forceinline__ unsigned xb_ld(unsigned* p)              { return __hip_atomic_load(p, __ATOMIC_RELAXED, __HIP_MEMORY_SCOPE_AGENT); }
__device__ __forceinline__ unsigned xb_add(unsigned* p, unsigned v) { return __hip_atomic_fetch_add(p, v, __ATOMIC_RELAXED, __HIP_MEMORY_SCOPE_AGENT); }
__device__ __forceinline__ unsigned xb_xcc_id() { return (unsigned)__builtin_amdgcn_s_getreg((3 << 11) | 20) & 0xFu; }
#define XB_SPIN(cond, bar) do { unsigned _sp = 0; while (cond) { __builtin_amdgcn_s_sleep(1); \
    if ((++_sp & 255u) == 0u) { if (xb_ld(&(bar)[XB_TMO])) break; if (_sp > XB_SPIN_CAP) { atomicAdd(&(bar)[XB_TMO], 1u); break; } } } } while (0)

struct XcdBarrier {
    unsigned* bar; unsigned x;
    volatile LAS unsigned* st;
};

__device__ __forceinline__ XcdBarrier xcd_barrier_post(unsigned* bar, volatile LAS unsigned* st) {
    XcdBarrier b; b.bar = bar; b.x = xb_xcc_id(); b.st = st;
    if (threadIdx.x == 0) (void)xb_add(&bar[XB_XCNT(b.x)], 1u);
    return b;
}
__device__ __forceinline__ void xcd_barrier_complete(unsigned* bar, unsigned x, unsigned& nloc, unsigned& nx) {
    const unsigned G = gridDim.x * gridDim.y * gridDim.z;
    unsigned sum, cnt, mine, sp = 0u;
    for (;;) {
        sum = 0u; cnt = 0u; mine = 0u;
#pragma unroll
        for (unsigned j = 0; j < 16; ++j) { const unsigned c = xb_ld(&bar[XB_XCNT(j)]); sum += c; cnt += (c > 0u) ? 1u : 0u; mine = (j == x) ? c : mine; }
        if (sum == G) break;
        __builtin_amdgcn_s_sleep(1);
        if ((++sp & 255u) == 0u) { if (xb_ld(&bar[XB_TMO])) break; if (sp > XB_SPIN_CAP) { atomicAdd(&bar[XB_TMO], 1u); break; } }
    }
    nloc = mine > 0u ? mine : 1u; nx = cnt > 0u ? cnt : 1u;
}

__device__ __forceinline__ void xcd_barrier(const XcdBarrier& b) {
    asm volatile("s_waitcnt vmcnt(0)" ::: "memory");
    __syncthreads();
    if (threadIdx.x == 0) {
        unsigned* bar = b.bar;
        __builtin_amdgcn_s_waitcnt(0);
        unsigned nloc = b.st[0], nx = b.st[1];
        if (nloc == 0u) { xcd_barrier_complete(bar, b.x, nloc, nx); b.st[0] = nloc; b.st[1] = nx; }
        const unsigned old = xb_add(&bar[XB_XSUB(b.x)], 1u);
        const unsigned gen = old / nloc;
        if (old + 1u == (gen + 1u) * nloc) {
            __builtin_amdgcn_fence(__ATOMIC_RELEASE, "agent");
            asm volatile("s_waitcnt vmcnt(0)" ::: "memory");
            const unsigned og = xb_add(&bar[XB_TOP], 1u);
            const unsigned tg = og / nx;
            if (og + 1u == (tg + 1u) * nx) xb_add(&bar[XB_TOPGEN], 1u);
            else XB_SPIN(xb_ld(&bar[XB_TOPGEN]) == tg, bar);
            __builtin_amdgcn_fence(__ATOMIC_ACQUIRE, "agent");
            xb_add(&bar[XB_XGEN(b.x)], 1u);
            asm volatile("s_waitcnt vmcnt(0)" ::: "memory");
        } else {
            XB_SPIN(xb_ld(&bar[XB_XGEN(b.x)]) == gen, bar);
            __builtin_amdgcn_fence(__ATOMIC_ACQUIRE, "agent");
            asm volatile("s_waitcnt vmcnt(0)" ::: "memory");
        }
    }
    __syncthreads();
}

struct Frame {
    ldsp lds;
    volatile LAS unsigned* MISC;
    gu32* ctl;
    int tid, lane, wave;
    int vcu, G;
};
__device__ __forceinline__ float wave_sum(float v) {
#pragma unroll
    for (int o = 1; o < 64; o <<= 1) v += __shfl_xor(v, o);
    return v;
}
__device__ __forceinline__ float log_sigmoid(float z) { return fminf(z, 0.f) - log1pf(expf(-fabsf(z))); }

__device__ __forceinline__ void transpose_job(Frame& F, const float* W, int K, int ld, int ncols, bf16* WT, int ilv, const float* gvec) {
    LAS float* scr = (LAS float*)(F.lds + RING_OFF + F.wave * 16384);
    const int gw = F.vcu * NWAVES + F.wave, NGW = F.G * NWAVES, lane = F.lane;
    const int nblk = ncols / 32, nitems = (K / 64) * nblk;
    for (int it = gw; it < nitems; it += NGW) {
        const int kb = it / nblk, nb = it % nblk, k0 = 64 * kb, n0 = 32 * nb;
        const int drow0 = ilv == 0 ? n0 : ((n0 >> 7) * 256 + (n0 & 127) + (ilv == 2 ? 128 : 0));
        float wv[32];
#pragma unroll
        for (int i = 0; i < 32; ++i) wv[i] = W[(size_t)(k0 + 2 * i + (lane >> 5)) * ld + n0 + (lane & 31)];
#pragma unroll
        for (int i = 0; i < 32; ++i) scr[(2 * i + (lane >> 5)) * 33 + (lane & 31)] = wv[i];
        LDS_WAIT(); asm volatile("" ::: "memory");
        const int c = lane & 7;
        f32x4 ga = {1.f, 1.f, 1.f, 1.f}, gb = {1.f, 1.f, 1.f, 1.f};
        if (gvec) { ga = *(const f32x4*)(gvec + k0 + 8 * c); gb = *(const f32x4*)(gvec + k0 + 8 * c + 4); }
#pragma unroll
        for (int j = 0; j < 4; ++j) { const int n = (lane >> 3) + 8 * j; const LAS float* s = scr + (8 * c) * 33 + n;
            v4u o; o.x = cvtpk(s[0 * 33] * ga[0], s[1 * 33] * ga[1]); o.y = cvtpk(s[2 * 33] * ga[2], s[3 * 33] * ga[3]); o.z = cvtpk(s[4 * 33] * gb[0], s[5 * 33] * gb[1]); o.w = cvtpk(s[6 * 33] * gb[2], s[7 * 33] * gb[3]);
            *(GAS v4u*)(WT + (size_t)(drow0 + n) * K + k0 + 8 * c) = o; }
        LDS_WAIT(); asm volatile("" ::: "memory");
    }
}
__device__ __forceinline__ void p0_prologue(Frame& F, const void* const* in, unsigned char* ws) {
    const float* mixg = (const float*)in[2]; const float* ffng = (const float*)in[3];
    for (int j = 0; j < 2; ++j) {
        transpose_job(F, (const float*)in[4] + (size_t)j * DM * RET_N, DM, RET_N, RET_N, (bf16*)(ws + WS_W_RET_IN + j * SZ_W_RET_IN), 0, mixg + (size_t)(3 * j) * DM);
        transpose_job(F, (const float*)in[6] + (size_t)j * 4096 * DM, 4096, DM, DM, (bf16*)(ws + WS_W_RET_OUT + j * SZ_W_RET_OUT), 0, nullptr);
    }
    transpose_job(F, (const float*)in[7], DM, GM_N, GM_N, (bf16*)(ws + WS_W_GM_IN), 0, mixg + DM);
    transpose_job(F, (const float*)in[12], GM_HALF, DM, DM, (bf16*)(ws + WS_W_GM_OUT), 0, nullptr);
    transpose_job(F, (const float*)in[13], DM, FOX_LD, FOX_N, (bf16*)(ws + WS_W_FOX_IN), 0, mixg + 2 * DM);
    transpose_job(F, (const float*)in[17], DM, DM, DM, (bf16*)(ws + WS_W_FOX_OUT), 0, nullptr);
    for (int i = 0; i < DEPTH; ++i) {
        transpose_job(F, (const float*)in[18] + (size_t)i * DM * FFN_H, DM, FFN_H, FFN_H, (bf16*)(ws + WS_W_GU + i * SZ_W_GU), 1, ffng + (size_t)i * DM);
        transpose_job(F, (const float*)in[19] + (size_t)i * DM * FFN_H, DM, FFN_H, FFN_H, (bf16*)(ws + WS_W_GU + i * SZ_W_GU), 2, ffng + (size_t)i * DM);
        transpose_job(F, (const float*)in[20] + (size_t)i * FFN_H * DM, FFN_H, DM, DM, (bf16*)(ws + WS_W_DN + i * SZ_W_DN), 0, nullptr);
    }
    { const float* x = (const float*)in[0]; bf16* xb = (bf16*)(ws + WS_H); float* rss = (float*)(ws + WS_RSP);
      const int gw = F.vcu * NWAVES + F.wave, NGW = F.G * NWAVES, lane = F.lane;
      for (int m = gw; m < M; m += NGW) { const f32x4* xr = (const f32x4*)(x + (size_t)m * DM) + lane; v2u* o8 = (v2u*)(xb + (size_t)m * DM) + lane; float ss = 0.f;
#pragma unroll
          for (int j = 0; j < 8; ++j) { const f32x4 v = xr[64 * j]; ss += (v.x * v.x + v.y * v.y) + (v.z * v.z + v.w * v.w); v2u w; w.x = cvtpk(v.x, v.y); w.y = cvtpk(v.z, v.w); o8[64 * j] = w; }
          ss = wave_sum(ss); if (lane < 32) rss[(size_t)m * 32 + lane] = lane == 0 ? ss : 0.f; } }
    { const int* pos = (const int*)in[1]; float* cs = (float*)(ws + WS_ROPE_C); float* sn = (float*)(ws + WS_ROPE_S);
      const int gid = F.vcu * NTHR + F.tid, i = gid & 127, step = (F.G * NTHR) >> 7;
      const double invf = exp2(-(double)i * (13.287712379549449 / 128.0));
      for (int r = gid >> 7; r < M; r += step) { const double ang = (double)pos[r] * invf; const double rr = ang - 6.283185307179586 * rint(ang * 0.15915494309189535);
          const float a = (float)rr; cs[(size_t)r * 128 + i] = cosf(a); sn[(size_t)r * 128 + i] = sinf(a); } }
}

__device__ __forceinline__ void ret_p_phase(Frame& F, const bf16* q, const bf16* k, bf16* P) {
    constexpr int RSQ = 272;
    const ldsp LQ = F.lds, LK = F.lds + 34816;
    const int tid = F.tid, lane = F.lane, w = F.wave, g4 = lane >> 4, l15 = lane & 15;
    for (int unit = F.vcu; unit < 512; unit += F.G) {
        const int bh = unit >> 5, ci = unit & 31, h = bh & 7;
        const float lg2 = log1pf(-exp2f(-5.0f - (float)h)) * LOG2E;
        const size_t rowbase = (size_t)bh * SEQ + ci * 128;
        v4u pq[4], pk[4];
#define RP_LD(dd) do { _Pragma("unroll") for (int ps = 0; ps < 4; ++ps) { const int r_ = ps * 32 + (tid >> 4), c_ = tid & 15; \
            pq[ps] = *(const v4u*)(q + (rowbase + r_) * 256 + (dd) * 128 + c_ * 8); pk[ps] = *(const v4u*)(k + (rowbase + r_) * 256 + (dd) * 128 + c_ * 8); } } while (0)
        RP_LD(0);
        f32x4 S[8];
#pragma unroll
        for (int t = 0; t < 8; ++t) S[t] = (f32x4){0.f, 0.f, 0.f, 0.f};
#pragma unroll
        for (int dh = 0; dh < 2; ++dh) {
            __syncthreads();
#pragma unroll
            for (int ps = 0; ps < 4; ++ps) { const int r_ = ps * 32 + (tid >> 4), c_ = tid & 15; *(LAS v4u*)(LQ + r_ * RSQ + c_ * 16) = pq[ps]; *(LAS v4u*)(LK + r_ * RSQ + c_ * 16) = pk[ps]; }
            if (dh == 0) RP_LD(1);
            __syncthreads();
#pragma unroll
            for (int ks = 0; ks < 4; ++ks) { const bf16x8 a = frag_row(LQ + (16 * w) * RSQ + ks * 64, RSQ, lane);
#pragma unroll
                for (int t = 0; t < 8; ++t) S[t] = MFMA16(a, frag_row(LK + (16 * t) * RSQ + ks * 64, RSQ, lane), S[t]); }
        }
#undef RP_LD
#pragma unroll
        for (int t = 0; t < 8; ++t)
#pragma unroll
            for (int r = 0; r < 4; ++r) { const int n = 16 * w + 4 * g4 + r, mm = 16 * t + l15;
                const float pv_ = n >= mm ? S[t][r] * exp2f((float)(n - mm) * lg2) : 0.f;
                *(LAS unsigned short*)(LQ + n * RSQ + mm * 2) = (unsigned short)(cvtpk(pv_, 0.f) & 0xffffu); }
        bf16* Pw = P + (((size_t)bh * 32 + ci) * 128 + 16 * w) * 128;
#pragma unroll
        for (int i = 0; i < 4; ++i) { const int row = lane >> 2, ch = (lane & 3) + 4 * i;
            *(v4u*)(Pw + row * 128 + ch * 8) = *(const LAS v4u*)(LQ + (16 * w + row) * RSQ + ch * 16); }
    }
}
__device__ __forceinline__ void ret_core_phase(Frame& F, const bf16* q, const bf16* k, const bf16* v, const bf16* P, bf16* o) {
    constexpr int RSQ = 272, RSV = 72, RSS = 528;
    const ldsp LK0 = F.lds, LK1 = F.lds + 34816, LV = F.lds + 69632, LV2 = F.lds + 78848, LST = F.lds + 88064;
    const ldsp LOw = F.lds + 121856 + F.wave * 1024;
    const int tid = F.tid, lane = F.lane, w = F.wave, g4 = lane >> 4, l15 = lane & 15;
    for (int unit = F.vcu; unit < 256; unit += F.G) {
        const int bh = unit >> 4, es = unit & 15, h = bh & 7, b = bh >> 3, e0 = es * 32;
        const float lg2 = log1pf(-exp2f(-5.0f - (float)h)) * LOG2E;
        const float cd = exp2f(128.0f * lg2);
        const size_t rb0 = (size_t)bh * SEQ;
        f32x4 st[2][2];
#pragma unroll
        for (int a = 0; a < 2; ++a)
#pragma unroll
            for (int t = 0; t < 2; ++t) st[a][t] = (f32x4){0.f, 0.f, 0.f, 0.f};
        __syncthreads();
        for (int i = tid; i < 16896 / 4; i += NTHR) ((LAS unsigned*)LST)[i] = 0u;
        v4u pk[8], pv; bf16x8 qf[8], pf[4];
#define RC_LD_KV(cc) do { _Pragma("unroll") for (int ps = 0; ps < 8; ++ps) { const int id_ = ps * NTHR + tid; pk[ps] = *(const v4u*)(k + (rb0 + (cc) * 128 + (id_ >> 5)) * 256 + (id_ & 31) * 8); } \
            pv = *(const v4u*)(v + (rb0 + (cc) * 128 + (tid >> 2)) * 512 + e0 + (tid & 3) * 8); } while (0)
#define RC_LD_QP(cc) do { _Pragma("unroll") for (int ks = 0; ks < 8; ++ks) qf[ks] = *(const bf16x8*)(q + (rb0 + (cc) * 128 + 16 * w + l15) * 256 + ks * 32 + 8 * g4); \
            _Pragma("unroll") for (int ks = 0; ks < 4; ++ks) pf[ks] = *(const bf16x8*)(P + (((size_t)bh * 32 + (cc)) * 128 + 16 * w + l15) * 128 + ks * 32 + 8 * g4); } while (0)
        RC_LD_KV(0); RC_LD_QP(0);
        for (int ci = 0; ci < 32; ++ci) {
            const ldsp LSc = LST + (ci & 1) * 16896, LSn = LST + ((ci + 1) & 1) * 16896;
            __syncthreads();
#pragma unroll
            for (int ps = 0; ps < 8; ++ps) { const int id_ = ps * NTHR + tid, r_ = id_ >> 5, c_ = id_ & 31;
                *(LAS v4u*)(((c_ & 16) ? LK1 : LK0) + r_ * RSQ + (c_ & 15) * 16) = pk[ps]; }
            { const int r = tid >> 2, c = tid & 3; const v4u vv = pv;
              *(LAS v4u*)(LV + r * RSV + c * 16) = vv;
              const float kd = exp2f((float)(127 - r) * lg2); v4u v2;
              v2.x = cvtpk(bflo(vv.x) * kd, bfhi(vv.x) * kd); v2.y = cvtpk(bflo(vv.y) * kd, bfhi(vv.y) * kd); v2.z = cvtpk(bflo(vv.z) * kd, bfhi(vv.z) * kd); v2.w = cvtpk(bflo(vv.w) * kd, bfhi(vv.w) * kd);
              *(LAS v4u*)(LV2 + r * RSV + c * 16) = v2; }
            if (ci + 1 < 32) RC_LD_KV(ci + 1);
            __syncthreads();
            f32x4 cr[2], in[2];
            cr[0] = (f32x4){0.f, 0.f, 0.f, 0.f}; cr[1] = (f32x4){0.f, 0.f, 0.f, 0.f}; in[0] = (f32x4){0.f, 0.f, 0.f, 0.f}; in[1] = (f32x4){0.f, 0.f, 0.f, 0.f};
#pragma unroll
            for (int ks = 0; ks < 8; ++ks)
#pragma unroll
                for (int t = 0; t < 2; ++t) cr[t] = MFMA16(qf[ks], frag_row(LSc + (16 * t) * RSS + (ks * 32) * 2, RSS, lane), cr[t]);
#pragma unroll
            for (int ks = 0; ks < 4; ++ks)
#pragma unroll
                for (int t = 0; t < 2; ++t) in[t] = MFMA16(pf[ks], frag_tr(LV + (32 * ks) * RSV + (16 * t) * 2, RSV, lane), in[t]);
#pragma unroll
            for (int dh = 0; dh < 2; ++dh) {
#pragma unroll
                for (int t = 0; t < 2; ++t) st[dh][t] = st[dh][t] * cd;
#pragma unroll
                for (int ks = 0; ks < 4; ++ks) {
                    const bf16x8 a = frag_tr((dh ? LK1 : LK0) + (32 * ks) * RSQ + (16 * w) * 2, RSQ, lane);
#pragma unroll
                    for (int t = 0; t < 2; ++t) st[dh][t] = MFMA16(a, frag_tr(LV2 + (32 * ks) * RSV + (16 * t) * 2, RSV, lane), st[dh][t]);
                }
#pragma unroll
                for (int t = 0; t < 2; ++t) { v2u pk2; pk2.x = cvtpk(st[dh][t][0], st[dh][t][1]); pk2.y = cvtpk(st[dh][t][2], st[dh][t][3]);
                    *(LAS v2u*)(LSn + (16 * t + l15) * RSS + (dh * 128 + 16 * w + 4 * g4) * 2) = pk2; }
            }
#pragma unroll
            for (int r = 0; r < 4; ++r) { const int n = 16 * w + 4 * g4 + r; const float qd = exp2f((float)(n + 1) * lg2);
#pragma unroll
                for (int t = 0; t < 2; ++t) *(LAS unsigned short*)(LOw + (4 * g4 + r) * 64 + (16 * t + l15) * 2) = (unsigned short)(cvtpk(in[t][r] + cr[t][r] * qd, 0.f) & 0xffffu); }
            *(v4u*)(o + ((size_t)b * SEQ + ci * 128 + 16 * w + (lane >> 2)) * 4096 + h * 512 + e0 + (lane & 3) * 8) = *(const LAS v4u*)(LOw + (lane >> 2) * 64 + (lane & 3) * 16);
            if (ci + 1 < 32) RC_LD_QP(ci + 1);
        }
#undef RC_LD_KV
#undef RC_LD_QP
    }
}

__device__ __forceinline__ void ret_gn_phase(Frame& F, const bf16* o, const bf16* g, const float* gn, bf16* y) {
    const int lane = F.lane, gw = F.vcu * NWAVES + F.wave, NGW = F.G * NWAVES;
    for (int it = gw; it < M * 8; it += NGW) {
        const int row = it >> 3, h = it & 7; const size_t off = (size_t)row * 4096 + h * 512 + lane * 8;
        const v4u ov = *(const v4u*)(o + off), gv = *(const v4u*)(g + off);
        float x[8] = {bflo(ov.x), bfhi(ov.x), bflo(ov.y), bfhi(ov.y), bflo(ov.z), bfhi(ov.z), bflo(ov.w), bfhi(ov.w)};
        float gg[8] = {bflo(gv.x), bfhi(gv.x), bflo(gv.y), bfhi(gv.y), bflo(gv.z), bfhi(gv.z), bflo(gv.w), bfhi(gv.w)};
        float s = 0.f;
#pragma unroll
        for (int e = 0; e < 8; ++e) s += x[e];
        const float mean = wave_sum(s) * (1.0f / 512.0f); float qv = 0.f;
#pragma unroll
        for (int e = 0; e < 8; ++e) { x[e] -= mean; qv += x[e] * x[e]; }
        const float rstd = 1.0f / sqrtf(wave_sum(qv) * (1.0f / 512.0f) + EPS);
        const f32x4 g0 = *(const f32x4*)(gn + h * 512 + lane * 8), g1 = *(const f32x4*)(gn + h * 512 + lane * 8 + 4);
        float r[8];
#pragma unroll
        for (int e = 0; e < 8; ++e) { const float gw_ = e < 4 ? g0[e & 3] : g1[e & 3]; r[e] = x[e] * rstd * gw_ * (gg[e] * pg8::fast_sigmoid(gg[e])); }
        v4u w; w.x = cvtpk(r[0], r[1]); w.y = cvtpk(r[2], r[3]); w.z = cvtpk(r[4], r[5]); w.w = cvtpk(r[6], r[7]);
        *(v4u*)(y + off) = w;
    }
}

__device__ __forceinline__ void gm_stat_phase(Frame& F, const f32x2* part, f32x2* rstat) {
    const int lane = F.lane, gw = F.vcu * NWAVES + F.wave, NGW = F.G * NWAVES;
    for (int row = gw; row < M; row += NGW) {
        float s = 0.f, ss = 0.f;
        if (lane < 48) { const f32x4 p = *(const f32x4*)(part + (size_t)row * 96 + lane * 2); s = p.x + p.z; ss = p.y + p.w; }
        s = wave_sum(s); ss = wave_sum(ss);
        const float mean = s * (1.0f / GM_HALF), var = fmaxf(ss * (1.0f / GM_HALF) - mean * mean, 0.f);
        if (lane == 0) rstat[row] = (f32x2){mean, 1.0f / sqrtf(var + EPS)};
    }
}
__device__ __forceinline__ void gm_spatial_phase(Frame& F, const bf16* u, const bf16* v, const f32x2* rstat, const float* lng, const float* lnb, const float* wsp, const float* bsp, bf16* y) {
    constexpr int RSW = 272, RSN = 528;
    const ldsp LW = F.lds, LN = F.lds + 34816;
    const int tid = F.tid, lane = F.lane, w = F.wave, g4 = lane >> 4, l15 = lane & 15;
    for (int unit = F.vcu; unit < 1536; unit += F.G) {
        const int cs = unit % 3, gg = (unit / 3) & 7, ch = unit / 24, row0 = ch * 128, col0 = gg * 768 + cs * 256;
        __syncthreads();
#pragma unroll
        for (int ps = 0; ps < 8; ++ps) { const int id = ps * NTHR + tid, t = id >> 5, s4 = (id & 31) * 4;
            f32x4 wv = *(const f32x4*)(wsp + ((size_t)gg * 128 + t) * 128 + s4);
#pragma unroll
            for (int e = 0; e < 4; ++e) if (s4 + e > t) wv[e] = 0.f;
            v2u pk; pk.x = cvtpk(wv[0], wv[1]); pk.y = cvtpk(wv[2], wv[3]);
            *(LAS v2u*)(LW + t * RSW + s4 * 2) = pk; }
#pragma unroll
        for (int ps = 0; ps < 8; ++ps) { const int id = ps * NTHR + tid, r = id >> 5, c8 = (id & 31) * 8;
            const v4u vv = *(const v4u*)(v + (size_t)(row0 + r) * GM_HALF + col0 + c8); const f32x2 rs = rstat[row0 + r];
            const f32x4 ga = *(const f32x4*)(lng + col0 + c8), gb = *(const f32x4*)(lng + col0 + c8 + 4), ba = *(const f32x4*)(lnb + col0 + c8), bb = *(const f32x4*)(lnb + col0 + c8 + 4);
            v4u o;
            o.x = cvtpk((bflo(vv.x) - rs.x) * rs.y * ga[0] + ba[0], (bfhi(vv.x) - rs.x) * rs.y * ga[1] + ba[1]);
            o.y = cvtpk((bflo(vv.y) - rs.x) * rs.y * ga[2] + ba[2], (bfhi(vv.y) - rs.x) * rs.y * ga[3] + ba[3]);
            o.z = cvtpk((bflo(vv.z) - rs.x) * rs.y * gb[0] + bb[0], (bfhi(vv.z) - rs.x) * rs.y * gb[1] + bb[1]);
            o.w = cvtpk((bflo(vv.w) - rs.x) * rs.y * gb[2] + bb[2], (bfhi(vv.w) - rs.x) * rs.y * gb[3] + bb[3]);
            *(LAS v4u*)(LN + r * RSN + c8 * 2) = o; }
        __syncthreads();
        f32x4 acc[16];
#pragma unroll
        for (int c = 0; c < 16; ++c) acc[c] = (f32x4){0.f, 0.f, 0.f, 0.f};
#pragma unroll
        for (int ks = 0; ks < 4; ++ks) {
            const bf16x8 a = frag_row(LW + (16 * w) * RSW + ks * 64, RSW, lane);
#pragma unroll
            for (int c = 0; c < 16; ++c) acc[c] = MFMA16(a, frag_tr(LN + (32 * ks) * RSN + (16 * c) * 2, RSN, lane), acc[c]);
        }
        __syncthreads();
#pragma unroll
        for (int r = 0; r < 4; ++r) { const int t = 16 * w + 4 * g4 + r; const float bs = bsp[gg * 128 + t];
#pragma unroll
            for (int c = 0; c < 16; ++c) *(LAS unsigned short*)(LN + t * RSN + (16 * c + l15) * 2) = (unsigned short)(cvtpk(acc[c][r] + bs, 0.f) & 0xffffu); }
        __syncthreads();
#pragma unroll
        for (int ps = 0; ps < 8; ++ps) { const int id = ps * NTHR + tid, r = id >> 5, c8 = (id & 31) * 8;
            const v4u mv = *(const LAS v4u*)(LN + r * RSN + c8 * 2); const size_t off = (size_t)(row0 + r) * GM_HALF + col0 + c8; const v4u uv = *(const v4u*)(u + off);
            v4u o; o.x = cvtpk(bflo(uv.x) * bflo(mv.x), bfhi(uv.x) * bfhi(mv.x)); o.y = cvtpk(bflo(uv.y) * bflo(mv.y), bfhi(uv.y) * bfhi(mv.y));
            o.z = cvtpk(bflo(uv.z) * bflo(mv.z), bfhi(uv.z) * bfhi(mv.z)); o.w = cvtpk(bflo(uv.w) * bflo(mv.w), bfhi(uv.w) * bfhi(mv.w));
            *(v4u*)(y + off) = o; }
    }
}

__device__ __forceinline__ void fox_prep_phase(Frame& F, const bf16* qk  , bf16* qkn, const float* qg, const float* kg,
                                               const bf16* x, const float* rs, const float* gmix, const float* wfox, const float* bfg, float* lf) {
    const int lane = F.lane, gw = F.vcu * NWAVES + F.wave, NGW = F.G * NWAVES;
    for (int idx = F.tid; idx < DM * 4; idx += NTHR) { const int k = idx >> 2, qd = idx & 3; const f32x4 w = *(const f32x4*)(wfox + (size_t)k * FOX_LD + FOX_N + 4 * qd) * gmix[k];
        const int slot = ((k >> 8) * 4 + (k & 3)) * 64 + ((k >> 2) & 63);
        *(LAS f32x4*)(F.lds + qd * 32768 + slot * 16) = w; }
    __syncthreads();
    for (int m = gw; m < M; m += NGW) {
        const v2u* xr = (const v2u*)(x + (size_t)m * DM) + lane;
        f32x4 v[8];
#pragma unroll
        for (int j = 0; j < 8; ++j) { const v2u t = xr[64 * j]; v[j] = (f32x4){bflo(t.x), bfhi(t.x), bflo(t.y), bfhi(t.y)}; }
        f32x4 a[4];
#pragma unroll
        for (int qd = 0; qd < 4; ++qd) a[qd] = (f32x4){0.f, 0.f, 0.f, 0.f};
#pragma unroll
        for (int j = 0; j < 8; ++j)
#pragma unroll
            for (int e = 0; e < 4; ++e) { const float hv = v[j][e];
#pragma unroll
                for (int qd = 0; qd < 4; ++qd) a[qd] += hv * *(const LAS f32x4*)(F.lds + qd * 32768 + ((j * 4 + e) * 64 + lane) * 16);
                asm volatile("" ::: "memory"); }
        float z = 0.f;
#pragma unroll
        for (int qd = 0; qd < 4; ++qd)
#pragma unroll
            for (int i = 0; i < 4; ++i) { const float t = wave_sum(a[qd][i]); z = (lane == qd * 4 + i) ? t : z; }
        if (lane < 16) lf[(size_t)m * 16 + lane] = log_sigmoid(z * pg8::row_rstd(rs, m) + bfg[lane]);
    }
    for (int it = gw; it < 2 * M; it += NGW) {
        const int isk = it >= M; const size_t base = (size_t)it * DM; const float* gp = isk ? kg : qg; const float sc = isk ? 1.0f : 0.08838834764831845f * LOG2E;
#pragma unroll
        for (int j = 0; j < 4; ++j) { const int e0 = 8 * (lane + 64 * j); const v4u xv = *(const v4u*)(qk + base + e0);
            float x8[8] = {bflo(xv.x), bfhi(xv.x), bflo(xv.y), bfhi(xv.y), bflo(xv.z), bfhi(xv.z), bflo(xv.w), bfhi(xv.w)};
            float ss = 0.f;
#pragma unroll
            for (int e = 0; e < 8; ++e) ss += x8[e] * x8[e];
            ss += __shfl_xor(ss, 1); ss += __shfl_xor(ss, 2); ss += __shfl_xor(ss, 4); ss += __shfl_xor(ss, 8);
            const float rstd = sc / sqrtf(ss * (1.0f / 128.0f) + EPS);
            const f32x4 g0 = *(const f32x4*)(gp + (e0 & 127)), g1 = *(const f32x4*)(gp + (e0 & 127) + 4);
            v4u w; w.x = cvtpk(x8[0] * rstd * g0[0], x8[1] * rstd * g0[1]); w.y = cvtpk(x8[2] * rstd * g0[2], x8[3] * rstd * g0[3]);
            w.z = cvtpk(x8[4] * rstd * g1[0], x8[5] * rstd * g1[1]); w.w = cvtpk(x8[6] * rstd * g1[2], x8[7] * rstd * g1[3]);
            *(v4u*)(qkn + base + e0) = w; }
    }
}

typedef float f32x16 __attribute__((ext_vector_type(16)));
#define MFMA32(a, b, c) __builtin_amdgcn_mfma_f32_32x32x16_bf16((a), (b), (c), 0, 0, 0)
__device__ __forceinline__ void fox_attn_phase(Frame& F, const bf16* qn, const bf16* kn, const bf16* vv, const bf16* gs, const float* lf, bf16* y) {
    constexpr int RSK = 272, RSV = 320, KSLOT = 64 * RSK, VSLOT = 64 * RSV;
    const ldsp LK = F.lds, LV = F.lds + 2 * KSLOT;
    LAS float* c2 = (LAS float*)(F.lds + 75776);
    LAS float* red = (LAS float*)(F.lds + 92160);
    const int tid = F.tid, lane = F.lane, w = F.wave, r32 = lane & 31, hi = lane >> 5;
    int bh_have = -1;
    for (int pr = F.vcu; pr < 256; pr += F.G) {
        const int bh = pr >> 3, pi = pr & 7, b = bh >> 4, h = bh & 15;
        const size_t tok0 = (size_t)b * SEQ;
        if (bh != bh_have) {
            bh_have = bh;
            float x8[8]; float run = 0.f;
#pragma unroll
            for (int e = 0; e < 8; ++e) { run += lf[(tok0 + tid * 8 + e) * 16 + h]; x8[e] = run; }
            float inc = run;
#pragma unroll
            for (int o = 1; o < 64; o <<= 1) { const float t = __shfl_up(inc, o); if (lane >= o) inc += t; }
            __syncthreads();
            if (lane == 63) red[w] = inc;
            __syncthreads();
            float pre = inc - run;
#pragma unroll
            for (int wv = 0; wv < 8; ++wv) if (wv < w) pre += red[wv];
#pragma unroll
            for (int e = 0; e < 8; ++e) c2[tid * 8 + e] = (pre + x8[e]) * LOG2E;
        }
        for (int half = 0; half < 2; ++half) {
            const int qb = half ? 15 - pi : pi, q0 = qb * 256, ntile = 4 * qb + 4, qrow = q0 + 32 * w + r32;
            bf16x8 qf[8];
#pragma unroll
            for (int ks = 0; ks < 8; ++ks) qf[ks] = *(const bf16x8*)(qn + (tok0 + qrow) * DM + h * 128 + ks * 16 + 8 * hi);
            v4u kr[2], vr[2];
#define FA_LOAD(tt) do { _Pragma("unroll") for (int pp = 0; pp < 2; ++pp) { const int id_ = tid + NTHR * pp, r_ = id_ >> 4, c_ = id_ & 15; \
                kr[pp] = *(const v4u*)(kn + (tok0 + 64 * (tt) + r_) * DM + h * 128 + c_ * 8); vr[pp] = *(const v4u*)(vv + (tok0 + 64 * (tt) + r_) * DM + h * 128 + c_ * 8); } } while (0)
#define FA_STORE(sl) do { _Pragma("unroll") for (int pp = 0; pp < 2; ++pp) { const int id_ = tid + NTHR * pp, r_ = id_ >> 4, c_ = id_ & 15; \
                *(LAS v4u*)(LK + (sl) * KSLOT + r_ * RSK + c_ * 16) = kr[pp]; *(LAS v4u*)(LV + (sl) * VSLOT + r_ * RSV + c_ * 16) = vr[pp]; } } while (0)
            FA_LOAD(0);
            __syncthreads();
            FA_STORE(0);
            if (ntile > 1) FA_LOAD(1);
            const float cq = c2[qrow];
            float mx = -1e30f, ls = 0.f;
            f32x16 O[4];
#pragma unroll
            for (int dt = 0; dt < 4; ++dt)
#pragma unroll
                for (int r = 0; r < 16; ++r) O[dt][r] = 0.f;
            for (int t = 0; t < ntile; ++t) {
                __syncthreads();
                if (t + 1 < ntile) { FA_STORE((t + 1) & 1); if (t + 2 < ntile) FA_LOAD(t + 2); }
                const int key0 = 64 * t;
                if (key0 <= q0 + 32 * w + 31) {
                    const ldsp sk = LK + (t & 1) * KSLOT + r32 * RSK + 16 * hi, sv = LV + (t & 1) * VSLOT;
                    f32x16 S0, S1;
#pragma unroll
                    for (int r = 0; r < 16; ++r) { S0[r] = 0.f; S1[r] = 0.f; }
#pragma unroll
                    for (int ks = 0; ks < 8; ++ks) { S0 = MFMA32(*(const LAS bf16x8*)(sk + ks * 32), qf[ks], S0); S1 = MFMA32(*(const LAS bf16x8*)(sk + 32 * RSK + ks * 32), qf[ks], S1); }
                    const bool diag = key0 + 63 > q0 + 32 * w;
                    float mloc = -INFINITY;
#pragma unroll
                    for (int g = 0; g < 4; ++g) { const f32x4 ck0 = *(const LAS f32x4*)(c2 + key0 + 8 * g + 4 * hi), ck1 = *(const LAS f32x4*)(c2 + key0 + 32 + 8 * g + 4 * hi);
#pragma unroll
                        for (int e = 0; e < 4; ++e) { float s0 = S0[4 * g + e] + (cq - ck0[e]), s1 = S1[4 * g + e] + (cq - ck1[e]);
                            if (diag) { const int key = key0 + 8 * g + 4 * hi + e; if (key > qrow) s0 = -INFINITY; if (key + 32 > qrow) s1 = -INFINITY; }
                            S0[4 * g + e] = s0; S1[4 * g + e] = s1; mloc = fmaxf(mloc, fmaxf(s0, s1)); } }
                    mloc = fmaxf(mloc, __shfl_xor(mloc, 32));
                    if (__any(mloc > mx + 8.0f)) { const float mnew = fmaxf(mx, mloc), alpha = __builtin_amdgcn_exp2f(mx - mnew); mx = mnew; ls *= alpha;
#pragma unroll
                        for (int dt = 0; dt < 4; ++dt)
#pragma unroll
                            for (int r = 0; r < 16; ++r) O[dt][r] *= alpha; }
                    float psum = 0.f;
#pragma unroll
                    for (int r = 0; r < 16; ++r) { S0[r] = __builtin_amdgcn_exp2f(S0[r] - mx); S1[r] = __builtin_amdgcn_exp2f(S1[r] - mx); psum += S0[r] + S1[r]; }
                    ls += psum;
                    v4u pf[4];
#pragma unroll
                    for (int s2 = 0; s2 < 2; ++s2) { pf[s2] = (v4u){cvtpk(S0[8 * s2 + 0], S0[8 * s2 + 1]), cvtpk(S0[8 * s2 + 2], S0[8 * s2 + 3]), cvtpk(S0[8 * s2 + 4], S0[8 * s2 + 5]), cvtpk(S0[8 * s2 + 6], S0[8 * s2 + 7])};
                        pf[2 + s2] = (v4u){cvtpk(S1[8 * s2 + 0], S1[8 * s2 + 1]), cvtpk(S1[8 * s2 + 2], S1[8 * s2 + 3]), cvtpk(S1[8 * s2 + 4], S1[8 * s2 + 5]), cvtpk(S1[8 * s2 + 6], S1[8 * s2 + 7])}; }
                    const ldsp vb = sv + (4 * hi + ((lane & 15) >> 2)) * RSV + (16 * ((lane >> 4) & 1) + 4 * (lane & 3)) * 2;
#pragma unroll
                    for (int s4 = 0; s4 < 4; ++s4)
#pragma unroll
                        for (int dt = 0; dt < 4; ++dt) { const ldsp va = vb + (16 * s4) * RSV + dt * 64; const s16x4 lo = vtr(va), hv = vtr(va + 8 * RSV);
                            const bf16x8 af = (bf16x8){lo[0], lo[1], lo[2], lo[3], hv[0], hv[1], hv[2], hv[3]};
                            O[dt] = MFMA32(af, __builtin_bit_cast(bf16x8, pf[s4]), O[dt]); }
                }
            }
            ls += __shfl_xor(ls, 32);
            const float il = 1.0f / ls;
            const size_t yoff = (tok0 + qrow) * DM + h * 128 + 4 * hi;
#pragma unroll
            for (int dt = 0; dt < 4; ++dt)
#pragma unroll
                for (int g = 0; g < 4; ++g) { const v2u gv = *(const v2u*)(gs + yoff + dt * 32 + 8 * g);
                    v2u o; o.x = cvtpk(O[dt][4 * g + 0] * il * bflo(gv.x), O[dt][4 * g + 1] * il * bfhi(gv.x)); o.y = cvtpk(O[dt][4 * g + 2] * il * bflo(gv.y), O[dt][4 * g + 3] * il * bfhi(gv.y));
                    *(v2u*)(y + yoff + dt * 32 + 8 * g) = o; }
        }
    }
#undef FA_LOAD
#undef FA_STORE
}
#ifndef R_RET_CORE
#define R_RET_CORE 1
#endif
#ifndef R_RET_GN
#define R_RET_GN 1
#endif
#ifndef R_GM_SP
#define R_GM_SP 1
#endif
#ifndef R_FOX_ATTN
#define R_FOX_ATTN 1
#endif
#ifndef R_FOX_PREP
#define R_FOX_PREP 1
#endif
#ifndef R_PRO
#define R_PRO 1
#endif
#ifndef F_GU_TAIL
#define F_GU_TAIL 0
#endif

struct Args { const void* in[21]; float* out; unsigned char* ws; int ph_lo, ph_hi, li, pad; };
#define IN(k) (lo <= (k) && (k) < hi)
#define SEAM(k) do { if (N_LAUNCHES == 1 && IN(k) && IN((k) + 1)) xcd_barrier(bar); } while (0)
template <int L>
__device__ __forceinline__ void layer_body(Frame& F, const Args& args, const XcdBarrier& bar, const int lo, const int hi) {
    unsigned char* ws = args.ws;
    constexpr int kind = L % 3, j = L / 3, pb = 1 + 6 * L;
    float* xo = args.out;
    bf16* XB = (bf16*)(ws + WS_H);
    bf16* A0 = (bf16*)(ws + WS_A); bf16* B0 = (bf16*)(ws + WS_B); bf16* C0 = (bf16*)(ws + WS_C);
    unsigned char* misc = ws + WS_MISC;
    float* rss = (float*)(ws + WS_RSP);
    PG8_LAS float* rtab = (PG8_LAS float*)(F.lds + RSTAB_OFF);
    if (IN(pb + 0)) {
        if (kind == 0) {
            pg8::Gemm g{XB, (const bf16*)(ws + WS_W_RET_IN + j * SZ_W_RET_IN), M, RET_N, DM}; pg8::RsOrder S; S.init(M, RET_N, F.G, (int)blockIdx.x); S.rs = rss + (size_t)(2 * L) * M * 32; S.tab = rtab; S.pend = 0.f; S.nready = 0;
            pg8::EpiRetIn E{A0, A0 + (size_t)M * 2048, A0 + (size_t)M * 4096, A0 + (size_t)M * 8192, (const float*)(ws + WS_ROPE_C), (const float*)(ws + WS_ROPE_S), rtab, 0};
            pg8::gemm_phase<pg8::EpiRetIn, pg8::RsOrder, PG8_ALIGN, PG8_SP2>(F.lds + RING_OFF, g, S, E);
        } else if (kind == 1) {
            pg8::Gemm g{XB, (const bf16*)(ws + WS_W_GM_IN), M, GM_N, DM}; pg8::RsOrder S; S.init(M, GM_N, F.G, (int)blockIdx.x); S.rs = rss + (size_t)(2 * L) * M * 32; S.tab = rtab; S.pend = 0.f; S.nready = 0;
            pg8::EpiGeluUV E{A0, A0 + (size_t)M * GM_HALF, (pg8::f32x2v*)(misc + MISC_PART), rtab, 0};
            pg8::gemm_phase<pg8::EpiGeluUV, pg8::RsOrder, PG8_ALIGN, PG8_SP2>(F.lds + RING_OFF, g, S, E);
        } else {
            pg8::Gemm g{XB, (const bf16*)(ws + WS_W_FOX_IN), M, FOX_N, DM}; pg8::RsOrder S; S.init(M, FOX_N, F.G, (int)blockIdx.x); S.rs = rss + (size_t)(2 * L) * M * 32; S.tab = rtab; S.pend = 0.f; S.nready = 0;
            pg8::EpiFoxIn E{A0, (size_t)M * 2048, rtab, 0};
            pg8::gemm_phase<pg8::EpiFoxIn, pg8::RsOrder, PG8_ALIGN, PG8_SP2>(F.lds + RING_OFF, g, S, E);
        }
    }
    SEAM(pb + 0);
    if (IN(pb + 1)) {
        if (kind == 0) { bf16* Pb = B0 + (size_t)M * 4096;
            ret_p_phase(F, A0, A0 + (size_t)M * 2048, Pb);
            if (N_LAUNCHES == 1) xcd_barrier(bar);
            for (int rep_ = 0; rep_ < R_RET_CORE; ++rep_) ret_core_phase(F, A0, A0 + (size_t)M * 2048, A0 + (size_t)M * 4096, Pb, B0); }
        else if (kind == 1) { gm_stat_phase(F, (const f32x2*)(misc + MISC_PART), (f32x2*)(misc + MISC_RSTAT)); }
        else { for (int rep_ = 0; rep_ < R_FOX_PREP; ++rep_) fox_prep_phase(F, A0, A0 + (size_t)M * 8192, (const float*)args.in[15], (const float*)args.in[16],
                              XB, rss + (size_t)(2 * L) * M * 32, (const float*)args.in[2] + (size_t)L * DM, (const float*)args.in[13], (const float*)args.in[14], (float*)(misc + MISC_LF)); }
    }
    SEAM(pb + 1);
    if (IN(pb + 2)) {
        if (kind == 0) { for (int rep_ = 0; rep_ < R_RET_GN; ++rep_) ret_gn_phase(F, B0, A0 + (size_t)M * 8192, (const float*)args.in[5] + (size_t)j * 4096, C0); }
        else if (kind == 1) { for (int rep_ = 0; rep_ < R_GM_SP; ++rep_) gm_spatial_phase(F, A0, A0 + (size_t)M * GM_HALF, (const f32x2*)(misc + MISC_RSTAT), (const float*)args.in[8], (const float*)args.in[9], (const float*)args.in[10], (const float*)args.in[11], B0); }
        else { for (int rep_ = 0; rep_ < R_FOX_ATTN; ++rep_) fox_attn_phase(F, A0 + (size_t)M * 8192, A0 + (size_t)M * 10240, A0 + (size_t)M * 4096, A0 + (size_t)M * 6144, (const float*)(misc + MISC_LF), B0); }
    }
    SEAM(pb + 2);
    if (IN(pb + 3)) {
        const bf16* Ain = kind == 0 ? C0 : B0; constexpr int K = kind == 0 ? 4096 : (kind == 1 ? GM_HALF : DM);
        const bf16* Wt = kind == 0 ? (const bf16*)(ws + WS_W_RET_OUT + j * SZ_W_RET_OUT) : (kind == 1 ? (const bf16*)(ws + WS_W_GM_OUT) : (const bf16*)(ws + WS_W_FOX_OUT));
        pg8::Gemm g{Ain, Wt, M, DM, K}; pg8::StaticOrder S; S.init(M, DM, F.G, (int)blockIdx.x);
        pg8::EpiRes<L == 0, false> E{(const float*)args.in[0], nullptr, XB, rss + (size_t)(2 * L + 1) * M * 32, DM};
        pg8::gemm_phase<pg8::EpiRes<L == 0, false>, pg8::StaticOrder, PG8_ALIGN, PG8_SP2>(F.lds + RING_OFF, g, S, E);
    }
    SEAM(pb + 3);
    if (IN(pb + 4)) {
        constexpr int NFULL = (F_GU_TAIL ? 40 : 44) * 256;
        { pg8::Gemm g{XB, (const bf16*)(ws + WS_W_GU + L * SZ_W_GU), M, NFULL, DM}; pg8::RsOrder S; S.init(M, NFULL, F.G, (int)blockIdx.x); S.rs = rss + (size_t)(2 * L + 1) * M * 32; S.tab = rtab; S.pend = 0.f; S.nready = 0;
          pg8::EpiSwiglu<false> E{A0, FFN_H, rtab, 0};
          pg8::gemm_phase<pg8::EpiSwiglu<false>, pg8::RsOrder, PG8_ALIGN, PG8_SP2>(F.lds + RING_OFF, g, S, E); }
        if (F_GU_TAIL) { pg8::Gemm g{XB, (const bf16*)(ws + WS_W_GU + L * SZ_W_GU), M, FFN_N2, DM}; pg8::TailOrder S; S.init(M, FFN_N2, F.G, (int)blockIdx.x); S.rs = rss + (size_t)(2 * L + 1) * M * 32; S.tab = rtab; S.pend = 0.f; S.nready = 0; S.pn0 = 40;
          pg8::EpiSwiglu<true> E{A0, FFN_H, rtab, 0};
          pg8::gemm_phase<pg8::EpiSwiglu<true>, pg8::TailOrder, PG8_ALIGN, PG8_SP2, true>(F.lds + RING_OFF, g, S, E); }
    }
    SEAM(pb + 4);
    if (IN(pb + 5)) {
        pg8::Gemm g{A0, (const bf16*)(ws + WS_W_DN + L * SZ_W_DN), M, DM, FFN_H}; pg8::StaticOrder S; S.init(M, DM, F.G, (int)blockIdx.x);
        pg8::EpiRes<false, L + 1 == DEPTH> E{nullptr, xo, XB, rss + (size_t)((2 * L + 2) & 7) * M * 32, DM};
        pg8::gemm_phase<pg8::EpiRes<false, L + 1 == DEPTH>, pg8::StaticOrder, PG8_ALIGN, PG8_SP2>(F.lds + RING_OFF, g, S, E);
    }
    SEAM(pb + 5);
}
__global__ void __launch_bounds__(NWAVES * 64, 2) trunk_fwd(Args args) {
    extern __shared__ __attribute__((aligned(16))) unsigned char lds[];
    Frame F;
    F.lds = (ldsp)lds;
    F.MISC = (volatile LAS unsigned*)(F.lds + MISC_OFF);
    F.tid = threadIdx.x; F.lane = F.tid & 63; F.wave = __builtin_amdgcn_readfirstlane(F.tid >> 6);
    F.G = gridDim.x; { const int bx = blockIdx.x; F.vcu = (F.G % 8 == 0) ? (bx % 8) * (F.G / 8) + bx / 8 : bx; }
    F.ctl = (gu32*)(args.ws + WS_CTL);
    for (int u = F.tid; u < (LDS_BYTES - LDSCTL_OFF) / 4; u += NWAVES * 64) ((LAS unsigned*)(F.lds + LDSCTL_OFF))[u] = 0u;
    __syncthreads();
    XcdBarrier bar; bar.bar = (unsigned*)(F.ctl + CW_BAR); bar.x = 0; bar.st = nullptr;
    if (N_LAUNCHES == 1) bar = xcd_barrier_post((unsigned*)(F.ctl + CW_BAR), F.MISC + 8);
    const int lo = args.ph_lo, hi = args.ph_hi;
    if (IN(0)) for (int rep_ = 0; rep_ < R_PRO; ++rep_) p0_prologue(F, args.in, args.ws);
    SEAM(0);
    layer_body<0>(F, args, bar, lo, hi); layer_body<1>(F, args, bar, lo, hi); layer_body<2>(F, args, bar, lo, hi); layer_body<3>(F, args, bar, lo, hi);
}
#undef IN
#undef SEAM

extern "C" void kernel_launch(void* const* d_in, const int* in_sizes, int n_in, void* d_out, int out_size, void* d_ws, size_t ws_size, hipStream_t stream) {
    static int grid = 0;
    if (grid == 0) {
        if (n_in != 21 || in_sizes[0] != M * DM || out_size != M * DM || ws_size < WS_END) { fprintf(stderr, "kernel_launch: unexpected shapes (n_in %d, in0 %d, out %d, ws %zu); nothing launched\n", n_in, n_in > 0 ? in_sizes[0] : -1, out_size, ws_size); grid = -1; return; }
        int dev = 0, cus = 0, per_cu = 0;
        if (hipGetDevice(&dev) != hipSuccess || hipDeviceGetAttribute(&cus, hipDeviceAttributeMultiprocessorCount, dev) != hipSuccess) { grid = -1; return; }
        if (hipFuncSetAttribute((const void*)trunk_fwd, hipFuncAttributeMaxDynamicSharedMemorySize, LDS_BYTES) != hipSuccess) { fprintf(stderr, "kernel_launch: hipFuncSetAttribute failed\n"); grid = -1; return; }
        if (hipOccupancyMaxActiveBlocksPerMultiprocessor(&per_cu, (const void*)trunk_fwd, NWAVES * 64, LDS_BYTES) != hipSuccess || per_cu < 1)
            fprintf(stderr, "kernel_launch: note: occupancy query reports %d workgroups per CU\n", per_cu);
        (void)hipGetLastError();
        grid = cus;
    }
    if (grid < 0) return;
    if (hipMemsetAsync((char*)d_ws + WS_CTL, 0, CTL_ZERO_BYTES, stream) != hipSuccess) return;
    Args a{};
    for (int i = 0; i < 21; ++i) a.in[i] = d_in[i];
    a.out = (float*)d_out; a.ws = (unsigned char*)d_ws;
    for (int li = 0; li < N_LAUNCHES; ++li) {
        a.ph_lo = (N_LAUNCHES == 1) ? 0 : li; a.ph_hi = (N_LAUNCHES == 1) ? N_PHASES : li + 1; a.li = li; a.pad = 0;
        hipLaunchKernelGGL(trunk_fwd, dim3(grid), dim3(NWAVES * 64), LDS_BYTES, stream, a);
        const hipError_t le = hipPeekAtLastError();
        if (le != hipSuccess) { fprintf(stderr, "kernel_launch: launch %d failed: %s\n", li, hipGetErrorName(le)); break; }
    }
}
```

```cpp
#include <hip/hip_runtime.h>
#include <cstdio>
#include <cstdint>
#include <cmath>
namespace pg8 {
#define PG8_LAS __attribute__((address_space(3)))
typedef unsigned short bf16_t;
typedef short bf16x8 __attribute__((ext_vector_type(8)));
typedef float f32x4 __attribute__((ext_vector_type(4)));
typedef unsigned u32x4 __attribute__((ext_vector_type(4)));
constexpr int BM = 256, BK = 64, HALF = 128, HTB = HALF * BK * 2  , STAGE_BYTES = 8 * HTB, NXCD = 8, WGM = 8;

__host__ __device__ __forceinline__ int lds_byte(int r, int c) { const int st = (r >> 4) * 2 + (c >> 5), rr = r & 15, cc = c & 31, ob = rr * 64 + cc * 2; return st * 1024 + (ob ^ (((ob >> 9) & 1) << 5)); }
__host__ __device__ __forceinline__ void stage_rc(int b, int& R, int& C) { const int st = b / 1024, sb = b % 1024, swz = sb ^ (((sb >> 9) & 1) << 5); R = (st >> 1) * 16 + swz / 64; C = (st & 1) * 32 + (swz % 64) / 2; }
__host__ __device__ __forceinline__ int perm32(int rho) { const int n = rho >> 4, i = rho & 15; return 8 * (i >> 2) + 4 * n + (i & 3); }

struct Unit { int pm, pn, hf; };
struct Gemm { const bf16_t* A; const bf16_t* Bt; int M, N, K; };

struct StaticOrder {
    int nM, nN, nwg, G, c;
    __host__ __device__ void init(int M, int N, int G_, int c_) { nM = M / BM; nN = N / BM; nwg = nM * nN; G = G_; c = c_; }
    __host__ __device__ bool next(int i, Unit& u) const {
        const long L = (long)i * G + c; if (L >= nwg) return false;
        int wgid = (int)L; { const int q = nwg / NXCD, r = nwg % NXCD, xcd = wgid % NXCD, off = wgid / NXCD; wgid = (xcd < r ? xcd * (q + 1) : r * (q + 1) + (xcd - r) * q) + off; }
        const int nig = WGM * nN, gid = wgid / nig, fm = gid * WGM, gsz = (nM - fm) < WGM ? (nM - fm) : WGM;
        u.pm = fm + ((wgid % nig) % gsz); u.pn = (wgid % nig) / gsz; u.hf = 0; return true;
    }
    __device__ __forceinline__ void a_ready(const Unit&) const {}
    __device__ __forceinline__ void done(const Unit&) const {}
};

__device__ __forceinline__ unsigned cvt_pk_bf16(float lo, float hi) { unsigned r; asm volatile("v_cvt_pk_bf16_f32 %0, %1, %2" : "=v"(r) : "v"(lo), "v"(hi)); return r; }
typedef float f32x2 __attribute__((ext_vector_type(2)));
__device__ __forceinline__ f32x2 gelu_pk(f32x2 v) {
    const f32x2 av = __builtin_elementwise_abs(v), d = av * 0.2316418882f + 1.0f;
    f32x2 t; t.x = __builtin_amdgcn_rcpf(d.x); t.y = __builtin_amdgcn_rcpf(d.y);
    f32x2 q = t * 0.5307027145f + (-0.7265760135f); q = q * t + 0.7107068705f; q = q * t + (-0.142248368f); q = q * t + 0.127414796f; q = q * t;
    const f32x2 s = (v * v) * (-0.72134752044f);
    f32x2 e; e.x = __builtin_amdgcn_exp2f(s.x); e.y = __builtin_amdgcn_exp2f(s.y);
    const f32x2 m = v * (q * e), r = v - m;
    f32x2 o; o.x = v.x < 0.f ? m.x : r.x; o.y = v.y < 0.f ? m.y : r.y; return o;
}

typedef float f32x2v __attribute__((ext_vector_type(2)));
typedef __bf16 bf16x2v __attribute__((ext_vector_type(2)));
__device__ __forceinline__ unsigned cvtpk(float lo, float hi) { f32x2v v = {lo, hi}; bf16x2v b = __builtin_convertvector(v, bf16x2v); return __builtin_bit_cast(unsigned, b); }
__device__ __forceinline__ u32x4 pack8(const f32x4 a, const f32x4 b) { u32x4 w; w.x = cvtpk(a[0], a[1]); w.y = cvtpk(a[2], a[3]); w.z = cvtpk(b[0], b[1]); w.w = cvtpk(b[2], b[3]); return w; }
#ifndef EPI_WT
#define EPI_WT 0
#endif
__device__ __forceinline__ void st16(void* p, const u32x4 v) {
#if EPI_WT
    asm volatile("global_store_dwordx4 %0, %1, off sc1\n\ts_nop 2" :: "v"(p), "v"(v) : "memory");
#else
    *(u32x4*)p = v;
#endif
}
__device__ __forceinline__ float fast_sigmoid(float x) { return __builtin_amdgcn_rcpf(1.0f + __builtin_amdgcn_exp2f(-1.44269504f * x)); }

template <bool BASE_F32, bool OUT_F32> struct EpiRes {
    static constexpr bool PERM = true, AFTER_DRAIN = false;
    const float* base; float* out; bf16_t* xb; float* rs; int ldc;
    __device__ __forceinline__ void operator()(const f32x4 (&acc)[2][2][4][2], const Unit& u, int wr, int wc, int fr, int fq) const {
        const int row0 = u.pm * BM + wr * 64 + fr, col0 = u.pn * BM + wc * 32 + 8 * fq;
#pragma unroll
        for (int ai = 0; ai < 2; ++ai)
#pragma unroll
            for (int m = 0; m < 4; ++m) { const int row = row0 + ai * HALF + m * 16; const size_t off = (size_t)row * ldc + col0; float ss = 0.f;
#pragma unroll
                for (int bj = 0; bj < 2; ++bj) { f32x4 b0, b1;
                    if (BASE_F32) { b0 = *(const f32x4*)(base + off + bj * HALF); b1 = *(const f32x4*)(base + off + bj * HALF + 4); }
                    else { const u32x4 w = *(const u32x4*)(xb + off + bj * HALF);
                        b0 = (f32x4){__uint_as_float(w.x << 16), __uint_as_float(w.x & 0xffff0000u), __uint_as_float(w.y << 16), __uint_as_float(w.y & 0xffff0000u)};
                        b1 = (f32x4){__uint_as_float(w.z << 16), __uint_as_float(w.z & 0xffff0000u), __uint_as_float(w.w << 16), __uint_as_float(w.w & 0xffff0000u)}; }
                    const f32x4 x0 = b0 + acc[ai][bj][m][0], x1 = b1 + acc[ai][bj][m][1];
                    if (OUT_F32) { *(f32x4*)(out + off + bj * HALF) = x0; *(f32x4*)(out + off + bj * HALF + 4) = x1; }
                    else st16(xb + off + bj * HALF, pack8(x0, x1));
                    ss += (x0[0] * x0[0] + x0[1] * x0[1]) + (x0[2] * x0[2] + x0[3] * x0[3]) + (x1[0] * x1[0] + x1[1] * x1[1]) + (x1[2] * x1[2] + x1[3] * x1[3]); }
                if (!OUT_F32) { ss += __shfl_xor(ss, 16); ss += __shfl_xor(ss, 32);
                    if (fq == 0) rs[(size_t)row * 32 + u.pn * 4 + wc] = ss; }
                if (m & 1) asm volatile("" ::: "memory"); }
    }
};
__device__ __forceinline__ float row_sumsq(const float* rs, int row) {
    const f32x4* p = (const f32x4*)(rs + (size_t)row * 32); f32x4 t = p[0];
#pragma unroll
    for (int i = 1; i < 8; ++i) t += p[i];
    return (t[0] + t[1]) + (t[2] + t[3]);
}
__device__ __forceinline__ float row_rstd(const float* rs, int row) { return 1.0f / sqrtf(row_sumsq(rs, row) * (1.0f / 2048.0f) + 1e-6f); }
struct RsOrder : StaticOrder {
    const float* rs; PG8_LAS float* tab; mutable float pend; mutable int nready;
    __device__ __forceinline__ void a_ready(const Unit& u) const {
        if (threadIdx.x < 256) pend = row_sumsq(rs, u.pm * BM + u.hf * HALF + threadIdx.x);
        ++nready;
    }
    __device__ __forceinline__ bool next(int i, Unit& u) const {
        if (i == 1 && threadIdx.x < 256) tab[threadIdx.x] = 1.0f / sqrtf(pend * (1.0f / 2048.0f) + 1e-6f);
        return StaticOrder::next(i, u);
    }
    __device__ __forceinline__ void done(const Unit&) const {
        if (threadIdx.x < 256) tab[((nready - 1) & 1) * 256 + threadIdx.x] = 1.0f / sqrtf(pend * (1.0f / 2048.0f) + 1e-6f);
    }
};
struct TailOrder : RsOrder {
    int pn0;
    __device__ __forceinline__ bool next(int i, Unit& u) const {
        if (i == 1 && threadIdx.x < 256) tab[threadIdx.x] = 1.0f / sqrtf(pend * (1.0f / 2048.0f) + 1e-6f);
        if (i != 0 || G != 256) return false;
        const int x = c & 7, l = c >> 3; u.pm = 4 * x + (l & 3); u.hf = (l >> 2) & 1; u.pn = pn0 + (l >> 3); return true;
    }
};
template <bool HALF_M> struct EpiSwiglu {
    static constexpr bool PERM = true, AFTER_DRAIN = false;
    bf16_t* O; int ldc; const PG8_LAS float* tab; mutable int ui;
    __device__ __forceinline__ void operator()(const f32x4 (&acc)[2][2][4][2], const Unit& u, int wr, int wc, int fr, int fq) const {
        const int row0 = u.pm * BM + (HALF_M ? u.hf * HALF : 0) + wr * 64 + fr, col0 = u.pn * HALF + wc * 32 + 8 * fq;
#pragma unroll
        for (int ai = 0; ai < (HALF_M ? 1 : 2); ++ai)
#pragma unroll
            for (int m = 0; m < 4; ++m) { bf16_t* rowp = O + (size_t)(row0 + ai * HALF + m * 16) * ldc + col0; const float r = tab[(ui & 1) * 256 + wr * 64 + fr + ai * HALF + m * 16];
                f32x4 v0, v1;
#pragma unroll
                for (int j = 0; j < 4; ++j) { const float g0 = acc[ai][0][m][0][j] * r, g1 = acc[ai][0][m][1][j] * r;
                    v0[j] = g0 * fast_sigmoid(g0) * (acc[ai][1][m][0][j] * r); v1[j] = g1 * fast_sigmoid(g1) * (acc[ai][1][m][1][j] * r); }
                st16(rowp, pack8(v0, v1)); }
        ++ui;
    }
};

struct EpiSwigluProbe {
    static constexpr bool PERM = true, AFTER_DRAIN = false;
    bf16_t* O; int never;
    __device__ __forceinline__ void operator()(const f32x4 (&acc)[2][2][4][2], const Unit& u, int wr, int wc, int fr, int fq) const {
        if (never) {
#pragma unroll
        for (int ai = 0; ai < 2; ++ai)
#pragma unroll
            for (int m = 0; m < 4; ++m) { bf16_t* rowp = O + (size_t)(u.pm * BM + wr * 64 + fr + ai * HALF + m * 16) * 5632 + u.pn * HALF + wc * 32 + 8 * fq;
                st16(rowp, pack8(acc[ai][0][m][0] + acc[ai][1][m][0], acc[ai][0][m][1] + acc[ai][1][m][1])); } }
    }
};
struct EpiRetIn {
    static constexpr bool PERM = true, AFTER_DRAIN = false;
    bf16_t *q, *k, *v, *g; const float *cs, *sn; const PG8_LAS float* tab; mutable int ui;
    __device__ __forceinline__ void operator()(const f32x4 (&acc)[2][2][4][2], const Unit& u, int wr, int wc, int fr, int fq) const {
        const int pn = u.pn, ci = wc * 32 + 8 * fq;
#pragma unroll
        for (int ai = 0; ai < 2; ++ai)
#pragma unroll
            for (int m = 0; m < 4; ++m) {
                const int row = u.pm * BM + ai * HALF + wr * 64 + m * 16 + fr, b = row >> 12, s = row & 4095; const float rr = tab[(ui & 1) * 256 + ai * HALF + wr * 64 + m * 16 + fr];
                if (pn < 16) {
                    const int h = pn & 7; const float sc = (pn < 8 ? 1.0f : 0.0625f) * rr;
                    bf16_t* dst = (pn < 8 ? q : k) + ((size_t)((b * 8 + h) * 4096 + s)) * 256 + ci;
                    f32x4 o1[2], o2[2];
#pragma unroll
                    for (int n = 0; n < 2; ++n) { const f32x4 c4 = *(const f32x4*)(cs + (size_t)row * 128 + ci + 4 * n), s4 = *(const f32x4*)(sn + (size_t)row * 128 + ci + 4 * n);
                        const f32x4 x1 = acc[ai][0][m][n], x2 = acc[ai][1][m][n];
                        o1[n] = (x1 * c4 - x2 * s4) * sc; o2[n] = (x2 * c4 + x1 * s4) * sc; }
                    st16(dst, pack8(o1[0], o1[1])); st16(dst + 128, pack8(o2[0], o2[1]));
                } else if (pn < 32) {
                    const int t = pn - 16, h = t >> 1, hf = t & 1;
                    bf16_t* dst = v + ((size_t)((b * 8 + h) * 4096 + s)) * 512 + hf * 256 + ci;
                    st16(dst, pack8(acc[ai][0][m][0] * rr, acc[ai][0][m][1] * rr)); st16(dst + 128, pack8(acc[ai][1][m][0] * rr, acc[ai][1][m][1] * rr));
                } else {
                    bf16_t* dst = g + (size_t)row * 4096 + (pn - 32) * 256 + ci;
                    st16(dst, pack8(acc[ai][0][m][0] * rr, acc[ai][0][m][1] * rr)); st16(dst + 128, pack8(acc[ai][1][m][0] * rr, acc[ai][1][m][1] * rr));
                }
            }
        ++ui;
    }
};
struct EpiGeluUV {
    static constexpr bool PERM = true, AFTER_DRAIN = false;
    bf16_t *uo, *vo; f32x2v* part; const PG8_LAS float* tab; mutable int ui;
    __device__ __forceinline__ void operator()(const f32x4 (&acc)[2][2][4][2], const Unit& u, int wr, int wc, int fr, int fq) const {
        const bool isv = u.pn >= 24; const int ct = isv ? u.pn - 24 : u.pn; bf16_t* dstb = isv ? vo : uo;
#pragma unroll
        for (int ai = 0; ai < 2; ++ai)
#pragma unroll
            for (int m = 0; m < 4; ++m) {
                const int row = u.pm * BM + ai * HALF + wr * 64 + m * 16 + fr;
                bf16_t* dst = dstb + (size_t)row * 6144 + ct * 256 + wc * 32 + 8 * fq;
                float s = 0.f, ss = 0.f; const float rr = tab[(ui & 1) * 256 + ai * HALF + wr * 64 + m * 16 + fr];
#pragma unroll
                for (int bj = 0; bj < 2; ++bj) { const f32x4 v0 = acc[ai][bj][m][0] * rr, v1 = acc[ai][bj][m][1] * rr;
                    const f32x2 a = gelu_pk((f32x2){v0[0], v0[1]}), b = gelu_pk((f32x2){v0[2], v0[3]}), c = gelu_pk((f32x2){v1[0], v1[1]}), d = gelu_pk((f32x2){v1[2], v1[3]});
                    const f32x4 z0 = {a.x, a.y, b.x, b.y}, z1 = {c.x, c.y, d.x, d.y};
                    st16(dst + bj * HALF, pack8(z0, z1));
                    s += (z0[0] + z0[1]) + (z0[2] + z0[3]) + (z1[0] + z1[1]) + (z1[2] + z1[3]);
                    ss += (z0[0] * z0[0] + z0[1] * z0[1]) + (z0[2] * z0[2] + z0[3] * z0[3]) + (z1[0] * z1[0] + z1[1] * z1[1]) + (z1[2] * z1[2] + z1[3] * z1[3]); }
                if (isv) { s += __shfl_xor(s, 16); s += __shfl_xor(s, 32); ss += __shfl_xor(ss, 16); ss += __shfl_xor(ss, 32);
                    if (fq == 0) part[((size_t)row * 24 + ct) * 4 + wc] = (f32x2v){s, ss}; }
            }
        ++ui;
    }
};
struct EpiFoxIn {
    static constexpr bool PERM = true, AFTER_DRAIN = false;
    bf16_t* O; size_t stride; const PG8_LAS float* tab; mutable int ui; PG8_LAS float* qkt; const PG8_LAS float* gains;
    __device__ __forceinline__ void operator()(const f32x4 (&acc)[2][2][4][2], const Unit& u, int wr, int wc, int fr, int fq) const {
        const int t = u.pn >> 3; bf16_t* base = O + (size_t)t * stride + (u.pn & 7) * 256 + wc * 32 + 8 * fq;
        if (t < 2) {
#pragma unroll
            for (int ai = 0; ai < 2; ++ai)
#pragma unroll
                for (int m = 0; m < 4; ++m) { const int rt = ai * HALF + wr * 64 + m * 16 + fr; const float rr = tab[(ui & 1) * 256 + rt];
#pragma unroll
                    for (int bj = 0; bj < 2; ++bj) { const f32x4 v0 = acc[ai][bj][m][0] * rr, v1 = acc[ai][bj][m][1] * rr;
                        float ss = (v0[0] * v0[0] + v0[1] * v0[1]) + (v0[2] * v0[2] + v0[3] * v0[3]) + (v1[0] * v1[0] + v1[1] * v1[1]) + (v1[2] * v1[2] + v1[3] * v1[3]);
                        ss += __shfl_xor(ss, 16); ss += __shfl_xor(ss, 32);
                        if (fq == 0) qkt[(rt * 2 + bj) * 4 + wc] = ss; } }
            asm volatile("s_waitcnt lgkmcnt(0)" ::: "memory"); __builtin_amdgcn_s_barrier(); asm volatile("" ::: "memory");
            const float sc = t == 0 ? 0.08838834764831845f * 1.4426950408889634f : 1.0f;
            const f32x4 g0 = *(const PG8_LAS f32x4*)(gains + t * 128 + wc * 32 + 8 * fq), g1 = *(const PG8_LAS f32x4*)(gains + t * 128 + wc * 32 + 8 * fq + 4);
#pragma unroll
            for (int ai = 0; ai < 2; ++ai)
#pragma unroll
                for (int m = 0; m < 4; ++m) { const int rt = ai * HALF + wr * 64 + m * 16 + fr; const float rr = tab[(ui & 1) * 256 + rt]; bf16_t* dst = base + (size_t)(u.pm * BM + rt) * 2048;
#pragma unroll
                    for (int bj = 0; bj < 2; ++bj) { const f32x4 p = *(const PG8_LAS f32x4*)(qkt + (rt * 2 + bj) * 4);
                        const float rs = rr * sc / sqrtf(((p[0] + p[1]) + (p[2] + p[3])) * (1.0f / 128.0f) + 1e-6f);
                        st16(dst + bj * HALF, pack8(acc[ai][bj][m][0] * rs * g0, acc[ai][bj][m][1] * rs * g1)); } }
        } else {
#pragma unroll
            for (int ai = 0; ai < 2; ++ai)
#pragma unroll
                for (int m = 0; m < 4; ++m) { const int row = u.pm * BM + ai * HALF + wr * 64 + m * 16 + fr; bf16_t* dst = base + (size_t)row * 2048; const float rr = tab[(ui & 1) * 256 + ai * HALF + wr * 64 + m * 16 + fr];
#pragma unroll
                    for (int bj = 0; bj < 2; ++bj) { f32x4 v0 = acc[ai][bj][m][0] * rr, v1 = acc[ai][bj][m][1] * rr;
                        if (t == 3) {
#pragma unroll
                            for (int j = 0; j < 4; ++j) { v0[j] = fast_sigmoid(v0[j]); v1[j] = fast_sigmoid(v1[j]); } }
                        st16(dst + bj * HALF, pack8(v0, v1)); } }
        }
        ++ui;
    }
};

template <class Epi, class Sched, bool ALIGN_EPI = false, bool SP2 = false, bool HALF_M = false>
__device__ __forceinline__ void gemm_phase(PG8_LAS unsigned char* lds, const Gemm g, const Sched& S, const Epi& E) {
    const int tid = threadIdx.x, wid = __builtin_amdgcn_readfirstlane(tid >> 6), lane = tid & 63, wr = wid >> 2, wc = wid & 3, fr = lane & 15, fq = lane >> 4;
    static_assert(!HALF_M || SP2, "HALF_M is written for the SP2 loop");
    const int K = g.K, nt = K / BK;
    unsigned voffA[2], voffB[2];
#pragma unroll
    for (int i = 0; i < 2; ++i) { int R, C; stage_rc(tid * 16 + i * 8192, R, C); const int Rb = Epi::PERM ? ((R & ~31) + perm32(R & 31)) : R;
        voffA[i] = (unsigned)(R * K + C) * 2u; voffB[i] = (unsigned)(Rb * K + C) * 2u; }
    const size_t kstep = (size_t)(BK * 2);
    const size_t hstep = (size_t)HALF * K * 2;
    const size_t tstep = 2 * hstep;
    const unsigned ldsw = (unsigned)wid * 1024u;
    const int aoff = lds_byte(wr * 64 + fr, fq * 8), boff = lds_byte(wc * 32 + fr, fq * 8);
#define PG8_SA(b, h) (((b) * 2 + (h)) * HTB)
#define PG8_SB(b, h) ((4 + (b) * 2 + (h)) * HTB)
#define PG8_STAGE(bufoff, gbase, voff) do { _Pragma("unroll") for (int _i = 0; _i < 2; ++_i) \
        __builtin_amdgcn_global_load_lds((const unsigned*)((const char*)(gbase) + (voff)[_i]), (PG8_LAS unsigned*)(lds + (bufoff) + ldsw + _i * 8192), 16, 0, 0); } while (0)
#define PG8_LDA(dst, b, h) do { _Pragma("unroll") for (int m = 0; m < 4; ++m) _Pragma("unroll") for (int k = 0; k < 2; ++k) dst[m][k] = *(const PG8_LAS bf16x8*)(lds + PG8_SA(b, h) + aoff + m * 2048 + k * 1024); } while (0)
#define PG8_LDB(dst, b, h) do { _Pragma("unroll") for (int n = 0; n < 2; ++n) _Pragma("unroll") for (int k = 0; k < 2; ++k) dst[n][k] = *(const PG8_LAS bf16x8*)(lds + PG8_SB(b, h) + boff + n * 2048 + k * 1024); } while (0)
#define PG8_MMA(ai, bj, At, Bt) do { __builtin_amdgcn_s_setprio(1); _Pragma("unroll") for (int m = 0; m < 4; ++m) _Pragma("unroll") for (int n = 0; n < 2; ++n) _Pragma("unroll") for (int k = 0; k < 2; ++k) \
        acc[ai][bj][m][n] = __builtin_amdgcn_mfma_f32_16x16x32_bf16(Bt[n][k], At[m][k], acc[ai][bj][m][n], 0, 0, 0); __builtin_amdgcn_s_setprio(0); } while (0)
#define PG8_WAIT_V(n) asm volatile("s_waitcnt vmcnt(" #n ")" ::: "memory")
#define PG8_WAIT_L(n) asm volatile("s_waitcnt lgkmcnt(" #n ")" ::: "memory")
#define PG8_BAR __builtin_amdgcn_s_barrier()
#define PG8_SCHED __builtin_amdgcn_sched_barrier(0)
    Unit cur, nxt; int ui = 0;
    if (!S.next(0, cur)) return;
    f32x4 acc[2][2][4][2];
#pragma unroll
    for (int a = 0; a < 2; ++a)
#pragma unroll
        for (int b = 0; b < 2; ++b)
#pragma unroll
            for (int m = 0; m < 4; ++m)
#pragma unroll
                for (int n = 0; n < 2; ++n) acc[a][b][m][n] = (f32x4){0.f, 0.f, 0.f, 0.f};
    bf16x8 At[4][2], B0[2][2], B1[2][2];
    const char* cA = (const char*)g.A + (size_t)cur.pm * tstep + (HALF_M ? (size_t)cur.hf * hstep : (size_t)0); const char* cB = (const char*)g.Bt + (size_t)cur.pn * tstep;
    S.a_ready(cur);
    if constexpr (SP2) {
        PG8_STAGE(PG8_SB(0, 0), cB, voffB); PG8_STAGE(PG8_SB(0, 1), cB + hstep, voffB); PG8_STAGE(PG8_SA(0, 0), cA, voffA); PG8_STAGE(PG8_SA(0, 1), cA + hstep, voffA);
        if (wr == 1) PG8_BAR;
        PG8_WAIT_V(2); PG8_BAR;
        PG8_STAGE(PG8_SB(1, 0), cB + kstep, voffB); PG8_STAGE(PG8_SA(1, 0), cA + kstep, voffA); PG8_STAGE(PG8_SB(1, 1), cB + hstep + kstep, voffB);
        PG8_WAIT_V(6); PG8_BAR;
    } else {
        PG8_STAGE(PG8_SB(0, 0), cB, voffB); PG8_STAGE(PG8_SA(0, 0), cA, voffA); PG8_STAGE(PG8_SB(0, 1), cB + hstep, voffB); PG8_STAGE(PG8_SA(0, 1), cA + hstep, voffA);
        if (wr == 1) PG8_BAR;
        PG8_WAIT_V(4); PG8_BAR;
        PG8_STAGE(PG8_SB(1, 0), cB + kstep, voffB); PG8_STAGE(PG8_SA(1, 0), cA + kstep, voffA); PG8_STAGE(PG8_SB(1, 1), cB + hstep + kstep, voffB);
        PG8_WAIT_V(6); PG8_BAR;
    }
    for (;;) {
        const bool has_next = S.next(ui + 1, nxt);
        const char* nA = has_next ? (const char*)g.A + (size_t)nxt.pm * tstep + (HALF_M ? (size_t)nxt.hf * hstep : (size_t)0) : cA; const char* nB = has_next ? (const char*)g.Bt + (size_t)nxt.pn * tstep : cB;
        for (int t = 0; t < nt; t += 2) {
            const bool last = (t == nt - 2);
            const char* a1 = cA + (size_t)(t + 1) * kstep;
            const char* a2 = last ? nA : cA + (size_t)(t + 2) * kstep; const char* b2 = last ? nB : cB + (size_t)(t + 2) * kstep;
            const char* a3 = a2 + kstep; const char* b3 = b2 + kstep;
            if (last && has_next) S.a_ready(nxt);
            if constexpr (SP2) {
            PG8_LDB(B0, 0, 0); PG8_LDB(B1, 0, 1); PG8_SCHED; PG8_LDA(At, 0, 0); PG8_STAGE(PG8_SA(1, 1), a1 + hstep, voffA);
            PG8_WAIT_V(8); PG8_WAIT_L(0); PG8_BAR; PG8_MMA(0, 0, At, B0); PG8_MMA(0, 1, At, B1); PG8_BAR; PG8_SCHED;
            if constexpr (!HALF_M) { PG8_LDA(At, 0, 1); } PG8_STAGE(PG8_SB(0, 0), b2, voffB); PG8_STAGE(PG8_SB(0, 1), b2 + hstep, voffB); PG8_STAGE(PG8_SA(0, 0), a2, voffA);
            PG8_WAIT_V(8); PG8_WAIT_L(0); PG8_BAR; if constexpr (!HALF_M) { PG8_MMA(1, 0, At, B0); PG8_MMA(1, 1, At, B1); } PG8_BAR; PG8_SCHED;
            PG8_LDB(B0, 1, 0); PG8_LDB(B1, 1, 1); PG8_SCHED; PG8_LDA(At, 1, 0); PG8_STAGE(PG8_SA(0, 1), a2 + hstep, voffA);
            PG8_WAIT_V(8); PG8_WAIT_L(0); PG8_BAR; PG8_MMA(0, 0, At, B0); PG8_MMA(0, 1, At, B1); PG8_BAR; PG8_SCHED;
            if constexpr (!HALF_M) { PG8_LDA(At, 1, 1); } PG8_STAGE(PG8_SB(1, 0), b3, voffB); PG8_STAGE(PG8_SB(1, 1), b3 + hstep, voffB); PG8_STAGE(PG8_SA(1, 0), a3, voffA);
            PG8_WAIT_V(8); PG8_WAIT_L(0); PG8_BAR; if constexpr (!HALF_M) { PG8_MMA(1, 0, At, B0); PG8_MMA(1, 1, At, B1); } PG8_BAR; PG8_SCHED;
            } else {
            PG8_LDB(B0, 0, 0); PG8_SCHED; PG8_LDA(At, 0, 0); PG8_STAGE(PG8_SA(1, 1), a1 + hstep, voffA);
            PG8_WAIT_L(8); PG8_BAR; PG8_WAIT_L(0); PG8_MMA(0, 0, At, B0); PG8_BAR; PG8_SCHED;
            PG8_LDB(B1, 0, 1); PG8_STAGE(PG8_SB(0, 0), b2, voffB);
            PG8_BAR; PG8_WAIT_L(0); PG8_MMA(0, 1, At, B1); PG8_BAR;
            PG8_LDA(At, 0, 1); PG8_STAGE(PG8_SA(0, 0), a2, voffA);
            PG8_BAR; PG8_WAIT_L(0); PG8_MMA(1, 0, At, B0); PG8_BAR; PG8_SCHED;
            PG8_STAGE(PG8_SB(0, 1), b2 + hstep, voffB);
            PG8_WAIT_V(6); PG8_BAR; PG8_MMA(1, 1, At, B1); PG8_BAR;
            PG8_LDB(B0, 1, 0); PG8_SCHED; PG8_LDA(At, 1, 0); PG8_STAGE(PG8_SA(0, 1), a2 + hstep, voffA);
            PG8_WAIT_L(8); PG8_BAR; PG8_WAIT_L(0); PG8_MMA(0, 0, At, B0); PG8_BAR; PG8_SCHED;
            PG8_LDB(B1, 1, 1); PG8_STAGE(PG8_SB(1, 0), b3, voffB);
            PG8_BAR; PG8_WAIT_L(0); PG8_MMA(0, 1, At, B1); PG8_BAR;
            PG8_LDA(At, 1, 1); PG8_STAGE(PG8_SA(1, 0), a3, voffA);
            PG8_BAR; PG8_WAIT_L(0); PG8_MMA(1, 0, At, B0); PG8_BAR; PG8_SCHED;
            PG8_STAGE(PG8_SB(1, 1), b3 + hstep, voffB);
            PG8_WAIT_V(6); PG8_BAR; PG8_MMA(1, 1, At, B1); PG8_BAR;
            }
        }
        if constexpr (ALIGN_EPI) { if (wr == 0) PG8_BAR; }
        if constexpr (!Epi::AFTER_DRAIN) { E(acc, cur, wr, wc, fr, fq); S.done(cur); }
        if (!has_next) break;
#pragma unroll
        for (int a = 0; a < 2; ++a)
#pragma unroll
            for (int b = 0; b < 2; ++b)
#pragma unroll
                for (int m = 0; m < 4; ++m)
#pragma unroll
                    for (int n = 0; n < 2; ++n) acc[a][b][m][n] = (f32x4){0.f, 0.f, 0.f, 0.f};
        cur = nxt; cA = nA; cB = nB; ++ui;
        if constexpr (ALIGN_EPI) { if (wr == 1) PG8_BAR; }
    }
    PG8_WAIT_V(0);
    if constexpr (!ALIGN_EPI) { if (wr == 0) PG8_BAR; }
    PG8_BAR;
    if constexpr (Epi::AFTER_DRAIN) { E.fused(acc, cur, wr, wc, fr, fq, lds, wid, lane); S.done(cur); }
#undef PG8_SA
#undef PG8_SB
#undef PG8_STAGE
#undef PG8_LDA
#undef PG8_LDB
#undef PG8_MMA
#undef PG8_WAIT_V
#undef PG8_WAIT_L
#undef PG8_BAR
#undef PG8_SCHED
}
}

#ifndef PG8_SP2
#define PG8_SP2 true
#endif
#ifndef PG8_ALIGN
#define PG8_ALIGN true
#endif
constexpr int NWAVES = 8, NTHR = 512;
#ifndef MK_N_LAUNCHES
#define MK_N_LAUNCHES 1
#endif
constexpr int N_PHASES = 25;
constexpr int N_LAUNCHES = MK_N_LAUNCHES;
static_assert(N_LAUNCHES == 1, "this build runs as ONE launch (the retention mixer has a grid barrier inside its phase)");

constexpr int BATCH = 2, SEQ = 4096, DM = 2048, M = BATCH * SEQ, DEPTH = 4;
constexpr int RET_N = 12288, GM_N = 12288, GM_HALF = 6144, FOX_LD = 8208, FOX_N = 8192, FFN_H = 5632, FFN_N2 = 2 * FFN_H;
constexpr float EPS = 1e-6f;
constexpr float LOG2E = 1.4426950408889634f;

constexpr size_t MiB = (size_t)1 << 20;
constexpr size_t WS_CTL = 0, CTL_ZERO_BYTES = 1 * MiB;
constexpr size_t WS_W_RET_IN = 1 * MiB, SZ_W_RET_IN = 48 * MiB;
constexpr size_t WS_W_RET_OUT = 97 * MiB, SZ_W_RET_OUT = 16 * MiB;
constexpr size_t WS_W_GM_IN = 129 * MiB, WS_W_GM_OUT = 177 * MiB, WS_W_FOX_IN = 201 * MiB, WS_W_FOX_OUT = 233 * MiB;
constexpr size_t WS_W_GU = 241 * MiB, SZ_W_GU = 44 * MiB;
constexpr size_t WS_W_DN = 417 * MiB, SZ_W_DN = 22 * MiB;
constexpr size_t WS_ROPE_C = 505 * MiB, WS_ROPE_S = 509 * MiB;
constexpr size_t WS_H = 513 * MiB;
constexpr size_t WS_A = 545 * MiB;
constexpr size_t WS_B = 737 * MiB;
constexpr size_t WS_C = 833 * MiB;
constexpr size_t WS_MISC = 897 * MiB, WS_RSP = 913 * MiB, WS_KF = 921 * MiB, WS_QF = 953 * MiB, WS_END = 985 * MiB;
constexpr size_t MISC_PART = 0, MISC_RSTAT = 8 * MiB, MISC_LF = 9 * MiB, MISC_WTRI = 12 * MiB;
constexpr int CW_BAR = 4096;

constexpr int RING_OFF = 0, RING_BYTES = 131072;
constexpr int LDSCTL_OFF = RING_BYTES, MISC_OFF = LDSCTL_OFF + 320;
constexpr int RSTAB_OFF = LDSCTL_OFF + 1024;
constexpr int QKT_OFF = LDSCTL_OFF + 3072, QKG_OFF = QKT_OFF + 8192;
constexpr int LDS_BYTES = 147456;
static_assert(MISC_OFF + 128 <= RSTAB_OFF && RSTAB_OFF + 2048 <= QKT_OFF && QKG_OFF + 1024 <= LDS_BYTES, "LDS map");

#define GAS __attribute__((address_space(1)))
#define LAS __attribute__((address_space(3)))
typedef unsigned short bf16;
typedef unsigned v4u __attribute__((ext_vector_type(4)));
typedef unsigned v2u __attribute__((ext_vector_type(2)));
typedef float f32x4 __attribute__((ext_vector_type(4)));
typedef float f32x2 __attribute__((ext_vector_type(2)));
typedef short bf16x8 __attribute__((ext_vector_type(8)));
typedef short s16x4 __attribute__((ext_vector_type(4)));
typedef GAS unsigned gu32;
typedef LAS unsigned char* ldsp;
#define RLX_AGENT __ATOMIC_RELAXED, __HIP_MEMORY_SCOPE_AGENT
#define LDS_WAIT() asm volatile("s_waitcnt lgkmcnt(0)" ::: "memory")
using pg8::cvtpk;
__device__ __forceinline__ float bflo(unsigned w) { return __uint_as_float(w << 16); }
__device__ __forceinline__ float bfhi(unsigned w) { return __uint_as_float(w & 0xffff0000u); }
#define MFMA16(a, b, c) __builtin_amdgcn_mfma_f32_16x16x32_bf16((a), (b), (c), 0, 0, 0)
__device__ __forceinline__ bf16x8 frag_row(const ldsp tile, int RS, int lane) { return *(const LAS bf16x8*)(tile + (lane & 15) * RS + (lane >> 4) * 16); }
typedef short v4i16_t __attribute__((ext_vector_type(4)));
__device__ __forceinline__ s16x4 vtr(const ldsp p) { return __builtin_bit_cast(s16x4, __builtin_amdgcn_ds_read_tr16_b64_v4i16((LAS v4i16_t*)p)); }
__device__ __forceinline__ bf16x8 frag_tr(const ldsp tile, int RS, int lane) {
    const ldsp a = tile + (8 * (lane >> 4) + ((lane & 15) >> 2)) * RS + 8 * (lane & 3);
    const s16x4 lo = vtr(a), hi = vtr(a + 4 * RS);
    return (bf16x8){lo[0], lo[1], lo[2], lo[3], hi[0], hi[1], hi[2], hi[3]};
}

#define XB_TMO      128
#define XB_XCNT(j)  (256  + 64 * (j))
#define XB_XSUB(j)  (1280 + 64 * (j))
#define XB_XGEN(j)  (2304 + 64 * (j))
#define XB_TOP      3328
#define XB_TOPGEN   3392
#define XCD_BAR_WORDS 3456
#define XB_SPIN_CAP (1u << 18)

__device__ __forceinline__ unsigned xb_ld(unsigned* p)              { return __hip_atomic_load(p, __ATOMIC_RELAXED, __HIP_MEMORY_SCOPE_AGENT); }
__device__ __forceinline__ unsigned xb_add(unsigned* p, unsigned v) { return __hip_atomic_fetch_add(p, v, __ATOMIC_RELAXED, __HIP_MEMORY_SCOPE_AGENT); }
__device__ __forceinline__ unsigned xb_xcc_id() { return (unsigned)__builtin_amdgcn_s_getreg((3 << 11) | 20) & 0xFu; }
#define XB_SPIN(cond, bar) do { unsigned _sp = 0; while (cond) { __builtin_amdgcn_s_sleep(1); \
    if ((++_sp & 255u) == 0u) { if (xb_ld(&(bar)[XB_TMO])) break; if (_sp > XB_SPIN_CAP) { atomicAdd(&(bar)[XB_TMO], 1u); break; } } } } while (0)

struct XcdBarrier {
    unsigned* bar; unsigned x;
    volatile LAS unsigned* st;
};

__device__ __forceinline__ XcdBarrier xcd_barrier_post(unsigned* bar, volatile LAS unsigned* st) {
    XcdBarrier b; b.bar = bar; b.x = xb_xcc_id(); b.st = st;
    if (threadIdx.x == 0) (void)xb_add(&bar[XB_XCNT(b.x)], 1u);
    return b;
}
__device__ __forceinline__ void xcd_barrier_complete(unsigned* bar, unsigned x, unsigned& nloc, unsigned& nx) {
    const unsigned G = gridDim.x * gridDim.y * gridDim.z;
    unsigned sum, cnt, mine, sp = 0u;
    for (;;) {
        sum = 0u; cnt = 0u; mine = 0u;
#pragma unroll
        for (unsigned j = 0; j < 16; ++j) { const unsigned c = xb_ld(&bar[XB_XCNT(j)]); sum += c; cnt += (c > 0u) ? 1u : 0u; mine = (j == x) ? c : mine; }
        if (sum == G) break;
        __builtin_amdgcn_s_sleep(1);
        if ((++sp & 255u) == 0u) { if (xb_ld(&bar[XB_TMO])) break; if (sp > XB_SPIN_CAP) { atomicAdd(&bar[XB_TMO], 1u); break; } }
    }
    nloc = mine > 0u ? mine : 1u; nx = cnt > 0u ? cnt : 1u;
}

__device__ __forceinline__ void xcd_barrier(const XcdBarrier& b) {
    asm volatile("s_waitcnt vmcnt(0)" ::: "memory");
    __syncthreads();
    if (threadIdx.x == 0) {
        unsigned* bar = b.bar;
        __builtin_amdgcn_s_waitcnt(0);
        unsigned nloc = b.st[0], nx = b.st[1];
        if (nloc == 0u) { xcd_barrier_complete(bar, b.x, nloc, nx); b.st[0] = nloc; b.st[1] = nx; }
        const unsigned old = xb_add(&bar[XB_XSUB(b.x)], 1u);
        const unsigned gen = old / nloc;
        if (old + 1u == (gen + 1u) * nloc) {
            __builtin_amdgcn_fence(__ATOMIC_RELEASE, "agent");
            asm volatile("s_waitcnt vmcnt(0)" ::: "memory");
            const unsigned og = xb_add(&bar[XB_TOP], 1u);
            const unsigned tg = og / nx;
            if (og + 1u == (tg + 1u) * nx) xb_add(&bar[XB_TOPGEN], 1u);
            else XB_SPIN(xb_ld(&bar[XB_TOPGEN]) == tg, bar);
            __builtin_amdgcn_fence(__ATOMIC_ACQUIRE, "agent");
            xb_add(&bar[XB_XGEN(b.x)], 1u);
            asm volatile("s_waitcnt vmcnt(0)" ::: "memory");
        } else {
            XB_SPIN(xb_ld(&bar[XB_XGEN(b.x)]) == gen, bar);
            __builtin_amdgcn_fence(__ATOMIC_ACQUIRE, "agent");
            asm volatile("s_waitcnt vmcnt(0)" ::: "memory");
        }
    }
    __syncthreads();
}

struct Frame {
    ldsp lds;
    volatile LAS unsigned* MISC;
    gu32* ctl;
    int tid, lane, wave;
    int vcu, G;
};
__device__ __forceinline__ float wave_sum(float v) {
#pragma unroll
    for (int o = 1; o < 64; o <<= 1) v += __shfl_xor(v, o);
    return v;
}
__device__ __forceinline__ float log_sigmoid(float z) { return fminf(z, 0.f) - log1pf(expf(-fabsf(z))); }

__device__ __forceinline__ void transpose_job(Frame& F, const float* W, int K, int ld, int ncols, bf16* WT, int ilv, const float* gvec) {
    LAS float* scr = (LAS float*)(F.lds + RING_OFF + F.wave * 16384);
    const int gw = F.vcu * NWAVES + F.wave, NGW = F.G * NWAVES, lane = F.lane;
    const int nblk = ncols / 32, nitems = (K / 64) * nblk;
    float wv[32];
#define TJ_LOAD(item) do { const int kb_ = (item) / nblk, nb_ = (item) % nblk; const float* src_ = W + (size_t)(64 * kb_ + (lane >> 5)) * ld + 32 * nb_ + (lane & 31); \
        _Pragma("unroll") for (int i = 0; i < 32; ++i) wv[i] = src_[(size_t)(2 * i) * ld]; } while (0)
    if (gw < nitems) TJ_LOAD(gw);
    for (int it = gw; it < nitems; it += NGW) {
        const int kb = it / nblk, nb = it % nblk, k0 = 64 * kb, n0 = 32 * nb;
        const int drow0 = ilv == 0 ? n0 : ((n0 >> 7) * 256 + (n0 & 127) + (ilv == 2 ? 128 : 0));
#pragma unroll
        for (int i = 0; i < 32; ++i) scr[(2 * i + (lane >> 5)) * 33 + (lane & 31)] = wv[i];
        if (it + NGW < nitems) TJ_LOAD(it + NGW);
        LDS_WAIT(); asm volatile("" ::: "memory");
        const int c = lane & 7;
        f32x4 ga = {1.f, 1.f, 1.f, 1.f}, gb = {1.f, 1.f, 1.f, 1.f};
        if (gvec) { ga = *(const f32x4*)(gvec + k0 + 8 * c); gb = *(const f32x4*)(gvec + k0 + 8 * c + 4); }
#pragma unroll
        for (int j = 0; j < 4; ++j) { const int n = (lane >> 3) + 8 * j; const LAS float* s = scr + (8 * c) * 33 + n;
            v4u o; o.x = cvtpk(s[0 * 33] * ga[0], s[1 * 33] * ga[1]); o.y = cvtpk(s[2 * 33] * ga[2], s[3 * 33] * ga[3]); o.z = cvtpk(s[4 * 33] * gb[0], s[5 * 33] * gb[1]); o.w = cvtpk(s[6 * 33] * gb[2], s[7 * 33] * gb[3]);
            *(GAS v4u*)(WT + (size_t)(drow0 + n) * K + k0 + 8 * c) = o; }
        LDS_WAIT(); asm volatile("" ::: "memory");
    }
#undef TJ_LOAD
}
__device__ __forceinline__ void p0_prologue(Frame& F, const void* const* in, unsigned char* ws) {
    const float* mixg = (const float*)in[2]; const float* ffng = (const float*)in[3];
    for (int j = 0; j < 2; ++j) {
        transpose_job(F, (const float*)in[4] + (size_t)j * DM * RET_N, DM, RET_N, RET_N, (bf16*)(ws + WS_W_RET_IN + j * SZ_W_RET_IN), 0, mixg + (size_t)(3 * j) * DM);
        transpose_job(F, (const float*)in[6] + (size_t)j * 4096 * DM, 4096, DM, DM, (bf16*)(ws + WS_W_RET_OUT + j * SZ_W_RET_OUT), 0, nullptr);
    }
    transpose_job(F, (const float*)in[7], DM, GM_N, GM_N, (bf16*)(ws + WS_W_GM_IN), 0, mixg + DM);
    transpose_job(F, (const float*)in[12], GM_HALF, DM, DM, (bf16*)(ws + WS_W_GM_OUT), 0, nullptr);
    transpose_job(F, (const float*)in[13], DM, FOX_LD, FOX_N, (bf16*)(ws + WS_W_FOX_IN), 0, mixg + 2 * DM);
    transpose_job(F, (const float*)in[17], DM, DM, DM, (bf16*)(ws + WS_W_FOX_OUT), 0, nullptr);
    for (int i = 0; i < DEPTH; ++i) {
        transpose_job(F, (const float*)in[18] + (size_t)i * DM * FFN_H, DM, FFN_H, FFN_H, (bf16*)(ws + WS_W_GU + i * SZ_W_GU), 1, ffng + (size_t)i * DM);
        transpose_job(F, (const float*)in[19] + (size_t)i * DM * FFN_H, DM, FFN_H, FFN_H, (bf16*)(ws + WS_W_GU + i * SZ_W_GU), 2, ffng + (size_t)i * DM);
        transpose_job(F, (const float*)in[20] + (size_t)i * FFN_H * DM, FFN_H, DM, DM, (bf16*)(ws + WS_W_DN + i * SZ_W_DN), 0, nullptr);
    }
    { const float* x = (const float*)in[0]; bf16* xb = (bf16*)(ws + WS_H); float* rss = (float*)(ws + WS_RSP);
      const int gw = F.vcu * NWAVES + F.wave, NGW = F.G * NWAVES, lane = F.lane;
      for (int m = gw; m < M; m += NGW) { const f32x4* xr = (const f32x4*)(x + (size_t)m * DM) + lane; v2u* o8 = (v2u*)(xb + (size_t)m * DM) + lane; float ss = 0.f;
#pragma unroll
          for (int j = 0; j < 8; ++j) { const f32x4 v = xr[64 * j]; ss += (v.x * v.x + v.y * v.y) + (v.z * v.z + v.w * v.w); v2u w; w.x = cvtpk(v.x, v.y); w.y = cvtpk(v.z, v.w); o8[64 * j] = w; }
          ss = wave_sum(ss); if (lane < 32) rss[(size_t)m * 32 + lane] = lane == 0 ? ss : 0.f; } }
    { const float* wsp = (const float*)in[10]; bf16* wtri = (bf16*)(ws + WS_MISC + MISC_WTRI);
      for (int i4 = F.vcu * NTHR + F.tid; i4 < 8 * 128 * 32; i4 += F.G * NTHR) { const int t = (i4 >> 5) & 127, s4 = (i4 & 31) * 4; f32x4 wv = *(const f32x4*)(wsp + (size_t)i4 * 4);
#pragma unroll
          for (int e = 0; e < 4; ++e) if (s4 + e > t) wv[e] = 0.f;
          v2u pk; pk.x = cvtpk(wv[0], wv[1]); pk.y = cvtpk(wv[2], wv[3]); *(v2u*)(wtri + (size_t)i4 * 4) = pk; } }
    { const int* pos = (const int*)in[1]; float* cs = (float*)(ws + WS_ROPE_C); float* sn = (float*)(ws + WS_ROPE_S);
      const int gid = F.vcu * NTHR + F.tid, i = gid & 127, step = (F.G * NTHR) >> 7;
      const double invf = exp2(-(double)i * (13.287712379549449 / 128.0));
      for (int r = gid >> 7; r < M; r += step) { const double ang = (double)pos[r] * invf; const double rr = ang - 6.283185307179586 * rint(ang * 0.15915494309189535);
          const float a = (float)rr; cs[(size_t)r * 128 + i] = cosf(a); sn[(size_t)r * 128 + i] = sinf(a); } }
}

__device__ __forceinline__ void ret_p_phase(Frame& F, const bf16* q, const bf16* k, bf16* PF, bf16* KF, bf16* QF) {
    constexpr int RSQ = 272;
    const ldsp LQ = F.lds, LK = F.lds + 34816;
    const int tid = F.tid, lane = F.lane, w = F.wave, g4 = lane >> 4, l15 = lane & 15;
    for (int unit = F.vcu; unit < 512; unit += F.G) {
        const int bh = unit >> 5, ci = unit & 31, h = bh & 7;
        const float lg2 = log1pf(-exp2f(-5.0f - (float)h)) * LOG2E;
        const size_t rowbase = (size_t)bh * SEQ + ci * 128;
        v4u pq[4], pk[4];
#define RP_LD(dd) do { _Pragma("unroll") for (int ps = 0; ps < 4; ++ps) { const int r_ = ps * 32 + (tid >> 4), c_ = tid & 15; \
            pq[ps] = *(const v4u*)(q + (rowbase + r_) * 256 + (dd) * 128 + c_ * 8); pk[ps] = *(const v4u*)(k + (rowbase + r_) * 256 + (dd) * 128 + c_ * 8); } } while (0)
        RP_LD(0);
        f32x4 S[8];
#pragma unroll
        for (int t = 0; t < 8; ++t) S[t] = (f32x4){0.f, 0.f, 0.f, 0.f};
#pragma unroll
        for (int dh = 0; dh < 2; ++dh) {
            __syncthreads();
#pragma unroll
            for (int ps = 0; ps < 4; ++ps) { const int r_ = ps * 32 + (tid >> 4), c_ = tid & 15; *(LAS v4u*)(LQ + r_ * RSQ + c_ * 16) = pq[ps]; *(LAS v4u*)(LK + r_ * RSQ + c_ * 16) = pk[ps]; }
            if (dh == 0) RP_LD(1);
            __syncthreads();
#pragma unroll
            for (int ks = 0; ks < 4; ++ks) { const bf16x8 a = frag_row(LQ + (16 * w) * RSQ + ks * 64, RSQ, lane);
                *(bf16x8*)(QF + ((((size_t)(bh * 32 + ci) * 8 + w) * 8 + dh * 4 + ks) * 512 + lane * 8)) = a;
#pragma unroll
                for (int t = 0; t < 8; ++t) S[t] = MFMA16(a, frag_row(LK + (16 * t) * RSQ + ks * 64, RSQ, lane), S[t]); }
#pragma unroll
            for (int ks = 0; ks < 4; ++ks) { const bf16x8 f = frag_tr(LK + (32 * ks) * RSQ + (16 * w) * 2, RSQ, lane); const v4u fu = __builtin_bit_cast(v4u, f); v4u o;
                const float k0 = exp2f((float)(127 - 32 * ks - 8 * g4) * lg2), gi = exp2f(-lg2), k1 = k0 * gi, k2 = k1 * gi, k3 = k2 * gi, k4 = k3 * gi, k5 = k4 * gi, k6 = k5 * gi, k7 = k6 * gi;
                o.x = cvtpk(bflo(fu.x) * k0, bfhi(fu.x) * k1); o.y = cvtpk(bflo(fu.y) * k2, bfhi(fu.y) * k3); o.z = cvtpk(bflo(fu.z) * k4, bfhi(fu.z) * k5); o.w = cvtpk(bflo(fu.w) * k6, bfhi(fu.w) * k7);
                *(v4u*)(KF + ((((size_t)(bh * 32 + ci) * 2 + dh) * 8 + w) * 4 + ks) * 512 + lane * 8) = o; }
        }
#undef RP_LD
#pragma unroll
        for (int t = 0; t < 8; ++t)
#pragma unroll
            for (int r = 0; r < 4; ++r) { const int n = 16 * w + 4 * g4 + r, mm = 16 * t + l15;
                const float pv_ = n >= mm ? S[t][r] * exp2f((float)(n - mm) * lg2) : 0.f;
                *(LAS unsigned short*)(LQ + n * RSQ + mm * 2) = (unsigned short)(cvtpk(pv_, 0.f) & 0xffffu); }
#pragma unroll
        for (int ks = 0; ks < 4; ++ks) *(bf16x8*)(PF + ((((size_t)(bh * 32 + ci) * 8 + w) * 4 + ks) * 512 + lane * 8)) = frag_row(LQ + (16 * w) * RSQ + ks * 64, RSQ, lane);
    }
}
__device__ __forceinline__ void ret_core_phase(Frame& F, const bf16* QF, const bf16* v, const bf16* PF, const bf16* KF, bf16* o) {
    constexpr int RSV = 72, RSS = 528;
    const ldsp LV = F.lds, LST = F.lds + 9216;
    const ldsp LOw = F.lds + 43008 + F.wave * 1024;
    const int tid = F.tid, lane = F.lane, w = F.wave, g4 = lane >> 4, l15 = lane & 15;
    for (int unit = F.vcu; unit < 256; unit += F.G) {
        const int bh = unit >> 4, es = unit & 15, h = bh & 7, b = bh >> 3, e0 = es * 32;
        const float lg2 = log1pf(-exp2f(-5.0f - (float)h)) * LOG2E;
        const float cd = exp2f(128.0f * lg2);
        const size_t rb0 = (size_t)bh * SEQ;
        f32x4 st[2][2];
#pragma unroll
        for (int a = 0; a < 2; ++a)
#pragma unroll
            for (int t = 0; t < 2; ++t) st[a][t] = (f32x4){0.f, 0.f, 0.f, 0.f};
        __syncthreads();
        for (int i = tid; i < 16896 / 4; i += NTHR) ((LAS unsigned*)LST)[i] = 0u;
        v4u pv, pvn; bf16x8 qf[8], pf[4], kf[8], qn[8], pn[4], kn[8];
#define RC_LD(cc) do { pvn = *(const v4u*)(v + (rb0 + (cc) * 128 + (tid >> 2)) * 512 + e0 + (tid & 3) * 8); \
            _Pragma("unroll") for (int ks = 0; ks < 8; ++ks) qn[ks] = *(const bf16x8*)(QF + ((((size_t)(bh * 32 + (cc)) * 8 + w) * 8 + ks) * 512 + lane * 8)); \
            _Pragma("unroll") for (int ks = 0; ks < 4; ++ks) pn[ks] = *(const bf16x8*)(PF + ((((size_t)(bh * 32 + (cc)) * 8 + w) * 4 + ks) * 512 + lane * 8)); \
            _Pragma("unroll") for (int i_ = 0; i_ < 8; ++i_) kn[i_] = *(const bf16x8*)(KF + ((((size_t)(bh * 32 + (cc)) * 2 + (i_ >> 2)) * 8 + w) * 4 + (i_ & 3)) * 512 + lane * 8); } while (0)
        RC_LD(0);
        for (int ci = 0; ci < 32; ++ci) {
            const ldsp LSc = LST + (ci & 1) * 16896, LSn = LST + ((ci + 1) & 1) * 16896;
            __syncthreads();
            pv = pvn;
#pragma unroll
            for (int i_ = 0; i_ < 8; ++i_) { qf[i_] = qn[i_]; kf[i_] = kn[i_]; }
#pragma unroll
            for (int i_ = 0; i_ < 4; ++i_) pf[i_] = pn[i_];
            *(LAS v4u*)(LV + (tid >> 2) * RSV + (tid & 3) * 16) = pv;
            if (ci + 1 < 32) RC_LD(ci + 1);
            __syncthreads();
            bf16x8 vf[4][2];
#pragma unroll
            for (int ks = 0; ks < 4; ++ks)
#pragma unroll
                for (int t = 0; t < 2; ++t) vf[ks][t] = frag_tr(LV + (32 * ks) * RSV + (16 * t) * 2, RSV, lane);
            f32x4 cr[2], in[2];
            cr[0] = (f32x4){0.f, 0.f, 0.f, 0.f}; cr[1] = (f32x4){0.f, 0.f, 0.f, 0.f}; in[0] = (f32x4){0.f, 0.f, 0.f, 0.f}; in[1] = (f32x4){0.f, 0.f, 0.f, 0.f};
#pragma unroll
            for (int ks = 0; ks < 8; ++ks)
#pragma unroll
                for (int t = 0; t < 2; ++t) cr[t] = MFMA16(qf[ks], frag_row(LSc + (16 * t) * RSS + (ks * 32) * 2, RSS, lane), cr[t]);
#pragma unroll
            for (int ks = 0; ks < 4; ++ks)
#pragma unroll
                for (int t = 0; t < 2; ++t) in[t] = MFMA16(pf[ks], vf[ks][t], in[t]);
#pragma unroll
            for (int dh = 0; dh < 2; ++dh) {
#pragma unroll
                for (int t = 0; t < 2; ++t) st[dh][t] = st[dh][t] * cd;
#pragma unroll
                for (int ks = 0; ks < 4; ++ks)
#pragma unroll
                    for (int t = 0; t < 2; ++t) st[dh][t] = MFMA16(kf[dh * 4 + ks], vf[ks][t], st[dh][t]);
#pragma unroll
                for (int t = 0; t < 2; ++t) { v2u pk2; pk2.x = cvtpk(st[dh][t][0], st[dh][t][1]); pk2.y = cvtpk(st[dh][t][2], st[dh][t][3]);
                    *(LAS v2u*)(LSn + (16 * t + l15) * RSS + (dh * 128 + 16 * w + 4 * g4) * 2) = pk2; }
            }
#pragma unroll
            for (int r = 0; r < 4; ++r) { const int n = 16 * w + 4 * g4 + r; const float qd = exp2f((float)(n + 1) * lg2);
#pragma unroll
                for (int t = 0; t < 2; ++t) *(LAS unsigned short*)(LOw + (4 * g4 + r) * 64 + (16 * t + l15) * 2) = (unsigned short)(cvtpk(in[t][r] + cr[t][r] * qd, 0.f) & 0xffffu); }
            *(v4u*)(o + ((size_t)b * SEQ + ci * 128 + 16 * w + (lane >> 2)) * 4096 + h * 512 + e0 + (lane & 3) * 8) = *(const LAS v4u*)(LOw + (lane >> 2) * 64 + (lane & 3) * 16);
        }
#undef RC_LD
    }
}

__device__ __forceinline__ void ret_gn_phase(Frame& F, const bf16* o, const bf16* g, const float* gn, bf16* y) {
    const int lane = F.lane, gw = F.vcu * NWAVES + F.wave, NGW = F.G * NWAVES;
    for (int it0 = gw; it0 < M * 8; it0 += 4 * NGW) {
        v4u ov[4], gv[4];
#pragma unroll
        for (int u = 0; u < 4; ++u) { const int it = it0 + u * NGW; const size_t off = (size_t)(it >> 3) * 4096 + (it & 7) * 512 + lane * 8;
            if (it < M * 8) { ov[u] = *(const v4u*)(o + off); gv[u] = *(const v4u*)(g + off); } else { ov[u] = (v4u){0u, 0u, 0u, 0u}; gv[u] = ov[u]; } }
#pragma unroll
        for (int u = 0; u < 4; ++u) { const int it = it0 + u * NGW, h = it & 7; const size_t off = (size_t)(it >> 3) * 4096 + h * 512 + lane * 8;
            float x[8] = {bflo(ov[u].x), bfhi(ov[u].x), bflo(ov[u].y), bfhi(ov[u].y), bflo(ov[u].z), bfhi(ov[u].z), bflo(ov[u].w), bfhi(ov[u].w)};
            float gg[8] = {bflo(gv[u].x), bfhi(gv[u].x), bflo(gv[u].y), bfhi(gv[u].y), bflo(gv[u].z), bfhi(gv[u].z), bflo(gv[u].w), bfhi(gv[u].w)};
            float s = 0.f;
#pragma unroll
            for (int e = 0; e < 8; ++e) s += x[e];
            const float mean = wave_sum(s) * (1.0f / 512.0f); float qv = 0.f;
#pragma unroll
            for (int e = 0; e < 8; ++e) { x[e] -= mean; qv += x[e] * x[e]; }
            const float rstd = 1.0f / sqrtf(wave_sum(qv) * (1.0f / 512.0f) + EPS);
            const f32x4 g0 = *(const f32x4*)(gn + h * 512 + lane * 8), g1 = *(const f32x4*)(gn + h * 512 + lane * 8 + 4);
            float r[8];
#pragma unroll
            for (int e = 0; e < 8; ++e) { const float gw_ = e < 4 ? g0[e & 3] : g1[e & 3]; r[e] = x[e] * rstd * gw_ * (gg[e] * pg8::fast_sigmoid(gg[e])); }
            v4u w; w.x = cvtpk(r[0], r[1]); w.y = cvtpk(r[2], r[3]); w.z = cvtpk(r[4], r[5]); w.w = cvtpk(r[6], r[7]);
            if (it < M * 8) *(v4u*)(y + off) = w; }
    }
}

__device__ __forceinline__ void gm_stat_phase(Frame& F, const f32x2* part, f32x2* rstat) {
    const int lane = F.lane, gw = F.vcu * NWAVES + F.wave, NGW = F.G * NWAVES;
    for (int row = gw; row < M; row += NGW) {
        float s = 0.f, ss = 0.f;
        if (lane < 48) { const f32x4 p = *(const f32x4*)(part + (size_t)row * 96 + lane * 2); s = p.x + p.z; ss = p.y + p.w; }
        s = wave_sum(s); ss = wave_sum(ss);
        const float mean = s * (1.0f / GM_HALF), var = fmaxf(ss * (1.0f / GM_HALF) - mean * mean, 0.f);
        if (lane == 0) rstat[row] = (f32x2){mean, 1.0f / sqrtf(var + EPS)};
    }
}
__device__ __forceinline__ void gm_spatial_phase(Frame& F, const bf16* u, const bf16* v, const f32x2* rstat, const float* lng, const float* lnb, const bf16* wtri, const float* bsp, bf16* y) {
    constexpr int RSW = 272, RSN = 528;
    const ldsp LW = F.lds, LN = F.lds + 34816;
    const int tid = F.tid, lane = F.lane, w = F.wave, g4 = lane >> 4, l15 = lane & 15;
    for (int wgi = F.vcu; wgi < 256; wgi += F.G) {
        const int gg = wgi & 7, jj = wgi >> 3;
        __syncthreads();
#pragma unroll
        for (int ps = 0; ps < 4; ++ps) { const int id = ps * NTHR + tid, t = id >> 4, c = id & 15;
            *(LAS v4u*)(LW + t * RSW + c * 16) = *(const v4u*)(wtri + ((size_t)gg * 128 + t) * 128 + c * 8); }
        float bs[8];
#pragma unroll
        for (int tt = 0; tt < 8; ++tt) bs[tt] = bsp[gg * 128 + 16 * tt + l15];
        v4u vr[8], ur[8];
#define GS_ROW0(i_) ((((jj) * 6 + (i_)) / 3) * 128)
#define GS_COL0(i_) (gg * 768 + (((jj) * 6 + (i_)) % 3) * 256)
#define GS_LDV(i_) do { _Pragma("unroll") for (int ps = 0; ps < 8; ++ps) { const int id_ = ps * NTHR + tid; vr[ps] = *(const v4u*)(v + (size_t)(GS_ROW0(i_) + (id_ >> 5)) * GM_HALF + GS_COL0(i_) + (id_ & 31) * 8); } } while (0)
        GS_LDV(0);
        for (int ui = 0; ui < 6; ++ui) {
            const int row0 = GS_ROW0(ui), col0 = GS_COL0(ui);
            __syncthreads();
#pragma unroll
            for (int ps = 0; ps < 8; ++ps) { const int id = ps * NTHR + tid, r = id >> 5, c8 = (id & 31) * 8;
                const v4u vv = vr[ps]; const f32x2 rs = rstat[row0 + r];
                const f32x4 ga = *(const f32x4*)(lng + col0 + c8), gb = *(const f32x4*)(lng + col0 + c8 + 4), ba = *(const f32x4*)(lnb + col0 + c8), bb = *(const f32x4*)(lnb + col0 + c8 + 4);
                v4u o;
                o.x = cvtpk((bflo(vv.x) - rs.x) * rs.y * ga[0] + ba[0], (bfhi(vv.x) - rs.x) * rs.y * ga[1] + ba[1]);
                o.y = cvtpk((bflo(vv.y) - rs.x) * rs.y * ga[2] + ba[2], (bfhi(vv.y) - rs.x) * rs.y * ga[3] + ba[3]);
                o.z = cvtpk((bflo(vv.z) - rs.x) * rs.y * gb[0] + bb[0], (bfhi(vv.z) - rs.x) * rs.y * gb[1] + bb[1]);
                o.w = cvtpk((bflo(vv.w) - rs.x) * rs.y * gb[2] + bb[2], (bfhi(vv.w) - rs.x) * rs.y * gb[3] + bb[3]);
                *(LAS v4u*)(LN + r * RSN + c8 * 2) = o; }
#pragma unroll
            for (int ps = 0; ps < 8; ++ps) { const int id_ = ps * NTHR + tid; ur[ps] = *(const v4u*)(u + (size_t)(row0 + (id_ >> 5)) * GM_HALF + col0 + (id_ & 31) * 8); }
            if (ui + 1 < 6) GS_LDV(ui + 1);
            __syncthreads();
            f32x4 acc[2][8];
#pragma unroll
            for (int ci = 0; ci < 2; ++ci)
#pragma unroll
                for (int tt = 0; tt < 8; ++tt) acc[ci][tt] = (f32x4){0.f, 0.f, 0.f, 0.f};
#pragma unroll
            for (int ks = 0; ks < 4; ++ks) {
                const bf16x8 a0 = frag_tr(LN + (32 * ks) * RSN + (32 * w) * 2, RSN, lane), a1 = frag_tr(LN + (32 * ks) * RSN + (32 * w + 16) * 2, RSN, lane);
#pragma unroll
                for (int tt = 2 * ks; tt < 8; ++tt) { const bf16x8 bfr = frag_row(LW + (16 * tt) * RSW + ks * 64, RSW, lane);
                    acc[0][tt] = MFMA16(a0, bfr, acc[0][tt]); acc[1][tt] = MFMA16(a1, bfr, acc[1][tt]); }
            }
            __syncthreads();
#pragma unroll
            for (int ci = 0; ci < 2; ++ci)
#pragma unroll
                for (int tt = 0; tt < 8; ++tt) { v2u pk; pk.x = cvtpk(acc[ci][tt][0] + bs[tt], acc[ci][tt][1] + bs[tt]); pk.y = cvtpk(acc[ci][tt][2] + bs[tt], acc[ci][tt][3] + bs[tt]);
                    *(LAS v2u*)(LN + (16 * tt + l15) * RSN + (32 * w + 16 * ci + 4 * g4) * 2) = pk; }
            __syncthreads();
#pragma unroll
            for (int ps = 0; ps < 8; ++ps) { const int id = ps * NTHR + tid, r = id >> 5, c8 = (id & 31) * 8;
                const v4u mv = *(const LAS v4u*)(LN + r * RSN + c8 * 2); const size_t off = (size_t)(row0 + r) * GM_HALF + col0 + c8; const v4u uv = ur[ps];
                v4u o; o.x = cvtpk(bflo(uv.x) * bflo(mv.x), bfhi(uv.x) * bfhi(mv.x)); o.y = cvtpk(bflo(uv.y) * bflo(mv.y), bfhi(uv.y) * bfhi(mv.y));
                o.z = cvtpk(bflo(uv.z) * bflo(mv.z), bfhi(uv.z) * bfhi(mv.z)); o.w = cvtpk(bflo(uv.w) * bflo(mv.w), bfhi(uv.w) * bfhi(mv.w));
                *(v4u*)(y + off) = o; }
        }
#undef GS_ROW0
#undef GS_COL0
#undef GS_LDV
    }
}

__device__ __forceinline__ void fox_prep_phase(Frame& F, const bf16* x, const float* rs, const float* gmix, const float* wfox, const float* bfg, float* lf) {
    const int lane = F.lane, gw = F.vcu * NWAVES + F.wave, NGW = F.G * NWAVES;
    for (int idx = F.tid; idx < DM * 4; idx += NTHR) { const int k = idx >> 2, qd = idx & 3; const f32x4 w = *(const f32x4*)(wfox + (size_t)k * FOX_LD + FOX_N + 4 * qd) * gmix[k];
        const int slot = ((k >> 8) * 4 + (k & 3)) * 64 + ((k >> 2) & 63);
        *(LAS f32x4*)(F.lds + qd * 32768 + slot * 16) = w; }
    __syncthreads();
    for (int m = gw; m < M; m += NGW) {
        const v2u* xr = (const v2u*)(x + (size_t)m * DM) + lane;
        f32x4 v[8];
#pragma unroll
        for (int j = 0; j < 8; ++j) { const v2u t = xr[64 * j]; v[j] = (f32x4){bflo(t.x), bfhi(t.x), bflo(t.y), bfhi(t.y)}; }
        f32x4 a[4];
#pragma unroll
        for (int qd = 0; qd < 4; ++qd) a[qd] = (f32x4){0.f, 0.f, 0.f, 0.f};
#pragma unroll
        for (int j = 0; j < 8; ++j)
#pragma unroll
            for (int e = 0; e < 4; ++e) { const float hv = v[j][e];
#pragma unroll
                for (int qd = 0; qd < 4; ++qd) a[qd] += hv * *(const LAS f32x4*)(F.lds + qd * 32768 + ((j * 4 + e) * 64 + lane) * 16);
                asm volatile("" ::: "memory"); }
        float z = 0.f;
#pragma unroll
        for (int qd = 0; qd < 4; ++qd)
#pragma unroll
            for (int i = 0; i < 4; ++i) { const float t = wave_sum(a[qd][i]); z = (lane == qd * 4 + i) ? t : z; }
        if (lane < 16) lf[(size_t)m * 16 + lane] = log_sigmoid(z * pg8::row_rstd(rs, m) + bfg[lane]);
    }
}

typedef float f32x16 __attribute__((ext_vector_type(16)));
#define MFMA32(a, b, c) __builtin_amdgcn_mfma_f32_32x32x16_bf16((a), (b), (c), 0, 0, 0)
__device__ __forceinline__ void fox_attn_phase(Frame& F, const bf16* qn, const bf16* kn, const bf16* vv, const bf16* gs, const float* lf, bf16* y) {
    constexpr int RSK = 272, RSV = 320, KSLOT = 64 * RSK, VSLOT = 64 * RSV;
    const ldsp LK = F.lds, LV = F.lds + 2 * KSLOT;
    LAS float* c2 = (LAS float*)(F.lds + 75776);
    LAS float* red = (LAS float*)(F.lds + 92160);
    const int tid = F.tid, lane = F.lane, w = F.wave, r32 = lane & 31, hi = lane >> 5;
    int bh_have = -1;
    for (int pr = F.vcu; pr < 256; pr += F.G) {
        const int bh = pr >> 3, pi = pr & 7, b = bh >> 4, h = bh & 15;
        const size_t tok0 = (size_t)b * SEQ;
        if (bh != bh_have) {
            bh_have = bh;
            float x8[8]; float run = 0.f;
#pragma unroll
            for (int e = 0; e < 8; ++e) { run += lf[(tok0 + tid * 8 + e) * 16 + h]; x8[e] = run; }
            float inc = run;
#pragma unroll
            for (int o = 1; o < 64; o <<= 1) { const float t = __shfl_up(inc, o); if (lane >= o) inc += t; }
            __syncthreads();
            if (lane == 63) red[w] = inc;
            __syncthreads();
            float pre = inc - run;
#pragma unroll
            for (int wv = 0; wv < 8; ++wv) if (wv < w) pre += red[wv];
#pragma unroll
            for (int e = 0; e < 8; ++e) c2[tid * 8 + e] = (pre + x8[e]) * LOG2E;
        }
        for (int half = 0; half < 2; ++half) {
            const int qb = half ? 15 - pi : pi, q0 = qb * 256, ntile = 4 * qb + 4, qrow = q0 + 32 * w + r32;
            bf16x8 qf[8];
#pragma unroll
            for (int ks = 0; ks < 8; ++ks) qf[ks] = *(const bf16x8*)(qn + (tok0 + qrow) * DM + h * 128 + ks * 16 + 8 * hi);
            v4u kr[2], vr[2];
#define FA_LOAD(tt) do { _Pragma("unroll") for (int pp = 0; pp < 2; ++pp) { const int id_ = tid + NTHR * pp, r_ = id_ >> 4, c_ = id_ & 15; \
                kr[pp] = *(const v4u*)(kn + (tok0 + 64 * (tt) + r_) * DM + h * 128 + c_ * 8); vr[pp] = *(const v4u*)(vv + (tok0 + 64 * (tt) + r_) * DM + h * 128 + c_ * 8); } } while (0)
#define FA_STORE(sl) do { _Pragma("unroll") for (int pp = 0; pp < 2; ++pp) { const int id_ = tid + NTHR * pp, r_ = id_ >> 4, c_ = id_ & 15; \
                *(LAS v4u*)(LK + (sl) * KSLOT + r_ * RSK + c_ * 16) = kr[pp]; *(LAS v4u*)(LV + (sl) * VSLOT + r_ * RSV + c_ * 16) = vr[pp]; } } while (0)
            FA_LOAD(0);
            __syncthreads();
            FA_STORE(0);
            if (ntile > 1) FA_LOAD(1);
            const float cq = c2[qrow];
            float mx = 0.f, ls = 0.f;
            f32x16 O[4];
#pragma unroll
            for (int dt = 0; dt < 4; ++dt)
#pragma unroll
                for (int r = 0; r < 16; ++r) O[dt][r] = 0.f;
            for (int t = 0; t < ntile; ++t) {
                __syncthreads();
                if (t + 1 < ntile) { FA_STORE((t + 1) & 1); if (t + 2 < ntile) FA_LOAD(t + 2); }
                const int key0 = 64 * t;
                if (key0 <= q0 + 32 * w + 31) {
                    const ldsp sk = LK + (t & 1) * KSLOT + r32 * RSK + 16 * hi, sv = LV + (t & 1) * VSLOT;
                    f32x16 S0, S1;
                    const float cbase = cq - mx;
#pragma unroll
                    for (int g = 0; g < 4; ++g) { const f32x4 ck0 = *(const LAS f32x4*)(c2 + key0 + 8 * g + 4 * hi), ck1 = *(const LAS f32x4*)(c2 + key0 + 32 + 8 * g + 4 * hi);
#pragma unroll
                        for (int e = 0; e < 4; ++e) { S0[4 * g + e] = cbase - ck0[e]; S1[4 * g + e] = cbase - ck1[e]; } }
#pragma unroll
                    for (int ks = 0; ks < 8; ++ks) { S0 = MFMA32(*(const LAS bf16x8*)(sk + ks * 32), qf[ks], S0); S1 = MFMA32(*(const LAS bf16x8*)(sk + 32 * RSK + ks * 32), qf[ks], S1); }
                    if (key0 + 63 > q0 + 32 * w) {
#pragma unroll
                        for (int g = 0; g < 4; ++g)
#pragma unroll
                            for (int e = 0; e < 4; ++e) { const int key = key0 + 8 * g + 4 * hi + e; if (key > qrow) S0[4 * g + e] = -INFINITY; if (key + 32 > qrow) S1[4 * g + e] = -INFINITY; } }
                    float mloc = fmaxf(S0[0], S1[0]);
#pragma unroll
                    for (int r = 1; r < 16; ++r) mloc = __builtin_fmaxf(__builtin_fmaxf(mloc, S0[r]), S1[r]);
                    mloc = fmaxf(mloc, __shfl_xor(mloc, 32));
                    if (__any(mloc > 8.0f)) { const float dl = fmaxf(mloc, 0.f), alpha = __builtin_amdgcn_exp2f(-dl); mx += dl; ls *= alpha;
#pragma unroll
                        for (int r = 0; r < 16; ++r) { S0[r] -= dl; S1[r] -= dl; }
#pragma unroll
                        for (int dt = 0; dt < 4; ++dt)
#pragma unroll
                            for (int r = 0; r < 16; ++r) O[dt][r] *= alpha; }
                    float psum = 0.f;
#pragma unroll
                    for (int r = 0; r < 16; ++r) { S0[r] = __builtin_amdgcn_exp2f(S0[r]); S1[r] = __builtin_amdgcn_exp2f(S1[r]); psum += S0[r] + S1[r]; }
                    ls += psum;
                    v4u pf[4];
#pragma unroll
                    for (int s2 = 0; s2 < 2; ++s2) { pf[s2] = (v4u){cvtpk(S0[8 * s2 + 0], S0[8 * s2 + 1]), cvtpk(S0[8 * s2 + 2], S0[8 * s2 + 3]), cvtpk(S0[8 * s2 + 4], S0[8 * s2 + 5]), cvtpk(S0[8 * s2 + 6], S0[8 * s2 + 7])};
                        pf[2 + s2] = (v4u){cvtpk(S1[8 * s2 + 0], S1[8 * s2 + 1]), cvtpk(S1[8 * s2 + 2], S1[8 * s2 + 3]), cvtpk(S1[8 * s2 + 4], S1[8 * s2 + 5]), cvtpk(S1[8 * s2 + 6], S1[8 * s2 + 7])}; }
                    const ldsp vb = sv + (4 * hi + ((lane & 15) >> 2)) * RSV + (16 * ((lane >> 4) & 1) + 4 * (lane & 3)) * 2;
#pragma unroll
                    for (int s4 = 0; s4 < 4; ++s4)
#pragma unroll
                        for (int dt = 0; dt < 4; ++dt) { const ldsp va = vb + (16 * s4) * RSV + dt * 64; const s16x4 lo = vtr(va), hv = vtr(va + 8 * RSV);
                            const bf16x8 af = (bf16x8){lo[0], lo[1], lo[2], lo[3], hv[0], hv[1], hv[2], hv[3]};
                            O[dt] = MFMA32(af, __builtin_bit_cast(bf16x8, pf[s4]), O[dt]); }
                }
            }
            ls += __shfl_xor(ls, 32);
            const float il = 1.0f / ls;
            const size_t yoff = (tok0 + qrow) * DM + h * 128 + 4 * hi;
#pragma unroll
            for (int dt = 0; dt < 4; ++dt)
#pragma unroll
                for (int g = 0; g < 4; ++g) { const v2u gv = *(const v2u*)(gs + yoff + dt * 32 + 8 * g);
                    v2u o; o.x = cvtpk(O[dt][4 * g + 0] * il * bflo(gv.x), O[dt][4 * g + 1] * il * bfhi(gv.x)); o.y = cvtpk(O[dt][4 * g + 2] * il * bflo(gv.y), O[dt][4 * g + 3] * il * bfhi(gv.y));
                    *(v2u*)(y + yoff + dt * 32 + 8 * g) = o; }
        }
    }
#undef FA_LOAD
#undef FA_STORE
}
#ifndef R_RET_CORE
#define R_RET_CORE 1
#endif
#ifndef R_RET_GN
#define R_RET_GN 1
#endif
#ifndef R_GM_SP
#define R_GM_SP 1
#endif
#ifndef R_FOX_ATTN
#define R_FOX_ATTN 1
#endif
#ifndef R_FOX_PREP
#define R_FOX_PREP 1
#endif
#ifndef R_PRO
#define R_PRO 1
#endif
#ifndef F_GU_TAIL
#define F_GU_TAIL 0
#endif

#ifndef PROBE_A
#define PROBE_A -1
#endif
#ifndef PROBE_B
#define PROBE_B -1
#endif
#ifndef PROBE_MUL
#define PROBE_MUL 4
#endif
#define STAMP_AT(id) do { if (PROBE_A >= 0 && ((id) == PROBE_A || (id) == PROBE_B)) { if (F.tid == 0) { const unsigned long long t_ = __builtin_amdgcn_s_memrealtime(); \
        volatile LAS unsigned* m_ = F.MISC + ((id) == PROBE_A ? 16 : 20); m_[0] = (unsigned)t_; m_[1] = (unsigned)(t_ >> 32); } } } while (0)
struct Args { const void* in[21]; float* out; unsigned char* ws; int ph_lo, ph_hi, li, pad; };
#define IN(k) (lo <= (k) && (k) < hi)
#define SEAM(k) do { if (N_LAUNCHES == 1 && IN(k) && IN((k) + 1)) xcd_barrier(bar); STAMP_AT(k); } while (0)
template <int L>
__device__ __forceinline__ void layer_body(Frame& F, const Args& args, const XcdBarrier& bar, const int lo, const int hi) {
    unsigned char* ws = args.ws;
    constexpr int kind = L % 3, j = L / 3, pb = 1 + 6 * L;
    float* xo = args.out;
    bf16* XB = (bf16*)(ws + WS_H);
    bf16* A0 = (bf16*)(ws + WS_A); bf16* B0 = (bf16*)(ws + WS_B); bf16* C0 = (bf16*)(ws + WS_C);
    unsigned char* misc = ws + WS_MISC;
    float* rss = (float*)(ws + WS_RSP);
    PG8_LAS float* rtab = (PG8_LAS float*)(F.lds + RSTAB_OFF);
    if (IN(pb + 0)) {
        if (kind == 0) {
            pg8::Gemm g{XB, (const bf16*)(ws + WS_W_RET_IN + j * SZ_W_RET_IN), M, RET_N, DM}; pg8::RsOrder S; S.init(M, RET_N, F.G, (int)blockIdx.x); S.rs = rss + (size_t)(2 * L) * M * 32; S.tab = rtab; S.pend = 0.f; S.nready = 0;
            pg8::EpiRetIn E{A0, A0 + (size_t)M * 2048, A0 + (size_t)M * 4096, A0 + (size_t)M * 8192, (const float*)(ws + WS_ROPE_C), (const float*)(ws + WS_ROPE_S), rtab, 0};
            pg8::gemm_phase<pg8::EpiRetIn, pg8::RsOrder, PG8_ALIGN, PG8_SP2>(F.lds + RING_OFF, g, S, E);
        } else if (kind == 1) {
            pg8::Gemm g{XB, (const bf16*)(ws + WS_W_GM_IN), M, GM_N, DM}; pg8::RsOrder S; S.init(M, GM_N, F.G, (int)blockIdx.x); S.rs = rss + (size_t)(2 * L) * M * 32; S.tab = rtab; S.pend = 0.f; S.nready = 0;
            pg8::EpiGeluUV E{A0, A0 + (size_t)M * GM_HALF, (pg8::f32x2v*)(misc + MISC_PART), rtab, 0};
            pg8::gemm_phase<pg8::EpiGeluUV, pg8::RsOrder, PG8_ALIGN, PG8_SP2>(F.lds + RING_OFF, g, S, E);
        } else {
            pg8::Gemm g{XB, (const bf16*)(ws + WS_W_FOX_IN), M, FOX_N, DM}; pg8::RsOrder S; S.init(M, FOX_N, F.G, (int)blockIdx.x); S.rs = rss + (size_t)(2 * L) * M * 32; S.tab = rtab; S.pend = 0.f; S.nready = 0;
            PG8_LAS float* qkg = (PG8_LAS float*)(F.lds + QKG_OFF);
            if (F.tid < 256) qkg[F.tid] = F.tid < 128 ? ((const float*)args.in[15])[F.tid] : ((const float*)args.in[16])[F.tid - 128];
            __syncthreads();
            pg8::EpiFoxIn E{A0, (size_t)M * 2048, rtab, 0, (PG8_LAS float*)(F.lds + QKT_OFF), qkg};
            pg8::gemm_phase<pg8::EpiFoxIn, pg8::RsOrder, PG8_ALIGN, PG8_SP2>(F.lds + RING_OFF, g, S, E);
        }
    }
    SEAM(pb + 0);
    if (IN(pb + 1)) {
        if (kind == 0) { bf16* Pb = B0 + (size_t)M * 4096;
            bf16* KFb = (bf16*)(ws + WS_KF);
            bf16* QFb = (bf16*)(ws + WS_QF);
            ret_p_phase(F, A0, A0 + (size_t)M * 2048, Pb, KFb, QFb);
            if (N_LAUNCHES == 1) xcd_barrier(bar);
            STAMP_AT(500 + L);
            for (int rep_ = 0; rep_ < R_RET_CORE; ++rep_) ret_core_phase(F, QFb, A0 + (size_t)M * 4096, Pb, KFb, B0); }
        else if (kind == 1) { gm_stat_phase(F, (const f32x2*)(misc + MISC_PART), (f32x2*)(misc + MISC_RSTAT)); }
        else { for (int rep_ = 0; rep_ < R_FOX_PREP; ++rep_) fox_prep_phase(F,
                              XB, rss + (size_t)(2 * L) * M * 32, (const float*)args.in[2] + (size_t)L * DM, (const float*)args.in[13], (const float*)args.in[14], (float*)(misc + MISC_LF)); }
    }
    SEAM(pb + 1);
    if (IN(pb + 2)) {
        if (kind == 0) { for (int rep_ = 0; rep_ < R_RET_GN; ++rep_) ret_gn_phase(F, B0, A0 + (size_t)M * 8192, (const float*)args.in[5] + (size_t)j * 4096, C0); }
        else if (kind == 1) { for (int rep_ = 0; rep_ < R_GM_SP; ++rep_) gm_spatial_phase(F, A0, A0 + (size_t)M * GM_HALF, (const f32x2*)(misc + MISC_RSTAT), (const float*)args.in[8], (const float*)args.in[9], (const bf16*)(misc + MISC_WTRI), (const float*)args.in[11], B0); }
        else { for (int rep_ = 0; rep_ < R_FOX_ATTN; ++rep_) fox_attn_phase(F, A0, A0 + (size_t)M * 2048, A0 + (size_t)M * 4096, A0 + (size_t)M * 6144, (const float*)(misc + MISC_LF), B0); }
    }
    SEAM(pb + 2);
    if (IN(pb + 3)) {
        const bf16* Ain = kind == 0 ? C0 : B0; constexpr int K = kind == 0 ? 4096 : (kind == 1 ? GM_HALF : DM);
        const bf16* Wt = kind == 0 ? (const bf16*)(ws + WS_W_RET_OUT + j * SZ_W_RET_OUT) : (kind == 1 ? (const bf16*)(ws + WS_W_GM_OUT) : (const bf16*)(ws + WS_W_FOX_OUT));
        pg8::Gemm g{Ain, Wt, M, DM, K}; pg8::StaticOrder S; S.init(M, DM, F.G, (int)blockIdx.x);
        pg8::EpiRes<L == 0, false> E{(const float*)args.in[0], nullptr, XB, rss + (size_t)(2 * L + 1) * M * 32, DM};
        pg8::gemm_phase<pg8::EpiRes<L == 0, false>, pg8::StaticOrder, PG8_ALIGN, PG8_SP2>(F.lds + RING_OFF, g, S, E);
    }
    SEAM(pb + 3);
    if (IN(pb + 4)) {
        constexpr int NFULL = (F_GU_TAIL ? 40 : 44) * 256;
        { pg8::Gemm g{XB, (const bf16*)(ws + WS_W_GU + L * SZ_W_GU), M, NFULL, DM}; pg8::RsOrder S; S.init(M, NFULL, F.G, (int)blockIdx.x); S.rs = rss + (size_t)(2 * L + 1) * M * 32; S.tab = rtab; S.pend = 0.f; S.nready = 0;
          pg8::EpiSwiglu<false> E{A0, FFN_H, rtab, 0};
          pg8::gemm_phase<pg8::EpiSwiglu<false>, pg8::RsOrder, PG8_ALIGN, PG8_SP2>(F.lds + RING_OFF, g, S, E); }
        if (F_GU_TAIL) { pg8::Gemm g{XB, (const bf16*)(ws + WS_W_GU + L * SZ_W_GU), M, FFN_N2, DM}; pg8::TailOrder S; S.init(M, FFN_N2, F.G, (int)blockIdx.x); S.rs = rss + (size_t)(2 * L + 1) * M * 32; S.tab = rtab; S.pend = 0.f; S.nready = 0; S.pn0 = 40;
          pg8::EpiSwiglu<true> E{A0, FFN_H, rtab, 0};
          pg8::gemm_phase<pg8::EpiSwiglu<true>, pg8::TailOrder, PG8_ALIGN, PG8_SP2, true>(F.lds + RING_OFF, g, S, E); }
    }
    SEAM(pb + 4);
    if (IN(pb + 5)) {
        pg8::Gemm g{A0, (const bf16*)(ws + WS_W_DN + L * SZ_W_DN), M, DM, FFN_H}; pg8::StaticOrder S; S.init(M, DM, F.G, (int)blockIdx.x);
        pg8::EpiRes<false, L + 1 == DEPTH> E{nullptr, xo, XB, rss + (size_t)((2 * L + 2) & 7) * M * 32, DM};
        pg8::gemm_phase<pg8::EpiRes<false, L + 1 == DEPTH>, pg8::StaticOrder, PG8_ALIGN, PG8_SP2>(F.lds + RING_OFF, g, S, E);
    }
    SEAM(pb + 5);
}
__global__ void __launch_bounds__(NWAVES * 64, 2) trunk_fwd(Args args) {
    extern __shared__ __attribute__((aligned(16))) unsigned char lds[];
    Frame F;
    F.lds = (ldsp)lds;
    F.MISC = (volatile LAS unsigned*)(F.lds + MISC_OFF);
    F.tid = threadIdx.x; F.lane = F.tid & 63; F.wave = __builtin_amdgcn_readfirstlane(F.tid >> 6);
    F.G = gridDim.x; { const int bx = blockIdx.x; F.vcu = (F.G % 8 == 0) ? (bx % 8) * (F.G / 8) + bx / 8 : bx; }
    F.ctl = (gu32*)(args.ws + WS_CTL);
    for (int u = F.tid; u < (LDS_BYTES - LDSCTL_OFF) / 4; u += NWAVES * 64) ((LAS unsigned*)(F.lds + LDSCTL_OFF))[u] = 0u;
    __syncthreads();
    XcdBarrier bar; bar.bar = (unsigned*)(F.ctl + CW_BAR); bar.x = 0; bar.st = nullptr;
    if (N_LAUNCHES == 1) bar = xcd_barrier_post((unsigned*)(F.ctl + CW_BAR), F.MISC + 8);
    const int lo = args.ph_lo, hi = args.ph_hi;
    STAMP_AT(999);
    if (IN(0)) for (int rep_ = 0; rep_ < R_PRO; ++rep_) p0_prologue(F, args.in, args.ws);
    SEAM(0);
    layer_body<0>(F, args, bar, lo, hi); layer_body<1>(F, args, bar, lo, hi); layer_body<2>(F, args, bar, lo, hi); layer_body<3>(F, args, bar, lo, hi);
    if (PROBE_A >= 0 && F.tid == 0) {
        const unsigned long long ta = ((unsigned long long)F.MISC[17] << 32) | F.MISC[16], tb = ((unsigned long long)F.MISC[21] << 32) | F.MISC[20];
        const unsigned long long dly = (tb - ta) * (unsigned long long)PROBE_MUL, t0 = __builtin_amdgcn_s_memrealtime();
        if (tb > ta && dly < 400000ull) while (__builtin_amdgcn_s_memrealtime() - t0 < dly) __builtin_amdgcn_s_sleep(16);
    }
}
#undef IN
#undef SEAM

extern "C" void kernel_launch(void* const* d_in, const int* in_sizes, int n_in, void* d_out, int out_size, void* d_ws, size_t ws_size, hipStream_t stream) {
    static int grid = 0;
    if (grid == 0) {
        if (n_in != 21 || in_sizes[0] != M * DM || out_size != M * DM || ws_size < WS_END) { fprintf(stderr, "kernel_launch: unexpected shapes (n_in %d, in0 %d, out %d, ws %zu); nothing launched\n", n_in, n_in > 0 ? in_sizes[0] : -1, out_size, ws_size); grid = -1; return; }
        int dev = 0, cus = 0, per_cu = 0;
        if (hipGetDevice(&dev) != hipSuccess || hipDeviceGetAttribute(&cus, hipDeviceAttributeMultiprocessorCount, dev) != hipSuccess) { grid = -1; return; }
        if (hipFuncSetAttribute((const void*)trunk_fwd, hipFuncAttributeMaxDynamicSharedMemorySize, LDS_BYTES) != hipSuccess) { fprintf(stderr, "kernel_launch: hipFuncSetAttribute failed\n"); grid = -1; return; }
        if (hipOccupancyMaxActiveBlocksPerMultiprocessor(&per_cu, (const void*)trunk_fwd, NWAVES * 64, LDS_BYTES) != hipSuccess || per_cu < 1)
            fprintf(stderr, "kernel_launch: note: occupancy query reports %d workgroups per CU\n", per_cu);
        (void)hipGetLastError();
        grid = cus;
    }
    if (grid < 0) return;
    if (hipMemsetAsync((char*)d_ws + WS_CTL, 0, CTL_ZERO_BYTES, stream) != hipSuccess) return;
    Args a{};
    for (int i = 0; i < 21; ++i) a.in[i] = d_in[i];
    a.out = (float*)d_out; a.ws = (unsigned char*)d_ws;
    for (int li = 0; li < N_LAUNCHES; ++li) {
        a.ph_lo = (N_LAUNCHES == 1) ? 0 : li; a.ph_hi = (N_LAUNCHES == 1) ? N_PHASES : li + 1; a.li = li; a.pad = 0;
        hipLaunchKernelGGL(trunk_fwd, dim3(grid), dim3(NWAVES * 64), LDS_BYTES, stream, a);
        const hipError_t le = hipPeekAtLastError();
        if (le != hipSuccess) { fprintf(stderr, "kernel_launch: launch %d failed: %s\n", li, hipGetErrorName(le)); break; }
    }
}
```

```cpp
#include <hip/hip_runtime.h>
#include <cstdio>
#include <cstdint>
#include <cmath>
namespace pg8 {
#define PG8_LAS __attribute__((address_space(3)))
typedef unsigned short bf16_t;
typedef short bf16x8 __attribute__((ext_vector_type(8)));
typedef float f32x4 __attribute__((ext_vector_type(4)));
typedef unsigned u32x4 __attribute__((ext_vector_type(4)));
constexpr int BM = 256, BK = 64, HALF = 128, HTB = HALF * BK * 2  , STAGE_BYTES = 8 * HTB, NXCD = 8, WGM = 8;

__host__ __device__ __forceinline__ int lds_byte(int r, int c) { const int st = (r >> 4) * 2 + (c >> 5), rr = r & 15, cc = c & 31, ob = rr * 64 + cc * 2; return st * 1024 + (ob ^ (((ob >> 9) & 1) << 5)); }
__host__ __device__ __forceinline__ void stage_rc(int b, int& R, int& C) { const int st = b / 1024, sb = b % 1024, swz = sb ^ (((sb >> 9) & 1) << 5); R = (st >> 1) * 16 + swz / 64; C = (st & 1) * 32 + (swz % 64) / 2; }
__host__ __device__ __forceinline__ int perm32(int rho) { const int n = rho >> 4, i = rho & 15; return 8 * (i >> 2) + 4 * n + (i & 3); }

struct Unit { int pm, pn, hf; };
struct Gemm { const bf16_t* A; const bf16_t* Bt; int M, N, K; };

struct StaticOrder {
    int nM, nN, nwg, G, c;
    __host__ __device__ void init(int M, int N, int G_, int c_) { nM = M / BM; nN = N / BM; nwg = nM * nN; G = G_; c = c_; }
    __host__ __device__ bool next(int i, Unit& u) const {
        const long L = (long)i * G + c; if (L >= nwg) return false;
        int wgid = (int)L; { const int q = nwg / NXCD, r = nwg % NXCD, xcd = wgid % NXCD, off = wgid / NXCD; wgid = (xcd < r ? xcd * (q + 1) : r * (q + 1) + (xcd - r) * q) + off; }
        const int nig = WGM * nN, gid = wgid / nig, fm = gid * WGM, gsz = (nM - fm) < WGM ? (nM - fm) : WGM;
        u.pm = fm + ((wgid % nig) % gsz); u.pn = (wgid % nig) / gsz; u.hf = 0; return true;
    }
    __device__ __forceinline__ void a_ready(const Unit&) const {}
    __device__ __forceinline__ void done(const Unit&) const {}
};

__device__ __forceinline__ unsigned cvt_pk_bf16(float lo, float hi) { unsigned r; asm volatile("v_cvt_pk_bf16_f32 %0, %1, %2" : "=v"(r) : "v"(lo), "v"(hi)); return r; }
typedef float f32x2 __attribute__((ext_vector_type(2)));
__device__ __forceinline__ f32x2 gelu_pk(f32x2 v) {
    const f32x2 av = __builtin_elementwise_abs(v), d = av * 0.2316418882f + 1.0f;
    f32x2 t; t.x = __builtin_amdgcn_rcpf(d.x); t.y = __builtin_amdgcn_rcpf(d.y);
    f32x2 q = t * 0.5307027145f + (-0.7265760135f); q = q * t + 0.7107068705f; q = q * t + (-0.142248368f); q = q * t + 0.127414796f; q = q * t;
    const f32x2 s = (v * v) * (-0.72134752044f);
    f32x2 e; e.x = __builtin_amdgcn_exp2f(s.x); e.y = __builtin_amdgcn_exp2f(s.y);
    const f32x2 m = v * (q * e), r = v - m;
    f32x2 o; o.x = v.x < 0.f ? m.x : r.x; o.y = v.y < 0.f ? m.y : r.y; return o;
}

typedef float f32x2v __attribute__((ext_vector_type(2)));
typedef __bf16 bf16x2v __attribute__((ext_vector_type(2)));
__device__ __forceinline__ unsigned cvtpk(float lo, float hi) { f32x2v v = {lo, hi}; bf16x2v b = __builtin_convertvector(v, bf16x2v); return __builtin_bit_cast(unsigned, b); }
__device__ __forceinline__ u32x4 pack8(const f32x4 a, const f32x4 b) { u32x4 w; w.x = cvtpk(a[0], a[1]); w.y = cvtpk(a[2], a[3]); w.z = cvtpk(b[0], b[1]); w.w = cvtpk(b[2], b[3]); return w; }
#ifndef EPI_WT
#define EPI_WT 0
#endif
__device__ __forceinline__ void st16(void* p, const u32x4 v) {
#if EPI_WT
    asm volatile("global_store_dwordx4 %0, %1, off sc1\n\ts_nop 2" :: "v"(p), "v"(v) : "memory");
#else
    *(u32x4*)p = v;
#endif
}
__device__ __forceinline__ float fast_sigmoid(float x) { return __builtin_amdgcn_rcpf(1.0f + __builtin_amdgcn_exp2f(-1.44269504f * x)); }

template <bool BASE_F32, bool OUT_F32> struct EpiRes {
    static constexpr bool PERM = true, AFTER_DRAIN = false;
    const float* base; float* out; bf16_t* xb; float* rs; int ldc;
    __device__ __forceinline__ void operator()(const f32x4 (&acc)[2][2][4][2], const Unit& u, int wr, int wc, int fr, int fq) const {
        const int row0 = u.pm * BM + wr * 64 + fr, col0 = u.pn * BM + wc * 32 + 8 * fq;
#pragma unroll
        for (int ai = 0; ai < 2; ++ai)
#pragma unroll
            for (int m = 0; m < 4; ++m) { const int row = row0 + ai * HALF + m * 16; const size_t off = (size_t)row * ldc + col0; float ss = 0.f;
#pragma unroll
                for (int bj = 0; bj < 2; ++bj) { f32x4 b0, b1;
                    if (BASE_F32) { b0 = *(const f32x4*)(base + off + bj * HALF); b1 = *(const f32x4*)(base + off + bj * HALF + 4); }
                    else { const u32x4 w = *(const u32x4*)(xb + off + bj * HALF);
                        b0 = (f32x4){__uint_as_float(w.x << 16), __uint_as_float(w.x & 0xffff0000u), __uint_as_float(w.y << 16), __uint_as_float(w.y & 0xffff0000u)};
                        b1 = (f32x4){__uint_as_float(w.z << 16), __uint_as_float(w.z & 0xffff0000u), __uint_as_float(w.w << 16), __uint_as_float(w.w & 0xffff0000u)}; }
                    const f32x4 x0 = b0 + acc[ai][bj][m][0], x1 = b1 + acc[ai][bj][m][1];
                    if (OUT_F32) { *(f32x4*)(out + off + bj * HALF) = x0; *(f32x4*)(out + off + bj * HALF + 4) = x1; }
                    else st16(xb + off + bj * HALF, pack8(x0, x1));
                    ss += (x0[0] * x0[0] + x0[1] * x0[1]) + (x0[2] * x0[2] + x0[3] * x0[3]) + (x1[0] * x1[0] + x1[1] * x1[1]) + (x1[2] * x1[2] + x1[3] * x1[3]); }
                if (!OUT_F32) { ss += __shfl_xor(ss, 16); ss += __shfl_xor(ss, 32);
                    if (fq == 0) rs[(size_t)row * 32 + u.pn * 4 + wc] = ss; }
                if (m & 1) asm volatile("" ::: "memory"); }
    }
};
__device__ __forceinline__ float row_sumsq(const float* rs, int row) {
    const f32x4* p = (const f32x4*)(rs + (size_t)row * 32); f32x4 t = p[0];
#pragma unroll
    for (int i = 1; i < 8; ++i) t += p[i];
    return (t[0] + t[1]) + (t[2] + t[3]);
}
__device__ __forceinline__ float row_rstd(const float* rs, int row) { return 1.0f / sqrtf(row_sumsq(rs, row) * (1.0f / 2048.0f) + 1e-6f); }
struct RsOrder : StaticOrder {
    const float* rs; PG8_LAS float* tab; mutable float pend; mutable int nready;
    __device__ __forceinline__ void a_ready(const Unit& u) const {
        if (threadIdx.x < 256) pend = row_sumsq(rs, u.pm * BM + u.hf * HALF + threadIdx.x);
        ++nready;
    }
    __device__ __forceinline__ bool next(int i, Unit& u) const {
        if (i == 1 && threadIdx.x < 256) tab[threadIdx.x] = 1.0f / sqrtf(pend * (1.0f / 2048.0f) + 1e-6f);
        return StaticOrder::next(i, u);
    }
    __device__ __forceinline__ void done(const Unit&) const {
        if (threadIdx.x < 256) tab[((nready - 1) & 1) * 256 + threadIdx.x] = 1.0f / sqrtf(pend * (1.0f / 2048.0f) + 1e-6f);
    }
};
struct TailOrder : RsOrder {
    int pn0;
    __device__ __forceinline__ bool next(int i, Unit& u) const {
        if (i == 1 && threadIdx.x < 256) tab[threadIdx.x] = 1.0f / sqrtf(pend * (1.0f / 2048.0f) + 1e-6f);
        if (i != 0 || G != 256) return false;
        const int x = c & 7, l = c >> 3; u.pm = 4 * x + (l & 3); u.hf = (l >> 2) & 1; u.pn = pn0 + (l >> 3); return true;
    }
};
template <bool HALF_M> struct EpiSwiglu {
    static constexpr bool PERM = true, AFTER_DRAIN = false;
    bf16_t* O; int ldc; const PG8_LAS float* tab; mutable int ui;
    __device__ __forceinline__ void operator()(const f32x4 (&acc)[2][2][4][2], const Unit& u, int wr, int wc, int fr, int fq) const {
        const int row0 = u.pm * BM + (HALF_M ? u.hf * HALF : 0) + wr * 64 + fr, col0 = u.pn * HALF + wc * 32 + 8 * fq;
#pragma unroll
        for (int ai = 0; ai < (HALF_M ? 1 : 2); ++ai)
#pragma unroll
            for (int m = 0; m < 4; ++m) { bf16_t* rowp = O + (size_t)(row0 + ai * HALF + m * 16) * ldc + col0; const float r = tab[(ui & 1) * 256 + wr * 64 + fr + ai * HALF + m * 16];
                f32x4 v0, v1;
#pragma unroll
                for (int j = 0; j < 4; ++j) { const float g0 = acc[ai][0][m][0][j] * r, g1 = acc[ai][0][m][1][j] * r;
                    v0[j] = g0 * fast_sigmoid(g0) * (acc[ai][1][m][0][j] * r); v1[j] = g1 * fast_sigmoid(g1) * (acc[ai][1][m][1][j] * r); }
                st16(rowp, pack8(v0, v1)); }
        ++ui;
    }
};

struct EpiSwigluProbe {
    static constexpr bool PERM = true, AFTER_DRAIN = false;
    bf16_t* O; int never;
    __device__ __forceinline__ void operator()(const f32x4 (&acc)[2][2][4][2], const Unit& u, int wr, int wc, int fr, int fq) const {
        if (never) {
#pragma unroll
        for (int ai = 0; ai < 2; ++ai)
#pragma unroll
            for (int m = 0; m < 4; ++m) { bf16_t* rowp = O + (size_t)(u.pm * BM + wr * 64 + fr + ai * HALF + m * 16) * 5632 + u.pn * HALF + wc * 32 + 8 * fq;
                st16(rowp, pack8(acc[ai][0][m][0] + acc[ai][1][m][0], acc[ai][0][m][1] + acc[ai][1][m][1])); } }
    }
};
struct EpiRetIn {
    static constexpr bool PERM = true, AFTER_DRAIN = false;
    bf16_t *q, *k, *v, *g; const float *cs, *sn; const PG8_LAS float* tab; mutable int ui;
    __device__ __forceinline__ void operator()(const f32x4 (&acc)[2][2][4][2], const Unit& u, int wr, int wc, int fr, int fq) const {
        const int pn = u.pn, ci = wc * 32 + 8 * fq;
#pragma unroll
        for (int ai = 0; ai < 2; ++ai)
#pragma unroll
            for (int m = 0; m < 4; ++m) {
                const int row = u.pm * BM + ai * HALF + wr * 64 + m * 16 + fr, b = row >> 12, s = row & 4095; const float rr = tab[(ui & 1) * 256 + ai * HALF + wr * 64 + m * 16 + fr];
                if (pn < 16) {
                    const int h = pn & 7; const float sc = (pn < 8 ? 1.0f : 0.0625f) * rr;
                    bf16_t* dst = (pn < 8 ? q : k) + ((size_t)((b * 8 + h) * 4096 + s)) * 256 + ci;
                    f32x4 o1[2], o2[2];
#pragma unroll
                    for (int n = 0; n < 2; ++n) { const f32x4 c4 = *(const f32x4*)(cs + (size_t)row * 128 + ci + 4 * n), s4 = *(const f32x4*)(sn + (size_t)row * 128 + ci + 4 * n);
                        const f32x4 x1 = acc[ai][0][m][n], x2 = acc[ai][1][m][n];
                        o1[n] = (x1 * c4 - x2 * s4) * sc; o2[n] = (x2 * c4 + x1 * s4) * sc; }
                    st16(dst, pack8(o1[0], o1[1])); st16(dst + 128, pack8(o2[0], o2[1]));
                } else if (pn < 32) {
                    const int t = pn - 16, h = t >> 1, hf = t & 1;
                    bf16_t* dst = v + ((size_t)((b * 8 + h) * 4096 + s)) * 512 + hf * 256 + ci;
                    st16(dst, pack8(acc[ai][0][m][0] * rr, acc[ai][0][m][1] * rr)); st16(dst + 128, pack8(acc[ai][1][m][0] * rr, acc[ai][1][m][1] * rr));
                } else {
                    bf16_t* dst = g + (size_t)row * 4096 + (pn - 32) * 256 + ci;
                    st16(dst, pack8(acc[ai][0][m][0] * rr, acc[ai][0][m][1] * rr)); st16(dst + 128, pack8(acc[ai][1][m][0] * rr, acc[ai][1][m][1] * rr));
                }
            }
        ++ui;
    }
};
struct EpiGeluUV {
    static constexpr bool PERM = true, AFTER_DRAIN = false;
    bf16_t *uo, *vo; f32x2v* part; const PG8_LAS float* tab; mutable int ui;
    __device__ __forceinline__ void operator()(const f32x4 (&acc)[2][2][4][2], const Unit& u, int wr, int wc, int fr, int fq) const {
        const bool isv = u.pn >= 24; const int ct = isv ? u.pn - 24 : u.pn; bf16_t* dstb = isv ? vo : uo;
#pragma unroll
        for (int ai = 0; ai < 2; ++ai)
#pragma unroll
            for (int m = 0; m < 4; ++m) {
                const int row = u.pm * BM + ai * HALF + wr * 64 + m * 16 + fr;
                bf16_t* dst = dstb + (size_t)row * 6144 + ct * 256 + wc * 32 + 8 * fq;
                float s = 0.f, ss = 0.f; const float rr = tab[(ui & 1) * 256 + ai * HALF + wr * 64 + m * 16 + fr];
#pragma unroll
                for (int bj = 0; bj < 2; ++bj) { const f32x4 v0 = acc[ai][bj][m][0] * rr, v1 = acc[ai][bj][m][1] * rr;
                    const f32x2 a = gelu_pk((f32x2){v0[0], v0[1]}), b = gelu_pk((f32x2){v0[2], v0[3]}), c = gelu_pk((f32x2){v1[0], v1[1]}), d = gelu_pk((f32x2){v1[2], v1[3]});
                    const f32x4 z0 = {a.x, a.y, b.x, b.y}, z1 = {c.x, c.y, d.x, d.y};
                    st16(dst + bj * HALF, pack8(z0, z1));
                    s += (z0[0] + z0[1]) + (z0[2] + z0[3]) + (z1[0] + z1[1]) + (z1[2] + z1[3]);
                    ss += (z0[0] * z0[0] + z0[1] * z0[1]) + (z0[2] * z0[2] + z0[3] * z0[3]) + (z1[0] * z1[0] + z1[1] * z1[1]) + (z1[2] * z1[2] + z1[3] * z1[3]); }
                if (isv) { s += __shfl_xor(s, 16); s += __shfl_xor(s, 32); ss += __shfl_xor(ss, 16); ss += __shfl_xor(ss, 32);
                    if (fq == 0) part[((size_t)row * 24 + ct) * 4 + wc] = (f32x2v){s, ss}; }
            }
        ++ui;
    }
};
struct EpiFoxIn {
    static constexpr bool PERM = true, AFTER_DRAIN = false;
    bf16_t* O; size_t stride; const PG8_LAS float* tab; mutable int ui; PG8_LAS float* qkt; const PG8_LAS float* gains;
    __device__ __forceinline__ void operator()(const f32x4 (&acc)[2][2][4][2], const Unit& u, int wr, int wc, int fr, int fq) const {
        const int t = u.pn >> 3; bf16_t* base = O + (size_t)t * stride + (u.pn & 7) * 256 + wc * 32 + 8 * fq;
        if (t < 2) {
#pragma unroll
            for (int ai = 0; ai < 2; ++ai)
#pragma unroll
                for (int m = 0; m < 4; ++m) { const int rt = ai * HALF + wr * 64 + m * 16 + fr; const float rr = tab[(ui & 1) * 256 + rt];
#pragma unroll
                    for (int bj = 0; bj < 2; ++bj) { const f32x4 v0 = acc[ai][bj][m][0] * rr, v1 = acc[ai][bj][m][1] * rr;
                        float ss = (v0[0] * v0[0] + v0[1] * v0[1]) + (v0[2] * v0[2] + v0[3] * v0[3]) + (v1[0] * v1[0] + v1[1] * v1[1]) + (v1[2] * v1[2] + v1[3] * v1[3]);
                        ss += __shfl_xor(ss, 16); ss += __shfl_xor(ss, 32);
                        if (fq == 0) qkt[(rt * 2 + bj) * 4 + wc] = ss; } }
            asm volatile("s_waitcnt lgkmcnt(0)" ::: "memory"); __builtin_amdgcn_s_barrier(); asm volatile("" ::: "memory");
            const float sc = t == 0 ? 0.08838834764831845f * 1.4426950408889634f : 1.0f;
            const f32x4 g0 = *(const PG8_LAS f32x4*)(gains + t * 128 + wc * 32 + 8 * fq), g1 = *(const PG8_LAS f32x4*)(gains + t * 128 + wc * 32 + 8 * fq + 4);
#pragma unroll
            for (int ai = 0; ai < 2; ++ai)
#pragma unroll
                for (int m = 0; m < 4; ++m) { const int rt = ai * HALF + wr * 64 + m * 16 + fr; const float rr = tab[(ui & 1) * 256 + rt]; bf16_t* dst = base + (size_t)(u.pm * BM + rt) * 2048;
#pragma unroll
                    for (int bj = 0; bj < 2; ++bj) { const f32x4 p = *(const PG8_LAS f32x4*)(qkt + (rt * 2 + bj) * 4);
                        const float rs = rr * sc / sqrtf(((p[0] + p[1]) + (p[2] + p[3])) * (1.0f / 128.0f) + 1e-6f);
                        st16(dst + bj * HALF, pack8(acc[ai][bj][m][0] * rs * g0, acc[ai][bj][m][1] * rs * g1)); } }
        } else {
#pragma unroll
            for (int ai = 0; ai < 2; ++ai)
#pragma unroll
                for (int m = 0; m < 4; ++m) { const int row = u.pm * BM + ai * HALF + wr * 64 + m * 16 + fr; bf16_t* dst = base + (size_t)row * 2048; const float rr = tab[(ui & 1) * 256 + ai * HALF + wr * 64 + m * 16 + fr];
#pragma unroll
                    for (int bj = 0; bj < 2; ++bj) { f32x4 v0 = acc[ai][bj][m][0] * rr, v1 = acc[ai][bj][m][1] * rr;
                        if (t == 3) {
#pragma unroll
                            for (int j = 0; j < 4; ++j) { v0[j] = fast_sigmoid(v0[j]); v1[j] = fast_sigmoid(v1[j]); } }
                        st16(dst + bj * HALF, pack8(v0, v1)); } }
        }
        ++ui;
    }
};

template <class Epi, class Sched, bool ALIGN_EPI = false, bool SP2 = false, bool HALF_M = false>
__device__ __forceinline__ void gemm_phase(PG8_LAS unsigned char* lds, const Gemm g, const Sched& S, const Epi& E) {
    const int tid = threadIdx.x, wid = __builtin_amdgcn_readfirstlane(tid >> 6), lane = tid & 63, wr = wid >> 2, wc = wid & 3, fr = lane & 15, fq = lane >> 4;
    static_assert(!HALF_M || SP2, "HALF_M is written for the SP2 loop");
    const int K = g.K, nt = K / BK;
    unsigned voffA[2], voffB[2];
#pragma unroll
    for (int i = 0; i < 2; ++i) { int R, C; stage_rc(tid * 16 + i * 8192, R, C); const int Rb = Epi::PERM ? ((R & ~31) + perm32(R & 31)) : R;
        voffA[i] = (unsigned)(R * K + C) * 2u; voffB[i] = (unsigned)(Rb * K + C) * 2u; }
    const size_t kstep = (size_t)(BK * 2);
    const size_t hstep = (size_t)HALF * K * 2;
    const size_t tstep = 2 * hstep;
    const unsigned ldsw = (unsigned)wid * 1024u;
    const int aoff = lds_byte(wr * 64 + fr, fq * 8), boff = lds_byte(wc * 32 + fr, fq * 8);
#define PG8_SA(b, h) (((b) * 2 + (h)) * HTB)
#define PG8_SB(b, h) ((4 + (b) * 2 + (h)) * HTB)
#define PG8_STAGE(bufoff, gbase, voff) do { _Pragma("unroll") for (int _i = 0; _i < 2; ++_i) \
        __builtin_amdgcn_global_load_lds((const unsigned*)((const char*)(gbase) + (voff)[_i]), (PG8_LAS unsigned*)(lds + (bufoff) + ldsw + _i * 8192), 16, 0, 0); } while (0)
#define PG8_LDA(dst, b, h) do { _Pragma("unroll") for (int m = 0; m < 4; ++m) _Pragma("unroll") for (int k = 0; k < 2; ++k) dst[m][k] = *(const PG8_LAS bf16x8*)(lds + PG8_SA(b, h) + aoff + m * 2048 + k * 1024); } while (0)
#define PG8_LDB(dst, b, h) do { _Pragma("unroll") for (int n = 0; n < 2; ++n) _Pragma("unroll") for (int k = 0; k < 2; ++k) dst[n][k] = *(const PG8_LAS bf16x8*)(lds + PG8_SB(b, h) + boff + n * 2048 + k * 1024); } while (0)
#define PG8_MMA(ai, bj, At, Bt) do { __builtin_amdgcn_s_setprio(1); _Pragma("unroll") for (int m = 0; m < 4; ++m) _Pragma("unroll") for (int n = 0; n < 2; ++n) _Pragma("unroll") for (int k = 0; k < 2; ++k) \
        acc[ai][bj][m][n] = __builtin_amdgcn_mfma_f32_16x16x32_bf16(Bt[n][k], At[m][k], acc[ai][bj][m][n], 0, 0, 0); __builtin_amdgcn_s_setprio(0); } while (0)
#define PG8_WAIT_V(n) asm volatile("s_waitcnt vmcnt(" #n ")" ::: "memory")
#define PG8_WAIT_L(n) asm volatile("s_waitcnt lgkmcnt(" #n ")" ::: "memory")
#define PG8_BAR __builtin_amdgcn_s_barrier()
#define PG8_SCHED __builtin_amdgcn_sched_barrier(0)
    Unit cur, nxt; int ui = 0;
    if (!S.next(0, cur)) return;
    f32x4 acc[2][2][4][2];
#pragma unroll
    for (int a = 0; a < 2; ++a)
#pragma unroll
        for (int b = 0; b < 2; ++b)
#pragma unroll
            for (int m = 0; m < 4; ++m)
#pragma unroll
                for (int n = 0; n < 2; ++n) acc[a][b][m][n] = (f32x4){0.f, 0.f, 0.f, 0.f};
    bf16x8 At[4][2], B0[2][2], B1[2][2];
    const char* cA = (const char*)g.A + (size_t)cur.pm * tstep + (HALF_M ? (size_t)cur.hf * hstep : (size_t)0); const char* cB = (const char*)g.Bt + (size_t)cur.pn * tstep;
    S.a_ready(cur);
    if constexpr (SP2) {
        PG8_STAGE(PG8_SB(0, 0), cB, voffB); PG8_STAGE(PG8_SB(0, 1), cB + hstep, voffB); PG8_STAGE(PG8_SA(0, 0), cA, voffA); PG8_STAGE(PG8_SA(0, 1), cA + hstep, voffA);
        if (wr == 1) PG8_BAR;
        PG8_WAIT_V(2); PG8_BAR;
        PG8_STAGE(PG8_SB(1, 0), cB + kstep, voffB); PG8_STAGE(PG8_SA(1, 0), cA + kstep, voffA); PG8_STAGE(PG8_SB(1, 1), cB + hstep + kstep, voffB);
        PG8_WAIT_V(6); PG8_BAR;
    } else {
        PG8_STAGE(PG8_SB(0, 0), cB, voffB); PG8_STAGE(PG8_SA(0, 0), cA, voffA); PG8_STAGE(PG8_SB(0, 1), cB + hstep, voffB); PG8_STAGE(PG8_SA(0, 1), cA + hstep, voffA);
        if (wr == 1) PG8_BAR;
        PG8_WAIT_V(4); PG8_BAR;
        PG8_STAGE(PG8_SB(1, 0), cB + kstep, voffB); PG8_STAGE(PG8_SA(1, 0), cA + kstep, voffA); PG8_STAGE(PG8_SB(1, 1), cB + hstep + kstep, voffB);
        PG8_WAIT_V(6); PG8_BAR;
    }
    for (;;) {
        const bool has_next = S.next(ui + 1, nxt);
        const char* nA = has_next ? (const char*)g.A + (size_t)nxt.pm * tstep + (HALF_M ? (size_t)nxt.hf * hstep : (size_t)0) : cA; const char* nB = has_next ? (const char*)g.Bt + (size_t)nxt.pn * tstep : cB;
        for (int t = 0; t < nt; t += 2) {
            const bool last = (t == nt - 2);
            const char* a1 = cA + (size_t)(t + 1) * kstep;
            const char* a2 = last ? nA : cA + (size_t)(t + 2) * kstep; const char* b2 = last ? nB : cB + (size_t)(t + 2) * kstep;
            const char* a3 = a2 + kstep; const char* b3 = b2 + kstep;
            if (last && has_next) S.a_ready(nxt);
            if constexpr (SP2) {
            PG8_LDB(B0, 0, 0); PG8_LDB(B1, 0, 1); PG8_SCHED; PG8_LDA(At, 0, 0); PG8_STAGE(PG8_SA(1, 1), a1 + hstep, voffA);
            PG8_WAIT_V(8); PG8_WAIT_L(0); PG8_BAR; PG8_MMA(0, 0, At, B0); PG8_MMA(0, 1, At, B1); PG8_BAR; PG8_SCHED;
            if constexpr (!HALF_M) { PG8_LDA(At, 0, 1); } PG8_STAGE(PG8_SB(0, 0), b2, voffB); PG8_STAGE(PG8_SB(0, 1), b2 + hstep, voffB); PG8_STAGE(PG8_SA(0, 0), a2, voffA);
            PG8_WAIT_V(8); PG8_WAIT_L(0); PG8_BAR; if constexpr (!HALF_M) { PG8_MMA(1, 0, At, B0); PG8_MMA(1, 1, At, B1); } PG8_BAR; PG8_SCHED;
            PG8_LDB(B0, 1, 0); PG8_LDB(B1, 1, 1); PG8_SCHED; PG8_LDA(At, 1, 0); PG8_STAGE(PG8_SA(0, 1), a2 + hstep, voffA);
            PG8_WAIT_V(8); PG8_WAIT_L(0); PG8_BAR; PG8_MMA(0, 0, At, B0); PG8_MMA(0, 1, At, B1); PG8_BAR; PG8_SCHED;
            if constexpr (!HALF_M) { PG8_LDA(At, 1, 1); } PG8_STAGE(PG8_SB(1, 0), b3, voffB); PG8_STAGE(PG8_SB(1, 1), b3 + hstep, voffB); PG8_STAGE(PG8_SA(1, 0), a3, voffA);
            PG8_WAIT_V(8); PG8_WAIT_L(0); PG8_BAR; if constexpr (!HALF_M) { PG8_MMA(1, 0, At, B0); PG8_MMA(1, 1, At, B1); } PG8_BAR; PG8_SCHED;
            } else {
            PG8_LDB(B0, 0, 0); PG8_SCHED; PG8_LDA(At, 0, 0); PG8_STAGE(PG8_SA(1, 1), a1 + hstep, voffA);
            PG8_WAIT_L(8); PG8_BAR; PG8_WAIT_L(0); PG8_MMA(0, 0, At, B0); PG8_BAR; PG8_SCHED;
            PG8_LDB(B1, 0, 1); PG8_STAGE(PG8_SB(0, 0), b2, voffB);
            PG8_BAR; PG8_WAIT_L(0); PG8_MMA(0, 1, At, B1); PG8_BAR;
            PG8_LDA(At, 0, 1); PG8_STAGE(PG8_SA(0, 0), a2, voffA);
            PG8_BAR; PG8_WAIT_L(0); PG8_MMA(1, 0, At, B0); PG8_BAR; PG8_SCHED;
            PG8_STAGE(PG8_SB(0, 1), b2 + hstep, voffB);
            PG8_WAIT_V(6); PG8_BAR; PG8_MMA(1, 1, At, B1); PG8_BAR;
            PG8_LDB(B0, 1, 0); PG8_SCHED; PG8_LDA(At, 1, 0); PG8_STAGE(PG8_SA(0, 1), a2 + hstep, voffA);
            PG8_WAIT_L(8); PG8_BAR; PG8_WAIT_L(0); PG8_MMA(0, 0, At, B0); PG8_BAR; PG8_SCHED;
            PG8_LDB(B1, 1, 1); PG8_STAGE(PG8_SB(1, 0), b3, voffB);
            PG8_BAR; PG8_WAIT_L(0); PG8_MMA(0, 1, At, B1); PG8_BAR;
            PG8_LDA(At, 1, 1); PG8_STAGE(PG8_SA(1, 0), a3, voffA);
            PG8_BAR; PG8_WAIT_L(0); PG8_MMA(1, 0, At, B0); PG8_BAR; PG8_SCHED;
            PG8_STAGE(PG8_SB(1, 1), b3 + hstep, voffB);
            PG8_WAIT_V(6); PG8_BAR; PG8_MMA(1, 1, At, B1); PG8_BAR;
            }
        }
        if constexpr (ALIGN_EPI) { if (wr == 0) PG8_BAR; }
        if constexpr (!Epi::AFTER_DRAIN) { E(acc, cur, wr, wc, fr, fq); S.done(cur); }
        if (!has_next) break;
#pragma unroll
        for (int a = 0; a < 2; ++a)
#pragma unroll
            for (int b = 0; b < 2; ++b)
#pragma unroll
                for (int m = 0; m < 4; ++m)
#pragma unroll
                    for (int n = 0; n < 2; ++n) acc[a][b][m][n] = (f32x4){0.f, 0.f, 0.f, 0.f};
        cur = nxt; cA = nA; cB = nB; ++ui;
        if constexpr (ALIGN_EPI) { if (wr == 1) PG8_BAR; }
    }
    PG8_WAIT_V(0);
    if constexpr (!ALIGN_EPI) { if (wr == 0) PG8_BAR; }
    PG8_BAR;
    if constexpr (Epi::AFTER_DRAIN) { E.fused(acc, cur, wr, wc, fr, fq, lds, wid, lane); S.done(cur); }
#undef PG8_SA
#undef PG8_SB
#undef PG8_STAGE
#undef PG8_LDA
#undef PG8_LDB
#undef PG8_MMA
#undef PG8_WAIT_V
#undef PG8_WAIT_L
#undef PG8_BAR
#undef PG8_SCHED
}
}

#ifndef PG8_SP2
#define PG8_SP2 true
#endif
#ifndef PG8_ALIGN
#define PG8_ALIGN true
#endif
constexpr int NWAVES = 8, NTHR = 512;
#ifndef MK_N_LAUNCHES
#define MK_N_LAUNCHES 1
#endif
constexpr int N_PHASES = 25;
constexpr int N_LAUNCHES = MK_N_LAUNCHES;
static_assert(N_LAUNCHES == 1, "this build runs as ONE launch (the retention mixer has a grid barrier inside its phase)");

constexpr int BATCH = 2, SEQ = 4096, DM = 2048, M = BATCH * SEQ, DEPTH = 4;
constexpr int RET_N = 12288, GM_N = 12288, GM_HALF = 6144, FOX_LD = 8208, FOX_N = 8192, FFN_H = 5632, FFN_N2 = 2 * FFN_H;
constexpr float EPS = 1e-6f;
constexpr float LOG2E = 1.4426950408889634f;

constexpr size_t MiB = (size_t)1 << 20;
constexpr size_t WS_CTL = 0, CTL_ZERO_BYTES = 1 * MiB;
constexpr size_t WS_W_RET_IN = 1 * MiB, SZ_W_RET_IN = 48 * MiB;
constexpr size_t WS_W_RET_OUT = 97 * MiB, SZ_W_RET_OUT = 16 * MiB;
constexpr size_t WS_W_GM_IN = 129 * MiB, WS_W_GM_OUT = 177 * MiB, WS_W_FOX_IN = 201 * MiB, WS_W_FOX_OUT = 233 * MiB;
constexpr size_t WS_W_GU = 241 * MiB, SZ_W_GU = 44 * MiB;
constexpr size_t WS_W_DN = 417 * MiB, SZ_W_DN = 22 * MiB;
constexpr size_t WS_ROPE_C = 505 * MiB, WS_ROPE_S = 509 * MiB;
constexpr size_t WS_H = 513 * MiB;
constexpr size_t WS_A = 545 * MiB;
constexpr size_t WS_B = 737 * MiB;
constexpr size_t WS_C = 833 * MiB;
constexpr size_t WS_MISC = 897 * MiB, WS_RSP = 913 * MiB, WS_KF = 921 * MiB, WS_QF = 953 * MiB, WS_END = 985 * MiB;
constexpr size_t MISC_PART = 0, MISC_RSTAT = 8 * MiB, MISC_LF = 9 * MiB, MISC_WTRI = 12 * MiB;
constexpr int CW_BAR = 4096;

constexpr int RING_OFF = 0, RING_BYTES = 131072;
constexpr int LDSCTL_OFF = RING_BYTES, MISC_OFF = LDSCTL_OFF + 320;
constexpr int RSTAB_OFF = LDSCTL_OFF + 1024;
constexpr int QKT_OFF = LDSCTL_OFF + 3072, QKG_OFF = QKT_OFF + 8192;
constexpr int LDS_BYTES = 147456;
static_assert(MISC_OFF + 128 <= RSTAB_OFF && RSTAB_OFF + 2048 <= QKT_OFF && QKG_OFF + 1024 <= LDS_BYTES, "LDS map");

#define GAS __attribute__((address_space(1)))
#define LAS __attribute__((address_space(3)))
typedef unsigned short bf16;
typedef unsigned v4u __attribute__((ext_vector_type(4)));
typedef unsigned v2u __attribute__((ext_vector_type(2)));
typedef float f32x4 __attribute__((ext_vector_type(4)));
typedef float f32x2 __attribute__((ext_vector_type(2)));
typedef short bf16x8 __attribute__((ext_vector_type(8)));
typedef short s16x4 __attribute__((ext_vector_type(4)));
typedef GAS unsigned gu32;
typedef LAS unsigned char* ldsp;
#define RLX_AGENT __ATOMIC_RELAXED, __HIP_MEMORY_SCOPE_AGENT
#define LDS_WAIT() asm volatile("s_waitcnt lgkmcnt(0)" ::: "memory")
using pg8::cvtpk;
__device__ __forceinline__ float bflo(unsigned w) { return __uint_as_float(w << 16); }
__device__ __forceinline__ float bfhi(unsigned w) { return __uint_as_float(w & 0xffff0000u); }
#define MFMA16(a, b, c) __builtin_amdgcn_mfma_f32_16x16x32_bf16((a), (b), (c), 0, 0, 0)
__device__ __forceinline__ bf16x8 frag_row(const ldsp tile, int RS, int lane) { return *(const LAS bf16x8*)(tile + (lane & 15) * RS + (lane >> 4) * 16); }
typedef short v4i16_t __attribute__((ext_vector_type(4)));
__device__ __forceinline__ s16x4 vtr(const ldsp p) { return __builtin_bit_cast(s16x4, __builtin_amdgcn_ds_read_tr16_b64_v4i16((LAS v4i16_t*)p)); }
__device__ __forceinline__ bf16x8 frag_tr(const ldsp tile, int RS, int lane) {
    const ldsp a = tile + (8 * (lane >> 4) + ((lane & 15) >> 2)) * RS + 8 * (lane & 3);
    const s16x4 lo = vtr(a), hi = vtr(a + 4 * RS);
    return (bf16x8){lo[0], lo[1], lo[2], lo[3], hi[0], hi[1], hi[2], hi[3]};
}

#define XB_TMO      128
#define XB_XCNT(j)  (256  + 64 * (j))
#define XB_XSUB(j)  (1280 + 64 * (j))
#define XB_XGEN(j)  (2304 + 64 * (j))
#define XB_TOP      3328
#define XB_TOPGEN   3392
#define XCD_BAR_WORDS 3456
#define XB_SPIN_CAP (1u << 18)

__device__ __forceinline__ unsigned xb_ld(unsigned* p)              { return __hip_atomic_load(p, __ATOMIC_RELAXED, __HIP_MEMORY_SCOPE_AGENT); }
__device__ __forceinline__ unsigned xb_add(unsigned* p, unsigned v) { return __hip_atomic_fetch_add(p, v, __ATOMIC_RELAXED, __HIP_MEMORY_SCOPE_AGENT); }
__device__ __forceinline__ unsigned xb_xcc_id() { return (unsigned)__builtin_amdgcn_s_getreg((3 << 11) | 20) & 0xFu; }
#define XB_SPIN(cond, bar) do { unsigned _sp = 0; while (cond) { __builtin_amdgcn_s_sleep(1); \
    if ((++_sp & 255u) == 0u) { if (xb_ld(&(bar)[XB_TMO])) break; if (_sp > XB_SPIN_CAP) { atomicAdd(&(bar)[XB_TMO], 1u); break; } } } } while (0)

struct XcdBarrier {
    unsigned* bar; unsigned x;
    volatile LAS unsigned* st;
};

__device__ __forceinline__ XcdBarrier xcd_barrier_post(unsigned* bar, volatile LAS unsigned* st) {
    XcdBarrier b; b.bar = bar; b.x = xb_xcc_id(); b.st = st;
    if (threadIdx.x == 0) (void)xb_add(&bar[XB_XCNT(b.x)], 1u);
    return b;
}
__device__ __forceinline__ void xcd_barrier_complete(unsigned* bar, unsigned x, unsigned& nloc, unsigned& nx) {
    const unsigned G = gridDim.x * gridDim.y * gridDim.z;
    unsigned sum, cnt, mine, sp = 0u;
    for (;;) {
        sum = 0u; cnt = 0u; mine = 0u;
#pragma unroll
        for (unsigned j = 0; j < 16; ++j) { const unsigned c = xb_ld(&bar[XB_XCNT(j)]); sum += c; cnt += (c > 0u) ? 1u : 0u; mine = (j == x) ? c : mine; }
        if (sum == G) break;
        __builtin_amdgcn_s_sleep(1);
        if ((++sp & 255u) == 0u) { if (xb_ld(&bar[XB_TMO])) break; if (sp > XB_SPIN_CAP) { atomicAdd(&bar[XB_TMO], 1u); break; } }
    }
    nloc = mine > 0u ? mine : 1u; nx = cnt > 0u ? cnt : 1u;
}

__device__ __forceinline__ void xcd_barrier(const XcdBarrier& b) {
    asm volatile("s_waitcnt vmcnt(0)" ::: "memory");
    __syncthreads();
    if (threadIdx.x == 0) {
        unsigned* bar = b.bar;
        __builtin_amdgcn_s_waitcnt(0);
        unsigned nloc = b.st[0], nx = b.st[1];
        if (nloc == 0u) { xcd_barrier_complete(bar, b.x, nloc, nx); b.st[0] = nloc; b.st[1] = nx; }
        const unsigned old = xb_add(&bar[XB_XSUB(b.x)], 1u);
        const unsigned gen = old / nloc;
        if (old + 1u == (gen + 1u) * nloc) {
            __builtin_amdgcn_fence(__ATOMIC_RELEASE, "agent");
            asm volatile("s_waitcnt vmcnt(0)" ::: "memory");
            const unsigned og = xb_add(&bar[XB_TOP], 1u);
            const unsigned tg = og / nx;
            if (og + 1u == (tg + 1u) * nx) xb_add(&bar[XB_TOPGEN], 1u);
            else XB_SPIN(xb_ld(&bar[XB_TOPGEN]) == tg, bar);
            __builtin_amdgcn_fence(__ATOMIC_ACQUIRE, "agent");
            xb_add(&bar[XB_XGEN(b.x)], 1u);
            asm volatile("s_waitcnt vmcnt(0)" ::: "memory");
        } else {
            XB_SPIN(xb_ld(&bar[XB_XGEN(b.x)]) == gen, bar);
            __builtin_amdgcn_fence(__ATOMIC_ACQUIRE, "agent");
            asm volatile("s_waitcnt vmcnt(0)" ::: "memory");
        }
    }
    __syncthreads();
}

struct Frame {
    ldsp lds;
    volatile LAS unsigned* MISC;
    gu32* ctl;
    int tid, lane, wave;
    int vcu, G;
};
__device__ __forceinline__ float wave_sum(float v) {
#pragma unroll
    for (int o = 1; o < 64; o <<= 1) v += __shfl_xor(v, o);
    return v;
}
__device__ __forceinline__ float log_sigmoid(float z) { return fminf(z, 0.f) - log1pf(expf(-fabsf(z))); }

__device__ __forceinline__ void transpose_job(Frame& F, const float* W, int K, int ld, int ncols, bf16* WT, int ilv, const float* gvec) {
    LAS float* scr = (LAS float*)(F.lds + RING_OFF + F.wave * 16384);
    const int gw = F.vcu * NWAVES + F.wave, NGW = F.G * NWAVES, lane = F.lane;
    const int nblk = ncols / 32, nitems = (K / 64) * nblk;
    float wv[32];
#define TJ_LOAD(item) do { const int kb_ = (item) / nblk, nb_ = (item) % nblk; const float* src_ = W + (size_t)(64 * kb_ + (lane >> 5)) * ld + 32 * nb_ + (lane & 31); \
        _Pragma("unroll") for (int i = 0; i < 32; ++i) wv[i] = src_[(size_t)(2 * i) * ld]; } while (0)
    if (gw < nitems) TJ_LOAD(gw);
    for (int it = gw; it < nitems; it += NGW) {
        const int kb = it / nblk, nb = it % nblk, k0 = 64 * kb, n0 = 32 * nb;
        const int drow0 = ilv == 0 ? n0 : ((n0 >> 7) * 256 + (n0 & 127) + (ilv == 2 ? 128 : 0));
#pragma unroll
        for (int i = 0; i < 32; ++i) scr[(2 * i + (lane >> 5)) * 33 + (lane & 31)] = wv[i];
        if (it + NGW < nitems) TJ_LOAD(it + NGW);
        LDS_WAIT(); asm volatile("" ::: "memory");
        const int c = lane & 7;
        f32x4 ga = {1.f, 1.f, 1.f, 1.f}, gb = {1.f, 1.f, 1.f, 1.f};
        if (gvec) { ga = *(const f32x4*)(gvec + k0 + 8 * c); gb = *(const f32x4*)(gvec + k0 + 8 * c + 4); }
#pragma unroll
        for (int j = 0; j < 4; ++j) { const int n = (lane >> 3) + 8 * j; const LAS float* s = scr + (8 * c) * 33 + n;
            v4u o; o.x = cvtpk(s[0 * 33] * ga[0], s[1 * 33] * ga[1]); o.y = cvtpk(s[2 * 33] * ga[2], s[3 * 33] * ga[3]); o.z = cvtpk(s[4 * 33] * gb[0], s[5 * 33] * gb[1]); o.w = cvtpk(s[6 * 33] * gb[2], s[7 * 33] * gb[3]);
            *(GAS v4u*)(WT + (size_t)(drow0 + n) * K + k0 + 8 * c) = o; }
        LDS_WAIT(); asm volatile("" ::: "memory");
    }
#undef TJ_LOAD
}
__device__ __forceinline__ void p0_prologue(Frame& F, const void* const* in, unsigned char* ws) {
    const float* mixg = (const float*)in[2]; const float* ffng = (const float*)in[3];
    for (int j = 0; j < 2; ++j) {
        transpose_job(F, (const float*)in[4] + (size_t)j * DM * RET_N, DM, RET_N, RET_N, (bf16*)(ws + WS_W_RET_IN + j * SZ_W_RET_IN), 0, mixg + (size_t)(3 * j) * DM);
        transpose_job(F, (const float*)in[6] + (size_t)j * 4096 * DM, 4096, DM, DM, (bf16*)(ws + WS_W_RET_OUT + j * SZ_W_RET_OUT), 0, nullptr);
    }
    transpose_job(F, (const float*)in[7], DM, GM_N, GM_N, (bf16*)(ws + WS_W_GM_IN), 0, mixg + DM);
    transpose_job(F, (const float*)in[12], GM_HALF, DM, DM, (bf16*)(ws + WS_W_GM_OUT), 0, nullptr);
    transpose_job(F, (const float*)in[13], DM, FOX_LD, FOX_N, (bf16*)(ws + WS_W_FOX_IN), 0, mixg + 2 * DM);
    transpose_job(F, (const float*)in[17], DM, DM, DM, (bf16*)(ws + WS_W_FOX_OUT), 0, nullptr);
    for (int i = 0; i < DEPTH; ++i) {
        transpose_job(F, (const float*)in[18] + (size_t)i * DM * FFN_H, DM, FFN_H, FFN_H, (bf16*)(ws + WS_W_GU + i * SZ_W_GU), 1, ffng + (size_t)i * DM);
        transpose_job(F, (const float*)in[19] + (size_t)i * DM * FFN_H, DM, FFN_H, FFN_H, (bf16*)(ws + WS_W_GU + i * SZ_W_GU), 2, ffng + (size_t)i * DM);
        transpose_job(F, (const float*)in[20] + (size_t)i * FFN_H * DM, FFN_H, DM, DM, (bf16*)(ws + WS_W_DN + i * SZ_W_DN), 0, nullptr);
    }
    { const float* x = (const float*)in[0]; bf16* xb = (bf16*)(ws + WS_H); float* rss = (float*)(ws + WS_RSP);
      const int gw = F.vcu * NWAVES + F.wave, NGW = F.G * NWAVES, lane = F.lane;
      for (int m = gw; m < M; m += NGW) { const f32x4* xr = (const f32x4*)(x + (size_t)m * DM) + lane; v2u* o8 = (v2u*)(xb + (size_t)m * DM) + lane; float ss = 0.f;
#pragma unroll
          for (int j = 0; j < 8; ++j) { const f32x4 v = xr[64 * j]; ss += (v.x * v.x + v.y * v.y) + (v.z * v.z + v.w * v.w); v2u w; w.x = cvtpk(v.x, v.y); w.y = cvtpk(v.z, v.w); o8[64 * j] = w; }
          ss = wave_sum(ss); if (lane < 32) rss[(size_t)m * 32 + lane] = lane == 0 ? ss : 0.f; } }
    { const float* wsp = (const float*)in[10]; bf16* wtri = (bf16*)(ws + WS_MISC + MISC_WTRI);
      for (int i4 = F.vcu * NTHR + F.tid; i4 < 8 * 128 * 32; i4 += F.G * NTHR) { const int t = (i4 >> 5) & 127, s4 = (i4 & 31) * 4; f32x4 wv = *(const f32x4*)(wsp + (size_t)i4 * 4);
#pragma unroll
          for (int e = 0; e < 4; ++e) if (s4 + e > t) wv[e] = 0.f;
          v2u pk; pk.x = cvtpk(wv[0], wv[1]); pk.y = cvtpk(wv[2], wv[3]); *(v2u*)(wtri + (size_t)i4 * 4) = pk; } }
    { const int* pos = (const int*)in[1]; float* cs = (float*)(ws + WS_ROPE_C); float* sn = (float*)(ws + WS_ROPE_S);
      const int gid = F.vcu * NTHR + F.tid, i = gid & 127, step = (F.G * NTHR) >> 7;
      const double invf = exp2(-(double)i * (13.287712379549449 / 128.0));
      for (int r = gid >> 7; r < M; r += step) { const double ang = (double)pos[r] * invf; const double rr = ang - 6.283185307179586 * rint(ang * 0.15915494309189535);
          const float a = (float)rr; cs[(size_t)r * 128 + i] = cosf(a); sn[(size_t)r * 128 + i] = sinf(a); } }
}

__device__ __forceinline__ void ret_p_phase(Frame& F, const bf16* q, const bf16* k, bf16* PF, bf16* KF, bf16* QF) {
    constexpr int RSQ = 272;
    const ldsp LQ = F.lds, LK = F.lds + 34816;
    const int tid = F.tid, lane = F.lane, w = F.wave, g4 = lane >> 4, l15 = lane & 15;
    for (int unit = F.vcu; unit < 512; unit += F.G) {
        const int bh = unit >> 5, ci = unit & 31, h = bh & 7;
        const float lg2 = log1pf(-exp2f(-5.0f - (float)h)) * LOG2E;
        const size_t rowbase = (size_t)bh * SEQ + ci * 128;
        v4u pq[4], pk[4];
#define RP_LD(dd) do { _Pragma("unroll") for (int ps = 0; ps < 4; ++ps) { const int r_ = ps * 32 + (tid >> 4), c_ = tid & 15; \
            pq[ps] = *(const v4u*)(q + (rowbase + r_) * 256 + (dd) * 128 + c_ * 8); pk[ps] = *(const v4u*)(k + (rowbase + r_) * 256 + (dd) * 128 + c_ * 8); } } while (0)
        RP_LD(0);
        f32x4 S[8];
#pragma unroll
        for (int t = 0; t < 8; ++t) S[t] = (f32x4){0.f, 0.f, 0.f, 0.f};
#pragma unroll
        for (int dh = 0; dh < 2; ++dh) {
            __syncthreads();
#pragma unroll
            for (int ps = 0; ps < 4; ++ps) { const int r_ = ps * 32 + (tid >> 4), c_ = tid & 15; *(LAS v4u*)(LQ + r_ * RSQ + c_ * 16) = pq[ps]; *(LAS v4u*)(LK + r_ * RSQ + c_ * 16) = pk[ps]; }
            if (dh == 0) RP_LD(1);
            __syncthreads();
#pragma unroll
            for (int ks = 0; ks < 4; ++ks) { const bf16x8 a = frag_row(LQ + (16 * w) * RSQ + ks * 64, RSQ, lane);
                *(bf16x8*)(QF + ((((size_t)(bh * 32 + ci) * 8 + w) * 8 + dh * 4 + ks) * 512 + lane * 8)) = a;
#pragma unroll
                for (int t = 0; t < 8; ++t) S[t] = MFMA16(a, frag_row(LK + (16 * t) * RSQ + ks * 64, RSQ, lane), S[t]); }
#pragma unroll
            for (int ks = 0; ks < 4; ++ks) { const bf16x8 f = frag_tr(LK + (32 * ks) * RSQ + (16 * w) * 2, RSQ, lane); const v4u fu = __builtin_bit_cast(v4u, f); v4u o;
                const float k0 = exp2f((float)(127 - 32 * ks - 8 * g4) * lg2), gi = exp2f(-lg2), k1 = k0 * gi, k2 = k1 * gi, k3 = k2 * gi, k4 = k3 * gi, k5 = k4 * gi, k6 = k5 * gi, k7 = k6 * gi;
                o.x = cvtpk(bflo(fu.x) * k0, bfhi(fu.x) * k1); o.y = cvtpk(bflo(fu.y) * k2, bfhi(fu.y) * k3); o.z = cvtpk(bflo(fu.z) * k4, bfhi(fu.z) * k5); o.w = cvtpk(bflo(fu.w) * k6, bfhi(fu.w) * k7);
                *(v4u*)(KF + ((((size_t)(bh * 32 + ci) * 2 + dh) * 8 + w) * 4 + ks) * 512 + lane * 8) = o; }
        }
#undef RP_LD
#pragma unroll
        for (int t = 0; t < 8; ++t)
#pragma unroll
            for (int r = 0; r < 4; ++r) { const int n = 16 * w + 4 * g4 + r, mm = 16 * t + l15;
                const float pv_ = n >= mm ? S[t][r] * exp2f((float)(n - mm) * lg2) : 0.f;
                *(LAS unsigned short*)(LQ + n * RSQ + mm * 2) = (unsigned short)(cvtpk(pv_, 0.f) & 0xffffu); }
#pragma unroll
        for (int ks = 0; ks < 4; ++ks) *(bf16x8*)(PF + ((((size_t)(bh * 32 + ci) * 8 + w) * 4 + ks) * 512 + lane * 8)) = frag_row(LQ + (16 * w) * RSQ + ks * 64, RSQ, lane);
    }
}
__device__ __forceinline__ void ret_core_phase(Frame& F, const bf16* QF, const bf16* v, const bf16* PF, const bf16* KF, bf16* o) {
    constexpr int RSV = 72, RSS = 528;
    const ldsp LV0 = F.lds, LST = F.lds + 18432;
    const ldsp LOw = F.lds + 52224 + F.wave * 1024;
    const int tid = F.tid, lane = F.lane, w = F.wave, g4 = lane >> 4, l15 = lane & 15;
    for (int unit = F.vcu; unit < 256; unit += F.G) {
        const int bh = unit >> 4, es = unit & 15, h = bh & 7, b = bh >> 3, e0 = es * 32;
        const float lg2 = log1pf(-exp2f(-5.0f - (float)h)) * LOG2E;
        const float cd = exp2f(128.0f * lg2);
        const size_t rb0 = (size_t)bh * SEQ;
        f32x4 st[2][2];
#pragma unroll
        for (int a = 0; a < 2; ++a)
#pragma unroll
            for (int t = 0; t < 2; ++t) st[a][t] = (f32x4){0.f, 0.f, 0.f, 0.f};
        __syncthreads();
        for (int i = tid; i < 16896 / 4; i += NTHR) ((LAS unsigned*)LST)[i] = 0u;
        v4u pv, pvn; bf16x8 qf[8], pf[4], kf[8], qn[8], pn[4], kn[8];
#define RC_LD(cc) do { pvn = *(const v4u*)(v + (rb0 + (cc) * 128 + (tid >> 2)) * 512 + e0 + (tid & 3) * 8); \
            _Pragma("unroll") for (int ks = 0; ks < 8; ++ks) qn[ks] = *(const bf16x8*)(QF + ((((size_t)(bh * 32 + (cc)) * 8 + w) * 8 + ks) * 512 + lane * 8)); \
            _Pragma("unroll") for (int ks = 0; ks < 4; ++ks) pn[ks] = *(const bf16x8*)(PF + ((((size_t)(bh * 32 + (cc)) * 8 + w) * 4 + ks) * 512 + lane * 8)); \
            _Pragma("unroll") for (int i_ = 0; i_ < 8; ++i_) kn[i_] = *(const bf16x8*)(KF + ((((size_t)(bh * 32 + (cc)) * 2 + (i_ >> 2)) * 8 + w) * 4 + (i_ & 3)) * 512 + lane * 8); } while (0)
        RC_LD(0);
        for (int ci = 0; ci < 32; ++ci) {
            const ldsp LSc = LST + (ci & 1) * 16896, LSn = LST + ((ci + 1) & 1) * 16896;
            const ldsp LV = LV0 + (ci & 1) * 9216;
            pv = pvn;
#pragma unroll
            for (int i_ = 0; i_ < 8; ++i_) { qf[i_] = qn[i_]; kf[i_] = kn[i_]; }
#pragma unroll
            for (int i_ = 0; i_ < 4; ++i_) pf[i_] = pn[i_];
            *(LAS v4u*)(LV + (tid >> 2) * RSV + (tid & 3) * 16) = pv;
            __syncthreads();
            if (ci + 1 < 32) RC_LD(ci + 1);
            bf16x8 vf[4][2];
#pragma unroll
            for (int ks = 0; ks < 4; ++ks)
#pragma unroll
                for (int t = 0; t < 2; ++t) vf[ks][t] = frag_tr(LV + (32 * ks) * RSV + (16 * t) * 2, RSV, lane);
            f32x4 cr[2], in[2];
            cr[0] = (f32x4){0.f, 0.f, 0.f, 0.f}; cr[1] = (f32x4){0.f, 0.f, 0.f, 0.f}; in[0] = (f32x4){0.f, 0.f, 0.f, 0.f}; in[1] = (f32x4){0.f, 0.f, 0.f, 0.f};
#pragma unroll
            for (int ks = 0; ks < 8; ++ks)
#pragma unroll
                for (int t = 0; t < 2; ++t) cr[t] = MFMA16(qf[ks], frag_row(LSc + (16 * t) * RSS + (ks * 32) * 2, RSS, lane), cr[t]);
#pragma unroll
            for (int ks = 0; ks < 4; ++ks)
#pragma unroll
                for (int t = 0; t < 2; ++t) in[t] = MFMA16(pf[ks], vf[ks][t], in[t]);
#pragma unroll
            for (int dh = 0; dh < 2; ++dh) {
#pragma unroll
                for (int t = 0; t < 2; ++t) st[dh][t] = st[dh][t] * cd;
#pragma unroll
                for (int ks = 0; ks < 4; ++ks)
#pragma unroll
                    for (int t = 0; t < 2; ++t) st[dh][t] = MFMA16(kf[dh * 4 + ks], vf[ks][t], st[dh][t]);
#pragma unroll
                for (int t = 0; t < 2; ++t) { v2u pk2; pk2.x = cvtpk(st[dh][t][0], st[dh][t][1]); pk2.y = cvtpk(st[dh][t][2], st[dh][t][3]);
                    *(LAS v2u*)(LSn + (16 * t + l15) * RSS + (dh * 128 + 16 * w + 4 * g4) * 2) = pk2; }
            }
#pragma unroll
            for (int r = 0; r < 4; ++r) { const int n = 16 * w + 4 * g4 + r; const float qd = exp2f((float)(n + 1) * lg2);
#pragma unroll
                for (int t = 0; t < 2; ++t) *(LAS unsigned short*)(LOw + (4 * g4 + r) * 64 + (16 * t + l15) * 2) = (unsigned short)(cvtpk(in[t][r] + cr[t][r] * qd, 0.f) & 0xffffu); }
            *(v4u*)(o + ((size_t)b * SEQ + ci * 128 + 16 * w + (lane >> 2)) * 4096 + h * 512 + e0 + (lane & 3) * 8) = *(const LAS v4u*)(LOw + (lane >> 2) * 64 + (lane & 3) * 16);
        }
#undef RC_LD
    }
}

__device__ __forceinline__ void ret_gn_phase(Frame& F, const bf16* o, const bf16* g, const float* gn, bf16* y) {
    const int lane = F.lane, gw = F.vcu * NWAVES + F.wave, NGW = F.G * NWAVES;
    for (int it0 = gw; it0 < M * 8; it0 += 4 * NGW) {
        v4u ov[4], gv[4];
#pragma unroll
        for (int u = 0; u < 4; ++u) { const int it = it0 + u * NGW; const size_t off = (size_t)(it >> 3) * 4096 + (it & 7) * 512 + lane * 8;
            if (it < M * 8) { ov[u] = *(const v4u*)(o + off); gv[u] = *(const v4u*)(g + off); } else { ov[u] = (v4u){0u, 0u, 0u, 0u}; gv[u] = ov[u]; } }
#pragma unroll
        for (int u = 0; u < 4; ++u) { const int it = it0 + u * NGW, h = it & 7; const size_t off = (size_t)(it >> 3) * 4096 + h * 512 + lane * 8;
            float x[8] = {bflo(ov[u].x), bfhi(ov[u].x), bflo(ov[u].y), bfhi(ov[u].y), bflo(ov[u].z), bfhi(ov[u].z), bflo(ov[u].w), bfhi(ov[u].w)};
            float gg[8] = {bflo(gv[u].x), bfhi(gv[u].x), bflo(gv[u].y), bfhi(gv[u].y), bflo(gv[u].z), bfhi(gv[u].z), bflo(gv[u].w), bfhi(gv[u].w)};
            float s = 0.f;
#pragma unroll
            for (int e = 0; e < 8; ++e) s += x[e];
            const float mean = wave_sum(s) * (1.0f / 512.0f); float qv = 0.f;
#pragma unroll
            for (int e = 0; e < 8; ++e) { x[e] -= mean; qv += x[e] * x[e]; }
            const float rstd = 1.0f / sqrtf(wave_sum(qv) * (1.0f / 512.0f) + EPS);
            const f32x4 g0 = *(const f32x4*)(gn + h * 512 + lane * 8), g1 = *(const f32x4*)(gn + h * 512 + lane * 8 + 4);
            float r[8];
#pragma unroll
            for (int e = 0; e < 8; ++e) { const float gw_ = e < 4 ? g0[e & 3] : g1[e & 3]; r[e] = x[e] * rstd * gw_ * (gg[e] * pg8::fast_sigmoid(gg[e])); }
            v4u w; w.x = cvtpk(r[0], r[1]); w.y = cvtpk(r[2], r[3]); w.z = cvtpk(r[4], r[5]); w.w = cvtpk(r[6], r[7]);
            if (it < M * 8) *(v4u*)(y + off) = w; }
    }
}

__device__ __forceinline__ void gm_stat_phase(Frame& F, const f32x2* part, f32x2* rstat) {
    const int lane = F.lane, gw = F.vcu * NWAVES + F.wave, NGW = F.G * NWAVES;
    for (int row = gw; row < M; row += NGW) {
        float s = 0.f, ss = 0.f;
        if (lane < 48) { const f32x4 p = *(const f32x4*)(part + (size_t)row * 96 + lane * 2); s = p.x + p.z; ss = p.y + p.w; }
        s = wave_sum(s); ss = wave_sum(ss);
        const float mean = s * (1.0f / GM_HALF), var = fmaxf(ss * (1.0f / GM_HALF) - mean * mean, 0.f);
        if (lane == 0) rstat[row] = (f32x2){mean, 1.0f / sqrtf(var + EPS)};
    }
}
__device__ __forceinline__ void gm_spatial_phase(Frame& F, const bf16* u, const bf16* v, const f32x2* rstat, const float* lng, const float* lnb, const bf16* wtri, const float* bsp, bf16* y) {
    constexpr int RSW = 272, RSN = 528;
    const ldsp LW = F.lds, LN = F.lds + 34816;
    const int tid = F.tid, lane = F.lane, w = F.wave, g4 = lane >> 4, l15 = lane & 15;
    for (int wgi = F.vcu; wgi < 256; wgi += F.G) {
        const int gg = wgi & 7, jj = wgi >> 3;
        __syncthreads();
#pragma unroll
        for (int ps = 0; ps < 4; ++ps) { const int id = ps * NTHR + tid, t = id >> 4, c = id & 15;
            *(LAS v4u*)(LW + t * RSW + c * 16) = *(const v4u*)(wtri + ((size_t)gg * 128 + t) * 128 + c * 8); }
        float bs[8];
#pragma unroll
        for (int tt = 0; tt < 8; ++tt) bs[tt] = bsp[gg * 128 + 16 * tt + l15];
        v4u vr[8], ur[8];
#define GS_ROW0(i_) ((((jj) * 6 + (i_)) / 3) * 128)
#define GS_COL0(i_) (gg * 768 + (((jj) * 6 + (i_)) % 3) * 256)
#define GS_LDV(i_) do { _Pragma("unroll") for (int ps = 0; ps < 8; ++ps) { const int id_ = ps * NTHR + tid; vr[ps] = *(const v4u*)(v + (size_t)(GS_ROW0(i_) + (id_ >> 5)) * GM_HALF + GS_COL0(i_) + (id_ & 31) * 8); } } while (0)
        GS_LDV(0);
        for (int ui = 0; ui < 6; ++ui) {
            const int row0 = GS_ROW0(ui), col0 = GS_COL0(ui);
            __syncthreads();
#pragma unroll
            for (int ps = 0; ps < 8; ++ps) { const int id = ps * NTHR + tid, r = id >> 5, c8 = (id & 31) * 8;
                const v4u vv = vr[ps]; const f32x2 rs = rstat[row0 + r];
                const f32x4 ga = *(const f32x4*)(lng + col0 + c8), gb = *(const f32x4*)(lng + col0 + c8 + 4), ba = *(const f32x4*)(lnb + col0 + c8), bb = *(const f32x4*)(lnb + col0 + c8 + 4);
                v4u o;
                o.x = cvtpk((bflo(vv.x) - rs.x) * rs.y * ga[0] + ba[0], (bfhi(vv.x) - rs.x) * rs.y * ga[1] + ba[1]);
                o.y = cvtpk((bflo(vv.y) - rs.x) * rs.y * ga[2] + ba[2], (bfhi(vv.y) - rs.x) * rs.y * ga[3] + ba[3]);
                o.z = cvtpk((bflo(vv.z) - rs.x) * rs.y * gb[0] + bb[0], (bfhi(vv.z) - rs.x) * rs.y * gb[1] + bb[1]);
                o.w = cvtpk((bflo(vv.w) - rs.x) * rs.y * gb[2] + bb[2], (bfhi(vv.w) - rs.x) * rs.y * gb[3] + bb[3]);
                *(LAS v4u*)(LN + r * RSN + c8 * 2) = o; }
#pragma unroll
            for (int ps = 0; ps < 8; ++ps) { const int id_ = ps * NTHR + tid; ur[ps] = *(const v4u*)(u + (size_t)(row0 + (id_ >> 5)) * GM_HALF + col0 + (id_ & 31) * 8); }
            if (ui + 1 < 6) GS_LDV(ui + 1);
            __syncthreads();
            f32x4 acc[2][8];
#pragma unroll
            for (int ci = 0; ci < 2; ++ci)
#pragma unroll
                for (int tt = 0; tt < 8; ++tt) acc[ci][tt] = (f32x4){0.f, 0.f, 0.f, 0.f};
#pragma unroll
            for (int ks = 0; ks < 4; ++ks) {
                const bf16x8 a0 = frag_tr(LN + (32 * ks) * RSN + (32 * w) * 2, RSN, lane), a1 = frag_tr(LN + (32 * ks) * RSN + (32 * w + 16) * 2, RSN, lane);
#pragma unroll
                for (int tt = 2 * ks; tt < 8; ++tt) { const bf16x8 bfr = frag_row(LW + (16 * tt) * RSW + ks * 64, RSW, lane);
                    acc[0][tt] = MFMA16(a0, bfr, acc[0][tt]); acc[1][tt] = MFMA16(a1, bfr, acc[1][tt]); }
            }
            __syncthreads();
#pragma unroll
            for (int ci = 0; ci < 2; ++ci)
#pragma unroll
                for (int tt = 0; tt < 8; ++tt) { v2u pk; pk.x = cvtpk(acc[ci][tt][0] + bs[tt], acc[ci][tt][1] + bs[tt]); pk.y = cvtpk(acc[ci][tt][2] + bs[tt], acc[ci][tt][3] + bs[tt]);
                    *(LAS v2u*)(LN + (16 * tt + l15) * RSN + (32 * w + 16 * ci + 4 * g4) * 2) = pk; }
            __syncthreads();
#pragma unroll
            for (int ps = 0; ps < 8; ++ps) { const int id = ps * NTHR + tid, r = id >> 5, c8 = (id & 31) * 8;
                const v4u mv = *(const LAS v4u*)(LN + r * RSN + c8 * 2); const size_t off = (size_t)(row0 + r) * GM_HALF + col0 + c8; const v4u uv = ur[ps];
                v4u o; o.x = cvtpk(bflo(uv.x) * bflo(mv.x), bfhi(uv.x) * bfhi(mv.x)); o.y = cvtpk(bflo(uv.y) * bflo(mv.y), bfhi(uv.y) * bfhi(mv.y));
                o.z = cvtpk(bflo(uv.z) * bflo(mv.z), bfhi(uv.z) * bfhi(mv.z)); o.w = cvtpk(bflo(uv.w) * bflo(mv.w), bfhi(uv.w) * bfhi(mv.w));
                *(v4u*)(y + off) = o; }
        }
#undef GS_ROW0
#undef GS_COL0
#undef GS_LDV
    }
}

__device__ __forceinline__ void fox_prep_phase(Frame& F, const bf16* x, const float* rs, const float* gmix, const float* wfox, const float* bfg, float* lf) {
    const int lane = F.lane, gw = F.vcu * NWAVES + F.wave, NGW = F.G * NWAVES;
    for (int idx = F.tid; idx < DM * 4; idx += NTHR) { const int k = idx >> 2, qd = idx & 3; const f32x4 w = *(const f32x4*)(wfox + (size_t)k * FOX_LD + FOX_N + 4 * qd) * gmix[k];
        const int slot = ((k >> 8) * 4 + (k & 3)) * 64 + ((k >> 2) & 63);
        *(LAS f32x4*)(F.lds + qd * 32768 + slot * 16) = w; }
    __syncthreads();
    for (int m = gw; m < M; m += NGW) {
        const v2u* xr = (const v2u*)(x + (size_t)m * DM) + lane;
        f32x4 v[8];
#pragma unroll
        for (int j = 0; j < 8; ++j) { const v2u t = xr[64 * j]; v[j] = (f32x4){bflo(t.x), bfhi(t.x), bflo(t.y), bfhi(t.y)}; }
        f32x4 a[4];
#pragma unroll
        for (int qd = 0; qd < 4; ++qd) a[qd] = (f32x4){0.f, 0.f, 0.f, 0.f};
#pragma unroll
        for (int j = 0; j < 8; ++j)
#pragma unroll
            for (int e = 0; e < 4; ++e) { const float hv = v[j][e];
#pragma unroll
                for (int qd = 0; qd < 4; ++qd) a[qd] += hv * *(const LAS f32x4*)(F.lds + qd * 32768 + ((j * 4 + e) * 64 + lane) * 16);
                asm volatile("" ::: "memory"); }
        float z = 0.f;
#pragma unroll
        for (int qd = 0; qd < 4; ++qd)
#pragma unroll
            for (int i = 0; i < 4; ++i) { const float t = wave_sum(a[qd][i]); z = (lane == qd * 4 + i) ? t : z; }
        if (lane < 16) lf[(size_t)m * 16 + lane] = log_sigmoid(z * pg8::row_rstd(rs, m) + bfg[lane]);
    }
}

typedef float f32x16 __attribute__((ext_vector_type(16)));
#define MFMA32(a, b, c) __builtin_amdgcn_mfma_f32_32x32x16_bf16((a), (b), (c), 0, 0, 0)
__device__ __forceinline__ void fox_attn_phase(Frame& F, const bf16* qn, const bf16* kn, const bf16* vv, const bf16* gs, const float* lf, bf16* y) {
    constexpr int RSK = 272, RSV = 320, KSLOT = 64 * RSK, VSLOT = 64 * RSV;
    const ldsp LK = F.lds, LV = F.lds + 2 * KSLOT;
    LAS float* c2 = (LAS float*)(F.lds + 75776);
    LAS float* red = (LAS float*)(F.lds + 92160);
    const int tid = F.tid, lane = F.lane, w = F.wave, r32 = lane & 31, hi = lane >> 5;
    int bh_have = -1;
    for (int pr = F.vcu; pr < 256; pr += F.G) {
        const int bh = pr >> 3, pi = pr & 7, b = bh >> 4, h = bh & 15;
        const size_t tok0 = (size_t)b * SEQ;
        if (bh != bh_have) {
            bh_have = bh;
            float x8[8]; float run = 0.f;
#pragma unroll
            for (int e = 0; e < 8; ++e) { run += lf[(tok0 + tid * 8 + e) * 16 + h]; x8[e] = run; }
            float inc = run;
#pragma unroll
            for (int o = 1; o < 64; o <<= 1) { const float t = __shfl_up(inc, o); if (lane >= o) inc += t; }
            __syncthreads();
            if (lane == 63) red[w] = inc;
            __syncthreads();
            float pre = inc - run;
#pragma unroll
            for (int wv = 0; wv < 8; ++wv) if (wv < w) pre += red[wv];
#pragma unroll
            for (int e = 0; e < 8; ++e) c2[tid * 8 + e] = (pre + x8[e]) * LOG2E;
        }
        for (int half = 0; half < 2; ++half) {
            const int qb = half ? 15 - pi : pi, q0 = qb * 256, ntile = 4 * qb + 4, qrow = q0 + 32 * w + r32;
            bf16x8 qf[8];
#pragma unroll
            for (int ks = 0; ks < 8; ++ks) qf[ks] = *(const bf16x8*)(qn + (tok0 + qrow) * DM + h * 128 + ks * 16 + 8 * hi);
            v4u kr[2], vr[2];
#define FA_LOAD(tt) do { _Pragma("unroll") for (int pp = 0; pp < 2; ++pp) { const int id_ = tid + NTHR * pp, r_ = id_ >> 4, c_ = id_ & 15; \
                kr[pp] = *(const v4u*)(kn + (tok0 + 64 * (tt) + r_) * DM + h * 128 + c_ * 8); vr[pp] = *(const v4u*)(vv + (tok0 + 64 * (tt) + r_) * DM + h * 128 + c_ * 8); } } while (0)
#define FA_STORE(sl) do { _Pragma("unroll") for (int pp = 0; pp < 2; ++pp) { const int id_ = tid + NTHR * pp, r_ = id_ >> 4, c_ = id_ & 15; \
                *(LAS v4u*)(LK + (sl) * KSLOT + r_ * RSK + c_ * 16) = kr[pp]; *(LAS v4u*)(LV + (sl) * VSLOT + r_ * RSV + c_ * 16) = vr[pp]; } } while (0)
            FA_LOAD(0);
            __syncthreads();
            FA_STORE(0);
            if (ntile > 1) FA_LOAD(1);
            const float cq = c2[qrow];
            float mx = 0.f, ls = 0.f;
            f32x16 O[4];
#pragma unroll
            for (int dt = 0; dt < 4; ++dt)
#pragma unroll
                for (int r = 0; r < 16; ++r) O[dt][r] = 0.f;
            for (int t = 0; t < ntile; ++t) {
                __syncthreads();
                if (t + 1 < ntile) { FA_STORE((t + 1) & 1); if (t + 2 < ntile) FA_LOAD(t + 2); }
                const int key0 = 64 * t;
                if (key0 <= q0 + 32 * w + 31) {
                    const ldsp sk = LK + (t & 1) * KSLOT + r32 * RSK + 16 * hi, sv = LV + (t & 1) * VSLOT;
                    f32x16 S0, S1;
                    const float cbase = cq - mx;
#pragma unroll
                    for (int g = 0; g < 4; ++g) { const f32x4 ck0 = *(const LAS f32x4*)(c2 + key0 + 8 * g + 4 * hi), ck1 = *(const LAS f32x4*)(c2 + key0 + 32 + 8 * g + 4 * hi);
#pragma unroll
                        for (int e = 0; e < 4; ++e) { S0[4 * g + e] = cbase - ck0[e]; S1[4 * g + e] = cbase - ck1[e]; } }
#pragma unroll
                    for (int ks = 0; ks < 8; ++ks) { S0 = MFMA32(*(const LAS bf16x8*)(sk + ks * 32), qf[ks], S0); S1 = MFMA32(*(const LAS bf16x8*)(sk + 32 * RSK + ks * 32), qf[ks], S1); }
                    if (key0 + 63 > q0 + 32 * w) {
#pragma unroll
                        for (int g = 0; g < 4; ++g)
#pragma unroll
                            for (int e = 0; e < 4; ++e) { const int key = key0 + 8 * g + 4 * hi + e; if (key > qrow) S0[4 * g + e] = -INFINITY; if (key + 32 > qrow) S1[4 * g + e] = -INFINITY; } }
                    float mloc = fmaxf(S0[0], S1[0]);
#pragma unroll
                    for (int r = 1; r < 16; ++r) mloc = __builtin_fmaxf(__builtin_fmaxf(mloc, S0[r]), S1[r]);
                    mloc = fmaxf(mloc, __shfl_xor(mloc, 32));
                    if (__any(mloc > 8.0f)) { const float dl = fmaxf(mloc, 0.f), alpha = __builtin_amdgcn_exp2f(-dl); mx += dl; ls *= alpha;
#pragma unroll
                        for (int r = 0; r < 16; ++r) { S0[r] -= dl; S1[r] -= dl; }
#pragma unroll
                        for (int dt = 0; dt < 4; ++dt)
#pragma unroll
                            for (int r = 0; r < 16; ++r) O[dt][r] *= alpha; }
                    float psum = 0.f;
#pragma unroll
                    for (int r = 0; r < 16; ++r) { S0[r] = __builtin_amdgcn_exp2f(S0[r]); S1[r] = __builtin_amdgcn_exp2f(S1[r]); psum += S0[r] + S1[r]; }
                    ls += psum;
                    v4u pf[4];
#pragma unroll
                    for (int s2 = 0; s2 < 2; ++s2) { pf[s2] = (v4u){cvtpk(S0[8 * s2 + 0], S0[8 * s2 + 1]), cvtpk(S0[8 * s2 + 2], S0[8 * s2 + 3]), cvtpk(S0[8 * s2 + 4], S0[8 * s2 + 5]), cvtpk(S0[8 * s2 + 6], S0[8 * s2 + 7])};
                        pf[2 + s2] = (v4u){cvtpk(S1[8 * s2 + 0], S1[8 * s2 + 1]), cvtpk(S1[8 * s2 + 2], S1[8 * s2 + 3]), cvtpk(S1[8 * s2 + 4], S1[8 * s2 + 5]), cvtpk(S1[8 * s2 + 6], S1[8 * s2 + 7])}; }
                    const ldsp vb = sv + (4 * hi + ((lane & 15) >> 2)) * RSV + (16 * ((lane >> 4) & 1) + 4 * (lane & 3)) * 2;
#pragma unroll
                    for (int s4 = 0; s4 < 4; ++s4)
#pragma unroll
                        for (int dt = 0; dt < 4; ++dt) { const ldsp va = vb + (16 * s4) * RSV + dt * 64; const s16x4 lo = vtr(va), hv = vtr(va + 8 * RSV);
                            const bf16x8 af = (bf16x8){lo[0], lo[1], lo[2], lo[3], hv[0], hv[1], hv[2], hv[3]};
                            O[dt] = MFMA32(af, __builtin_bit_cast(bf16x8, pf[s4]), O[dt]); }
                }
            }
            ls += __shfl_xor(ls, 32);
            const float il = 1.0f / ls;
            const size_t yoff = (tok0 + qrow) * DM + h * 128 + 4 * hi;
#pragma unroll
            for (int dt = 0; dt < 4; ++dt)
#pragma unroll
                for (int g = 0; g < 4; ++g) { const v2u gv = *(const v2u*)(gs + yoff + dt * 32 + 8 * g);
                    v2u o; o.x = cvtpk(O[dt][4 * g + 0] * il * bflo(gv.x), O[dt][4 * g + 1] * il * bfhi(gv.x)); o.y = cvtpk(O[dt][4 * g + 2] * il * bflo(gv.y), O[dt][4 * g + 3] * il * bfhi(gv.y));
                    *(v2u*)(y + yoff + dt * 32 + 8 * g) = o; }
        }
    }
#undef FA_LOAD
#undef FA_STORE
}
#ifndef R_RET_CORE
#define R_RET_CORE 1
#endif
#ifndef R_RET_GN
#define R_RET_GN 1
#endif
#ifndef R_GM_SP
#define R_GM_SP 1
#endif
#ifndef R_FOX_ATTN
#define R_FOX_ATTN 1
#endif
#ifndef R_FOX_PREP
#define R_FOX_PREP 1
#endif
#ifndef R_PRO
#define R_PRO 1
#endif
#ifndef F_GU_TAIL
#define F_GU_TAIL 0
#endif

#ifndef PROBE_A
#define PROBE_A -1
#endif
#ifndef PROBE_B
#define PROBE_B -1
#endif
#ifndef PROBE_MUL
#define PROBE_MUL 4
#endif
#define STAMP_AT(id) do { if (PROBE_A >= 0 && ((id) == PROBE_A || (id) == PROBE_B)) { if (F.tid == 0) { const unsigned long long t_ = __builtin_amdgcn_s_memrealtime(); \
        volatile LAS unsigned* m_ = F.MISC + ((id) == PROBE_A ? 16 : 20); m_[0] = (unsigned)t_; m_[1] = (unsigned)(t_ >> 32); } } } while (0)
struct Args { const void* in[21]; float* out; unsigned char* ws; int ph_lo, ph_hi, li, pad; };
#define IN(k) (lo <= (k) && (k) < hi)
#define SEAM(k) do { if (N_LAUNCHES == 1 && IN(k) && IN((k) + 1)) xcd_barrier(bar); STAMP_AT(k); } while (0)
template <int L>
__device__ __forceinline__ void layer_body(Frame& F, const Args& args, const XcdBarrier& bar, const int lo, const int hi) {
    unsigned char* ws = args.ws;
    constexpr int kind = L % 3, j = L / 3, pb = 1 + 6 * L;
    float* xo = args.out;
    bf16* XB = (bf16*)(ws + WS_H);
    bf16* A0 = (bf16*)(ws + WS_A); bf16* B0 = (bf16*)(ws + WS_B); bf16* C0 = (bf16*)(ws + WS_C);
    unsigned char* misc = ws + WS_MISC;
    float* rss = (float*)(ws + WS_RSP);
    PG8_LAS float* rtab = (PG8_LAS float*)(F.lds + RSTAB_OFF);
    if (IN(pb + 0)) {
        if (kind == 0) {
            pg8::Gemm g{XB, (const bf16*)(ws + WS_W_RET_IN + j * SZ_W_RET_IN), M, RET_N, DM}; pg8::RsOrder S; S.init(M, RET_N, F.G, (int)blockIdx.x); S.rs = rss + (size_t)(2 * L) * M * 32; S.tab = rtab; S.pend = 0.f; S.nready = 0;
            pg8::EpiRetIn E{A0, A0 + (size_t)M * 2048, A0 + (size_t)M * 4096, A0 + (size_t)M * 8192, (const float*)(ws + WS_ROPE_C), (const float*)(ws + WS_ROPE_S), rtab, 0};
            pg8::gemm_phase<pg8::EpiRetIn, pg8::RsOrder, PG8_ALIGN, PG8_SP2>(F.lds + RING_OFF, g, S, E);
        } else if (kind == 1) {
            pg8::Gemm g{XB, (const bf16*)(ws + WS_W_GM_IN), M, GM_N, DM}; pg8::RsOrder S; S.init(M, GM_N, F.G, (int)blockIdx.x); S.rs = rss + (size_t)(2 * L) * M * 32; S.tab = rtab; S.pend = 0.f; S.nready = 0;
            pg8::EpiGeluUV E{A0, A0 + (size_t)M * GM_HALF, (pg8::f32x2v*)(misc + MISC_PART), rtab, 0};
            pg8::gemm_phase<pg8::EpiGeluUV, pg8::RsOrder, PG8_ALIGN, PG8_SP2>(F.lds + RING_OFF, g, S, E);
        } else {
            pg8::Gemm g{XB, (const bf16*)(ws + WS_W_FOX_IN), M, FOX_N, DM}; pg8::RsOrder S; S.init(M, FOX_N, F.G, (int)blockIdx.x); S.rs = rss + (size_t)(2 * L) * M * 32; S.tab = rtab; S.pend = 0.f; S.nready = 0;
            PG8_LAS float* qkg = (PG8_LAS float*)(F.lds + QKG_OFF);
            if (F.tid < 256) qkg[F.tid] = F.tid < 128 ? ((const float*)args.in[15])[F.tid] : ((const float*)args.in[16])[F.tid - 128];
            __syncthreads();
            pg8::EpiFoxIn E{A0, (size_t)M * 2048, rtab, 0, (PG8_LAS float*)(F.lds + QKT_OFF), qkg};
            pg8::gemm_phase<pg8::EpiFoxIn, pg8::RsOrder, PG8_ALIGN, PG8_SP2>(F.lds + RING_OFF, g, S, E);
        }
    }
    SEAM(pb + 0);
    if (IN(pb + 1)) {
        if (kind == 0) { bf16* Pb = B0 + (size_t)M * 4096;
            bf16* KFb = (bf16*)(ws + WS_KF);
            bf16* QFb = (bf16*)(ws + WS_QF);
            ret_p_phase(F, A0, A0 + (size_t)M * 2048, Pb, KFb, QFb);
            if (N_LAUNCHES == 1) xcd_barrier(bar);
            STAMP_AT(500 + L);
            for (int rep_ = 0; rep_ < R_RET_CORE; ++rep_) ret_core_phase(F, QFb, A0 + (size_t)M * 4096, Pb, KFb, B0); }
        else if (kind == 1) { gm_stat_phase(F, (const f32x2*)(misc + MISC_PART), (f32x2*)(misc + MISC_RSTAT)); }
        else { for (int rep_ = 0; rep_ < R_FOX_PREP; ++rep_) fox_prep_phase(F,
                              XB, rss + (size_t)(2 * L) * M * 32, (const float*)args.in[2] + (size_t)L * DM, (const float*)args.in[13], (const float*)args.in[14], (float*)(misc + MISC_LF)); }
    }
    SEAM(pb + 1);
    if (IN(pb + 2)) {
        if (kind == 0) { for (int rep_ = 0; rep_ < R_RET_GN; ++rep_) ret_gn_phase(F, B0, A0 + (size_t)M * 8192, (const float*)args.in[5] + (size_t)j * 4096, C0); }
        else if (kind == 1) { for (int rep_ = 0; rep_ < R_GM_SP; ++rep_) gm_spatial_phase(F, A0, A0 + (size_t)M * GM_HALF, (const f32x2*)(misc + MISC_RSTAT), (const float*)args.in[8], (const float*)args.in[9], (const bf16*)(misc + MISC_WTRI), (const float*)args.in[11], B0); }
        else { for (int rep_ = 0; rep_ < R_FOX_ATTN; ++rep_) fox_attn_phase(F, A0, A0 + (size_t)M * 2048, A0 + (size_t)M * 4096, A0 + (size_t)M * 6144, (const float*)(misc + MISC_LF), B0); }
    }
    SEAM(pb + 2);
    if (IN(pb + 3)) {
        const bf16* Ain = kind == 0 ? C0 : B0; constexpr int K = kind == 0 ? 4096 : (kind == 1 ? GM_HALF : DM);
        const bf16* Wt = kind == 0 ? (const bf16*)(ws + WS_W_RET_OUT + j * SZ_W_RET_OUT) : (kind == 1 ? (const bf16*)(ws + WS_W_GM_OUT) : (const bf16*)(ws + WS_W_FOX_OUT));
        pg8::Gemm g{Ain, Wt, M, DM, K}; pg8::StaticOrder S; S.init(M, DM, F.G, (int)blockIdx.x);
        pg8::EpiRes<L == 0, false> E{(const float*)args.in[0], nullptr, XB, rss + (size_t)(2 * L + 1) * M * 32, DM};
        pg8::gemm_phase<pg8::EpiRes<L == 0, false>, pg8::StaticOrder, PG8_ALIGN, PG8_SP2>(F.lds + RING_OFF, g, S, E);
    }
    SEAM(pb + 3);
    if (IN(pb + 4)) {
        constexpr int NFULL = (F_GU_TAIL ? 40 : 44) * 256;
        { pg8::Gemm g{XB, (const bf16*)(ws + WS_W_GU + L * SZ_W_GU), M, NFULL, DM}; pg8::RsOrder S; S.init(M, NFULL, F.G, (int)blockIdx.x); S.rs = rss + (size_t)(2 * L + 1) * M * 32; S.tab = rtab; S.pend = 0.f; S.nready = 0;
          pg8::EpiSwiglu<false> E{A0, FFN_H, rtab, 0};
          pg8::gemm_phase<pg8::EpiSwiglu<false>, pg8::RsOrder, PG8_ALIGN, PG8_SP2>(F.lds + RING_OFF, g, S, E); }
        if (F_GU_TAIL) { pg8::Gemm g{XB, (const bf16*)(ws + WS_W_GU + L * SZ_W_GU), M, FFN_N2, DM}; pg8::TailOrder S; S.init(M, FFN_N2, F.G, (int)blockIdx.x); S.rs = rss + (size_t)(2 * L + 1) * M * 32; S.tab = rtab; S.pend = 0.f; S.nready = 0; S.pn0 = 40;
          pg8::EpiSwiglu<true> E{A0, FFN_H, rtab, 0};
          pg8::gemm_phase<pg8::EpiSwiglu<true>, pg8::TailOrder, PG8_ALIGN, PG8_SP2, true>(F.lds + RING_OFF, g, S, E); }
    }
    SEAM(pb + 4);
    if (IN(pb + 5)) {
        pg8::Gemm g{A0, (const bf16*)(ws + WS_W_DN + L * SZ_W_DN), M, DM, FFN_H}; pg8::StaticOrder S; S.init(M, DM, F.G, (int)blockIdx.x);
        pg8::EpiRes<false, L + 1 == DEPTH> E{nullptr, xo, XB, rss + (size_t)((2 * L + 2) & 7) * M * 32, DM};
        pg8::gemm_phase<pg8::EpiRes<false, L + 1 == DEPTH>, pg8::StaticOrder, PG8_ALIGN, PG8_SP2>(F.lds + RING_OFF, g, S, E);
    }
    SEAM(pb + 5);
}
__global__ void __launch_bounds__(NWAVES * 64, 2) trunk_fwd(Args args) {
    extern __shared__ __attribute__((aligned(16))) unsigned char lds[];
    Frame F;
    F.lds = (ldsp)lds;
    F.MISC = (volatile LAS unsigned*)(F.lds + MISC_OFF);
    F.tid = threadIdx.x; F.lane = F.tid & 63; F.wave = __builtin_amdgcn_readfirstlane(F.tid >> 6);
    F.G = gridDim.x; { const int bx = blockIdx.x; F.vcu = (F.G % 8 == 0) ? (bx % 8) * (F.G / 8) + bx / 8 : bx; }
    F.ctl = (gu32*)(args.ws + WS_CTL);
    for (int u = F.tid; u < (LDS_BYTES - LDSCTL_OFF) / 4; u += NWAVES * 64) ((LAS unsigned*)(F.lds + LDSCTL_OFF))[u] = 0u;
    __syncthreads();
    XcdBarrier bar; bar.bar = (unsigned*)(F.ctl + CW_BAR); bar.x = 0; bar.st = nullptr;
    if (N_LAUNCHES == 1) bar = xcd_barrier_post((unsigned*)(F.ctl + CW_BAR), F.MISC + 8);
    const int lo = args.ph_lo, hi = args.ph_hi;
    STAMP_AT(999);
    if (IN(0)) for (int rep_ = 0; rep_ < R_PRO; ++rep_) p0_prologue(F, args.in, args.ws);
    SEAM(0);
    layer_body<0>(F, args, bar, lo, hi); layer_body<1>(F, args, bar, lo, hi); layer_body<2>(F, args, bar, lo, hi); layer_body<3>(F, args, bar, lo, hi);
    if (PROBE_A >= 0 && F.tid == 0) {
        const unsigned long long ta = ((unsigned long long)F.MISC[17] << 32) | F.MISC[16], tb = ((unsigned long long)F.MISC[21] << 32) | F.MISC[20];
        const unsigned long long dly = (tb - ta) * (unsigned long long)PROBE_MUL, t0 = __builtin_amdgcn_s_memrealtime();
        if (tb > ta && dly < 400000ull) while (__builtin_amdgcn_s_memrealtime() - t0 < dly) __builtin_amdgcn_s_sleep(16);
    }
}
#undef IN
#undef SEAM

extern "C" void kernel_launch(void* const* d_in, const int* in_sizes, int n_in, void* d_out, int out_size, void* d_ws, size_t ws_size, hipStream_t stream) {
    static int grid = 0;
    if (grid == 0) {
        if (n_in != 21 || in_sizes[0] != M * DM || out_size != M * DM || ws_size < WS_END) { fprintf(stderr, "kernel_launch: unexpected shapes (n_in %d, in0 %d, out %d, ws %zu); nothing launched\n", n_in, n_in > 0 ? in_sizes[0] : -1, out_size, ws_size); grid = -1; return; }
        int dev = 0, cus = 0, per_cu = 0;
        if (hipGetDevice(&dev) != hipSuccess || hipDeviceGetAttribute(&cus, hipDeviceAttributeMultiprocessorCount, dev) != hipSuccess) { grid = -1; return; }
        if (hipFuncSetAttribute((const void*)trunk_fwd, hipFuncAttributeMaxDynamicSharedMemorySize, LDS_BYTES) != hipSuccess) { fprintf(stderr, "kernel_launch: hipFuncSetAttribute failed\n"); grid = -1; return; }
        if (hipOccupancyMaxActiveBlocksPerMultiprocessor(&per_cu, (const void*)trunk_fwd, NWAVES * 64, LDS_BYTES) != hipSuccess || per_cu < 1)
            fprintf(stderr, "kernel_launch: note: occupancy query reports %d workgroups per CU\n", per_cu);
        (void)hipGetLastError();
        grid = cus;
    }
    if (grid < 0) return;
    if (hipMemsetAsync((char*)d_ws + WS_CTL, 0, CTL_ZERO_BYTES, stream) != hipSuccess) return;
    Args a{};
    for (int i = 0; i < 21; ++i) a.in[i] = d_in[i];
    a.out = (float*)d_out; a.ws = (unsigned char*)d_ws;
    for (int li = 0; li < N_LAUNCHES; ++li) {
        a.ph_lo = (N_LAUNCHES == 1) ? 0 : li; a.ph_hi = (N_LAUNCHES == 1) ? N_PHASES : li + 1; a.li = li; a.pad = 0;
        hipLaunchKernelGGL(trunk_fwd, dim3(grid), dim3(NWAVES * 64), LDS_BYTES, stream, a);
        const hipError_t le = hipPeekAtLastError();
        if (le != hipSuccess) { fprintf(stderr, "kernel_launch: launch %d failed: %s\n", li, hipGetErrorName(le)); break; }
    }
}
```

```cpp
#include <hip/hip_runtime.h>
#include <cstdio>
#include <cstdint>
#include <cmath>
namespace pg8 {
#define PG8_LAS __attribute__((address_space(3)))
typedef unsigned short bf16_t;
typedef short bf16x8 __attribute__((ext_vector_type(8)));
typedef float f32x4 __attribute__((ext_vector_type(4)));
typedef unsigned u32x4 __attribute__((ext_vector_type(4)));
constexpr int BM = 256, BK = 64, HALF = 128, HTB = HALF * BK * 2  , STAGE_BYTES = 8 * HTB, NXCD = 8, WGM = 8;

__host__ __device__ __forceinline__ int lds_byte(int r, int c) { const int st = (r >> 4) * 2 + (c >> 5), rr = r & 15, cc = c & 31, ob = rr * 64 + cc * 2; return st * 1024 + (ob ^ (((ob >> 9) & 1) << 5)); }
__host__ __device__ __forceinline__ void stage_rc(int b, int& R, int& C) { const int st = b / 1024, sb = b % 1024, swz = sb ^ (((sb >> 9) & 1) << 5); R = (st >> 1) * 16 + swz / 64; C = (st & 1) * 32 + (swz % 64) / 2; }
__host__ __device__ __forceinline__ int perm32(int rho) { const int n = rho >> 4, i = rho & 15; return 8 * (i >> 2) + 4 * n + (i & 3); }

struct Unit { int pm, pn, hf; };
struct Gemm { const bf16_t* A; const bf16_t* Bt; int M, N, K; };

struct StaticOrder {
    int nM, nN, nwg, G, c;
    __host__ __device__ void init(int M, int N, int G_, int c_) { nM = M / BM; nN = N / BM; nwg = nM * nN; G = G_; c = c_; }
    __host__ __device__ bool next(int i, Unit& u) const {
        const long L = (long)i * G + c; if (L >= nwg) return false;
        int wgid = (int)L; { const int q = nwg / NXCD, r = nwg % NXCD, xcd = wgid % NXCD, off = wgid / NXCD; wgid = (xcd < r ? xcd * (q + 1) : r * (q + 1) + (xcd - r) * q) + off; }
        const int nig = WGM * nN, gid = wgid / nig, fm = gid * WGM, gsz = (nM - fm) < WGM ? (nM - fm) : WGM;
        u.pm = fm + ((wgid % nig) % gsz); u.pn = (wgid % nig) / gsz; u.hf = 0; return true;
    }
    __device__ __forceinline__ void a_ready(const Unit&) const {}
    __device__ __forceinline__ void done(const Unit&) const {}
};

__device__ __forceinline__ unsigned cvt_pk_bf16(float lo, float hi) { unsigned r; asm volatile("v_cvt_pk_bf16_f32 %0, %1, %2" : "=v"(r) : "v"(lo), "v"(hi)); return r; }
typedef float f32x2 __attribute__((ext_vector_type(2)));
__device__ __forceinline__ f32x2 gelu_pk(f32x2 v) {
    const f32x2 av = __builtin_elementwise_abs(v), d = av * 0.2316418882f + 1.0f;
    f32x2 t; t.x = __builtin_amdgcn_rcpf(d.x); t.y = __builtin_amdgcn_rcpf(d.y);
    f32x2 q = t * 0.5307027145f + (-0.7265760135f); q = q * t + 0.7107068705f; q = q * t + (-0.142248368f); q = q * t + 0.127414796f; q = q * t;
    const f32x2 s = (v * v) * (-0.72134752044f);
    f32x2 e; e.x = __builtin_amdgcn_exp2f(s.x); e.y = __builtin_amdgcn_exp2f(s.y);
    const f32x2 m = v * (q * e), r = v - m;
    f32x2 o; o.x = v.x < 0.f ? m.x : r.x; o.y = v.y < 0.f ? m.y : r.y; return o;
}

typedef float f32x2v __attribute__((ext_vector_type(2)));
typedef __bf16 bf16x2v __attribute__((ext_vector_type(2)));
__device__ __forceinline__ unsigned cvtpk(float lo, float hi) { f32x2v v = {lo, hi}; bf16x2v b = __builtin_convertvector(v, bf16x2v); return __builtin_bit_cast(unsigned, b); }
__device__ __forceinline__ u32x4 pack8(const f32x4 a, const f32x4 b) { u32x4 w; w.x = cvtpk(a[0], a[1]); w.y = cvtpk(a[2], a[3]); w.z = cvtpk(b[0], b[1]); w.w = cvtpk(b[2], b[3]); return w; }
#ifndef EPI_WT
#define EPI_WT 0
#endif
__device__ __forceinline__ void st16(void* p, const u32x4 v) {
#if EPI_WT
    asm volatile("global_store_dwordx4 %0, %1, off sc1\n\ts_nop 2" :: "v"(p), "v"(v) : "memory");
#else
    *(u32x4*)p = v;
#endif
}
__device__ __forceinline__ float fast_sigmoid(float x) { return __builtin_amdgcn_rcpf(1.0f + __builtin_amdgcn_exp2f(-1.44269504f * x)); }

template <bool BASE_F32, bool OUT_F32> struct EpiRes {
    static constexpr bool PERM = true, AFTER_DRAIN = false;
    const float* base; float* out; bf16_t* xb; float* rs; int ldc;
    __device__ __forceinline__ void operator()(const f32x4 (&acc)[2][2][4][2], const Unit& u, int wr, int wc, int fr, int fq) const {
        const int row0 = u.pm * BM + wr * 64 + fr, col0 = u.pn * BM + wc * 32 + 8 * fq;
#pragma unroll
        for (int ai = 0; ai < 2; ++ai)
#pragma unroll
            for (int m = 0; m < 4; ++m) { const int row = row0 + ai * HALF + m * 16; const size_t off = (size_t)row * ldc + col0; float ss = 0.f;
#pragma unroll
                for (int bj = 0; bj < 2; ++bj) { f32x4 b0, b1;
                    if (BASE_F32) { b0 = *(const f32x4*)(base + off + bj * HALF); b1 = *(const f32x4*)(base + off + bj * HALF + 4); }
                    else { const u32x4 w = *(const u32x4*)(xb + off + bj * HALF);
                        b0 = (f32x4){__uint_as_float(w.x << 16), __uint_as_float(w.x & 0xffff0000u), __uint_as_float(w.y << 16), __uint_as_float(w.y & 0xffff0000u)};
                        b1 = (f32x4){__uint_as_float(w.z << 16), __uint_as_float(w.z & 0xffff0000u), __uint_as_float(w.w << 16), __uint_as_float(w.w & 0xffff0000u)}; }
                    const f32x4 x0 = b0 + acc[ai][bj][m][0], x1 = b1 + acc[ai][bj][m][1];
                    if (OUT_F32) { *(f32x4*)(out + off + bj * HALF) = x0; *(f32x4*)(out + off + bj * HALF + 4) = x1; }
                    else st16(xb + off + bj * HALF, pack8(x0, x1));
                    ss += (x0[0] * x0[0] + x0[1] * x0[1]) + (x0[2] * x0[2] + x0[3] * x0[3]) + (x1[0] * x1[0] + x1[1] * x1[1]) + (x1[2] * x1[2] + x1[3] * x1[3]); }
                if (!OUT_F32) { ss += __shfl_xor(ss, 16); ss += __shfl_xor(ss, 32);
                    if (fq == 0) rs[(size_t)row * 32 + u.pn * 4 + wc] = ss; }
                }
    }
};
__device__ __forceinline__ float row_sumsq(const float* rs, int row) {
    const f32x4* p = (const f32x4*)(rs + (size_t)row * 32); f32x4 t = p[0];
#pragma unroll
    for (int i = 1; i < 8; ++i) t += p[i];
    return (t[0] + t[1]) + (t[2] + t[3]);
}
__device__ __forceinline__ float row_rstd(const float* rs, int row) { return 1.0f / sqrtf(row_sumsq(rs, row) * (1.0f / 2048.0f) + 1e-6f); }
struct RsOrder : StaticOrder {
    const float* rs; PG8_LAS float* tab; mutable float pend; mutable int nready;
    __device__ __forceinline__ void a_ready(const Unit& u) const {
        if (threadIdx.x < 256) pend = row_sumsq(rs, u.pm * BM + u.hf * HALF + threadIdx.x);
        ++nready;
    }
    __device__ __forceinline__ bool next(int i, Unit& u) const {
        if (i == 1 && threadIdx.x < 256) tab[threadIdx.x] = 1.0f / sqrtf(pend * (1.0f / 2048.0f) + 1e-6f);
        return StaticOrder::next(i, u);
    }
    __device__ __forceinline__ void done(const Unit&) const {
        if (threadIdx.x < 256) tab[((nready - 1) & 1) * 256 + threadIdx.x] = 1.0f / sqrtf(pend * (1.0f / 2048.0f) + 1e-6f);
    }
};
struct TailOrder : RsOrder {
    int pn0;
    __device__ __forceinline__ bool next(int i, Unit& u) const {
        if (i == 1 && threadIdx.x < 256) tab[threadIdx.x] = 1.0f / sqrtf(pend * (1.0f / 2048.0f) + 1e-6f);
        if (i != 0 || G != 256) return false;
        const int x = c & 7, l = c >> 3; u.pm = 4 * x + (l & 3); u.hf = (l >> 2) & 1; u.pn = pn0 + (l >> 3); return true;
    }
};
template <bool HALF_M> struct EpiSwiglu {
    static constexpr bool PERM = true, AFTER_DRAIN = false;
    bf16_t* O; int ldc; const PG8_LAS float* tab; mutable int ui;
    __device__ __forceinline__ void operator()(const f32x4 (&acc)[2][2][4][2], const Unit& u, int wr, int wc, int fr, int fq) const {
        const int row0 = u.pm * BM + (HALF_M ? u.hf * HALF : 0) + wr * 64 + fr, col0 = u.pn * HALF + wc * 32 + 8 * fq;
#pragma unroll
        for (int ai = 0; ai < (HALF_M ? 1 : 2); ++ai)
#pragma unroll
            for (int m = 0; m < 4; ++m) { bf16_t* rowp = O + (size_t)(row0 + ai * HALF + m * 16) * ldc + col0; const float r = tab[(ui & 1) * 256 + wr * 64 + fr + ai * HALF + m * 16];
                f32x4 v0, v1;
#pragma unroll
                for (int j = 0; j < 4; ++j) { const float g0 = acc[ai][0][m][0][j] * r, g1 = acc[ai][0][m][1][j] * r;
                    v0[j] = g0 * fast_sigmoid(g0) * (acc[ai][1][m][0][j] * r); v1[j] = g1 * fast_sigmoid(g1) * (acc[ai][1][m][1][j] * r); }
                st16(rowp, pack8(v0, v1)); }
        ++ui;
    }
};

struct EpiSwigluProbe {
    static constexpr bool PERM = true, AFTER_DRAIN = false;
    bf16_t* O; int never;
    __device__ __forceinline__ void operator()(const f32x4 (&acc)[2][2][4][2], const Unit& u, int wr, int wc, int fr, int fq) const {
        if (never) {
#pragma unroll
        for (int ai = 0; ai < 2; ++ai)
#pragma unroll
            for (int m = 0; m < 4; ++m) { bf16_t* rowp = O + (size_t)(u.pm * BM + wr * 64 + fr + ai * HALF + m * 16) * 5632 + u.pn * HALF + wc * 32 + 8 * fq;
                st16(rowp, pack8(acc[ai][0][m][0] + acc[ai][1][m][0], acc[ai][0][m][1] + acc[ai][1][m][1])); } }
    }
};
struct EpiRetIn {
    static constexpr bool PERM = true, AFTER_DRAIN = false;
    bf16_t *q, *k, *v, *g; const float *cs, *sn; const PG8_LAS float* tab; mutable int ui;
    __device__ __forceinline__ void operator()(const f32x4 (&acc)[2][2][4][2], const Unit& u, int wr, int wc, int fr, int fq) const {
        const int pn = u.pn, ci = wc * 32 + 8 * fq;
#pragma unroll
        for (int ai = 0; ai < 2; ++ai)
#pragma unroll
            for (int m = 0; m < 4; ++m) {
                const int row = u.pm * BM + ai * HALF + wr * 64 + m * 16 + fr, b = row >> 12, s = row & 4095; const float rr = tab[(ui & 1) * 256 + ai * HALF + wr * 64 + m * 16 + fr];
                if (pn < 16) {
                    const int h = pn & 7; const float sc = (pn < 8 ? 1.0f : 0.0625f) * rr;
                    bf16_t* dst = (pn < 8 ? q : k) + ((size_t)((b * 8 + h) * 4096 + s)) * 256 + ci;
                    f32x4 o1[2], o2[2];
#pragma unroll
                    for (int n = 0; n < 2; ++n) { const f32x4 c4 = *(const f32x4*)(cs + (size_t)row * 128 + ci + 4 * n), s4 = *(const f32x4*)(sn + (size_t)row * 128 + ci + 4 * n);
                        const f32x4 x1 = acc[ai][0][m][n], x2 = acc[ai][1][m][n];
                        o1[n] = (x1 * c4 - x2 * s4) * sc; o2[n] = (x2 * c4 + x1 * s4) * sc; }
                    st16(dst, pack8(o1[0], o1[1])); st16(dst + 128, pack8(o2[0], o2[1]));
                } else if (pn < 32) {
                    const int t = pn - 16, h = t >> 1, hf = t & 1;
                    bf16_t* dst = v + ((size_t)((b * 8 + h) * 4096 + s)) * 512 + hf * 256 + ci;
                    st16(dst, pack8(acc[ai][0][m][0] * rr, acc[ai][0][m][1] * rr)); st16(dst + 128, pack8(acc[ai][1][m][0] * rr, acc[ai][1][m][1] * rr));
                } else {
                    bf16_t* dst = g + (size_t)row * 4096 + (pn - 32) * 256 + ci;
                    st16(dst, pack8(acc[ai][0][m][0] * rr, acc[ai][0][m][1] * rr)); st16(dst + 128, pack8(acc[ai][1][m][0] * rr, acc[ai][1][m][1] * rr));
                }
            }
        ++ui;
    }
};
struct EpiGeluUV {
    static constexpr bool PERM = true, AFTER_DRAIN = false;
    bf16_t *uo, *vo; f32x2v* part; const PG8_LAS float* tab; mutable int ui;
    __device__ __forceinline__ void operator()(const f32x4 (&acc)[2][2][4][2], const Unit& u, int wr, int wc, int fr, int fq) const {
        const bool isv = u.pn >= 24; const int ct = isv ? u.pn - 24 : u.pn; bf16_t* dstb = isv ? vo : uo;
#pragma unroll
        for (int ai = 0; ai < 2; ++ai)
#pragma unroll
            for (int m = 0; m < 4; ++m) {
                const int row = u.pm * BM + ai * HALF + wr * 64 + m * 16 + fr;
                bf16_t* dst = dstb + (size_t)row * 6144 + ct * 256 + wc * 32 + 8 * fq;
                float s = 0.f, ss = 0.f; const float rr = tab[(ui & 1) * 256 + ai * HALF + wr * 64 + m * 16 + fr];
#pragma unroll
                for (int bj = 0; bj < 2; ++bj) { const f32x4 v0 = acc[ai][bj][m][0] * rr, v1 = acc[ai][bj][m][1] * rr;
                    const f32x2 a = gelu_pk((f32x2){v0[0], v0[1]}), b = gelu_pk((f32x2){v0[2], v0[3]}), c = gelu_pk((f32x2){v1[0], v1[1]}), d = gelu_pk((f32x2){v1[2], v1[3]});
                    const f32x4 z0 = {a.x, a.y, b.x, b.y}, z1 = {c.x, c.y, d.x, d.y};
                    st16(dst + bj * HALF, pack8(z0, z1));
                    s += (z0[0] + z0[1]) + (z0[2] + z0[3]) + (z1[0] + z1[1]) + (z1[2] + z1[3]);
                    ss += (z0[0] * z0[0] + z0[1] * z0[1]) + (z0[2] * z0[2] + z0[3] * z0[3]) + (z1[0] * z1[0] + z1[1] * z1[1]) + (z1[2] * z1[2] + z1[3] * z1[3]); }
                if (isv) { s += __shfl_xor(s, 16); s += __shfl_xor(s, 32); ss += __shfl_xor(ss, 16); ss += __shfl_xor(ss, 32);
                    if (fq == 0) part[((size_t)row * 24 + ct) * 4 + wc] = (f32x2v){s, ss}; }
            }
        ++ui;
    }
};
struct EpiFoxIn {
    static constexpr bool PERM = true, AFTER_DRAIN = false;
    bf16_t* O; size_t stride; const PG8_LAS float* tab; mutable int ui; PG8_LAS float* qkt; const PG8_LAS float* gains;
    __device__ __forceinline__ void operator()(const f32x4 (&acc)[2][2][4][2], const Unit& u, int wr, int wc, int fr, int fq) const {
        const int t = u.pn >> 3; bf16_t* base = O + (size_t)t * stride + (u.pn & 7) * 256 + wc * 32 + 8 * fq;
        if (t < 2) {
#pragma unroll
            for (int ai = 0; ai < 2; ++ai)
#pragma unroll
                for (int m = 0; m < 4; ++m) { const int rt = ai * HALF + wr * 64 + m * 16 + fr; const float rr = tab[(ui & 1) * 256 + rt];
#pragma unroll
                    for (int bj = 0; bj < 2; ++bj) { const f32x4 v0 = acc[ai][bj][m][0] * rr, v1 = acc[ai][bj][m][1] * rr;
                        float ss = (v0[0] * v0[0] + v0[1] * v0[1]) + (v0[2] * v0[2] + v0[3] * v0[3]) + (v1[0] * v1[0] + v1[1] * v1[1]) + (v1[2] * v1[2] + v1[3] * v1[3]);
                        ss += __shfl_xor(ss, 16); ss += __shfl_xor(ss, 32);
                        if (fq == 0) qkt[(rt * 2 + bj) * 4 + wc] = ss; } }
            asm volatile("s_waitcnt lgkmcnt(0)" ::: "memory"); __builtin_amdgcn_s_barrier(); asm volatile("" ::: "memory");
            const float sc = t == 0 ? 0.08838834764831845f * 1.4426950408889634f : 1.0f;
            const f32x4 g0 = *(const PG8_LAS f32x4*)(gains + t * 128 + wc * 32 + 8 * fq), g1 = *(const PG8_LAS f32x4*)(gains + t * 128 + wc * 32 + 8 * fq + 4);
#pragma unroll
            for (int ai = 0; ai < 2; ++ai)
#pragma unroll
                for (int m = 0; m < 4; ++m) { const int rt = ai * HALF + wr * 64 + m * 16 + fr; const float rr = tab[(ui & 1) * 256 + rt]; bf16_t* dst = base + (size_t)(u.pm * BM + rt) * 2048;
#pragma unroll
                    for (int bj = 0; bj < 2; ++bj) { const f32x4 p = *(const PG8_LAS f32x4*)(qkt + (rt * 2 + bj) * 4);
                        const float rs = rr * sc / sqrtf(((p[0] + p[1]) + (p[2] + p[3])) * (1.0f / 128.0f) + 1e-6f);
                        st16(dst + bj * HALF, pack8(acc[ai][bj][m][0] * rs * g0, acc[ai][bj][m][1] * rs * g1)); } }
        } else {
#pragma unroll
            for (int ai = 0; ai < 2; ++ai)
#pragma unroll
                for (int m = 0; m < 4; ++m) { const int row = u.pm * BM + ai * HALF + wr * 64 + m * 16 + fr; bf16_t* dst = base + (size_t)row * 2048; const float rr = tab[(ui & 1) * 256 + ai * HALF + wr * 64 + m * 16 + fr];
#pragma unroll
                    for (int bj = 0; bj < 2; ++bj) { f32x4 v0 = acc[ai][bj][m][0] * rr, v1 = acc[ai][bj][m][1] * rr;
                        if (t == 3) {
#pragma unroll
                            for (int j = 0; j < 4; ++j) { v0[j] = fast_sigmoid(v0[j]); v1[j] = fast_sigmoid(v1[j]); } }
                        st16(dst + bj * HALF, pack8(v0, v1)); } }
        }
        ++ui;
    }
};

template <class Epi, class Sched, bool ALIGN_EPI = false, bool SP2 = false, bool HALF_M = false>
__device__ __forceinline__ void gemm_phase(PG8_LAS unsigned char* lds, const Gemm g, const Sched& S, const Epi& E) {
    const int tid = threadIdx.x, wid = __builtin_amdgcn_readfirstlane(tid >> 6), lane = tid & 63, wr = wid >> 2, wc = wid & 3, fr = lane & 15, fq = lane >> 4;
    static_assert(!HALF_M || SP2, "HALF_M is written for the SP2 loop");
    const int K = g.K, nt = K / BK;
    unsigned voffA[2], voffB[2];
#pragma unroll
    for (int i = 0; i < 2; ++i) { int R, C; stage_rc(tid * 16 + i * 8192, R, C); const int Rb = Epi::PERM ? ((R & ~31) + perm32(R & 31)) : R;
        voffA[i] = (unsigned)(R * K + C) * 2u; voffB[i] = (unsigned)(Rb * K + C) * 2u; }
    const size_t kstep = (size_t)(BK * 2);
    const size_t hstep = (size_t)HALF * K * 2;
    const size_t tstep = 2 * hstep;
    const unsigned ldsw = (unsigned)wid * 1024u;
    const int aoff = lds_byte(wr * 64 + fr, fq * 8), boff = lds_byte(wc * 32 + fr, fq * 8);
#define PG8_SA(b, h) (((b) * 2 + (h)) * HTB)
#define PG8_SB(b, h) ((4 + (b) * 2 + (h)) * HTB)
#define PG8_STAGE(bufoff, gbase, voff) do { _Pragma("unroll") for (int _i = 0; _i < 2; ++_i) \
        __builtin_amdgcn_global_load_lds((const unsigned*)((const char*)(gbase) + (voff)[_i]), (PG8_LAS unsigned*)(lds + (bufoff) + ldsw + _i * 8192), 16, 0, 0); } while (0)
#define PG8_LDA(dst, b, h) do { _Pragma("unroll") for (int m = 0; m < 4; ++m) _Pragma("unroll") for (int k = 0; k < 2; ++k) dst[m][k] = *(const PG8_LAS bf16x8*)(lds + PG8_SA(b, h) + aoff + m * 2048 + k * 1024); } while (0)
#define PG8_LDB(dst, b, h) do { _Pragma("unroll") for (int n = 0; n < 2; ++n) _Pragma("unroll") for (int k = 0; k < 2; ++k) dst[n][k] = *(const PG8_LAS bf16x8*)(lds + PG8_SB(b, h) + boff + n * 2048 + k * 1024); } while (0)
#define PG8_MMA(ai, bj, At, Bt) do { __builtin_amdgcn_s_setprio(1); _Pragma("unroll") for (int m = 0; m < 4; ++m) _Pragma("unroll") for (int n = 0; n < 2; ++n) _Pragma("unroll") for (int k = 0; k < 2; ++k) \
        acc[ai][bj][m][n] = __builtin_amdgcn_mfma_f32_16x16x32_bf16(Bt[n][k], At[m][k], acc[ai][bj][m][n], 0, 0, 0); __builtin_amdgcn_s_setprio(0); } while (0)
#define PG8_WAIT_V(n) asm volatile("s_waitcnt vmcnt(" #n ")" ::: "memory")
#define PG8_WAIT_L(n) asm volatile("s_waitcnt lgkmcnt(" #n ")" ::: "memory")
#define PG8_BAR __builtin_amdgcn_s_barrier()
#define PG8_SCHED __builtin_amdgcn_sched_barrier(0)
    Unit cur, nxt; int ui = 0;
    if (!S.next(0, cur)) return;
    f32x4 acc[2][2][4][2];
#pragma unroll
    for (int a = 0; a < 2; ++a)
#pragma unroll
        for (int b = 0; b < 2; ++b)
#pragma unroll
            for (int m = 0; m < 4; ++m)
#pragma unroll
                for (int n = 0; n < 2; ++n) acc[a][b][m][n] = (f32x4){0.f, 0.f, 0.f, 0.f};
    bf16x8 At[4][2], B0[2][2], B1[2][2];
    const char* cA = (const char*)g.A + (size_t)cur.pm * tstep + (HALF_M ? (size_t)cur.hf * hstep : (size_t)0); const char* cB = (const char*)g.Bt + (size_t)cur.pn * tstep;
    S.a_ready(cur);
    if constexpr (SP2) {
        PG8_STAGE(PG8_SB(0, 0), cB, voffB); PG8_STAGE(PG8_SB(0, 1), cB + hstep, voffB); PG8_STAGE(PG8_SA(0, 0), cA, voffA); PG8_STAGE(PG8_SA(0, 1), cA + hstep, voffA);
        if (wr == 1) PG8_BAR;
        PG8_WAIT_V(2); PG8_BAR;
        PG8_STAGE(PG8_SB(1, 0), cB + kstep, voffB); PG8_STAGE(PG8_SA(1, 0), cA + kstep, voffA); PG8_STAGE(PG8_SB(1, 1), cB + hstep + kstep, voffB);
        PG8_WAIT_V(6); PG8_BAR;
    } else {
        PG8_STAGE(PG8_SB(0, 0), cB, voffB); PG8_STAGE(PG8_SA(0, 0), cA, voffA); PG8_STAGE(PG8_SB(0, 1), cB + hstep, voffB); PG8_STAGE(PG8_SA(0, 1), cA + hstep, voffA);
        if (wr == 1) PG8_BAR;
        PG8_WAIT_V(4); PG8_BAR;
        PG8_STAGE(PG8_SB(1, 0), cB + kstep, voffB); PG8_STAGE(PG8_SA(1, 0), cA + kstep, voffA); PG8_STAGE(PG8_SB(1, 1), cB + hstep + kstep, voffB);
        PG8_WAIT_V(6); PG8_BAR;
    }
    for (;;) {
        const bool has_next = S.next(ui + 1, nxt);
        const char* nA = has_next ? (const char*)g.A + (size_t)nxt.pm * tstep + (HALF_M ? (size_t)nxt.hf * hstep : (size_t)0) : cA; const char* nB = has_next ? (const char*)g.Bt + (size_t)nxt.pn * tstep : cB;
        for (int t = 0; t < nt; t += 2) {
            const bool last = (t == nt - 2);
            const char* a1 = cA + (size_t)(t + 1) * kstep;
            const char* a2 = last ? nA : cA + (size_t)(t + 2) * kstep; const char* b2 = last ? nB : cB + (size_t)(t + 2) * kstep;
            const char* a3 = a2 + kstep; const char* b3 = b2 + kstep;
            if (last && has_next) S.a_ready(nxt);
            if constexpr (SP2) {
            PG8_LDB(B0, 0, 0); PG8_LDB(B1, 0, 1); PG8_SCHED; PG8_LDA(At, 0, 0); PG8_STAGE(PG8_SA(1, 1), a1 + hstep, voffA);
            PG8_WAIT_V(8); PG8_WAIT_L(0); PG8_BAR; PG8_MMA(0, 0, At, B0); PG8_MMA(0, 1, At, B1); PG8_BAR; PG8_SCHED;
            if constexpr (!HALF_M) { PG8_LDA(At, 0, 1); } PG8_STAGE(PG8_SB(0, 0), b2, voffB); PG8_STAGE(PG8_SB(0, 1), b2 + hstep, voffB); PG8_STAGE(PG8_SA(0, 0), a2, voffA);
            PG8_WAIT_V(8); PG8_WAIT_L(0); PG8_BAR; if constexpr (!HALF_M) { PG8_MMA(1, 0, At, B0); PG8_MMA(1, 1, At, B1); } PG8_BAR; PG8_SCHED;
            PG8_LDB(B0, 1, 0); PG8_LDB(B1, 1, 1); PG8_SCHED; PG8_LDA(At, 1, 0); PG8_STAGE(PG8_SA(0, 1), a2 + hstep, voffA);
            PG8_WAIT_V(8); PG8_WAIT_L(0); PG8_BAR; PG8_MMA(0, 0, At, B0); PG8_MMA(0, 1, At, B1); PG8_BAR; PG8_SCHED;
            if constexpr (!HALF_M) { PG8_LDA(At, 1, 1); } PG8_STAGE(PG8_SB(1, 0), b3, voffB); PG8_STAGE(PG8_SB(1, 1), b3 + hstep, voffB); PG8_STAGE(PG8_SA(1, 0), a3, voffA);
            PG8_WAIT_V(8); PG8_WAIT_L(0); PG8_BAR; if constexpr (!HALF_M) { PG8_MMA(1, 0, At, B0); PG8_MMA(1, 1, At, B1); } PG8_BAR; PG8_SCHED;
            } else {
            PG8_LDB(B0, 0, 0); PG8_SCHED; PG8_LDA(At, 0, 0); PG8_STAGE(PG8_SA(1, 1), a1 + hstep, voffA);
            PG8_WAIT_L(8); PG8_BAR; PG8_WAIT_L(0); PG8_MMA(0, 0, At, B0); PG8_BAR; PG8_SCHED;
            PG8_LDB(B1, 0, 1); PG8_STAGE(PG8_SB(0, 0), b2, voffB);
            PG8_BAR; PG8_WAIT_L(0); PG8_MMA(0, 1, At, B1); PG8_BAR;
            PG8_LDA(At, 0, 1); PG8_STAGE(PG8_SA(0, 0), a2, voffA);
            PG8_BAR; PG8_WAIT_L(0); PG8_MMA(1, 0, At, B0); PG8_BAR; PG8_SCHED;
            PG8_STAGE(PG8_SB(0, 1), b2 + hstep, voffB);
            PG8_WAIT_V(6); PG8_BAR; PG8_MMA(1, 1, At, B1); PG8_BAR;
            PG8_LDB(B0, 1, 0); PG8_SCHED; PG8_LDA(At, 1, 0); PG8_STAGE(PG8_SA(0, 1), a2 + hstep, voffA);
            PG8_WAIT_L(8); PG8_BAR; PG8_WAIT_L(0); PG8_MMA(0, 0, At, B0); PG8_BAR; PG8_SCHED;
            PG8_LDB(B1, 1, 1); PG8_STAGE(PG8_SB(1, 0), b3, voffB);
            PG8_BAR; PG8_WAIT_L(0); PG8_MMA(0, 1, At, B1); PG8_BAR;
            PG8_LDA(At, 1, 1); PG8_STAGE(PG8_SA(1, 0), a3, voffA);
            PG8_BAR; PG8_WAIT_L(0); PG8_MMA(1, 0, At, B0); PG8_BAR; PG8_SCHED;
            PG8_STAGE(PG8_SB(1, 1), b3 + hstep, voffB);
            PG8_WAIT_V(6); PG8_BAR; PG8_MMA(1, 1, At, B1); PG8_BAR;
            }
        }
        if constexpr (ALIGN_EPI) { if (wr == 0) PG8_BAR; }
        if constexpr (!Epi::AFTER_DRAIN) { E(acc, cur, wr, wc, fr, fq); S.done(cur); }
        if (!has_next) break;
#pragma unroll
        for (int a = 0; a < 2; ++a)
#pragma unroll
            for (int b = 0; b < 2; ++b)
#pragma unroll
                for (int m = 0; m < 4; ++m)
#pragma unroll
                    for (int n = 0; n < 2; ++n) acc[a][b][m][n] = (f32x4){0.f, 0.f, 0.f, 0.f};
        cur = nxt; cA = nA; cB = nB; ++ui;
        if constexpr (ALIGN_EPI) { if (wr == 1) PG8_BAR; }
    }
    PG8_WAIT_V(0);
    if constexpr (!ALIGN_EPI) { if (wr == 0) PG8_BAR; }
    PG8_BAR;
    if constexpr (Epi::AFTER_DRAIN) { E.fused(acc, cur, wr, wc, fr, fq, lds, wid, lane); S.done(cur); }
#undef PG8_SA
#undef PG8_SB
#undef PG8_STAGE
#undef PG8_LDA
#undef PG8_LDB
#undef PG8_MMA
#undef PG8_WAIT_V
#undef PG8_WAIT_L
#undef PG8_BAR
#undef PG8_SCHED
}
}

#ifndef PG8_SP2
#define PG8_SP2 true
#endif
#ifndef PG8_ALIGN
#define PG8_ALIGN true
#endif
constexpr int NWAVES = 8, NTHR = 512;
#ifndef MK_N_LAUNCHES
#define MK_N_LAUNCHES 1
#endif
constexpr int N_PHASES = 25;
constexpr int N_LAUNCHES = MK_N_LAUNCHES;
static_assert(N_LAUNCHES == 1, "this build runs as ONE launch (the retention mixer has a grid barrier inside its phase)");

constexpr int BATCH = 2, SEQ = 4096, DM = 2048, M = BATCH * SEQ, DEPTH = 4;
constexpr int RET_N = 12288, GM_N = 12288, GM_HALF = 6144, FOX_LD = 8208, FOX_N = 8192, FFN_H = 5632, FFN_N2 = 2 * FFN_H;
constexpr float EPS = 1e-6f;
constexpr float LOG2E = 1.4426950408889634f;

constexpr size_t MiB = (size_t)1 << 20;
constexpr size_t WS_CTL = 0, CTL_ZERO_BYTES = 1 * MiB;
constexpr size_t WS_W_RET_IN = 1 * MiB, SZ_W_RET_IN = 48 * MiB;
constexpr size_t WS_W_RET_OUT = 97 * MiB, SZ_W_RET_OUT = 16 * MiB;
constexpr size_t WS_W_GM_IN = 129 * MiB, WS_W_GM_OUT = 177 * MiB, WS_W_FOX_IN = 201 * MiB, WS_W_FOX_OUT = 233 * MiB;
constexpr size_t WS_W_GU = 241 * MiB, SZ_W_GU = 44 * MiB;
constexpr size_t WS_W_DN = 417 * MiB, SZ_W_DN = 22 * MiB;
constexpr size_t WS_ROPE_C = 505 * MiB, WS_ROPE_S = 509 * MiB;
constexpr size_t WS_H = 513 * MiB;
constexpr size_t WS_A = 545 * MiB;
constexpr size_t WS_B = 737 * MiB;
constexpr size_t WS_C = 833 * MiB;
constexpr size_t WS_MISC = 897 * MiB, WS_RSP = 913 * MiB, WS_KF = 921 * MiB, WS_QF = 953 * MiB, WS_END = 985 * MiB;
constexpr size_t MISC_PART = 0, MISC_RSTAT = 8 * MiB, MISC_LF = 9 * MiB, MISC_WTRI = 12 * MiB;
constexpr int CW_BAR = 4096;

constexpr int RING_OFF = 0, RING_BYTES = 131072;
constexpr int LDSCTL_OFF = RING_BYTES, MISC_OFF = LDSCTL_OFF + 320;
constexpr int RSTAB_OFF = LDSCTL_OFF + 1024;
constexpr int QKT_OFF = LDSCTL_OFF + 3072, QKG_OFF = QKT_OFF + 8192;
constexpr int LDS_BYTES = 147456;
static_assert(MISC_OFF + 128 <= RSTAB_OFF && RSTAB_OFF + 2048 <= QKT_OFF && QKG_OFF + 1024 <= LDS_BYTES, "LDS map");

#define GAS __attribute__((address_space(1)))
#define LAS __attribute__((address_space(3)))
typedef unsigned short bf16;
typedef unsigned v4u __attribute__((ext_vector_type(4)));
typedef unsigned v2u __attribute__((ext_vector_type(2)));
typedef float f32x4 __attribute__((ext_vector_type(4)));
typedef float f32x2 __attribute__((ext_vector_type(2)));
typedef short bf16x8 __attribute__((ext_vector_type(8)));
typedef short s16x4 __attribute__((ext_vector_type(4)));
typedef GAS unsigned gu32;
typedef LAS unsigned char* ldsp;
#define RLX_AGENT __ATOMIC_RELAXED, __HIP_MEMORY_SCOPE_AGENT
#define LDS_WAIT() asm volatile("s_waitcnt lgkmcnt(0)" ::: "memory")
using pg8::cvtpk;
__device__ __forceinline__ float bflo(unsigned w) { return __uint_as_float(w << 16); }
__device__ __forceinline__ float bfhi(unsigned w) { return __uint_as_float(w & 0xffff0000u); }
#define MFMA16(a, b, c) __builtin_amdgcn_mfma_f32_16x16x32_bf16((a), (b), (c), 0, 0, 0)
__device__ __forceinline__ bf16x8 frag_row(const ldsp tile, int RS, int lane) { return *(const LAS bf16x8*)(tile + (lane & 15) * RS + (lane >> 4) * 16); }
typedef short v4i16_t __attribute__((ext_vector_type(4)));
__device__ __forceinline__ s16x4 vtr(const ldsp p) { return __builtin_bit_cast(s16x4, __builtin_amdgcn_ds_read_tr16_b64_v4i16((LAS v4i16_t*)p)); }
__device__ __forceinline__ bf16x8 frag_tr(const ldsp tile, int RS, int lane) {
    const ldsp a = tile + (8 * (lane >> 4) + ((lane & 15) >> 2)) * RS + 8 * (lane & 3);
    const s16x4 lo = vtr(a), hi = vtr(a + 4 * RS);
    return (bf16x8){lo[0], lo[1], lo[2], lo[3], hi[0], hi[1], hi[2], hi[3]};
}

#define XB_TMO      128
#define XB_XCNT(j)  (256  + 64 * (j))
#define XB_XSUB(j)  (1280 + 64 * (j))
#define XB_XGEN(j)  (2304 + 64 * (j))
#define XB_TOP      3328
#define XB_TOPGEN   3392
#define XCD_BAR_WORDS 3456
#define XB_SPIN_CAP (1u << 18)

__device__ __forceinline__ unsigned xb_ld(unsigned* p)              { return __hip_atomic_load(p, __ATOMIC_RELAXED, __HIP_MEMORY_SCOPE_AGENT); }
__device__ __forceinline__ unsigned xb_add(unsigned* p, unsigned v) { return __hip_atomic_fetch_add(p, v, __ATOMIC_RELAXED, __HIP_MEMORY_SCOPE_AGENT); }
__device__ __forceinline__ unsigned xb_xcc_id() { return (unsigned)__builtin_amdgcn_s_getreg((3 << 11) | 20) & 0xFu; }
#define XB_SPIN(cond, bar) do { unsigned _sp = 0; while (cond) { __builtin_amdgcn_s_sleep(1); \
    if ((++_sp & 255u) == 0u) { if (xb_ld(&(bar)[XB_TMO])) break; if (_sp > XB_SPIN_CAP) { atomicAdd(&(bar)[XB_TMO], 1u); break; } } } } while (0)

struct XcdBarrier {
    unsigned* bar; unsigned x;
    volatile LAS unsigned* st;
};

__device__ __forceinline__ XcdBarrier xcd_barrier_post(unsigned* bar, volatile LAS unsigned* st) {
    XcdBarrier b; b.bar = bar; b.x = xb_xcc_id(); b.st = st;
    if (threadIdx.x == 0) (void)xb_add(&bar[XB_XCNT(b.x)], 1u);
    return b;
}
__device__ __forceinline__ void xcd_barrier_complete(unsigned* bar, unsigned x, unsigned& nloc, unsigned& nx) {
    const unsigned G = gridDim.x * gridDim.y * gridDim.z;
    unsigned sum, cnt, mine, sp = 0u;
    for (;;) {
        sum = 0u; cnt = 0u; mine = 0u;
#pragma unroll
        for (unsigned j = 0; j < 16; ++j) { const unsigned c = xb_ld(&bar[XB_XCNT(j)]); sum += c; cnt += (c > 0u) ? 1u : 0u; mine = (j == x) ? c : mine; }
        if (sum == G) break;
        __builtin_amdgcn_s_sleep(1);
        if ((++sp & 255u) == 0u) { if (xb_ld(&bar[XB_TMO])) break; if (sp > XB_SPIN_CAP) { atomicAdd(&bar[XB_TMO], 1u); break; } }
    }
    nloc = mine > 0u ? mine : 1u; nx = cnt > 0u ? cnt : 1u;
}

__device__ __forceinline__ void xcd_barrier(const XcdBarrier& b) {
    asm volatile("s_waitcnt vmcnt(0)" ::: "memory");
    __syncthreads();
    if (threadIdx.x == 0) {
        unsigned* bar = b.bar;
        __builtin_amdgcn_s_waitcnt(0);
        unsigned nloc = b.st[0], nx = b.st[1];
        if (nloc == 0u) { xcd_barrier_complete(bar, b.x, nloc, nx); b.st[0] = nloc; b.st[1] = nx; }
        const unsigned old = xb_add(&bar[XB_XSUB(b.x)], 1u);
        const unsigned gen = old / nloc;
        if (old + 1u == (gen + 1u) * nloc) {
            __builtin_amdgcn_fence(__ATOMIC_RELEASE, "agent");
            asm volatile("s_waitcnt vmcnt(0)" ::: "memory");
            const unsigned og = xb_add(&bar[XB_TOP], 1u);
            const unsigned tg = og / nx;
            if (og + 1u == (tg + 1u) * nx) xb_add(&bar[XB_TOPGEN], 1u);
            else XB_SPIN(xb_ld(&bar[XB_TOPGEN]) == tg, bar);
            __builtin_amdgcn_fence(__ATOMIC_ACQUIRE, "agent");
            xb_add(&bar[XB_XGEN(b.x)], 1u);
            asm volatile("s_waitcnt vmcnt(0)" ::: "memory");
        } else {
            XB_SPIN(xb_ld(&bar[XB_XGEN(b.x)]) == gen, bar);
            __builtin_amdgcn_fence(__ATOMIC_ACQUIRE, "agent");
            asm volatile("s_waitcnt vmcnt(0)" ::: "memory");
        }
    }
    __syncthreads();
}

struct Frame {
    ldsp lds;
    volatile LAS unsigned* MISC;
    gu32* ctl;
    int tid, lane, wave;
    int vcu, G;
};
__device__ __forceinline__ float wave_sum(float v) {
#pragma unroll
    for (int o = 1; o < 64; o <<= 1) v += __shfl_xor(v, o);
    return v;
}
__device__ __forceinline__ float log_sigmoid(float z) { return fminf(z, 0.f) - log1pf(expf(-fabsf(z))); }

__device__ __forceinline__ void transpose_job(Frame& F, const float* W, int K, int ld, int ncols, bf16* WT, int ilv, const float* gvec) {
    LAS float* scr = (LAS float*)(F.lds + RING_OFF + F.wave * 16384);
    const int gw = F.vcu * NWAVES + F.wave, NGW = F.G * NWAVES, lane = F.lane;
    const int nblk = ncols / 32, nitems = (K / 64) * nblk;
    float wv[32];
#define TJ_LOAD(item) do { const int kb_ = (item) / nblk, nb_ = (item) % nblk; const float* src_ = W + (size_t)(64 * kb_ + (lane >> 5)) * ld + 32 * nb_ + (lane & 31); \
        _Pragma("unroll") for (int i = 0; i < 32; ++i) wv[i] = src_[(size_t)(2 * i) * ld]; } while (0)
    if (gw < nitems) TJ_LOAD(gw);
    for (int it = gw; it < nitems; it += NGW) {
        const int kb = it / nblk, nb = it % nblk, k0 = 64 * kb, n0 = 32 * nb;
        const int drow0 = ilv == 0 ? n0 : ((n0 >> 7) * 256 + (n0 & 127) + (ilv == 2 ? 128 : 0));
#pragma unroll
        for (int i = 0; i < 32; ++i) scr[(2 * i + (lane >> 5)) * 33 + (lane & 31)] = wv[i];
        if (it + NGW < nitems) TJ_LOAD(it + NGW);
        LDS_WAIT(); asm volatile("" ::: "memory");
        const int c = lane & 7;
        f32x4 ga = {1.f, 1.f, 1.f, 1.f}, gb = {1.f, 1.f, 1.f, 1.f};
        if (gvec) { ga = *(const f32x4*)(gvec + k0 + 8 * c); gb = *(const f32x4*)(gvec + k0 + 8 * c + 4); }
#pragma unroll
        for (int j = 0; j < 4; ++j) { const int n = (lane >> 3) + 8 * j; const LAS float* s = scr + (8 * c) * 33 + n;
            v4u o; o.x = cvtpk(s[0 * 33] * ga[0], s[1 * 33] * ga[1]); o.y = cvtpk(s[2 * 33] * ga[2], s[3 * 33] * ga[3]); o.z = cvtpk(s[4 * 33] * gb[0], s[5 * 33] * gb[1]); o.w = cvtpk(s[6 * 33] * gb[2], s[7 * 33] * gb[3]);
            *(GAS v4u*)(WT + (size_t)(drow0 + n) * K + k0 + 8 * c) = o; }
        LDS_WAIT(); asm volatile("" ::: "memory");
    }
#undef TJ_LOAD
}
__device__ __forceinline__ void p0_prologue(Frame& F, const void* const* in, unsigned char* ws) {
    const float* mixg = (const float*)in[2]; const float* ffng = (const float*)in[3];
    for (int j = 0; j < 2; ++j) {
        transpose_job(F, (const float*)in[4] + (size_t)j * DM * RET_N, DM, RET_N, RET_N, (bf16*)(ws + WS_W_RET_IN + j * SZ_W_RET_IN), 0, mixg + (size_t)(3 * j) * DM);
        transpose_job(F, (const float*)in[6] + (size_t)j * 4096 * DM, 4096, DM, DM, (bf16*)(ws + WS_W_RET_OUT + j * SZ_W_RET_OUT), 0, nullptr);
    }
    transpose_job(F, (const float*)in[7], DM, GM_N, GM_N, (bf16*)(ws + WS_W_GM_IN), 0, mixg + DM);
    transpose_job(F, (const float*)in[12], GM_HALF, DM, DM, (bf16*)(ws + WS_W_GM_OUT), 0, nullptr);
    transpose_job(F, (const float*)in[13], DM, FOX_LD, FOX_N, (bf16*)(ws + WS_W_FOX_IN), 0, mixg + 2 * DM);
    transpose_job(F, (const float*)in[17], DM, DM, DM, (bf16*)(ws + WS_W_FOX_OUT), 0, nullptr);
    for (int i = 0; i < DEPTH; ++i) {
        transpose_job(F, (const float*)in[18] + (size_t)i * DM * FFN_H, DM, FFN_H, FFN_H, (bf16*)(ws + WS_W_GU + i * SZ_W_GU), 1, ffng + (size_t)i * DM);
        transpose_job(F, (const float*)in[19] + (size_t)i * DM * FFN_H, DM, FFN_H, FFN_H, (bf16*)(ws + WS_W_GU + i * SZ_W_GU), 2, ffng + (size_t)i * DM);
        transpose_job(F, (const float*)in[20] + (size_t)i * FFN_H * DM, FFN_H, DM, DM, (bf16*)(ws + WS_W_DN + i * SZ_W_DN), 0, nullptr);
    }
    { const float* x = (const float*)in[0]; bf16* xb = (bf16*)(ws + WS_H); float* rss = (float*)(ws + WS_RSP);
      const int gw = F.vcu * NWAVES + F.wave, NGW = F.G * NWAVES, lane = F.lane;
      for (int m = gw; m < M; m += NGW) { const f32x4* xr = (const f32x4*)(x + (size_t)m * DM) + lane; v2u* o8 = (v2u*)(xb + (size_t)m * DM) + lane; float ss = 0.f;
#pragma unroll
          for (int j = 0; j < 8; ++j) { const f32x4 v = xr[64 * j]; ss += (v.x * v.x + v.y * v.y) + (v.z * v.z + v.w * v.w); v2u w; w.x = cvtpk(v.x, v.y); w.y = cvtpk(v.z, v.w); o8[64 * j] = w; }
          ss = wave_sum(ss); if (lane < 32) rss[(size_t)m * 32 + lane] = lane == 0 ? ss : 0.f; } }
    { const float* wsp = (const float*)in[10]; bf16* wtri = (bf16*)(ws + WS_MISC + MISC_WTRI);
      for (int i4 = F.vcu * NTHR + F.tid; i4 < 8 * 128 * 32; i4 += F.G * NTHR) { const int t = (i4 >> 5) & 127, s4 = (i4 & 31) * 4; f32x4 wv = *(const f32x4*)(wsp + (size_t)i4 * 4);
#pragma unroll
          for (int e = 0; e < 4; ++e) if (s4 + e > t) wv[e] = 0.f;
          v2u pk; pk.x = cvtpk(wv[0], wv[1]); pk.y = cvtpk(wv[2], wv[3]); *(v2u*)(wtri + (size_t)i4 * 4) = pk; } }
    { const int* pos = (const int*)in[1]; float* cs = (float*)(ws + WS_ROPE_C); float* sn = (float*)(ws + WS_ROPE_S);
      const int gid = F.vcu * NTHR + F.tid, i = gid & 127, step = (F.G * NTHR) >> 7;
      const double invf = exp2(-(double)i * (13.287712379549449 / 128.0));
      for (int r = gid >> 7; r < M; r += step) { const double ang = (double)pos[r] * invf; const double rr = ang - 6.283185307179586 * rint(ang * 0.15915494309189535);
          const float a = (float)rr; cs[(size_t)r * 128 + i] = cosf(a); sn[(size_t)r * 128 + i] = sinf(a); } }
}

__device__ __forceinline__ void ret_p_phase(Frame& F, const bf16* q, const bf16* k, bf16* PF, bf16* KF, bf16* QF) {
    constexpr int RSQ = 272;
    const ldsp LQ = F.lds, LK = F.lds + 34816;
    const int tid = F.tid, lane = F.lane, w = F.wave, g4 = lane >> 4, l15 = lane & 15;
    for (int unit = F.vcu; unit < 512; unit += F.G) {
        const int bh = unit >> 5, ci = unit & 31, h = bh & 7;
        const float lg2 = log1pf(-exp2f(-5.0f - (float)h)) * LOG2E;
        const size_t rowbase = (size_t)bh * SEQ + ci * 128;
        v4u pq[4], pk[4];
#define RP_LD(dd) do { _Pragma("unroll") for (int ps = 0; ps < 4; ++ps) { const int r_ = ps * 32 + (tid >> 4), c_ = tid & 15; \
            pq[ps] = *(const v4u*)(q + (rowbase + r_) * 256 + (dd) * 128 + c_ * 8); pk[ps] = *(const v4u*)(k + (rowbase + r_) * 256 + (dd) * 128 + c_ * 8); } } while (0)
        RP_LD(0);
        f32x4 S[8];
#pragma unroll
        for (int t = 0; t < 8; ++t) S[t] = (f32x4){0.f, 0.f, 0.f, 0.f};
#pragma unroll
        for (int dh = 0; dh < 2; ++dh) {
            __syncthreads();
#pragma unroll
            for (int ps = 0; ps < 4; ++ps) { const int r_ = ps * 32 + (tid >> 4), c_ = tid & 15; *(LAS v4u*)(LQ + r_ * RSQ + c_ * 16) = pq[ps]; *(LAS v4u*)(LK + r_ * RSQ + c_ * 16) = pk[ps]; }
            if (dh == 0) RP_LD(1);
            __syncthreads();
#pragma unroll
            for (int ks = 0; ks < 4; ++ks) { const bf16x8 a = frag_row(LQ + (16 * w) * RSQ + ks * 64, RSQ, lane);
                *(bf16x8*)(QF + ((((size_t)(bh * 32 + ci) * 8 + w) * 8 + dh * 4 + ks) * 512 + lane * 8)) = a;
#pragma unroll
                for (int t = 0; t < 8; ++t) S[t] = MFMA16(a, frag_row(LK + (16 * t) * RSQ + ks * 64, RSQ, lane), S[t]); }
#pragma unroll
            for (int ks = 0; ks < 4; ++ks) { const bf16x8 f = frag_tr(LK + (32 * ks) * RSQ + (16 * w) * 2, RSQ, lane); const v4u fu = __builtin_bit_cast(v4u, f); v4u o;
                const float k0 = exp2f((float)(127 - 32 * ks - 8 * g4) * lg2), gi = exp2f(-lg2), k1 = k0 * gi, k2 = k1 * gi, k3 = k2 * gi, k4 = k3 * gi, k5 = k4 * gi, k6 = k5 * gi, k7 = k6 * gi;
                o.x = cvtpk(bflo(fu.x) * k0, bfhi(fu.x) * k1); o.y = cvtpk(bflo(fu.y) * k2, bfhi(fu.y) * k3); o.z = cvtpk(bflo(fu.z) * k4, bfhi(fu.z) * k5); o.w = cvtpk(bflo(fu.w) * k6, bfhi(fu.w) * k7);
                *(v4u*)(KF + ((((size_t)(bh * 32 + ci) * 2 + dh) * 8 + w) * 4 + ks) * 512 + lane * 8) = o; }
        }
#undef RP_LD
#pragma unroll
        for (int t = 0; t < 8; ++t)
#pragma unroll
            for (int r = 0; r < 4; ++r) { const int n = 16 * w + 4 * g4 + r, mm = 16 * t + l15;
                const float pv_ = n >= mm ? S[t][r] * exp2f((float)(n - mm) * lg2) : 0.f;
                *(LAS unsigned short*)(LQ + n * RSQ + mm * 2) = (unsigned short)(cvtpk(pv_, 0.f) & 0xffffu); }
#pragma unroll
        for (int ks = 0; ks < 4; ++ks) *(bf16x8*)(PF + ((((size_t)(bh * 32 + ci) * 8 + w) * 4 + ks) * 512 + lane * 8)) = frag_row(LQ + (16 * w) * RSQ + ks * 64, RSQ, lane);
    }
}
__device__ __forceinline__ void ret_core_phase(Frame& F, const bf16* QF, const bf16* v, const bf16* PF, const bf16* KF, bf16* o) {
    constexpr int RSV = 72, RSS = 528;
    const ldsp LV0 = F.lds, LST = F.lds + 18432;
    const ldsp LOw = F.lds + 52224 + F.wave * 1024;
    const int tid = F.tid, lane = F.lane, w = F.wave, g4 = lane >> 4, l15 = lane & 15;
    for (int unit = F.vcu; unit < 256; unit += F.G) {
        const int bh = unit >> 4, es = unit & 15, h = bh & 7, b = bh >> 3, e0 = es * 32;
        const float lg2 = log1pf(-exp2f(-5.0f - (float)h)) * LOG2E;
        const float cd = exp2f(128.0f * lg2);
        const size_t rb0 = (size_t)bh * SEQ;
        f32x4 st[2][2];
#pragma unroll
        for (int a = 0; a < 2; ++a)
#pragma unroll
            for (int t = 0; t < 2; ++t) st[a][t] = (f32x4){0.f, 0.f, 0.f, 0.f};
        __syncthreads();
        for (int i = tid; i < 16896 / 4; i += NTHR) ((LAS unsigned*)LST)[i] = 0u;
        v4u pv, pvn; bf16x8 qf[8], pf[4], kf[8], qn[8], pn[4], kn[8];
#define RC_LD(cc) do { pvn = *(const v4u*)(v + (rb0 + (cc) * 128 + (tid >> 2)) * 512 + e0 + (tid & 3) * 8); \
            _Pragma("unroll") for (int ks = 0; ks < 8; ++ks) qn[ks] = *(const bf16x8*)(QF + ((((size_t)(bh * 32 + (cc)) * 8 + w) * 8 + ks) * 512 + lane * 8)); \
            _Pragma("unroll") for (int ks = 0; ks < 4; ++ks) pn[ks] = *(const bf16x8*)(PF + ((((size_t)(bh * 32 + (cc)) * 8 + w) * 4 + ks) * 512 + lane * 8)); \
            _Pragma("unroll") for (int i_ = 0; i_ < 8; ++i_) kn[i_] = *(const bf16x8*)(KF + ((((size_t)(bh * 32 + (cc)) * 2 + (i_ >> 2)) * 8 + w) * 4 + (i_ & 3)) * 512 + lane * 8); } while (0)
        RC_LD(0);
        for (int ci = 0; ci < 32; ++ci) {
            const ldsp LSc = LST + (ci & 1) * 16896, LSn = LST + ((ci + 1) & 1) * 16896;
            const ldsp LV = LV0 + (ci & 1) * 9216;
            pv = pvn;
#pragma unroll
            for (int i_ = 0; i_ < 8; ++i_) { qf[i_] = qn[i_]; kf[i_] = kn[i_]; }
#pragma unroll
            for (int i_ = 0; i_ < 4; ++i_) pf[i_] = pn[i_];
            *(LAS v4u*)(LV + (tid >> 2) * RSV + (tid & 3) * 16) = pv;
            __syncthreads();
            if (ci + 1 < 32) RC_LD(ci + 1);
            bf16x8 vf[4][2];
#pragma unroll
            for (int ks = 0; ks < 4; ++ks)
#pragma unroll
                for (int t = 0; t < 2; ++t) vf[ks][t] = frag_tr(LV + (32 * ks) * RSV + (16 * t) * 2, RSV, lane);
            f32x4 cr[2], in[2];
            cr[0] = (f32x4){0.f, 0.f, 0.f, 0.f}; cr[1] = (f32x4){0.f, 0.f, 0.f, 0.f}; in[0] = (f32x4){0.f, 0.f, 0.f, 0.f}; in[1] = (f32x4){0.f, 0.f, 0.f, 0.f};
#pragma unroll
            for (int ks = 0; ks < 8; ++ks)
#pragma unroll
                for (int t = 0; t < 2; ++t) cr[t] = MFMA16(qf[ks], frag_row(LSc + (16 * t) * RSS + (ks * 32) * 2, RSS, lane), cr[t]);
#pragma unroll
            for (int ks = 0; ks < 4; ++ks)
#pragma unroll
                for (int t = 0; t < 2; ++t) in[t] = MFMA16(pf[ks], vf[ks][t], in[t]);
#pragma unroll
            for (int dh = 0; dh < 2; ++dh) {
#pragma unroll
                for (int t = 0; t < 2; ++t) st[dh][t] = st[dh][t] * cd;
#pragma unroll
                for (int ks = 0; ks < 4; ++ks)
#pragma unroll
                    for (int t = 0; t < 2; ++t) st[dh][t] = MFMA16(kf[dh * 4 + ks], vf[ks][t], st[dh][t]);
#pragma unroll
                for (int t = 0; t < 2; ++t) { v2u pk2; pk2.x = cvtpk(st[dh][t][0], st[dh][t][1]); pk2.y = cvtpk(st[dh][t][2], st[dh][t][3]);
                    *(LAS v2u*)(LSn + (16 * t + l15) * RSS + (dh * 128 + 16 * w + 4 * g4) * 2) = pk2; }
            }
#pragma unroll
            for (int r = 0; r < 4; ++r) { const int n = 16 * w + 4 * g4 + r; const float qd = exp2f((float)(n + 1) * lg2);
#pragma unroll
                for (int t = 0; t < 2; ++t) *(LAS unsigned short*)(LOw + (4 * g4 + r) * 64 + (16 * t + l15) * 2) = (unsigned short)(cvtpk(in[t][r] + cr[t][r] * qd, 0.f) & 0xffffu); }
            *(v4u*)(o + ((size_t)b * SEQ + ci * 128 + 16 * w + (lane >> 2)) * 4096 + h * 512 + e0 + (lane & 3) * 8) = *(const LAS v4u*)(LOw + (lane >> 2) * 64 + (lane & 3) * 16);
        }
#undef RC_LD
    }
}

__device__ __forceinline__ void ret_gn_phase(Frame& F, const bf16* o, const bf16* g, const float* gn, bf16* y) {
    const int lane = F.lane, gw = F.vcu * NWAVES + F.wave, NGW = F.G * NWAVES;
    for (int it0 = gw; it0 < M * 8; it0 += 4 * NGW) {
        v4u ov[4], gv[4];
#pragma unroll
        for (int u = 0; u < 4; ++u) { const int it = it0 + u * NGW; const size_t off = (size_t)(it >> 3) * 4096 + (it & 7) * 512 + lane * 8;
            if (it < M * 8) { ov[u] = *(const v4u*)(o + off); gv[u] = *(const v4u*)(g + off); } else { ov[u] = (v4u){0u, 0u, 0u, 0u}; gv[u] = ov[u]; } }
#pragma unroll
        for (int u = 0; u < 4; ++u) { const int it = it0 + u * NGW, h = it & 7; const size_t off = (size_t)(it >> 3) * 4096 + h * 512 + lane * 8;
            float x[8] = {bflo(ov[u].x), bfhi(ov[u].x), bflo(ov[u].y), bfhi(ov[u].y), bflo(ov[u].z), bfhi(ov[u].z), bflo(ov[u].w), bfhi(ov[u].w)};
            float gg[8] = {bflo(gv[u].x), bfhi(gv[u].x), bflo(gv[u].y), bfhi(gv[u].y), bflo(gv[u].z), bfhi(gv[u].z), bflo(gv[u].w), bfhi(gv[u].w)};
            float s = 0.f;
#pragma unroll
            for (int e = 0; e < 8; ++e) s += x[e];
            const float mean = wave_sum(s) * (1.0f / 512.0f); float qv = 0.f;
#pragma unroll
            for (int e = 0; e < 8; ++e) { x[e] -= mean; qv += x[e] * x[e]; }
            const float rstd = 1.0f / sqrtf(wave_sum(qv) * (1.0f / 512.0f) + EPS);
            const f32x4 g0 = *(const f32x4*)(gn + h * 512 + lane * 8), g1 = *(const f32x4*)(gn + h * 512 + lane * 8 + 4);
            float r[8];
#pragma unroll
            for (int e = 0; e < 8; ++e) { const float gw_ = e < 4 ? g0[e & 3] : g1[e & 3]; r[e] = x[e] * rstd * gw_ * (gg[e] * pg8::fast_sigmoid(gg[e])); }
            v4u w; w.x = cvtpk(r[0], r[1]); w.y = cvtpk(r[2], r[3]); w.z = cvtpk(r[4], r[5]); w.w = cvtpk(r[6], r[7]);
            if (it < M * 8) *(v4u*)(y + off) = w; }
    }
}

__device__ __forceinline__ void gm_stat_phase(Frame& F, const f32x2* part, f32x2* rstat) {
    const int lane = F.lane, gw = F.vcu * NWAVES + F.wave, NGW = F.G * NWAVES;
    for (int row = gw; row < M; row += NGW) {
        float s = 0.f, ss = 0.f;
        if (lane < 48) { const f32x4 p = *(const f32x4*)(part + (size_t)row * 96 + lane * 2); s = p.x + p.z; ss = p.y + p.w; }
        s = wave_sum(s); ss = wave_sum(ss);
        const float mean = s * (1.0f / GM_HALF), var = fmaxf(ss * (1.0f / GM_HALF) - mean * mean, 0.f);
        if (lane == 0) rstat[row] = (f32x2){mean, 1.0f / sqrtf(var + EPS)};
    }
}
__device__ __forceinline__ void gm_spatial_phase(Frame& F, const bf16* u, const bf16* v, const f32x2* rstat, const float* lng, const float* lnb, const bf16* wtri, const float* bsp, bf16* y) {
    constexpr int RSW = 272, RSN = 528;
    const ldsp LW = F.lds, LN = F.lds + 34816;
    const int tid = F.tid, lane = F.lane, w = F.wave, g4 = lane >> 4, l15 = lane & 15;
    for (int wgi = F.vcu; wgi < 256; wgi += F.G) {
        const int gg = wgi & 7, jj = wgi >> 3;
        __syncthreads();
#pragma unroll
        for (int ps = 0; ps < 4; ++ps) { const int id = ps * NTHR + tid, t = id >> 4, c = id & 15;
            *(LAS v4u*)(LW + t * RSW + c * 16) = *(const v4u*)(wtri + ((size_t)gg * 128 + t) * 128 + c * 8); }
        float bs[8];
#pragma unroll
        for (int tt = 0; tt < 8; ++tt) bs[tt] = bsp[gg * 128 + 16 * tt + l15];
        v4u vr[8], ur[8];
#define GS_ROW0(i_) ((((jj) * 6 + (i_)) / 3) * 128)
#define GS_COL0(i_) (gg * 768 + (((jj) * 6 + (i_)) % 3) * 256)
#define GS_LDV(i_) do { _Pragma("unroll") for (int ps = 0; ps < 8; ++ps) { const int id_ = ps * NTHR + tid; vr[ps] = *(const v4u*)(v + (size_t)(GS_ROW0(i_) + (id_ >> 5)) * GM_HALF + GS_COL0(i_) + (id_ & 31) * 8); } } while (0)
        GS_LDV(0);
        for (int ui = 0; ui < 6; ++ui) {
            const int row0 = GS_ROW0(ui), col0 = GS_COL0(ui);
            __syncthreads();
#pragma unroll
            for (int ps = 0; ps < 8; ++ps) { const int id = ps * NTHR + tid, r = id >> 5, c8 = (id & 31) * 8;
                const v4u vv = vr[ps]; const f32x2 rs = rstat[row0 + r];
                const f32x4 ga = *(const f32x4*)(lng + col0 + c8), gb = *(const f32x4*)(lng + col0 + c8 + 4), ba = *(const f32x4*)(lnb + col0 + c8), bb = *(const f32x4*)(lnb + col0 + c8 + 4);
                v4u o;
                o.x = cvtpk((bflo(vv.x) - rs.x) * rs.y * ga[0] + ba[0], (bfhi(vv.x) - rs.x) * rs.y * ga[1] + ba[1]);
                o.y = cvtpk((bflo(vv.y) - rs.x) * rs.y * ga[2] + ba[2], (bfhi(vv.y) - rs.x) * rs.y * ga[3] + ba[3]);
                o.z = cvtpk((bflo(vv.z) - rs.x) * rs.y * gb[0] + bb[0], (bfhi(vv.z) - rs.x) * rs.y * gb[1] + bb[1]);
                o.w = cvtpk((bflo(vv.w) - rs.x) * rs.y * gb[2] + bb[2], (bfhi(vv.w) - rs.x) * rs.y * gb[3] + bb[3]);
                *(LAS v4u*)(LN + r * RSN + c8 * 2) = o; }
#pragma unroll
            for (int ps = 0; ps < 8; ++ps) { const int id_ = ps * NTHR + tid; ur[ps] = *(const v4u*)(u + (size_t)(row0 + (id_ >> 5)) * GM_HALF + col0 + (id_ & 31) * 8); }
            if (ui + 1 < 6) GS_LDV(ui + 1);
            __syncthreads();
            f32x4 acc[2][8];
#pragma unroll
            for (int ci = 0; ci < 2; ++ci)
#pragma unroll
                for (int tt = 0; tt < 8; ++tt) acc[ci][tt] = (f32x4){0.f, 0.f, 0.f, 0.f};
#pragma unroll
            for (int ks = 0; ks < 4; ++ks) {
                const bf16x8 a0 = frag_tr(LN + (32 * ks) * RSN + (32 * w) * 2, RSN, lane), a1 = frag_tr(LN + (32 * ks) * RSN + (32 * w + 16) * 2, RSN, lane);
#pragma unroll
                for (int tt = 2 * ks; tt < 8; ++tt) { const bf16x8 bfr = frag_row(LW + (16 * tt) * RSW + ks * 64, RSW, lane);
                    acc[0][tt] = MFMA16(a0, bfr, acc[0][tt]); acc[1][tt] = MFMA16(a1, bfr, acc[1][tt]); }
            }
            __syncthreads();
#pragma unroll
            for (int ci = 0; ci < 2; ++ci)
#pragma unroll
                for (int tt = 0; tt < 8; ++tt) { v2u pk; pk.x = cvtpk(acc[ci][tt][0] + bs[tt], acc[ci][tt][1] + bs[tt]); pk.y = cvtpk(acc[ci][tt][2] + bs[tt], acc[ci][tt][3] + bs[tt]);
                    *(LAS v2u*)(LN + (16 * tt + l15) * RSN + (32 * w + 16 * ci + 4 * g4) * 2) = pk; }
            __syncthreads();
#pragma unroll
            for (int ps = 0; ps < 8; ++ps) { const int id = ps * NTHR + tid, r = id >> 5, c8 = (id & 31) * 8;
                const v4u mv = *(const LAS v4u*)(LN + r * RSN + c8 * 2); const size_t off = (size_t)(row0 + r) * GM_HALF + col0 + c8; const v4u uv = ur[ps];
                v4u o; o.x = cvtpk(bflo(uv.x) * bflo(mv.x), bfhi(uv.x) * bfhi(mv.x)); o.y = cvtpk(bflo(uv.y) * bflo(mv.y), bfhi(uv.y) * bfhi(mv.y));
                o.z = cvtpk(bflo(uv.z) * bflo(mv.z), bfhi(uv.z) * bfhi(mv.z)); o.w = cvtpk(bflo(uv.w) * bflo(mv.w), bfhi(uv.w) * bfhi(mv.w));
                *(v4u*)(y + off) = o; }
        }
#undef GS_ROW0
#undef GS_COL0
#undef GS_LDV
    }
}

__device__ __forceinline__ void fox_prep_phase(Frame& F, const bf16* x, const float* rs, const float* gmix, const float* wfox, const float* bfg, float* lf) {
    const int lane = F.lane, gw = F.vcu * NWAVES + F.wave, NGW = F.G * NWAVES;
    for (int idx = F.tid; idx < DM * 4; idx += NTHR) { const int k = idx >> 2, qd = idx & 3; const f32x4 w = *(const f32x4*)(wfox + (size_t)k * FOX_LD + FOX_N + 4 * qd) * gmix[k];
        const int slot = ((k >> 8) * 4 + (k & 3)) * 64 + ((k >> 2) & 63);
        *(LAS f32x4*)(F.lds + qd * 32768 + slot * 16) = w; }
    __syncthreads();
    for (int m = gw; m < M; m += NGW) {
        const v2u* xr = (const v2u*)(x + (size_t)m * DM) + lane;
        f32x4 v[8];
#pragma unroll
        for (int j = 0; j < 8; ++j) { const v2u t = xr[64 * j]; v[j] = (f32x4){bflo(t.x), bfhi(t.x), bflo(t.y), bfhi(t.y)}; }
        f32x4 a[4];
#pragma unroll
        for (int qd = 0; qd < 4; ++qd) a[qd] = (f32x4){0.f, 0.f, 0.f, 0.f};
#pragma unroll
        for (int j = 0; j < 8; ++j)
#pragma unroll
            for (int e = 0; e < 4; ++e) { const float hv = v[j][e];
#pragma unroll
                for (int qd = 0; qd < 4; ++qd) a[qd] += hv * *(const LAS f32x4*)(F.lds + qd * 32768 + ((j * 4 + e) * 64 + lane) * 16);
                asm volatile("" ::: "memory"); }
        float z = 0.f;
#pragma unroll
        for (int qd = 0; qd < 4; ++qd)
#pragma unroll
            for (int i = 0; i < 4; ++i) { const float t = wave_sum(a[qd][i]); z = (lane == qd * 4 + i) ? t : z; }
        if (lane < 16) lf[(size_t)m * 16 + lane] = log_sigmoid(z * pg8::row_rstd(rs, m) + bfg[lane]);
    }
}

typedef float f32x16 __attribute__((ext_vector_type(16)));
#define MFMA32(a, b, c) __builtin_amdgcn_mfma_f32_32x32x16_bf16((a), (b), (c), 0, 0, 0)
__device__ __forceinline__ void fox_attn_phase(Frame& F, const bf16* qn, const bf16* kn, const bf16* vv, const bf16* gs, const float* lf, bf16* y) {
    constexpr int RSK = 272, RSV = 320, KSLOT = 64 * RSK, VSLOT = 64 * RSV;
    const ldsp LK = F.lds, LV = F.lds + 2 * KSLOT;
    LAS float* c2 = (LAS float*)(F.lds + 75776);
    LAS float* red = (LAS float*)(F.lds + 92160);
    const int tid = F.tid, lane = F.lane, w = F.wave, r32 = lane & 31, hi = lane >> 5;
    int bh_have = -1;
    for (int pr = F.vcu; pr < 256; pr += F.G) {
        const int bh = pr >> 3, pi = pr & 7, b = bh >> 4, h = bh & 15;
        const size_t tok0 = (size_t)b * SEQ;
        if (bh != bh_have) {
            bh_have = bh;
            float x8[8]; float run = 0.f;
#pragma unroll
            for (int e = 0; e < 8; ++e) { run += lf[(tok0 + tid * 8 + e) * 16 + h]; x8[e] = run; }
            float inc = run;
#pragma unroll
            for (int o = 1; o < 64; o <<= 1) { const float t = __shfl_up(inc, o); if (lane >= o) inc += t; }
            __syncthreads();
            if (lane == 63) red[w] = inc;
            __syncthreads();
            float pre = inc - run;
#pragma unroll
            for (int wv = 0; wv < 8; ++wv) if (wv < w) pre += red[wv];
#pragma unroll
            for (int e = 0; e < 8; ++e) c2[tid * 8 + e] = (pre + x8[e]) * LOG2E;
        }
        for (int half = 0; half < 2; ++half) {
            const int qb = half ? 15 - pi : pi, q0 = qb * 256, ntile = 4 * qb + 4, qrow = q0 + 32 * w + r32;
            bf16x8 qf[8];
#pragma unroll
            for (int ks = 0; ks < 8; ++ks) qf[ks] = *(const bf16x8*)(qn + (tok0 + qrow) * DM + h * 128 + ks * 16 + 8 * hi);
            v4u kr[2], vr[2];
#define FA_LOAD(tt) do { _Pragma("unroll") for (int pp = 0; pp < 2; ++pp) { const int id_ = tid + NTHR * pp, r_ = id_ >> 4, c_ = id_ & 15; \
                kr[pp] = *(const v4u*)(kn + (tok0 + 64 * (tt) + r_) * DM + h * 128 + c_ * 8); vr[pp] = *(const v4u*)(vv + (tok0 + 64 * (tt) + r_) * DM + h * 128 + c_ * 8); } } while (0)
#define FA_STORE(sl) do { _Pragma("unroll") for (int pp = 0; pp < 2; ++pp) { const int id_ = tid + NTHR * pp, r_ = id_ >> 4, c_ = id_ & 15; \
                *(LAS v4u*)(LK + (sl) * KSLOT + r_ * RSK + c_ * 16) = kr[pp]; *(LAS v4u*)(LV + (sl) * VSLOT + r_ * RSV + c_ * 16) = vr[pp]; } } while (0)
            FA_LOAD(0);
            __syncthreads();
            FA_STORE(0);
            if (ntile > 1) FA_LOAD(1);
            const float cq = c2[qrow];
            float mx = 0.f, ls = 0.f;
            f32x16 O[4];
#pragma unroll
            for (int dt = 0; dt < 4; ++dt)
#pragma unroll
                for (int r = 0; r < 16; ++r) O[dt][r] = 0.f;
            for (int t = 0; t < ntile; ++t) {
                __syncthreads();
                if (t + 1 < ntile) { FA_STORE((t + 1) & 1); if (t + 2 < ntile) FA_LOAD(t + 2); }
                const int key0 = 64 * t;
                if (key0 <= q0 + 32 * w + 31) {
                    const ldsp sk = LK + (t & 1) * KSLOT + r32 * RSK + 16 * hi, sv = LV + (t & 1) * VSLOT;
                    f32x16 S0, S1;
                    const float cbase = cq - mx;
#pragma unroll
                    for (int g = 0; g < 4; ++g) { const f32x4 ck0 = *(const LAS f32x4*)(c2 + key0 + 8 * g + 4 * hi), ck1 = *(const LAS f32x4*)(c2 + key0 + 32 + 8 * g + 4 * hi);
#pragma unroll
                        for (int e = 0; e < 4; ++e) { S0[4 * g + e] = cbase - ck0[e]; S1[4 * g + e] = cbase - ck1[e]; } }
#pragma unroll
                    for (int ks = 0; ks < 8; ++ks) { S0 = MFMA32(*(const LAS bf16x8*)(sk + ks * 32), qf[ks], S0); S1 = MFMA32(*(const LAS bf16x8*)(sk + 32 * RSK + ks * 32), qf[ks], S1); }
                    if (key0 + 63 > q0 + 32 * w) {
#pragma unroll
                        for (int g = 0; g < 4; ++g)
#pragma unroll
                            for (int e = 0; e < 4; ++e) { const int key = key0 + 8 * g + 4 * hi + e; if (key > qrow) S0[4 * g + e] = -INFINITY; if (key + 32 > qrow) S1[4 * g + e] = -INFINITY; } }
                    float mloc = fmaxf(S0[0], S1[0]);
#pragma unroll
                    for (int r = 1; r < 16; ++r) mloc = __builtin_fmaxf(__builtin_fmaxf(mloc, S0[r]), S1[r]);
                    mloc = fmaxf(mloc, __shfl_xor(mloc, 32));
                    if (__any(mloc > 8.0f)) { const float dl = fmaxf(mloc, 0.f), alpha = __builtin_amdgcn_exp2f(-dl); mx += dl; ls *= alpha;
#pragma unroll
                        for (int r = 0; r < 16; ++r) { S0[r] -= dl; S1[r] -= dl; }
#pragma unroll
                        for (int dt = 0; dt < 4; ++dt)
#pragma unroll
                            for (int r = 0; r < 16; ++r) O[dt][r] *= alpha; }
                    float psum = 0.f;
#pragma unroll
                    for (int r = 0; r < 16; ++r) { S0[r] = __builtin_amdgcn_exp2f(S0[r]); S1[r] = __builtin_amdgcn_exp2f(S1[r]); psum += S0[r] + S1[r]; }
                    ls += psum;
                    v4u pf[4];
#pragma unroll
                    for (int s2 = 0; s2 < 2; ++s2) { pf[s2] = (v4u){cvtpk(S0[8 * s2 + 0], S0[8 * s2 + 1]), cvtpk(S0[8 * s2 + 2], S0[8 * s2 + 3]), cvtpk(S0[8 * s2 + 4], S0[8 * s2 + 5]), cvtpk(S0[8 * s2 + 6], S0[8 * s2 + 7])};
                        pf[2 + s2] = (v4u){cvtpk(S1[8 * s2 + 0], S1[8 * s2 + 1]), cvtpk(S1[8 * s2 + 2], S1[8 * s2 + 3]), cvtpk(S1[8 * s2 + 4], S1[8 * s2 + 5]), cvtpk(S1[8 * s2 + 6], S1[8 * s2 + 7])}; }
                    const ldsp vb = sv + (4 * hi + ((lane & 15) >> 2)) * RSV + (16 * ((lane >> 4) & 1) + 4 * (lane & 3)) * 2;
#pragma unroll
                    for (int s4 = 0; s4 < 4; ++s4)
#pragma unroll
                        for (int dt = 0; dt < 4; ++dt) { const ldsp va = vb + (16 * s4) * RSV + dt * 64; const s16x4 lo = vtr(va), hv = vtr(va + 8 * RSV);
                            const bf16x8 af = (bf16x8){lo[0], lo[1], lo[2], lo[3], hv[0], hv[1], hv[2], hv[3]};
                            O[dt] = MFMA32(af, __builtin_bit_cast(bf16x8, pf[s4]), O[dt]); }
                }
            }
            ls += __shfl_xor(ls, 32);
            const float il = 1.0f / ls;
            const size_t yoff = (tok0 + qrow) * DM + h * 128 + 4 * hi;
#pragma unroll
            for (int dt = 0; dt < 4; ++dt)
#pragma unroll
                for (int g = 0; g < 4; ++g) { const v2u gv = *(const v2u*)(gs + yoff + dt * 32 + 8 * g);
                    v2u o; o.x = cvtpk(O[dt][4 * g + 0] * il * bflo(gv.x), O[dt][4 * g + 1] * il * bfhi(gv.x)); o.y = cvtpk(O[dt][4 * g + 2] * il * bflo(gv.y), O[dt][4 * g + 3] * il * bfhi(gv.y));
                    *(v2u*)(y + yoff + dt * 32 + 8 * g) = o; }
        }
    }
#undef FA_LOAD
#undef FA_STORE
}
#ifndef R_RET_CORE
#define R_RET_CORE 1
#endif
#ifndef R_RET_GN
#define R_RET_GN 1
#endif
#ifndef R_GM_SP
#define R_GM_SP 1
#endif
#ifndef R_FOX_ATTN
#define R_FOX_ATTN 1
#endif
#ifndef R_FOX_PREP
#define R_FOX_PREP 1
#endif
#ifndef R_PRO
#define R_PRO 1
#endif
#ifndef F_GU_TAIL
#define F_GU_TAIL 0
#endif

#ifndef PROBE_A
#define PROBE_A -1
#endif
#ifndef PROBE_B
#define PROBE_B -1
#endif
#ifndef PROBE_MUL
#define PROBE_MUL 4
#endif
#define STAMP_AT(id) do { if (PROBE_A >= 0 && ((id) == PROBE_A || (id) == PROBE_B)) { if (F.tid == 0) { const unsigned long long t_ = __builtin_amdgcn_s_memrealtime(); \
        volatile LAS unsigned* m_ = F.MISC + ((id) == PROBE_A ? 16 : 20); m_[0] = (unsigned)t_; m_[1] = (unsigned)(t_ >> 32); } } } while (0)
struct Args { const void* in[21]; float* out; unsigned char* ws; int ph_lo, ph_hi, li, pad; };
#define IN(k) (lo <= (k) && (k) < hi)
#define SEAM(k) do { if (N_LAUNCHES == 1 && IN(k) && IN((k) + 1)) xcd_barrier(bar); STAMP_AT(k); } while (0)
template <int L>
__device__ __forceinline__ void layer_body(Frame& F, const Args& args, const XcdBarrier& bar, const int lo, const int hi) {
    unsigned char* ws = args.ws;
    constexpr int kind = L % 3, j = L / 3, pb = 1 + 6 * L;
    float* xo = args.out;
    bf16* XB = (bf16*)(ws + WS_H);
    bf16* A0 = (bf16*)(ws + WS_A); bf16* B0 = (bf16*)(ws + WS_B); bf16* C0 = (bf16*)(ws + WS_C);
    unsigned char* misc = ws + WS_MISC;
    float* rss = (float*)(ws + WS_RSP);
    PG8_LAS float* rtab = (PG8_LAS float*)(F.lds + RSTAB_OFF);
    if (IN(pb + 0)) {
        if (kind == 0) {
            pg8::Gemm g{XB, (const bf16*)(ws + WS_W_RET_IN + j * SZ_W_RET_IN), M, RET_N, DM}; pg8::RsOrder S; S.init(M, RET_N, F.G, (int)blockIdx.x); S.rs = rss + (size_t)(2 * L) * M * 32; S.tab = rtab; S.pend = 0.f; S.nready = 0;
            pg8::EpiRetIn E{A0, A0 + (size_t)M * 2048, A0 + (size_t)M * 4096, A0 + (size_t)M * 8192, (const float*)(ws + WS_ROPE_C), (const float*)(ws + WS_ROPE_S), rtab, 0};
            pg8::gemm_phase<pg8::EpiRetIn, pg8::RsOrder, PG8_ALIGN, PG8_SP2>(F.lds + RING_OFF, g, S, E);
        } else if (kind == 1) {
            pg8::Gemm g{XB, (const bf16*)(ws + WS_W_GM_IN), M, GM_N, DM}; pg8::RsOrder S; S.init(M, GM_N, F.G, (int)blockIdx.x); S.rs = rss + (size_t)(2 * L) * M * 32; S.tab = rtab; S.pend = 0.f; S.nready = 0;
            pg8::EpiGeluUV E{A0, A0 + (size_t)M * GM_HALF, (pg8::f32x2v*)(misc + MISC_PART), rtab, 0};
            pg8::gemm_phase<pg8::EpiGeluUV, pg8::RsOrder, PG8_ALIGN, PG8_SP2>(F.lds + RING_OFF, g, S, E);
        } else {
            pg8::Gemm g{XB, (const bf16*)(ws + WS_W_FOX_IN), M, FOX_N, DM}; pg8::RsOrder S; S.init(M, FOX_N, F.G, (int)blockIdx.x); S.rs = rss + (size_t)(2 * L) * M * 32; S.tab = rtab; S.pend = 0.f; S.nready = 0;
            PG8_LAS float* qkg = (PG8_LAS float*)(F.lds + QKG_OFF);
            if (F.tid < 256) qkg[F.tid] = F.tid < 128 ? ((const float*)args.in[15])[F.tid] : ((const float*)args.in[16])[F.tid - 128];
            __syncthreads();
            pg8::EpiFoxIn E{A0, (size_t)M * 2048, rtab, 0, (PG8_LAS float*)(F.lds + QKT_OFF), qkg};
            pg8::gemm_phase<pg8::EpiFoxIn, pg8::RsOrder, PG8_ALIGN, PG8_SP2>(F.lds + RING_OFF, g, S, E);
        }
    }
    SEAM(pb + 0);
    if (IN(pb + 1)) {
        if (kind == 0) { bf16* Pb = B0 + (size_t)M * 4096;
            bf16* KFb = (bf16*)(ws + WS_KF);
            bf16* QFb = (bf16*)(ws + WS_QF);
            ret_p_phase(F, A0, A0 + (size_t)M * 2048, Pb, KFb, QFb);
            if (N_LAUNCHES == 1) xcd_barrier(bar);
            STAMP_AT(500 + L);
            for (int rep_ = 0; rep_ < R_RET_CORE; ++rep_) ret_core_phase(F, QFb, A0 + (size_t)M * 4096, Pb, KFb, B0); }
        else if (kind == 1) { gm_stat_phase(F, (const f32x2*)(misc + MISC_PART), (f32x2*)(misc + MISC_RSTAT)); }
        else { for (int rep_ = 0; rep_ < R_FOX_PREP; ++rep_) fox_prep_phase(F,
                              XB, rss + (size_t)(2 * L) * M * 32, (const float*)args.in[2] + (size_t)L * DM, (const float*)args.in[13], (const float*)args.in[14], (float*)(misc + MISC_LF)); }
    }
    SEAM(pb + 1);
    if (IN(pb + 2)) {
        if (kind == 0) { for (int rep_ = 0; rep_ < R_RET_GN; ++rep_) ret_gn_phase(F, B0, A0 + (size_t)M * 8192, (const float*)args.in[5] + (size_t)j * 4096, C0); }
        else if (kind == 1) { for (int rep_ = 0; rep_ < R_GM_SP; ++rep_) gm_spatial_phase(F, A0, A0 + (size_t)M * GM_HALF, (const f32x2*)(misc + MISC_RSTAT), (const float*)args.in[8], (const float*)args.in[9], (const bf16*)(misc + MISC_WTRI), (const float*)args.in[11], B0); }
        else { for (int rep_ = 0; rep_ < R_FOX_ATTN; ++rep_) fox_attn_phase(F, A0, A0 + (size_t)M * 2048, A0 + (size_t)M * 4096, A0 + (size_t)M * 6144, (const float*)(misc + MISC_LF), B0); }
    }
    SEAM(pb + 2);
    if (IN(pb + 3)) {
        const bf16* Ain = kind == 0 ? C0 : B0; constexpr int K = kind == 0 ? 4096 : (kind == 1 ? GM_HALF : DM);
        const bf16* Wt = kind == 0 ? (const bf16*)(ws + WS_W_RET_OUT + j * SZ_W_RET_OUT) : (kind == 1 ? (const bf16*)(ws + WS_W_GM_OUT) : (const bf16*)(ws + WS_W_FOX_OUT));
        pg8::Gemm g{Ain, Wt, M, DM, K}; pg8::StaticOrder S; S.init(M, DM, F.G, (int)blockIdx.x);
        pg8::EpiRes<L == 0, false> E{(const float*)args.in[0], nullptr, XB, rss + (size_t)(2 * L + 1) * M * 32, DM};
        pg8::gemm_phase<pg8::EpiRes<L == 0, false>, pg8::StaticOrder, PG8_ALIGN, PG8_SP2>(F.lds + RING_OFF, g, S, E);
    }
    SEAM(pb + 3);
    if (IN(pb + 4)) {
        constexpr int NFULL = (F_GU_TAIL ? 40 : 44) * 256;
        { pg8::Gemm g{XB, (const bf16*)(ws + WS_W_GU + L * SZ_W_GU), M, NFULL, DM}; pg8::RsOrder S; S.init(M, NFULL, F.G, (int)blockIdx.x); S.rs = rss + (size_t)(2 * L + 1) * M * 32; S.tab = rtab; S.pend = 0.f; S.nready = 0;
          pg8::EpiSwiglu<false> E{A0, FFN_H, rtab, 0};
          pg8::gemm_phase<pg8::EpiSwiglu<false>, pg8::RsOrder, PG8_ALIGN, PG8_SP2>(F.lds + RING_OFF, g, S, E); }
        if (F_GU_TAIL) { pg8::Gemm g{XB, (const bf16*)(ws + WS_W_GU + L * SZ_W_GU), M, FFN_N2, DM}; pg8::TailOrder S; S.init(M, FFN_N2, F.G, (int)blockIdx.x); S.rs = rss + (size_t)(2 * L + 1) * M * 32; S.tab = rtab; S.pend = 0.f; S.nready = 0; S.pn0 = 40;
          pg8::EpiSwiglu<true> E{A0, FFN_H, rtab, 0};
          pg8::gemm_phase<pg8::EpiSwiglu<true>, pg8::TailOrder, PG8_ALIGN, PG8_SP2, true>(F.lds + RING_OFF, g, S, E); }
    }
    SEAM(pb + 4);
    if (IN(pb + 5)) {
        pg8::Gemm g{A0, (const bf16*)(ws + WS_W_DN + L * SZ_W_DN), M, DM, FFN_H}; pg8::StaticOrder S; S.init(M, DM, F.G, (int)blockIdx.x);
        pg8::EpiRes<false, L + 1 == DEPTH> E{nullptr, xo, XB, rss + (size_t)((2 * L + 2) & 7) * M * 32, DM};
        pg8::gemm_phase<pg8::EpiRes<false, L + 1 == DEPTH>, pg8::StaticOrder, PG8_ALIGN, PG8_SP2>(F.lds + RING_OFF, g, S, E);
    }
    SEAM(pb + 5);
}
__global__ void __launch_bounds__(NWAVES * 64, 2) trunk_fwd(Args args) {
    extern __shared__ __attribute__((aligned(16))) unsigned char lds[];
    Frame F;
    F.lds = (ldsp)lds;
    F.MISC = (volatile LAS unsigned*)(F.lds + MISC_OFF);
    F.tid = threadIdx.x; F.lane = F.tid & 63; F.wave = __builtin_amdgcn_readfirstlane(F.tid >> 6);
    F.G = gridDim.x; { const int bx = blockIdx.x; F.vcu = (F.G % 8 == 0) ? (bx % 8) * (F.G / 8) + bx / 8 : bx; }
    F.ctl = (gu32*)(args.ws + WS_CTL);
    for (int u = F.tid; u < (LDS_BYTES - LDSCTL_OFF) / 4; u += NWAVES * 64) ((LAS unsigned*)(F.lds + LDSCTL_OFF))[u] = 0u;
    __syncthreads();
    XcdBarrier bar; bar.bar = (unsigned*)(F.ctl + CW_BAR); bar.x = 0; bar.st = nullptr;
    if (N_LAUNCHES == 1) bar = xcd_barrier_post((unsigned*)(F.ctl + CW_BAR), F.MISC + 8);
    const int lo = args.ph_lo, hi = args.ph_hi;
    STAMP_AT(999);
    if (IN(0)) for (int rep_ = 0; rep_ < R_PRO; ++rep_) p0_prologue(F, args.in, args.ws);
    SEAM(0);
    layer_body<0>(F, args, bar, lo, hi); layer_body<1>(F, args, bar, lo, hi); layer_body<2>(F, args, bar, lo, hi); layer_body<3>(F, args, bar, lo, hi);
    if (PROBE_A >= 0 && F.tid == 0) {
        const unsigned long long ta = ((unsigned long long)F.MISC[17] << 32) | F.MISC[16], tb = ((unsigned long long)F.MISC[21] << 32) | F.MISC[20];
        const unsigned long long dly = (tb - ta) * (unsigned long long)PROBE_MUL, t0 = __builtin_amdgcn_s_memrealtime();
        if (tb > ta && dly < 400000ull) while (__builtin_amdgcn_s_memrealtime() - t0 < dly) __builtin_amdgcn_s_sleep(16);
    }
}
#undef IN
#undef SEAM

extern "C" void kernel_launch(void* const* d_in, const int* in_sizes, int n_in, void* d_out, int out_size, void* d_ws, size_t ws_size, hipStream_t stream) {
    static int grid = 0;
    if (grid == 0) {
        if (n_in != 21 || in_sizes[0] != M * DM || out_size != M * DM || ws_size < WS_END) { fprintf(stderr, "kernel_launch: unexpected shapes (n_in %d, in0 %d, out %d, ws %zu); nothing launched\n", n_in, n_in > 0 ? in_sizes[0] : -1, out_size, ws_size); grid = -1; return; }
        int dev = 0, cus = 0, per_cu = 0;
        if (hipGetDevice(&dev) != hipSuccess || hipDeviceGetAttribute(&cus, hipDeviceAttributeMultiprocessorCount, dev) != hipSuccess) { grid = -1; return; }
        if (hipFuncSetAttribute((const void*)trunk_fwd, hipFuncAttributeMaxDynamicSharedMemorySize, LDS_BYTES) != hipSuccess) { fprintf(stderr, "kernel_launch: hipFuncSetAttribute failed\n"); grid = -1; return; }
        if (hipOccupancyMaxActiveBlocksPerMultiprocessor(&per_cu, (const void*)trunk_fwd, NWAVES * 64, LDS_BYTES) != hipSuccess || per_cu < 1)
            fprintf(stderr, "kernel_launch: note: occupancy query reports %d workgroups per CU\n", per_cu);
        (void)hipGetLastError();
        grid = cus;
    }
    if (grid < 0) return;
    if (hipMemsetAsync((char*)d_ws + WS_CTL, 0, CTL_ZERO_BYTES, stream) != hipSuccess) return;
    Args a{};
    for (int i = 0; i < 21; ++i) a.in[i] = d_in[i];
    a.out = (float*)d_out; a.ws = (unsigned char*)d_ws;
    for (int li = 0; li < N_LAUNCHES; ++li) {
        a.ph_lo = (N_LAUNCHES == 1) ? 0 : li; a.ph_hi = (N_LAUNCHES == 1) ? N_PHASES : li + 1; a.li = li; a.pad = 0;
        hipLaunchKernelGGL(trunk_fwd, dim3(grid), dim3(NWAVES * 64), LDS_BYTES, stream, a);
        const hipError_t le = hipPeekAtLastError();
        if (le != hipSuccess) { fprintf(stderr, "kernel_launch: launch %d failed: %s\n", li, hipGetErrorName(le)); break; }
    }
}
```

```cpp
#include <hip/hip_runtime.h>
#include <cstdio>
#include <cstdint>
#include <cmath>
namespace pg8 {
#define PG8_LAS __attribute__((address_space(3)))
typedef unsigned short bf16_t;
typedef short bf16x8 __attribute__((ext_vector_type(8)));
typedef float f32x4 __attribute__((ext_vector_type(4)));
typedef unsigned u32x4 __attribute__((ext_vector_type(4)));
constexpr int BM = 256, BK = 64, HALF = 128, HTB = HALF * BK * 2  , STAGE_BYTES = 8 * HTB, NXCD = 8, WGM = 8;

__host__ __device__ __forceinline__ int lds_byte(int r, int c) { const int st = (r >> 4) * 2 + (c >> 5), rr = r & 15, cc = c & 31, ob = rr * 64 + cc * 2; return st * 1024 + (ob ^ (((ob >> 9) & 1) << 5)); }
__host__ __device__ __forceinline__ void stage_rc(int b, int& R, int& C) { const int st = b / 1024, sb = b % 1024, swz = sb ^ (((sb >> 9) & 1) << 5); R = (st >> 1) * 16 + swz / 64; C = (st & 1) * 32 + (swz % 64) / 2; }
__host__ __device__ __forceinline__ int perm32(int rho) { const int n = rho >> 4, i = rho & 15; return 8 * (i >> 2) + 4 * n + (i & 3); }

struct Unit { int pm, pn, hf; };
struct Gemm { const bf16_t* A; const bf16_t* Bt; int M, N, K; };

struct StaticOrder {
    int nM, nN, nwg, G, c;
    __host__ __device__ void init(int M, int N, int G_, int c_) { nM = M / BM; nN = N / BM; nwg = nM * nN; G = G_; c = c_; }
    __host__ __device__ bool next(int i, Unit& u) const {
        const long L = (long)i * G + c; if (L >= nwg) return false;
        int wgid = (int)L; { const int q = nwg / NXCD, r = nwg % NXCD, xcd = wgid % NXCD, off = wgid / NXCD; wgid = (xcd < r ? xcd * (q + 1) : r * (q + 1) + (xcd - r) * q) + off; }
        const int nig = WGM * nN, gid = wgid / nig, fm = gid * WGM, gsz = (nM - fm) < WGM ? (nM - fm) : WGM;
        u.pm = fm + ((wgid % nig) % gsz); u.pn = (wgid % nig) / gsz; u.hf = 0; return true;
    }
    __device__ __forceinline__ void a_ready(const Unit&) const {}
    __device__ __forceinline__ void done(const Unit&) const {}
};

__device__ __forceinline__ unsigned cvt_pk_bf16(float lo, float hi) { unsigned r; asm volatile("v_cvt_pk_bf16_f32 %0, %1, %2" : "=v"(r) : "v"(lo), "v"(hi)); return r; }
typedef float f32x2 __attribute__((ext_vector_type(2)));
__device__ __forceinline__ f32x2 gelu_pk(f32x2 v) {
    const f32x2 av = __builtin_elementwise_abs(v), d = av * 0.2316418882f + 1.0f;
    f32x2 t; t.x = __builtin_amdgcn_rcpf(d.x); t.y = __builtin_amdgcn_rcpf(d.y);
    f32x2 q = t * 0.5307027145f + (-0.7265760135f); q = q * t + 0.7107068705f; q = q * t + (-0.142248368f); q = q * t + 0.127414796f; q = q * t;
    const f32x2 s = (v * v) * (-0.72134752044f);
    f32x2 e; e.x = __builtin_amdgcn_exp2f(s.x); e.y = __builtin_amdgcn_exp2f(s.y);
    const f32x2 m = v * (q * e), r = v - m;
    f32x2 o; o.x = v.x < 0.f ? m.x : r.x; o.y = v.y < 0.f ? m.y : r.y; return o;
}

typedef float f32x2v __attribute__((ext_vector_type(2)));
typedef __bf16 bf16x2v __attribute__((ext_vector_type(2)));
__device__ __forceinline__ unsigned cvtpk(float lo, float hi) { f32x2v v = {lo, hi}; bf16x2v b = __builtin_convertvector(v, bf16x2v); return __builtin_bit_cast(unsigned, b); }
__device__ __forceinline__ u32x4 pack8(const f32x4 a, const f32x4 b) { u32x4 w; w.x = cvtpk(a[0], a[1]); w.y = cvtpk(a[2], a[3]); w.z = cvtpk(b[0], b[1]); w.w = cvtpk(b[2], b[3]); return w; }
#ifndef EPI_WT
#define EPI_WT 0
#endif
__device__ __forceinline__ void st16(void* p, const u32x4 v) {
#if EPI_WT
    asm volatile("global_store_dwordx4 %0, %1, off sc1\n\ts_nop 2" :: "v"(p), "v"(v) : "memory");
#else
    *(u32x4*)p = v;
#endif
}
__device__ __forceinline__ float fast_sigmoid(float x) { return __builtin_amdgcn_rcpf(1.0f + __builtin_amdgcn_exp2f(-1.44269504f * x)); }

template <bool BASE_F32, bool OUT_F32> struct EpiRes {
    static constexpr bool PERM = true, AFTER_DRAIN = false, RESID = false;
    const float* base; float* out; bf16_t* xb; float* rs; int ldc;
    __device__ __forceinline__ void operator()(const f32x4 (&acc)[2][2][4][2], const Unit& u, int wr, int wc, int fr, int fq) const {
        const int row0 = u.pm * BM + wr * 64 + fr, col0 = u.pn * BM + wc * 32 + 8 * fq;
#pragma unroll
        for (int ai = 0; ai < 2; ++ai)
#pragma unroll
            for (int m = 0; m < 4; ++m) { const int row = row0 + ai * HALF + m * 16; const size_t off = (size_t)row * ldc + col0; float ss = 0.f;
#pragma unroll
                for (int bj = 0; bj < 2; ++bj) { f32x4 b0, b1;
                    if (BASE_F32) { b0 = *(const f32x4*)(base + off + bj * HALF); b1 = *(const f32x4*)(base + off + bj * HALF + 4); }
                    else { const u32x4 w = *(const u32x4*)(xb + off + bj * HALF);
                        b0 = (f32x4){__uint_as_float(w.x << 16), __uint_as_float(w.x & 0xffff0000u), __uint_as_float(w.y << 16), __uint_as_float(w.y & 0xffff0000u)};
                        b1 = (f32x4){__uint_as_float(w.z << 16), __uint_as_float(w.z & 0xffff0000u), __uint_as_float(w.w << 16), __uint_as_float(w.w & 0xffff0000u)}; }
                    const f32x4 x0 = b0 + acc[ai][bj][m][0], x1 = b1 + acc[ai][bj][m][1];
                    if (OUT_F32) { *(f32x4*)(out + off + bj * HALF) = x0; *(f32x4*)(out + off + bj * HALF + 4) = x1; }
                    else st16(xb + off + bj * HALF, pack8(x0, x1));
                    ss += (x0[0] * x0[0] + x0[1] * x0[1]) + (x0[2] * x0[2] + x0[3] * x0[3]) + (x1[0] * x1[0] + x1[1] * x1[1]) + (x1[2] * x1[2] + x1[3] * x1[3]); }
                if (!OUT_F32) { ss += __shfl_xor(ss, 16); ss += __shfl_xor(ss, 32);
                    if (fq == 0) rs[(size_t)row * 32 + u.pn * 4 + wc] = ss; }
                }
    }
};
template <bool OUT_F32> struct EpiResP {
    static constexpr bool PERM = true, AFTER_DRAIN = true, RESID = true;
    float* out; bf16_t* xb; float* rs; int ldc;
    __device__ __forceinline__ void fused(f32x4 (&acc)[2][2][4][2], const Unit& u, int wr, int wc, int fr, int fq, PG8_LAS unsigned char* lds, int wid, int lane) const {
        const int row0 = u.pm * BM + wr * 64 + fr, col0 = u.pn * BM + wc * 32 + 8 * fq, wh = wc >> 1;
        u32x4 g7[4];
        if (wh) {
#pragma unroll
            for (int m = 0; m < 4; ++m) g7[m] = *(const u32x4*)(xb + (size_t)(row0 + HALF + m * 16) * ldc + col0 + HALF); }
#pragma unroll
        for (int ai = 0; ai < 2; ++ai)
#pragma unroll
            for (int m = 0; m < 4; ++m) { const int row = row0 + ai * HALF + m * 16; const size_t off = (size_t)row * ldc + col0; float ss = 0.f;
                const int lb = lds_byte(wr * 64 + m * 16 + fr, (wc & 1) * 32 + 8 * fq);
#pragma unroll
                for (int bj = 0; bj < 2; ++bj) {
                    const int s0 = (ai == 0 && bj == 0) ? 4 : (ai == 1 && bj == 0) ? 5 : (ai == 0 && bj == 1) ? 6 : 7;
                    const int s1 = (ai == 0 && bj == 0) ? 0 : (ai == 1 && bj == 0) ? 1 : 2;
                    u32x4 w;
                    if (ai == 1 && bj == 1) { if (wh) w = g7[m]; else w = *(const PG8_LAS u32x4*)(lds + s0 * HTB + lb); }
                    else w = *(const PG8_LAS u32x4*)(lds + (wh ? s1 : s0) * HTB + lb);
                    const f32x4 b0 = {__uint_as_float(w.x << 16), __uint_as_float(w.x & 0xffff0000u), __uint_as_float(w.y << 16), __uint_as_float(w.y & 0xffff0000u)};
                    const f32x4 b1 = {__uint_as_float(w.z << 16), __uint_as_float(w.z & 0xffff0000u), __uint_as_float(w.w << 16), __uint_as_float(w.w & 0xffff0000u)};
                    const f32x4 x0 = b0 + acc[ai][bj][m][0], x1 = b1 + acc[ai][bj][m][1];
                    if (OUT_F32) { *(f32x4*)(out + off + bj * HALF) = x0; *(f32x4*)(out + off + bj * HALF + 4) = x1; }
                    else st16(xb + off + bj * HALF, pack8(x0, x1));
                    ss += (x0[0] * x0[0] + x0[1] * x0[1]) + (x0[2] * x0[2] + x0[3] * x0[3]) + (x1[0] * x1[0] + x1[1] * x1[1]) + (x1[2] * x1[2] + x1[3] * x1[3]); }
                if (!OUT_F32) { ss += __shfl_xor(ss, 16); ss += __shfl_xor(ss, 32);
                    if (fq == 0) rs[(size_t)row * 32 + u.pn * 4 + wc] = ss; } }
    }
};
__device__ __forceinline__ float row_sumsq(const float* rs, int row) {
    const f32x4* p = (const f32x4*)(rs + (size_t)row * 32); f32x4 t = p[0];
#pragma unroll
    for (int i = 1; i < 8; ++i) t += p[i];
    return (t[0] + t[1]) + (t[2] + t[3]);
}
__device__ __forceinline__ float row_rstd(const float* rs, int row) { return 1.0f / sqrtf(row_sumsq(rs, row) * (1.0f / 2048.0f) + 1e-6f); }
struct RsOrder : StaticOrder {
    const float* rs; PG8_LAS float* tab; mutable float pend; mutable int nready;
    __device__ __forceinline__ void a_ready(const Unit& u) const {
        if (threadIdx.x < 256) pend = row_sumsq(rs, u.pm * BM + u.hf * HALF + threadIdx.x);
        ++nready;
    }
    __device__ __forceinline__ bool next(int i, Unit& u) const {
        if (i == 1 && threadIdx.x < 256) tab[threadIdx.x] = 1.0f / sqrtf(pend * (1.0f / 2048.0f) + 1e-6f);
        return StaticOrder::next(i, u);
    }
    __device__ __forceinline__ void done(const Unit&) const {
        if (threadIdx.x < 256) tab[((nready - 1) & 1) * 256 + threadIdx.x] = 1.0f / sqrtf(pend * (1.0f / 2048.0f) + 1e-6f);
    }
};
struct TailOrder : RsOrder {
    int pn0;
    __device__ __forceinline__ bool next(int i, Unit& u) const {
        if (i == 1 && threadIdx.x < 256) tab[threadIdx.x] = 1.0f / sqrtf(pend * (1.0f / 2048.0f) + 1e-6f);
        if (i != 0 || G != 256) return false;
        const int x = c & 7, l = c >> 3; u.pm = 4 * x + (l & 3); u.hf = (l >> 2) & 1; u.pn = pn0 + (l >> 3); return true;
    }
};
template <bool HALF_M> struct EpiSwiglu {
    static constexpr bool PERM = true, AFTER_DRAIN = false, RESID = false;
    bf16_t* O; int ldc; const PG8_LAS float* tab; mutable int ui;
    __device__ __forceinline__ void operator()(const f32x4 (&acc)[2][2][4][2], const Unit& u, int wr, int wc, int fr, int fq) const {
        const int row0 = u.pm * BM + (HALF_M ? u.hf * HALF : 0) + wr * 64 + fr, col0 = u.pn * HALF + wc * 32 + 8 * fq;
#pragma unroll
        for (int ai = 0; ai < (HALF_M ? 1 : 2); ++ai)
#pragma unroll
            for (int m = 0; m < 4; ++m) { bf16_t* rowp = O + (size_t)(row0 + ai * HALF + m * 16) * ldc + col0; const float r = tab[(ui & 1) * 256 + wr * 64 + fr + ai * HALF + m * 16];
                f32x4 v0, v1;
#pragma unroll
                for (int j = 0; j < 4; ++j) { const float g0 = acc[ai][0][m][0][j] * r, g1 = acc[ai][0][m][1][j] * r;
                    v0[j] = g0 * fast_sigmoid(g0) * (acc[ai][1][m][0][j] * r); v1[j] = g1 * fast_sigmoid(g1) * (acc[ai][1][m][1][j] * r); }
                st16(rowp, pack8(v0, v1)); }
        ++ui;
    }
};

struct EpiSwigluProbe {
    static constexpr bool PERM = true, AFTER_DRAIN = false, RESID = false;
    bf16_t* O; int never;
    __device__ __forceinline__ void operator()(const f32x4 (&acc)[2][2][4][2], const Unit& u, int wr, int wc, int fr, int fq) const {
        if (never) {
#pragma unroll
        for (int ai = 0; ai < 2; ++ai)
#pragma unroll
            for (int m = 0; m < 4; ++m) { bf16_t* rowp = O + (size_t)(u.pm * BM + wr * 64 + fr + ai * HALF + m * 16) * 5632 + u.pn * HALF + wc * 32 + 8 * fq;
                st16(rowp, pack8(acc[ai][0][m][0] + acc[ai][1][m][0], acc[ai][0][m][1] + acc[ai][1][m][1])); } }
    }
};
struct EpiRetIn {
    static constexpr bool PERM = true, AFTER_DRAIN = false, RESID = false;
    bf16_t *q, *k, *v, *g; const float *cs, *sn; const PG8_LAS float* tab; mutable int ui;
    __device__ __forceinline__ void operator()(const f32x4 (&acc)[2][2][4][2], const Unit& u, int wr, int wc, int fr, int fq) const {
        const int pn = u.pn, ci = wc * 32 + 8 * fq;
#pragma unroll
        for (int ai = 0; ai < 2; ++ai)
#pragma unroll
            for (int m = 0; m < 4; ++m) {
                const int row = u.pm * BM + ai * HALF + wr * 64 + m * 16 + fr, b = row >> 12, s = row & 4095; const float rr = tab[(ui & 1) * 256 + ai * HALF + wr * 64 + m * 16 + fr];
                if (pn < 16) {
                    const int h = pn & 7; const float sc = (pn < 8 ? 1.0f : 0.0625f) * rr;
                    bf16_t* dst = (pn < 8 ? q : k) + ((size_t)((b * 8 + h) * 4096 + s)) * 256 + ci;
                    f32x4 o1[2], o2[2];
#pragma unroll
                    for (int n = 0; n < 2; ++n) { const f32x4 c4 = *(const f32x4*)(cs + (size_t)row * 128 + ci + 4 * n), s4 = *(const f32x4*)(sn + (size_t)row * 128 + ci + 4 * n);
                        const f32x4 x1 = acc[ai][0][m][n], x2 = acc[ai][1][m][n];
                        o1[n] = (x1 * c4 - x2 * s4) * sc; o2[n] = (x2 * c4 + x1 * s4) * sc; }
                    st16(dst, pack8(o1[0], o1[1])); st16(dst + 128, pack8(o2[0], o2[1]));
                } else if (pn < 32) {
                    const int t = pn - 16, h = t >> 1, hf = t & 1;
                    bf16_t* dst = v + ((size_t)((b * 8 + h) * 4096 + s)) * 512 + hf * 256 + ci;
                    st16(dst, pack8(acc[ai][0][m][0] * rr, acc[ai][0][m][1] * rr)); st16(dst + 128, pack8(acc[ai][1][m][0] * rr, acc[ai][1][m][1] * rr));
                } else {
                    bf16_t* dst = g + (size_t)row * 4096 + (pn - 32) * 256 + ci;
                    st16(dst, pack8(acc[ai][0][m][0] * rr, acc[ai][0][m][1] * rr)); st16(dst + 128, pack8(acc[ai][1][m][0] * rr, acc[ai][1][m][1] * rr));
                }
            }
        ++ui;
    }
};
struct EpiGeluUV {
    static constexpr bool PERM = true, AFTER_DRAIN = false, RESID = false;
    bf16_t *uo, *vo; f32x2v* part; const PG8_LAS float* tab; mutable int ui;
    __device__ __forceinline__ void operator()(const f32x4 (&acc)[2][2][4][2], const Unit& u, int wr, int wc, int fr, int fq) const {
        const bool isv = u.pn >= 24; const int ct = isv ? u.pn - 24 : u.pn; bf16_t* dstb = isv ? vo : uo;
#pragma unroll
        for (int ai = 0; ai < 2; ++ai)
#pragma unroll
            for (int m = 0; m < 4; ++m) {
                const int row = u.pm * BM + ai * HALF + wr * 64 + m * 16 + fr;
                bf16_t* dst = dstb + (size_t)row * 6144 + ct * 256 + wc * 32 + 8 * fq;
                float s = 0.f, ss = 0.f; const float rr = tab[(ui & 1) * 256 + ai * HALF + wr * 64 + m * 16 + fr];
#pragma unroll
                for (int bj = 0; bj < 2; ++bj) { const f32x4 v0 = acc[ai][bj][m][0] * rr, v1 = acc[ai][bj][m][1] * rr;
                    const f32x2 a = gelu_pk((f32x2){v0[0], v0[1]}), b = gelu_pk((f32x2){v0[2], v0[3]}), c = gelu_pk((f32x2){v1[0], v1[1]}), d = gelu_pk((f32x2){v1[2], v1[3]});
                    const f32x4 z0 = {a.x, a.y, b.x, b.y}, z1 = {c.x, c.y, d.x, d.y};
                    st16(dst + bj * HALF, pack8(z0, z1));
                    s += (z0[0] + z0[1]) + (z0[2] + z0[3]) + (z1[0] + z1[1]) + (z1[2] + z1[3]);
                    ss += (z0[0] * z0[0] + z0[1] * z0[1]) + (z0[2] * z0[2] + z0[3] * z0[3]) + (z1[0] * z1[0] + z1[1] * z1[1]) + (z1[2] * z1[2] + z1[3] * z1[3]); }
                if (isv) { s += __shfl_xor(s, 16); s += __shfl_xor(s, 32); ss += __shfl_xor(ss, 16); ss += __shfl_xor(ss, 32);
                    if (fq == 0) part[((size_t)row * 24 + ct) * 4 + wc] = (f32x2v){s, ss}; }
            }
        ++ui;
    }
};
struct EpiFoxIn {
    static constexpr bool PERM = true, AFTER_DRAIN = false, RESID = false;
    bf16_t* O; size_t stride; const PG8_LAS float* tab; mutable int ui; PG8_LAS float* qkt; const PG8_LAS float* gains;
    __device__ __forceinline__ void operator()(const f32x4 (&acc)[2][2][4][2], const Unit& u, int wr, int wc, int fr, int fq) const {
        const int t = u.pn >> 3; bf16_t* base = O + (size_t)t * stride + (u.pn & 7) * 256 + wc * 32 + 8 * fq;
        if (t < 2) {
#pragma unroll
            for (int ai = 0; ai < 2; ++ai)
#pragma unroll
                for (int m = 0; m < 4; ++m) { const int rt = ai * HALF + wr * 64 + m * 16 + fr; const float rr = tab[(ui & 1) * 256 + rt];
#pragma unroll
                    for (int bj = 0; bj < 2; ++bj) { const f32x4 v0 = acc[ai][bj][m][0] * rr, v1 = acc[ai][bj][m][1] * rr;
                        float ss = (v0[0] * v0[0] + v0[1] * v0[1]) + (v0[2] * v0[2] + v0[3] * v0[3]) + (v1[0] * v1[0] + v1[1] * v1[1]) + (v1[2] * v1[2] + v1[3] * v1[3]);
                        ss += __shfl_xor(ss, 16); ss += __shfl_xor(ss, 32);
                        if (fq == 0) qkt[(rt * 2 + bj) * 4 + wc] = ss; } }
            asm volatile("s_waitcnt lgkmcnt(0)" ::: "memory"); __builtin_amdgcn_s_barrier(); asm volatile("" ::: "memory");
            const float sc = t == 0 ? 0.08838834764831845f * 1.4426950408889634f : 1.0f;
            const f32x4 g0 = *(const PG8_LAS f32x4*)(gains + t * 128 + wc * 32 + 8 * fq), g1 = *(const PG8_LAS f32x4*)(gains + t * 128 + wc * 32 + 8 * fq + 4);
#pragma unroll
            for (int ai = 0; ai < 2; ++ai)
#pragma unroll
                for (int m = 0; m < 4; ++m) { const int rt = ai * HALF + wr * 64 + m * 16 + fr; const float rr = tab[(ui & 1) * 256 + rt]; bf16_t* dst = base + (size_t)(u.pm * BM + rt) * 2048;
#pragma unroll
                    for (int bj = 0; bj < 2; ++bj) { const f32x4 p = *(const PG8_LAS f32x4*)(qkt + (rt * 2 + bj) * 4);
                        const float rs = rr * sc / sqrtf(((p[0] + p[1]) + (p[2] + p[3])) * (1.0f / 128.0f) + 1e-6f);
                        st16(dst + bj * HALF, pack8(acc[ai][bj][m][0] * rs * g0, acc[ai][bj][m][1] * rs * g1)); } }
        } else {
#pragma unroll
            for (int ai = 0; ai < 2; ++ai)
#pragma unroll
                for (int m = 0; m < 4; ++m) { const int row = u.pm * BM + ai * HALF + wr * 64 + m * 16 + fr; bf16_t* dst = base + (size_t)row * 2048; const float rr = tab[(ui & 1) * 256 + ai * HALF + wr * 64 + m * 16 + fr];
#pragma unroll
                    for (int bj = 0; bj < 2; ++bj) { f32x4 v0 = acc[ai][bj][m][0] * rr, v1 = acc[ai][bj][m][1] * rr;
                        if (t == 3) {
#pragma unroll
                            for (int j = 0; j < 4; ++j) { v0[j] = fast_sigmoid(v0[j]); v1[j] = fast_sigmoid(v1[j]); } }
                        st16(dst + bj * HALF, pack8(v0, v1)); } }
        }
        ++ui;
    }
};

template <class Epi, class Sched, bool ALIGN_EPI = false, bool SP2 = false, bool HALF_M = false>
__device__ __forceinline__ void gemm_phase(PG8_LAS unsigned char* lds, const Gemm g, const Sched& S, const Epi& E) {
    const int tid = threadIdx.x, wid = __builtin_amdgcn_readfirstlane(tid >> 6), lane = tid & 63, wr = wid >> 2, wc = wid & 3, fr = lane & 15, fq = lane >> 4;
    static_assert(!HALF_M || SP2, "HALF_M is written for the SP2 loop");
    const int K = g.K, nt = K / BK;
    unsigned voffA[2], voffB[2];
#pragma unroll
    for (int i = 0; i < 2; ++i) { int R, C; stage_rc(tid * 16 + i * 8192, R, C); const int Rb = Epi::PERM ? ((R & ~31) + perm32(R & 31)) : R;
        voffA[i] = (unsigned)(R * K + C) * 2u; voffB[i] = (unsigned)(Rb * K + C) * 2u; }
    unsigned voffR[2] = {0u, 0u};
    if constexpr (Epi::RESID) {
#pragma unroll
        for (int i = 0; i < 2; ++i) { int R, C; stage_rc(tid * 16 + i * 8192, R, C); voffR[i] = (unsigned)(R * E.ldc + C) * 2u; } }
    const size_t kstep = (size_t)(BK * 2);
    const size_t hstep = (size_t)HALF * K * 2;
    const size_t tstep = 2 * hstep;
    const unsigned ldsw = (unsigned)wid * 1024u;
    const int aoff = lds_byte(wr * 64 + fr, fq * 8), boff = lds_byte(wc * 32 + fr, fq * 8);
#define PG8_SA(b, h) (((b) * 2 + (h)) * HTB)
#define PG8_SB(b, h) ((4 + (b) * 2 + (h)) * HTB)
#define PG8_STAGE(bufoff, gbase, voff) do { _Pragma("unroll") for (int _i = 0; _i < 2; ++_i) \
        __builtin_amdgcn_global_load_lds((const unsigned*)((const char*)(gbase) + (voff)[_i]), (PG8_LAS unsigned*)(lds + (bufoff) + ldsw + _i * 8192), 16, 0, 0); } while (0)
#define PG8_LDA(dst, b, h) do { _Pragma("unroll") for (int m = 0; m < 4; ++m) _Pragma("unroll") for (int k = 0; k < 2; ++k) dst[m][k] = *(const PG8_LAS bf16x8*)(lds + PG8_SA(b, h) + aoff + m * 2048 + k * 1024); } while (0)
#define PG8_LDB(dst, b, h) do { _Pragma("unroll") for (int n = 0; n < 2; ++n) _Pragma("unroll") for (int k = 0; k < 2; ++k) dst[n][k] = *(const PG8_LAS bf16x8*)(lds + PG8_SB(b, h) + boff + n * 2048 + k * 1024); } while (0)
#define PG8_MMA(ai, bj, At, Bt) do { __builtin_amdgcn_s_setprio(1); _Pragma("unroll") for (int m = 0; m < 4; ++m) _Pragma("unroll") for (int n = 0; n < 2; ++n) _Pragma("unroll") for (int k = 0; k < 2; ++k) \
        acc[ai][bj][m][n] = __builtin_amdgcn_mfma_f32_16x16x32_bf16(Bt[n][k], At[m][k], acc[ai][bj][m][n], 0, 0, 0); __builtin_amdgcn_s_setprio(0); } while (0)
#define PG8_WAIT_V(n) asm volatile("s_waitcnt vmcnt(" #n ")" ::: "memory")
#define PG8_WAIT_L(n) asm volatile("s_waitcnt lgkmcnt(" #n ")" ::: "memory")
#define PG8_BAR __builtin_amdgcn_s_barrier()
#define PG8_SCHED __builtin_amdgcn_sched_barrier(0)
    Unit cur, nxt; int ui = 0;
    if (!S.next(0, cur)) return;
    f32x4 acc[2][2][4][2];
#pragma unroll
    for (int a = 0; a < 2; ++a)
#pragma unroll
        for (int b = 0; b < 2; ++b)
#pragma unroll
            for (int m = 0; m < 4; ++m)
#pragma unroll
                for (int n = 0; n < 2; ++n) acc[a][b][m][n] = (f32x4){0.f, 0.f, 0.f, 0.f};
    bf16x8 At[4][2], B0[2][2], B1[2][2];
    const char* cA = (const char*)g.A + (size_t)cur.pm * tstep + (HALF_M ? (size_t)cur.hf * hstep : (size_t)0); const char* cB = (const char*)g.Bt + (size_t)cur.pn * tstep;
    S.a_ready(cur);
    if constexpr (SP2) {
        PG8_STAGE(PG8_SB(0, 0), cB, voffB); PG8_STAGE(PG8_SB(0, 1), cB + hstep, voffB); PG8_STAGE(PG8_SA(0, 0), cA, voffA); PG8_STAGE(PG8_SA(0, 1), cA + hstep, voffA);
        if (wr == 1) PG8_BAR;
        PG8_WAIT_V(2); PG8_BAR;
        PG8_STAGE(PG8_SB(1, 0), cB + kstep, voffB); PG8_STAGE(PG8_SA(1, 0), cA + kstep, voffA); PG8_STAGE(PG8_SB(1, 1), cB + hstep + kstep, voffB);
        PG8_WAIT_V(6); PG8_BAR;
    } else {
        PG8_STAGE(PG8_SB(0, 0), cB, voffB); PG8_STAGE(PG8_SA(0, 0), cA, voffA); PG8_STAGE(PG8_SB(0, 1), cB + hstep, voffB); PG8_STAGE(PG8_SA(0, 1), cA + hstep, voffA);
        if (wr == 1) PG8_BAR;
        PG8_WAIT_V(4); PG8_BAR;
        PG8_STAGE(PG8_SB(1, 0), cB + kstep, voffB); PG8_STAGE(PG8_SA(1, 0), cA + kstep, voffA); PG8_STAGE(PG8_SB(1, 1), cB + hstep + kstep, voffB);
        PG8_WAIT_V(6); PG8_BAR;
    }
    for (;;) {
        const bool has_next = S.next(ui + 1, nxt);
        const char* nA = has_next ? (const char*)g.A + (size_t)nxt.pm * tstep + (HALF_M ? (size_t)nxt.hf * hstep : (size_t)0) : cA; const char* nB = has_next ? (const char*)g.Bt + (size_t)nxt.pn * tstep : cB;
        for (int t = 0; t < nt; t += 2) {
            const bool last = (t == nt - 2);
            const char* a1 = cA + (size_t)(t + 1) * kstep;
            const char* a2 = last ? nA : cA + (size_t)(t + 2) * kstep; const char* b2 = last ? nB : cB + (size_t)(t + 2) * kstep;
            const char* a3 = a2 + kstep; const char* b3 = b2 + kstep;
            if (last && has_next) S.a_ready(nxt);
            bool rp = false; const char* rbase = nullptr; size_t rhstep = 0;
            if constexpr (Epi::RESID) { rp = last && !has_next; rbase = (const char*)E.xb + ((size_t)cur.pm * BM * E.ldc + (size_t)cur.pn * BM) * 2; rhstep = (size_t)HALF * E.ldc * 2; }
#define PG8_STAGE_R(bufoff, gbase, voff, blk) do { if constexpr (Epi::RESID) { const char* g_ = rp ? (rbase + ((blk) & 1) * rhstep + ((blk) >> 1) * 128) : (const char*)(gbase); \
                _Pragma("unroll") for (int _i = 0; _i < 2; ++_i) __builtin_amdgcn_global_load_lds((const unsigned*)(g_ + (rp ? voffR[_i] : (voff)[_i])), (PG8_LAS unsigned*)(lds + (bufoff) + ldsw + _i * 8192), 16, 0, 0); } \
            else { PG8_STAGE(bufoff, gbase, voff); } } while (0)
            if constexpr (SP2) {
            PG8_LDB(B0, 0, 0); PG8_LDB(B1, 0, 1); PG8_SCHED; PG8_LDA(At, 0, 0); PG8_STAGE(PG8_SA(1, 1), a1 + hstep, voffA);
            PG8_WAIT_V(8); PG8_WAIT_L(0); PG8_BAR; PG8_MMA(0, 0, At, B0); PG8_MMA(0, 1, At, B1); PG8_BAR; PG8_SCHED;
            if constexpr (!HALF_M) { PG8_LDA(At, 0, 1); } PG8_STAGE_R(PG8_SB(0, 0), b2, voffB, 0); PG8_STAGE_R(PG8_SB(0, 1), b2 + hstep, voffB, 1); PG8_STAGE_R(PG8_SA(0, 0), a2, voffA, 2);
            PG8_WAIT_V(8); PG8_WAIT_L(0); PG8_BAR; if constexpr (!HALF_M) { PG8_MMA(1, 0, At, B0); PG8_MMA(1, 1, At, B1); } PG8_BAR; PG8_SCHED;
            PG8_LDB(B0, 1, 0); PG8_LDB(B1, 1, 1); PG8_SCHED; PG8_LDA(At, 1, 0); PG8_STAGE_R(PG8_SA(0, 1), a2 + hstep, voffA, 3);
            PG8_WAIT_V(8); PG8_WAIT_L(0); PG8_BAR; PG8_MMA(0, 0, At, B0); PG8_MMA(0, 1, At, B1); PG8_BAR; PG8_SCHED;
            if constexpr (!HALF_M) { PG8_LDA(At, 1, 1); } PG8_STAGE_R(PG8_SB(1, 0), b3, voffB, 4); PG8_STAGE_R(PG8_SB(1, 1), b3 + hstep, voffB, 5); PG8_STAGE_R(PG8_SA(1, 0), a3, voffA, 6);
            PG8_WAIT_V(8); PG8_WAIT_L(0); PG8_BAR; if constexpr (!HALF_M) { PG8_MMA(1, 0, At, B0); PG8_MMA(1, 1, At, B1); } PG8_BAR; PG8_SCHED;
            } else {
            PG8_LDB(B0, 0, 0); PG8_SCHED; PG8_LDA(At, 0, 0); PG8_STAGE(PG8_SA(1, 1), a1 + hstep, voffA);
            PG8_WAIT_L(8); PG8_BAR; PG8_WAIT_L(0); PG8_MMA(0, 0, At, B0); PG8_BAR; PG8_SCHED;
            PG8_LDB(B1, 0, 1); PG8_STAGE(PG8_SB(0, 0), b2, voffB);
            PG8_BAR; PG8_WAIT_L(0); PG8_MMA(0, 1, At, B1); PG8_BAR;
            PG8_LDA(At, 0, 1); PG8_STAGE(PG8_SA(0, 0), a2, voffA);
            PG8_BAR; PG8_WAIT_L(0); PG8_MMA(1, 0, At, B0); PG8_BAR; PG8_SCHED;
            PG8_STAGE(PG8_SB(0, 1), b2 + hstep, voffB);
            PG8_WAIT_V(6); PG8_BAR; PG8_MMA(1, 1, At, B1); PG8_BAR;
            PG8_LDB(B0, 1, 0); PG8_SCHED; PG8_LDA(At, 1, 0); PG8_STAGE(PG8_SA(0, 1), a2 + hstep, voffA);
            PG8_WAIT_L(8); PG8_BAR; PG8_WAIT_L(0); PG8_MMA(0, 0, At, B0); PG8_BAR; PG8_SCHED;
            PG8_LDB(B1, 1, 1); PG8_STAGE(PG8_SB(1, 0), b3, voffB);
            PG8_BAR; PG8_WAIT_L(0); PG8_MMA(0, 1, At, B1); PG8_BAR;
            PG8_LDA(At, 1, 1); PG8_STAGE(PG8_SA(1, 0), a3, voffA);
            PG8_BAR; PG8_WAIT_L(0); PG8_MMA(1, 0, At, B0); PG8_BAR; PG8_SCHED;
            PG8_STAGE(PG8_SB(1, 1), b3 + hstep, voffB);
            PG8_WAIT_V(6); PG8_BAR; PG8_MMA(1, 1, At, B1); PG8_BAR;
            }
        }
        if constexpr (ALIGN_EPI) { if (wr == 0) PG8_BAR; }
        if constexpr (!Epi::AFTER_DRAIN) { E(acc, cur, wr, wc, fr, fq); S.done(cur); }
        if (!has_next) break;
#pragma unroll
        for (int a = 0; a < 2; ++a)
#pragma unroll
            for (int b = 0; b < 2; ++b)
#pragma unroll
                for (int m = 0; m < 4; ++m)
#pragma unroll
                    for (int n = 0; n < 2; ++n) acc[a][b][m][n] = (f32x4){0.f, 0.f, 0.f, 0.f};
        cur = nxt; cA = nA; cB = nB; ++ui;
        if constexpr (ALIGN_EPI) { if (wr == 1) PG8_BAR; }
    }
    PG8_WAIT_V(0);
    if constexpr (!ALIGN_EPI) { if (wr == 0) PG8_BAR; }
    PG8_BAR;
    if constexpr (Epi::AFTER_DRAIN) { E.fused(acc, cur, wr, wc, fr, fq, lds, wid, lane); S.done(cur); }
#undef PG8_SA
#undef PG8_SB
#undef PG8_STAGE
#undef PG8_STAGE_R
#undef PG8_LDA
#undef PG8_LDB
#undef PG8_MMA
#undef PG8_WAIT_V
#undef PG8_WAIT_L
#undef PG8_BAR
#undef PG8_SCHED
}
}

#ifndef PG8_SP2
#define PG8_SP2 true
#endif
#ifndef PG8_ALIGN
#define PG8_ALIGN true
#endif
constexpr int NWAVES = 8, NTHR = 512;
#ifndef MK_N_LAUNCHES
#define MK_N_LAUNCHES 1
#endif
constexpr int N_PHASES = 25;
constexpr int N_LAUNCHES = MK_N_LAUNCHES;
static_assert(N_LAUNCHES == 1, "this build runs as ONE launch (the retention mixer has a grid barrier inside its phase)");

constexpr int BATCH = 2, SEQ = 4096, DM = 2048, M = BATCH * SEQ, DEPTH = 4;
constexpr int RET_N = 12288, GM_N = 12288, GM_HALF = 6144, FOX_LD = 8208, FOX_N = 8192, FFN_H = 5632, FFN_N2 = 2 * FFN_H;
constexpr float EPS = 1e-6f;
constexpr float LOG2E = 1.4426950408889634f;

constexpr size_t MiB = (size_t)1 << 20;
constexpr size_t WS_CTL = 0, CTL_ZERO_BYTES = 1 * MiB;
constexpr size_t WS_W_RET_IN = 1 * MiB, SZ_W_RET_IN = 48 * MiB;
constexpr size_t WS_W_RET_OUT = 97 * MiB, SZ_W_RET_OUT = 16 * MiB;
constexpr size_t WS_W_GM_IN = 129 * MiB, WS_W_GM_OUT = 177 * MiB, WS_W_FOX_IN = 201 * MiB, WS_W_FOX_OUT = 233 * MiB;
constexpr size_t WS_W_GU = 241 * MiB, SZ_W_GU = 44 * MiB;
constexpr size_t WS_W_DN = 417 * MiB, SZ_W_DN = 22 * MiB;
constexpr size_t WS_ROPE_C = 505 * MiB, WS_ROPE_S = 509 * MiB;
constexpr size_t WS_H = 513 * MiB;
constexpr size_t WS_A = 545 * MiB;
constexpr size_t WS_B = 737 * MiB;
constexpr size_t WS_C = 833 * MiB;
constexpr size_t WS_MISC = 897 * MiB, WS_RSP = 913 * MiB, WS_KF = 921 * MiB, WS_QF = 953 * MiB, WS_END = 985 * MiB;
constexpr size_t MISC_PART = 0, MISC_RSTAT = 8 * MiB, MISC_LF = 9 * MiB, MISC_WTRI = 12 * MiB;
constexpr int CW_BAR = 4096;

constexpr int RING_OFF = 0, RING_BYTES = 131072;
constexpr int LDSCTL_OFF = RING_BYTES, MISC_OFF = LDSCTL_OFF + 320;
constexpr int RSTAB_OFF = LDSCTL_OFF + 1024;
constexpr int QKT_OFF = LDSCTL_OFF + 3072, QKG_OFF = QKT_OFF + 8192;
constexpr int LDS_BYTES = 147456;
static_assert(MISC_OFF + 128 <= RSTAB_OFF && RSTAB_OFF + 2048 <= QKT_OFF && QKG_OFF + 1024 <= LDS_BYTES, "LDS map");

#define GAS __attribute__((address_space(1)))
#define LAS __attribute__((address_space(3)))
typedef unsigned short bf16;
typedef unsigned v4u __attribute__((ext_vector_type(4)));
typedef unsigned v2u __attribute__((ext_vector_type(2)));
typedef float f32x4 __attribute__((ext_vector_type(4)));
typedef float f32x2 __attribute__((ext_vector_type(2)));
typedef short bf16x8 __attribute__((ext_vector_type(8)));
typedef short s16x4 __attribute__((ext_vector_type(4)));
typedef GAS unsigned gu32;
typedef LAS unsigned char* ldsp;
#define RLX_AGENT __ATOMIC_RELAXED, __HIP_MEMORY_SCOPE_AGENT
#define LDS_WAIT() asm volatile("s_waitcnt lgkmcnt(0)" ::: "memory")
using pg8::cvtpk;
__device__ __forceinline__ float bflo(unsigned w) { return __uint_as_float(w << 16); }
__device__ __forceinline__ float bfhi(unsigned w) { return __uint_as_float(w & 0xffff0000u); }
#define MFMA16(a, b, c) __builtin_amdgcn_mfma_f32_16x16x32_bf16((a), (b), (c), 0, 0, 0)
__device__ __forceinline__ bf16x8 frag_row(const ldsp tile, int RS, int lane) { return *(const LAS bf16x8*)(tile + (lane & 15) * RS + (lane >> 4) * 16); }
typedef short v4i16_t __attribute__((ext_vector_type(4)));
__device__ __forceinline__ s16x4 vtr(const ldsp p) { return __builtin_bit_cast(s16x4, __builtin_amdgcn_ds_read_tr16_b64_v4i16((LAS v4i16_t*)p)); }
__device__ __forceinline__ bf16x8 frag_tr(const ldsp tile, int RS, int lane) {
    const ldsp a = tile + (8 * (lane >> 4) + ((lane & 15) >> 2)) * RS + 8 * (lane & 3);
    const s16x4 lo = vtr(a), hi = vtr(a + 4 * RS);
    return (bf16x8){lo[0], lo[1], lo[2], lo[3], hi[0], hi[1], hi[2], hi[3]};
}

#define XB_TMO      128
#define XB_XCNT(j)  (256  + 64 * (j))
#define XB_XSUB(j)  (1280 + 64 * (j))
#define XB_XGEN(j)  (2304 + 64 * (j))
#define XB_TOP      3328
#define XB_TOPGEN   3392
#define XCD_BAR_WORDS 3456
#define XB_SPIN_CAP (1u << 18)

__device__ __forceinline__ unsigned xb_ld(unsigned* p)              { return __hip_atomic_load(p, __ATOMIC_RELAXED, __HIP_MEMORY_SCOPE_AGENT); }
__device__ __forceinline__ unsigned xb_add(unsigned* p, unsigned v) { return __hip_atomic_fetch_add(p, v, __ATOMIC_RELAXED, __HIP_MEMORY_SCOPE_AGENT); }
__device__ __forceinline__ unsigned xb_xcc_id() { return (unsigned)__builtin_amdgcn_s_getreg((3 << 11) | 20) & 0xFu; }
#define XB_SPIN(cond, bar) do { unsigned _sp = 0; while (cond) { __builtin_amdgcn_s_sleep(1); \
    if ((++_sp & 255u) == 0u) { if (xb_ld(&(bar)[XB_TMO])) break; if (_sp > XB_SPIN_CAP) { atomicAdd(&(bar)[XB_TMO], 1u); break; } } } } while (0)

struct XcdBarrier {
    unsigned* bar; unsigned x;
    volatile LAS unsigned* st;
};

__device__ __forceinline__ XcdBarrier xcd_barrier_post(unsigned* bar, volatile LAS unsigned* st) {
    XcdBarrier b; b.bar = bar; b.x = xb_xcc_id(); b.st = st;
    if (threadIdx.x == 0) (void)xb_add(&bar[XB_XCNT(b.x)], 1u);
    return b;
}
__device__ __forceinline__ void xcd_barrier_complete(unsigned* bar, unsigned x, unsigned& nloc, unsigned& nx) {
    const unsigned G = gridDim.x * gridDim.y * gridDim.z;
    unsigned sum, cnt, mine, sp = 0u;
    for (;;) {
        sum = 0u; cnt = 0u; mine = 0u;
#pragma unroll
        for (unsigned j = 0; j < 16; ++j) { const unsigned c = xb_ld(&bar[XB_XCNT(j)]); sum += c; cnt += (c > 0u) ? 1u : 0u; mine = (j == x) ? c : mine; }
        if (sum == G) break;
        __builtin_amdgcn_s_sleep(1);
        if ((++sp & 255u) == 0u) { if (xb_ld(&bar[XB_TMO])) break; if (sp > XB_SPIN_CAP) { atomicAdd(&bar[XB_TMO], 1u); break; } }
    }
    nloc = mine > 0u ? mine : 1u; nx = cnt > 0u ? cnt : 1u;
}

__device__ __forceinline__ void xcd_barrier(const XcdBarrier& b) {
    asm volatile("s_waitcnt vmcnt(0)" ::: "memory");
    __syncthreads();
    if (threadIdx.x == 0) {
        unsigned* bar = b.bar;
        __builtin_amdgcn_s_waitcnt(0);
        unsigned nloc = b.st[0], nx = b.st[1];
        if (nloc == 0u) { xcd_barrier_complete(bar, b.x, nloc, nx); b.st[0] = nloc; b.st[1] = nx; }
        const unsigned old = xb_add(&bar[XB_XSUB(b.x)], 1u);
        const unsigned gen = old / nloc;
        if (old + 1u == (gen + 1u) * nloc) {
            __builtin_amdgcn_fence(__ATOMIC_RELEASE, "agent");
            asm volatile("s_waitcnt vmcnt(0)" ::: "memory");
            const unsigned og = xb_add(&bar[XB_TOP], 1u);
            const unsigned tg = og / nx;
            if (og + 1u == (tg + 1u) * nx) xb_add(&bar[XB_TOPGEN], 1u);
            else XB_SPIN(xb_ld(&bar[XB_TOPGEN]) == tg, bar);
            __builtin_amdgcn_fence(__ATOMIC_ACQUIRE, "agent");
            xb_add(&bar[XB_XGEN(b.x)], 1u);
            asm volatile("s_waitcnt vmcnt(0)" ::: "memory");
        } else {
            XB_SPIN(xb_ld(&bar[XB_XGEN(b.x)]) == gen, bar);
            __builtin_amdgcn_fence(__ATOMIC_ACQUIRE, "agent");
            asm volatile("s_waitcnt vmcnt(0)" ::: "memory");
        }
    }
    __syncthreads();
}

struct Frame {
    ldsp lds;
    volatile LAS unsigned* MISC;
    gu32* ctl;
    int tid, lane, wave;
    int vcu, G;
};
__device__ __forceinline__ float wave_sum(float v) {
#pragma unroll
    for (int o = 1; o < 64; o <<= 1) v += __shfl_xor(v, o);
    return v;
}
__device__ __forceinline__ float log_sigmoid(float z) { return fminf(z, 0.f) - log1pf(expf(-fabsf(z))); }

__device__ __forceinline__ void transpose_job(Frame& F, const float* W, int K, int ld, int ncols, bf16* WT, int ilv, const float* gvec) {
    LAS float* scr = (LAS float*)(F.lds + RING_OFF + F.wave * 16384);
    const int gw = F.vcu * NWAVES + F.wave, NGW = F.G * NWAVES, lane = F.lane;
    const int nblk = ncols / 32, nitems = (K / 64) * nblk;
    float wv[32];
#define TJ_LOAD(item) do { const int kb_ = (item) / nblk, nb_ = (item) % nblk; const float* src_ = W + (size_t)(64 * kb_ + (lane >> 5)) * ld + 32 * nb_ + (lane & 31); \
        _Pragma("unroll") for (int i = 0; i < 32; ++i) wv[i] = src_[(size_t)(2 * i) * ld]; } while (0)
    if (gw < nitems) TJ_LOAD(gw);
    for (int it = gw; it < nitems; it += NGW) {
        const int kb = it / nblk, nb = it % nblk, k0 = 64 * kb, n0 = 32 * nb;
        const int drow0 = ilv == 0 ? n0 : ((n0 >> 7) * 256 + (n0 & 127) + (ilv == 2 ? 128 : 0));
#pragma unroll
        for (int i = 0; i < 32; ++i) scr[(2 * i + (lane >> 5)) * 33 + (lane & 31)] = wv[i];
        if (it + NGW < nitems) TJ_LOAD(it + NGW);
        LDS_WAIT(); asm volatile("" ::: "memory");
        const int c = lane & 7;
        f32x4 ga = {1.f, 1.f, 1.f, 1.f}, gb = {1.f, 1.f, 1.f, 1.f};
        if (gvec) { ga = *(const f32x4*)(gvec + k0 + 8 * c); gb = *(const f32x4*)(gvec + k0 + 8 * c + 4); }
#pragma unroll
        for (int j = 0; j < 4; ++j) { const int n = (lane >> 3) + 8 * j; const LAS float* s = scr + (8 * c) * 33 + n;
            v4u o; o.x = cvtpk(s[0 * 33] * ga[0], s[1 * 33] * ga[1]); o.y = cvtpk(s[2 * 33] * ga[2], s[3 * 33] * ga[3]); o.z = cvtpk(s[4 * 33] * gb[0], s[5 * 33] * gb[1]); o.w = cvtpk(s[6 * 33] * gb[2], s[7 * 33] * gb[3]);
            *(GAS v4u*)(WT + (size_t)(drow0 + n) * K + k0 + 8 * c) = o; }
        LDS_WAIT(); asm volatile("" ::: "memory");
    }
#undef TJ_LOAD
}
__device__ __forceinline__ void p0_prologue(Frame& F, const void* const* in, unsigned char* ws) {
    const float* mixg = (const float*)in[2]; const float* ffng = (const float*)in[3];
    for (int j = 0; j < 2; ++j) {
        transpose_job(F, (const float*)in[4] + (size_t)j * DM * RET_N, DM, RET_N, RET_N, (bf16*)(ws + WS_W_RET_IN + j * SZ_W_RET_IN), 0, mixg + (size_t)(3 * j) * DM);
        transpose_job(F, (const float*)in[6] + (size_t)j * 4096 * DM, 4096, DM, DM, (bf16*)(ws + WS_W_RET_OUT + j * SZ_W_RET_OUT), 0, nullptr);
    }
    transpose_job(F, (const float*)in[7], DM, GM_N, GM_N, (bf16*)(ws + WS_W_GM_IN), 0, mixg + DM);
    transpose_job(F, (const float*)in[12], GM_HALF, DM, DM, (bf16*)(ws + WS_W_GM_OUT), 0, nullptr);
    transpose_job(F, (const float*)in[13], DM, FOX_LD, FOX_N, (bf16*)(ws + WS_W_FOX_IN), 0, mixg + 2 * DM);
    transpose_job(F, (const float*)in[17], DM, DM, DM, (bf16*)(ws + WS_W_FOX_OUT), 0, nullptr);
    for (int i = 0; i < DEPTH; ++i) {
        transpose_job(F, (const float*)in[18] + (size_t)i * DM * FFN_H, DM, FFN_H, FFN_H, (bf16*)(ws + WS_W_GU + i * SZ_W_GU), 1, ffng + (size_t)i * DM);
        transpose_job(F, (const float*)in[19] + (size_t)i * DM * FFN_H, DM, FFN_H, FFN_H, (bf16*)(ws + WS_W_GU + i * SZ_W_GU), 2, ffng + (size_t)i * DM);
        transpose_job(F, (const float*)in[20] + (size_t)i * FFN_H * DM, FFN_H, DM, DM, (bf16*)(ws + WS_W_DN + i * SZ_W_DN), 0, nullptr);
    }
    { const float* x = (const float*)in[0]; bf16* xb = (bf16*)(ws + WS_H); float* rss = (float*)(ws + WS_RSP);
      const int gw = F.vcu * NWAVES + F.wave, NGW = F.G * NWAVES, lane = F.lane;
      for (int m = gw; m < M; m += NGW) { const f32x4* xr = (const f32x4*)(x + (size_t)m * DM) + lane; v2u* o8 = (v2u*)(xb + (size_t)m * DM) + lane; float ss = 0.f;
#pragma unroll
          for (int j = 0; j < 8; ++j) { const f32x4 v = xr[64 * j]; ss += (v.x * v.x + v.y * v.y) + (v.z * v.z + v.w * v.w); v2u w; w.x = cvtpk(v.x, v.y); w.y = cvtpk(v.z, v.w); o8[64 * j] = w; }
          ss = wave_sum(ss); if (lane < 32) rss[(size_t)m * 32 + lane] = lane == 0 ? ss : 0.f; } }
    { const float* wsp = (const float*)in[10]; bf16* wtri = (bf16*)(ws + WS_MISC + MISC_WTRI);
      for (int i4 = F.vcu * NTHR + F.tid; i4 < 8 * 128 * 32; i4 += F.G * NTHR) { const int t = (i4 >> 5) & 127, s4 = (i4 & 31) * 4; f32x4 wv = *(const f32x4*)(wsp + (size_t)i4 * 4);
#pragma unroll
          for (int e = 0; e < 4; ++e) if (s4 + e > t) wv[e] = 0.f;
          v2u pk; pk.x = cvtpk(wv[0], wv[1]); pk.y = cvtpk(wv[2], wv[3]); *(v2u*)(wtri + (size_t)i4 * 4) = pk; } }
    { const int* pos = (const int*)in[1]; float* cs = (float*)(ws + WS_ROPE_C); float* sn = (float*)(ws + WS_ROPE_S);
      const int gid = F.vcu * NTHR + F.tid, i = gid & 127, step = (F.G * NTHR) >> 7;
      const double invf = exp2(-(double)i * (13.287712379549449 / 128.0));
      for (int r = gid >> 7; r < M; r += step) { const double ang = (double)pos[r] * invf; const double rr = ang - 6.283185307179586 * rint(ang * 0.15915494309189535);
          const float a = (float)rr; cs[(size_t)r * 128 + i] = cosf(a); sn[(size_t)r * 128 + i] = sinf(a); } }
}

__device__ __forceinline__ void ret_p_phase(Frame& F, const bf16* q, const bf16* k, bf16* PF, bf16* KF, bf16* QF) {
    constexpr int RSQ = 272;
    const ldsp LQ = F.lds, LK = F.lds + 34816;
    const int tid = F.tid, lane = F.lane, w = F.wave, g4 = lane >> 4, l15 = lane & 15;
    for (int unit = F.vcu; unit < 512; unit += F.G) {
        const int bh = unit >> 5, ci = unit & 31, h = bh & 7;
        const float lg2 = log1pf(-exp2f(-5.0f - (float)h)) * LOG2E;
        const size_t rowbase = (size_t)bh * SEQ + ci * 128;
        v4u pq[4], pk[4];
#define RP_LD(dd) do { _Pragma("unroll") for (int ps = 0; ps < 4; ++ps) { const int r_ = ps * 32 + (tid >> 4), c_ = tid & 15; \
            pq[ps] = *(const v4u*)(q + (rowbase + r_) * 256 + (dd) * 128 + c_ * 8); pk[ps] = *(const v4u*)(k + (rowbase + r_) * 256 + (dd) * 128 + c_ * 8); } } while (0)
        RP_LD(0);
        f32x4 S[8];
#pragma unroll
        for (int t = 0; t < 8; ++t) S[t] = (f32x4){0.f, 0.f, 0.f, 0.f};
#pragma unroll
        for (int dh = 0; dh < 2; ++dh) {
            __syncthreads();
#pragma unroll
            for (int ps = 0; ps < 4; ++ps) { const int r_ = ps * 32 + (tid >> 4), c_ = tid & 15; *(LAS v4u*)(LQ + r_ * RSQ + c_ * 16) = pq[ps]; *(LAS v4u*)(LK + r_ * RSQ + c_ * 16) = pk[ps]; }
            if (dh == 0) RP_LD(1);
            __syncthreads();
#pragma unroll
            for (int ks = 0; ks < 4; ++ks) { const bf16x8 a = frag_row(LQ + (16 * w) * RSQ + ks * 64, RSQ, lane);
                *(bf16x8*)(QF + ((((size_t)(bh * 32 + ci) * 8 + w) * 8 + dh * 4 + ks) * 512 + lane * 8)) = a;
#pragma unroll
                for (int t = 0; t < 8; ++t) S[t] = MFMA16(a, frag_row(LK + (16 * t) * RSQ + ks * 64, RSQ, lane), S[t]); }
#pragma unroll
            for (int ks = 0; ks < 4; ++ks) { const bf16x8 f = frag_tr(LK + (32 * ks) * RSQ + (16 * w) * 2, RSQ, lane); const v4u fu = __builtin_bit_cast(v4u, f); v4u o;
                const float k0 = exp2f((float)(127 - 32 * ks - 8 * g4) * lg2), gi = exp2f(-lg2), k1 = k0 * gi, k2 = k1 * gi, k3 = k2 * gi, k4 = k3 * gi, k5 = k4 * gi, k6 = k5 * gi, k7 = k6 * gi;
                o.x = cvtpk(bflo(fu.x) * k0, bfhi(fu.x) * k1); o.y = cvtpk(bflo(fu.y) * k2, bfhi(fu.y) * k3); o.z = cvtpk(bflo(fu.z) * k4, bfhi(fu.z) * k5); o.w = cvtpk(bflo(fu.w) * k6, bfhi(fu.w) * k7);
                *(v4u*)(KF + ((((size_t)(bh * 32 + ci) * 2 + dh) * 8 + w) * 4 + ks) * 512 + lane * 8) = o; }
        }
#undef RP_LD
#pragma unroll
        for (int t = 0; t < 8; ++t)
#pragma unroll
            for (int r = 0; r < 4; ++r) { const int n = 16 * w + 4 * g4 + r, mm = 16 * t + l15;
                const float pv_ = n >= mm ? S[t][r] * exp2f((float)(n - mm) * lg2) : 0.f;
                *(LAS unsigned short*)(LQ + n * RSQ + mm * 2) = (unsigned short)(cvtpk(pv_, 0.f) & 0xffffu); }
#pragma unroll
        for (int ks = 0; ks < 4; ++ks) *(bf16x8*)(PF + ((((size_t)(bh * 32 + ci) * 8 + w) * 4 + ks) * 512 + lane * 8)) = frag_row(LQ + (16 * w) * RSQ + ks * 64, RSQ, lane);
    }
}
__device__ __forceinline__ void ret_core_phase(Frame& F, const bf16* QF, const bf16* v, const bf16* PF, const bf16* KF, bf16* o) {
    constexpr int RSV = 72, RSS = 528;
    const ldsp LV0 = F.lds, LST = F.lds + 18432;
    const ldsp LOw = F.lds + 52224 + F.wave * 1024;
    const int tid = F.tid, lane = F.lane, w = F.wave, g4 = lane >> 4, l15 = lane & 15;
    for (int unit = F.vcu; unit < 256; unit += F.G) {
        const int bh = unit >> 4, es = unit & 15, h = bh & 7, b = bh >> 3, e0 = es * 32;
        const float lg2 = log1pf(-exp2f(-5.0f - (float)h)) * LOG2E;
        const float cd = exp2f(128.0f * lg2);
        const size_t rb0 = (size_t)bh * SEQ;
        f32x4 st[2][2];
#pragma unroll
        for (int a = 0; a < 2; ++a)
#pragma unroll
            for (int t = 0; t < 2; ++t) st[a][t] = (f32x4){0.f, 0.f, 0.f, 0.f};
        __syncthreads();
        for (int i = tid; i < 16896 / 4; i += NTHR) ((LAS unsigned*)LST)[i] = 0u;
        v4u pv, pvn; bf16x8 qf[8], pf[4], kf[8], qn[8], pn[4], kn[8];
#define RC_LD(cc) do { pvn = *(const v4u*)(v + (rb0 + (cc) * 128 + (tid >> 2)) * 512 + e0 + (tid & 3) * 8); \
            _Pragma("unroll") for (int ks = 0; ks < 8; ++ks) qn[ks] = *(const bf16x8*)(QF + ((((size_t)(bh * 32 + (cc)) * 8 + w) * 8 + ks) * 512 + lane * 8)); \
            _Pragma("unroll") for (int ks = 0; ks < 4; ++ks) pn[ks] = *(const bf16x8*)(PF + ((((size_t)(bh * 32 + (cc)) * 8 + w) * 4 + ks) * 512 + lane * 8)); \
            _Pragma("unroll") for (int i_ = 0; i_ < 8; ++i_) kn[i_] = *(const bf16x8*)(KF + ((((size_t)(bh * 32 + (cc)) * 2 + (i_ >> 2)) * 8 + w) * 4 + (i_ & 3)) * 512 + lane * 8); } while (0)
        RC_LD(0);
        for (int ci = 0; ci < 32; ++ci) {
            const ldsp LSc = LST + (ci & 1) * 16896, LSn = LST + ((ci + 1) & 1) * 16896;
            const ldsp LV = LV0 + (ci & 1) * 9216;
            pv = pvn;
#pragma unroll
            for (int i_ = 0; i_ < 8; ++i_) { qf[i_] = qn[i_]; kf[i_] = kn[i_]; }
#pragma unroll
            for (int i_ = 0; i_ < 4; ++i_) pf[i_] = pn[i_];
            *(LAS v4u*)(LV + (tid >> 2) * RSV + (tid & 3) * 16) = pv;
            __syncthreads();
            if (ci + 1 < 32) RC_LD(ci + 1);
            bf16x8 vf[4][2];
#pragma unroll
            for (int ks = 0; ks < 4; ++ks)
#pragma unroll
                for (int t = 0; t < 2; ++t) vf[ks][t] = frag_tr(LV + (32 * ks) * RSV + (16 * t) * 2, RSV, lane);
            f32x4 cr[2], in[2];
            cr[0] = (f32x4){0.f, 0.f, 0.f, 0.f}; cr[1] = (f32x4){0.f, 0.f, 0.f, 0.f}; in[0] = (f32x4){0.f, 0.f, 0.f, 0.f}; in[1] = (f32x4){0.f, 0.f, 0.f, 0.f};
#pragma unroll
            for (int ks = 0; ks < 8; ++ks)
#pragma unroll
                for (int t = 0; t < 2; ++t) cr[t] = MFMA16(qf[ks], frag_row(LSc + (16 * t) * RSS + (ks * 32) * 2, RSS, lane), cr[t]);
#pragma unroll
            for (int ks = 0; ks < 4; ++ks)
#pragma unroll
                for (int t = 0; t < 2; ++t) in[t] = MFMA16(pf[ks], vf[ks][t], in[t]);
#pragma unroll
            for (int dh = 0; dh < 2; ++dh) {
#pragma unroll
                for (int t = 0; t < 2; ++t) st[dh][t] = st[dh][t] * cd;
#pragma unroll
                for (int ks = 0; ks < 4; ++ks)
#pragma unroll
                    for (int t = 0; t < 2; ++t) st[dh][t] = MFMA16(kf[dh * 4 + ks], vf[ks][t], st[dh][t]);
#pragma unroll
                for (int t = 0; t < 2; ++t) { v2u pk2; pk2.x = cvtpk(st[dh][t][0], st[dh][t][1]); pk2.y = cvtpk(st[dh][t][2], st[dh][t][3]);
                    *(LAS v2u*)(LSn + (16 * t + l15) * RSS + (dh * 128 + 16 * w + 4 * g4) * 2) = pk2; }
            }
#pragma unroll
            for (int r = 0; r < 4; ++r) { const int n = 16 * w + 4 * g4 + r; const float qd = exp2f((float)(n + 1) * lg2);
#pragma unroll
                for (int t = 0; t < 2; ++t) *(LAS unsigned short*)(LOw + (4 * g4 + r) * 64 + (16 * t + l15) * 2) = (unsigned short)(cvtpk(in[t][r] + cr[t][r] * qd, 0.f) & 0xffffu); }
            *(v4u*)(o + ((size_t)b * SEQ + ci * 128 + 16 * w + (lane >> 2)) * 4096 + h * 512 + e0 + (lane & 3) * 8) = *(const LAS v4u*)(LOw + (lane >> 2) * 64 + (lane & 3) * 16);
        }
#undef RC_LD
    }
}

__device__ __forceinline__ void ret_gn_phase(Frame& F, const bf16* o, const bf16* g, const float* gn, bf16* y) {
    const int lane = F.lane, gw = F.vcu * NWAVES + F.wave, NGW = F.G * NWAVES;
    for (int it0 = gw; it0 < M * 8; it0 += 4 * NGW) {
        v4u ov[4], gv[4];
#pragma unroll
        for (int u = 0; u < 4; ++u) { const int it = it0 + u * NGW; const size_t off = (size_t)(it >> 3) * 4096 + (it & 7) * 512 + lane * 8;
            if (it < M * 8) { ov[u] = *(const v4u*)(o + off); gv[u] = *(const v4u*)(g + off); } else { ov[u] = (v4u){0u, 0u, 0u, 0u}; gv[u] = ov[u]; } }
#pragma unroll
        for (int u = 0; u < 4; ++u) { const int it = it0 + u * NGW, h = it & 7; const size_t off = (size_t)(it >> 3) * 4096 + h * 512 + lane * 8;
            float x[8] = {bflo(ov[u].x), bfhi(ov[u].x), bflo(ov[u].y), bfhi(ov[u].y), bflo(ov[u].z), bfhi(ov[u].z), bflo(ov[u].w), bfhi(ov[u].w)};
            float gg[8] = {bflo(gv[u].x), bfhi(gv[u].x), bflo(gv[u].y), bfhi(gv[u].y), bflo(gv[u].z), bfhi(gv[u].z), bflo(gv[u].w), bfhi(gv[u].w)};
            float s = 0.f;
#pragma unroll
            for (int e = 0; e < 8; ++e) s += x[e];
            const float mean = wave_sum(s) * (1.0f / 512.0f); float qv = 0.f;
#pragma unroll
            for (int e = 0; e < 8; ++e) { x[e] -= mean; qv += x[e] * x[e]; }
            const float rstd = 1.0f / sqrtf(wave_sum(qv) * (1.0f / 512.0f) + EPS);
            const f32x4 g0 = *(const f32x4*)(gn + h * 512 + lane * 8), g1 = *(const f32x4*)(gn + h * 512 + lane * 8 + 4);
            float r[8];
#pragma unroll
            for (int e = 0; e < 8; ++e) { const float gw_ = e < 4 ? g0[e & 3] : g1[e & 3]; r[e] = x[e] * rstd * gw_ * (gg[e] * pg8::fast_sigmoid(gg[e])); }
            v4u w; w.x = cvtpk(r[0], r[1]); w.y = cvtpk(r[2], r[3]); w.z = cvtpk(r[4], r[5]); w.w = cvtpk(r[6], r[7]);
            if (it < M * 8) *(v4u*)(y + off) = w; }
    }
}

__device__ __forceinline__ void gm_stat_phase(Frame& F, const f32x2* part, f32x2* rstat) {
    const int lane = F.lane, gw = F.vcu * NWAVES + F.wave, NGW = F.G * NWAVES;
    for (int row = gw; row < M; row += NGW) {
        float s = 0.f, ss = 0.f;
        if (lane < 48) { const f32x4 p = *(const f32x4*)(part + (size_t)row * 96 + lane * 2); s = p.x + p.z; ss = p.y + p.w; }
        s = wave_sum(s); ss = wave_sum(ss);
        const float mean = s * (1.0f / GM_HALF), var = fmaxf(ss * (1.0f / GM_HALF) - mean * mean, 0.f);
        if (lane == 0) rstat[row] = (f32x2){mean, 1.0f / sqrtf(var + EPS)};
    }
}
__device__ __forceinline__ void gm_spatial_phase(Frame& F, const bf16* u, const bf16* v, const f32x2* rstat, const float* lng, const float* lnb, const bf16* wtri, const float* bsp, bf16* y) {
    constexpr int RSW = 272, RSN = 528;
    const ldsp LW = F.lds, LN = F.lds + 34816;
    const int tid = F.tid, lane = F.lane, w = F.wave, g4 = lane >> 4, l15 = lane & 15;
    for (int wgi = F.vcu; wgi < 256; wgi += F.G) {
        const int gg = wgi & 7, jj = wgi >> 3;
        __syncthreads();
#pragma unroll
        for (int ps = 0; ps < 4; ++ps) { const int id = ps * NTHR + tid, t = id >> 4, c = id & 15;
            *(LAS v4u*)(LW + t * RSW + c * 16) = *(const v4u*)(wtri + ((size_t)gg * 128 + t) * 128 + c * 8); }
        float bs[8];
#pragma unroll
        for (int tt = 0; tt < 8; ++tt) bs[tt] = bsp[gg * 128 + 16 * tt + l15];
        v4u vr[8], ur[8];
#define GS_ROW0(i_) ((((jj) * 6 + (i_)) / 3) * 128)
#define GS_COL0(i_) (gg * 768 + (((jj) * 6 + (i_)) % 3) * 256)
#define GS_LDV(i_) do { _Pragma("unroll") for (int ps = 0; ps < 8; ++ps) { const int id_ = ps * NTHR + tid; vr[ps] = *(const v4u*)(v + (size_t)(GS_ROW0(i_) + (id_ >> 5)) * GM_HALF + GS_COL0(i_) + (id_ & 31) * 8); } } while (0)
        GS_LDV(0);
        for (int ui = 0; ui < 6; ++ui) {
            const int row0 = GS_ROW0(ui), col0 = GS_COL0(ui);
            __syncthreads();
#pragma unroll
            for (int ps = 0; ps < 8; ++ps) { const int id = ps * NTHR + tid, r = id >> 5, c8 = (id & 31) * 8;
                const v4u vv = vr[ps]; const f32x2 rs = rstat[row0 + r];
                const f32x4 ga = *(const f32x4*)(lng + col0 + c8), gb = *(const f32x4*)(lng + col0 + c8 + 4), ba = *(const f32x4*)(lnb + col0 + c8), bb = *(const f32x4*)(lnb + col0 + c8 + 4);
                v4u o;
                o.x = cvtpk((bflo(vv.x) - rs.x) * rs.y * ga[0] + ba[0], (bfhi(vv.x) - rs.x) * rs.y * ga[1] + ba[1]);
                o.y = cvtpk((bflo(vv.y) - rs.x) * rs.y * ga[2] + ba[2], (bfhi(vv.y) - rs.x) * rs.y * ga[3] + ba[3]);
                o.z = cvtpk((bflo(vv.z) - rs.x) * rs.y * gb[0] + bb[0], (bfhi(vv.z) - rs.x) * rs.y * gb[1] + bb[1]);
                o.w = cvtpk((bflo(vv.w) - rs.x) * rs.y * gb[2] + bb[2], (bfhi(vv.w) - rs.x) * rs.y * gb[3] + bb[3]);
                *(LAS v4u*)(LN + r * RSN + c8 * 2) = o; }
#pragma unroll
            for (int ps = 0; ps < 8; ++ps) { const int id_ = ps * NTHR + tid; ur[ps] = *(const v4u*)(u + (size_t)(row0 + (id_ >> 5)) * GM_HALF + col0 + (id_ & 31) * 8); }
            if (ui + 1 < 6) GS_LDV(ui + 1);
            __syncthreads();
            f32x4 acc[2][8];
#pragma unroll
            for (int ci = 0; ci < 2; ++ci)
#pragma unroll
                for (int tt = 0; tt < 8; ++tt) acc[ci][tt] = (f32x4){0.f, 0.f, 0.f, 0.f};
#pragma unroll
            for (int ks = 0; ks < 4; ++ks) {
                const bf16x8 a0 = frag_tr(LN + (32 * ks) * RSN + (32 * w) * 2, RSN, lane), a1 = frag_tr(LN + (32 * ks) * RSN + (32 * w + 16) * 2, RSN, lane);
#pragma unroll
                for (int tt = 2 * ks; tt < 8; ++tt) { const bf16x8 bfr = frag_row(LW + (16 * tt) * RSW + ks * 64, RSW, lane);
                    acc[0][tt] = MFMA16(a0, bfr, acc[0][tt]); acc[1][tt] = MFMA16(a1, bfr, acc[1][tt]); }
            }
            __syncthreads();
#pragma unroll
            for (int ci = 0; ci < 2; ++ci)
#pragma unroll
                for (int tt = 0; tt < 8; ++tt) { v2u pk; pk.x = cvtpk(acc[ci][tt][0] + bs[tt], acc[ci][tt][1] + bs[tt]); pk.y = cvtpk(acc[ci][tt][2] + bs[tt], acc[ci][tt][3] + bs[tt]);
                    *(LAS v2u*)(LN + (16 * tt + l15) * RSN + (32 * w + 16 * ci + 4 * g4) * 2) = pk; }
            __syncthreads();
#pragma unroll
            for (int ps = 0; ps < 8; ++ps) { const int id = ps * NTHR + tid, r = id >> 5, c8 = (id & 31) * 8;
                const v4u mv = *(const LAS v4u*)(LN + r * RSN + c8 * 2); const size_t off = (size_t)(row0 + r) * GM_HALF + col0 + c8; const v4u uv = ur[ps];
                v4u o; o.x = cvtpk(bflo(uv.x) * bflo(mv.x), bfhi(uv.x) * bfhi(mv.x)); o.y = cvtpk(bflo(uv.y) * bflo(mv.y), bfhi(uv.y) * bfhi(mv.y));
                o.z = cvtpk(bflo(uv.z) * bflo(mv.z), bfhi(uv.z) * bfhi(mv.z)); o.w = cvtpk(bflo(uv.w) * bflo(mv.w), bfhi(uv.w) * bfhi(mv.w));
                *(v4u*)(y + off) = o; }
        }
#undef GS_ROW0
#undef GS_COL0
#undef GS_LDV
    }
}

__device__ __forceinline__ void fox_prep_phase(Frame& F, const bf16* x, const float* rs, const float* gmix, const float* wfox, const float* bfg, float* lf) {
    const int lane = F.lane, gw = F.vcu * NWAVES + F.wave, NGW = F.G * NWAVES;
    for (int idx = F.tid; idx < DM * 4; idx += NTHR) { const int k = idx >> 2, qd = idx & 3; const f32x4 w = *(const f32x4*)(wfox + (size_t)k * FOX_LD + FOX_N + 4 * qd) * gmix[k];
        const int slot = ((k >> 8) * 4 + (k & 3)) * 64 + ((k >> 2) & 63);
        *(LAS f32x4*)(F.lds + qd * 32768 + slot * 16) = w; }
    __syncthreads();
    for (int m = gw; m < M; m += NGW) {
        const v2u* xr = (const v2u*)(x + (size_t)m * DM) + lane;
        f32x4 v[8];
#pragma unroll
        for (int j = 0; j < 8; ++j) { const v2u t = xr[64 * j]; v[j] = (f32x4){bflo(t.x), bfhi(t.x), bflo(t.y), bfhi(t.y)}; }
        f32x4 a[4];
#pragma unroll
        for (int qd = 0; qd < 4; ++qd) a[qd] = (f32x4){0.f, 0.f, 0.f, 0.f};
#pragma unroll
        for (int j = 0; j < 8; ++j)
#pragma unroll
            for (int e = 0; e < 4; ++e) { const float hv = v[j][e];
#pragma unroll
                for (int qd = 0; qd < 4; ++qd) a[qd] += hv * *(const LAS f32x4*)(F.lds + qd * 32768 + ((j * 4 + e) * 64 + lane) * 16);
                asm volatile("" ::: "memory"); }
        float z = 0.f;
#pragma unroll
        for (int qd = 0; qd < 4; ++qd)
#pragma unroll
            for (int i = 0; i < 4; ++i) { const float t = wave_sum(a[qd][i]); z = (lane == qd * 4 + i) ? t : z; }
        if (lane < 16) lf[(size_t)m * 16 + lane] = log_sigmoid(z * pg8::row_rstd(rs, m) + bfg[lane]);
    }
}

typedef float f32x16 __attribute__((ext_vector_type(16)));
#define MFMA32(a, b, c) __builtin_amdgcn_mfma_f32_32x32x16_bf16((a), (b), (c), 0, 0, 0)
__device__ __forceinline__ void fox_attn_phase(Frame& F, const bf16* qn, const bf16* kn, const bf16* vv, const bf16* gs, const float* lf, bf16* y) {
    constexpr int RSK = 272, RSV = 320, KSLOT = 64 * RSK, VSLOT = 64 * RSV;
    const ldsp LK = F.lds, LV = F.lds + 2 * KSLOT;
    LAS float* c2 = (LAS float*)(F.lds + 75776);
    LAS float* red = (LAS float*)(F.lds + 92160);
    const int tid = F.tid, lane = F.lane, w = F.wave, r32 = lane & 31, hi = lane >> 5;
    int bh_have = -1;
    for (int pr = F.vcu; pr < 256; pr += F.G) {
        const int bh = pr >> 3, pi = pr & 7, b = bh >> 4, h = bh & 15;
        const size_t tok0 = (size_t)b * SEQ;
        if (bh != bh_have) {
            bh_have = bh;
            float x8[8]; float run = 0.f;
#pragma unroll
            for (int e = 0; e < 8; ++e) { run += lf[(tok0 + tid * 8 + e) * 16 + h]; x8[e] = run; }
            float inc = run;
#pragma unroll
            for (int o = 1; o < 64; o <<= 1) { const float t = __shfl_up(inc, o); if (lane >= o) inc += t; }
            __syncthreads();
            if (lane == 63) red[w] = inc;
            __syncthreads();
            float pre = inc - run;
#pragma unroll
            for (int wv = 0; wv < 8; ++wv) if (wv < w) pre += red[wv];
#pragma unroll
            for (int e = 0; e < 8; ++e) c2[tid * 8 + e] = (pre + x8[e]) * LOG2E;
        }
        for (int half = 0; half < 2; ++half) {
            const int qb = half ? 15 - pi : pi, q0 = qb * 256, ntile = 4 * qb + 4, qrow = q0 + 32 * w + r32;
            bf16x8 qf[8];
#pragma unroll
            for (int ks = 0; ks < 8; ++ks) qf[ks] = *(const bf16x8*)(qn + (tok0 + qrow) * DM + h * 128 + ks * 16 + 8 * hi);
            v4u kr[2], vr[2];
#define FA_LOAD(tt) do { _Pragma("unroll") for (int pp = 0; pp < 2; ++pp) { const int id_ = tid + NTHR * pp, r_ = id_ >> 4, c_ = id_ & 15; \
                kr[pp] = *(const v4u*)(kn + (tok0 + 64 * (tt) + r_) * DM + h * 128 + c_ * 8); vr[pp] = *(const v4u*)(vv + (tok0 + 64 * (tt) + r_) * DM + h * 128 + c_ * 8); } } while (0)
#define FA_STORE(sl) do { _Pragma("unroll") for (int pp = 0; pp < 2; ++pp) { const int id_ = tid + NTHR * pp, r_ = id_ >> 4, c_ = id_ & 15; \
                *(LAS v4u*)(LK + (sl) * KSLOT + r_ * RSK + c_ * 16) = kr[pp]; *(LAS v4u*)(LV + (sl) * VSLOT + r_ * RSV + c_ * 16) = vr[pp]; } } while (0)
            FA_LOAD(0);
            __syncthreads();
            FA_STORE(0);
            if (ntile > 1) FA_LOAD(1);
            const float cq = c2[qrow];
            float mx = 0.f, ls = 0.f;
            f32x16 O[4];
#pragma unroll
            for (int dt = 0; dt < 4; ++dt)
#pragma unroll
                for (int r = 0; r < 16; ++r) O[dt][r] = 0.f;
            for (int t = 0; t < ntile; ++t) {
                __syncthreads();
                if (t + 1 < ntile) { FA_STORE((t + 1) & 1); if (t + 2 < ntile) FA_LOAD(t + 2); }
                const int key0 = 64 * t;
                if (key0 <= q0 + 32 * w + 31) {
                    const ldsp sk = LK + (t & 1) * KSLOT + r32 * RSK + 16 * hi, sv = LV + (t & 1) * VSLOT;
                    f32x16 S0, S1;
                    const float cbase = cq - mx;
#pragma unroll
                    for (int g = 0; g < 4; ++g) { const f32x4 ck0 = *(const LAS f32x4*)(c2 + key0 + 8 * g + 4 * hi), ck1 = *(const LAS f32x4*)(c2 + key0 + 32 + 8 * g + 4 * hi);
#pragma unroll
                        for (int e = 0; e < 4; ++e) { S0[4 * g + e] = cbase - ck0[e]; S1[4 * g + e] = cbase - ck1[e]; } }
#pragma unroll
                    for (int ks = 0; ks < 8; ++ks) { S0 = MFMA32(*(const LAS bf16x8*)(sk + ks * 32), qf[ks], S0); S1 = MFMA32(*(const LAS bf16x8*)(sk + 32 * RSK + ks * 32), qf[ks], S1); }
                    if (key0 + 63 > q0 + 32 * w) {
#pragma unroll
                        for (int g = 0; g < 4; ++g)
#pragma unroll
                            for (int e = 0; e < 4; ++e) { const int key = key0 + 8 * g + 4 * hi + e; if (key > qrow) S0[4 * g + e] = -INFINITY; if (key + 32 > qrow) S1[4 * g + e] = -INFINITY; } }
                    float mloc = fmaxf(S0[0], S1[0]);
#pragma unroll
                    for (int r = 1; r < 16; ++r) mloc = __builtin_fmaxf(__builtin_fmaxf(mloc, S0[r]), S1[r]);
                    mloc = fmaxf(mloc, __shfl_xor(mloc, 32));
                    if (__any(mloc > 8.0f)) { const float dl = fmaxf(mloc, 0.f), alpha = __builtin_amdgcn_exp2f(-dl); mx += dl; ls *= alpha;
#pragma unroll
                        for (int r = 0; r < 16; ++r) { S0[r] -= dl; S1[r] -= dl; }
#pragma unroll
                        for (int dt = 0; dt < 4; ++dt)
#pragma unroll
                            for (int r = 0; r < 16; ++r) O[dt][r] *= alpha; }
                    float psum = 0.f;
#pragma unroll
                    for (int r = 0; r < 16; ++r) { S0[r] = __builtin_amdgcn_exp2f(S0[r]); S1[r] = __builtin_amdgcn_exp2f(S1[r]); psum += S0[r] + S1[r]; }
                    ls += psum;
                    v4u pf[4];
#pragma unroll
                    for (int s2 = 0; s2 < 2; ++s2) { pf[s2] = (v4u){cvtpk(S0[8 * s2 + 0], S0[8 * s2 + 1]), cvtpk(S0[8 * s2 + 2], S0[8 * s2 + 3]), cvtpk(S0[8 * s2 + 4], S0[8 * s2 + 5]), cvtpk(S0[8 * s2 + 6], S0[8 * s2 + 7])};
                        pf[2 + s2] = (v4u){cvtpk(S1[8 * s2 + 0], S1[8 * s2 + 1]), cvtpk(S1[8 * s2 + 2], S1[8 * s2 + 3]), cvtpk(S1[8 * s2 + 4], S1[8 * s2 + 5]), cvtpk(S1[8 * s2 + 6], S1[8 * s2 + 7])}; }
                    const ldsp vb = sv + (4 * hi + ((lane & 15) >> 2)) * RSV + (16 * ((lane >> 4) & 1) + 4 * (lane & 3)) * 2;
#pragma unroll
                    for (int s4 = 0; s4 < 4; ++s4)
#pragma unroll
                        for (int dt = 0; dt < 4; ++dt) { const ldsp va = vb + (16 * s4) * RSV + dt * 64; const s16x4 lo = vtr(va), hv = vtr(va + 8 * RSV);
                            const bf16x8 af = (bf16x8){lo[0], lo[1], lo[2], lo[3], hv[0], hv[1], hv[2], hv[3]};
                            O[dt] = MFMA32(af, __builtin_bit_cast(bf16x8, pf[s4]), O[dt]); }
                }
            }
            ls += __shfl_xor(ls, 32);
            const float il = 1.0f / ls;
            const size_t yoff = (tok0 + qrow) * DM + h * 128 + 4 * hi;
#pragma unroll
            for (int dt = 0; dt < 4; ++dt)
#pragma unroll
                for (int g = 0; g < 4; ++g) { const v2u gv = *(const v2u*)(gs + yoff + dt * 32 + 8 * g);
                    v2u o; o.x = cvtpk(O[dt][4 * g + 0] * il * bflo(gv.x), O[dt][4 * g + 1] * il * bfhi(gv.x)); o.y = cvtpk(O[dt][4 * g + 2] * il * bflo(gv.y), O[dt][4 * g + 3] * il * bfhi(gv.y));
                    *(v2u*)(y + yoff + dt * 32 + 8 * g) = o; }
        }
    }
#undef FA_LOAD
#undef FA_STORE
}
#ifndef R_RET_CORE
#define R_RET_CORE 1
#endif
#ifndef R_RET_GN
#define R_RET_GN 1
#endif
#ifndef R_GM_SP
#define R_GM_SP 1
#endif
#ifndef R_FOX_ATTN
#define R_FOX_ATTN 1
#endif
#ifndef R_FOX_PREP
#define R_FOX_PREP 1
#endif
#ifndef R_PRO
#define R_PRO 1
#endif
#ifndef F_GU_TAIL
#define F_GU_TAIL 0
#endif

#ifndef PROBE_A
#define PROBE_A -1
#endif
#ifndef PROBE_B
#define PROBE_B -1
#endif
#ifndef PROBE_MUL
#define PROBE_MUL 4
#endif
#define STAMP_AT(id) do { if (PROBE_A >= 0 && ((id) == PROBE_A || (id) == PROBE_B)) { if (F.tid == 0) { const unsigned long long t_ = __builtin_amdgcn_s_memrealtime(); \
        volatile LAS unsigned* m_ = F.MISC + ((id) == PROBE_A ? 16 : 20); m_[0] = (unsigned)t_; m_[1] = (unsigned)(t_ >> 32); } } } while (0)
struct Args { const void* in[21]; float* out; unsigned char* ws; int ph_lo, ph_hi, li, pad; };
#define IN(k) (lo <= (k) && (k) < hi)
#define SEAM(k) do { if (N_LAUNCHES == 1 && IN(k) && IN((k) + 1)) xcd_barrier(bar); STAMP_AT(k); } while (0)
template <int L>
__device__ __forceinline__ void layer_body(Frame& F, const Args& args, const XcdBarrier& bar, const int lo, const int hi) {
    unsigned char* ws = args.ws;
    constexpr int kind = L % 3, j = L / 3, pb = 1 + 6 * L;
    float* xo = args.out;
    bf16* XB = (bf16*)(ws + WS_H);
    bf16* A0 = (bf16*)(ws + WS_A); bf16* B0 = (bf16*)(ws + WS_B); bf16* C0 = (bf16*)(ws + WS_C);
    unsigned char* misc = ws + WS_MISC;
    float* rss = (float*)(ws + WS_RSP);
    PG8_LAS float* rtab = (PG8_LAS float*)(F.lds + RSTAB_OFF);
    if (IN(pb + 0)) {
        if (kind == 0) {
            pg8::Gemm g{XB, (const bf16*)(ws + WS_W_RET_IN + j * SZ_W_RET_IN), M, RET_N, DM}; pg8::RsOrder S; S.init(M, RET_N, F.G, (int)blockIdx.x); S.rs = rss + (size_t)(2 * L) * M * 32; S.tab = rtab; S.pend = 0.f; S.nready = 0;
            pg8::EpiRetIn E{A0, A0 + (size_t)M * 2048, A0 + (size_t)M * 4096, A0 + (size_t)M * 8192, (const float*)(ws + WS_ROPE_C), (const float*)(ws + WS_ROPE_S), rtab, 0};
            pg8::gemm_phase<pg8::EpiRetIn, pg8::RsOrder, PG8_ALIGN, PG8_SP2>(F.lds + RING_OFF, g, S, E);
        } else if (kind == 1) {
            pg8::Gemm g{XB, (const bf16*)(ws + WS_W_GM_IN), M, GM_N, DM}; pg8::RsOrder S; S.init(M, GM_N, F.G, (int)blockIdx.x); S.rs = rss + (size_t)(2 * L) * M * 32; S.tab = rtab; S.pend = 0.f; S.nready = 0;
            pg8::EpiGeluUV E{A0, A0 + (size_t)M * GM_HALF, (pg8::f32x2v*)(misc + MISC_PART), rtab, 0};
            pg8::gemm_phase<pg8::EpiGeluUV, pg8::RsOrder, PG8_ALIGN, PG8_SP2>(F.lds + RING_OFF, g, S, E);
        } else {
            pg8::Gemm g{XB, (const bf16*)(ws + WS_W_FOX_IN), M, FOX_N, DM}; pg8::RsOrder S; S.init(M, FOX_N, F.G, (int)blockIdx.x); S.rs = rss + (size_t)(2 * L) * M * 32; S.tab = rtab; S.pend = 0.f; S.nready = 0;
            PG8_LAS float* qkg = (PG8_LAS float*)(F.lds + QKG_OFF);
            if (F.tid < 256) qkg[F.tid] = F.tid < 128 ? ((const float*)args.in[15])[F.tid] : ((const float*)args.in[16])[F.tid - 128];
            __syncthreads();
            pg8::EpiFoxIn E{A0, (size_t)M * 2048, rtab, 0, (PG8_LAS float*)(F.lds + QKT_OFF), qkg};
            pg8::gemm_phase<pg8::EpiFoxIn, pg8::RsOrder, PG8_ALIGN, PG8_SP2>(F.lds + RING_OFF, g, S, E);
        }
    }
    SEAM(pb + 0);
    if (IN(pb + 1)) {
        if (kind == 0) { bf16* Pb = B0 + (size_t)M * 4096;
            bf16* KFb = (bf16*)(ws + WS_KF);
            bf16* QFb = (bf16*)(ws + WS_QF);
            ret_p_phase(F, A0, A0 + (size_t)M * 2048, Pb, KFb, QFb);
            if (N_LAUNCHES == 1) xcd_barrier(bar);
            STAMP_AT(500 + L);
            for (int rep_ = 0; rep_ < R_RET_CORE; ++rep_) ret_core_phase(F, QFb, A0 + (size_t)M * 4096, Pb, KFb, B0); }
        else if (kind == 1) { gm_stat_phase(F, (const f32x2*)(misc + MISC_PART), (f32x2*)(misc + MISC_RSTAT)); }
        else { for (int rep_ = 0; rep_ < R_FOX_PREP; ++rep_) fox_prep_phase(F,
                              XB, rss + (size_t)(2 * L) * M * 32, (const float*)args.in[2] + (size_t)L * DM, (const float*)args.in[13], (const float*)args.in[14], (float*)(misc + MISC_LF)); }
    }
    SEAM(pb + 1);
    if (IN(pb + 2)) {
        if (kind == 0) { for (int rep_ = 0; rep_ < R_RET_GN; ++rep_) ret_gn_phase(F, B0, A0 + (size_t)M * 8192, (const float*)args.in[5] + (size_t)j * 4096, C0); }
        else if (kind == 1) { for (int rep_ = 0; rep_ < R_GM_SP; ++rep_) gm_spatial_phase(F, A0, A0 + (size_t)M * GM_HALF, (const f32x2*)(misc + MISC_RSTAT), (const float*)args.in[8], (const float*)args.in[9], (const bf16*)(misc + MISC_WTRI), (const float*)args.in[11], B0); }
        else { for (int rep_ = 0; rep_ < R_FOX_ATTN; ++rep_) fox_attn_phase(F, A0, A0 + (size_t)M * 2048, A0 + (size_t)M * 4096, A0 + (size_t)M * 6144, (const float*)(misc + MISC_LF), B0); }
    }
    SEAM(pb + 2);
    if (IN(pb + 3)) {
        const bf16* Ain = kind == 0 ? C0 : B0; constexpr int K = kind == 0 ? 4096 : (kind == 1 ? GM_HALF : DM);
        const bf16* Wt = kind == 0 ? (const bf16*)(ws + WS_W_RET_OUT + j * SZ_W_RET_OUT) : (kind == 1 ? (const bf16*)(ws + WS_W_GM_OUT) : (const bf16*)(ws + WS_W_FOX_OUT));
        pg8::Gemm g{Ain, Wt, M, DM, K}; pg8::StaticOrder S; S.init(M, DM, F.G, (int)blockIdx.x);
        if constexpr (L == 0) {
            pg8::EpiRes<true, false> E{(const float*)args.in[0], nullptr, XB, rss + (size_t)(2 * L + 1) * M * 32, DM};
            pg8::gemm_phase<pg8::EpiRes<true, false>, pg8::StaticOrder, PG8_ALIGN, PG8_SP2>(F.lds + RING_OFF, g, S, E);
        } else {
            pg8::EpiResP<false> E{nullptr, XB, rss + (size_t)(2 * L + 1) * M * 32, DM};
            pg8::gemm_phase<pg8::EpiResP<false>, pg8::StaticOrder, PG8_ALIGN, PG8_SP2>(F.lds + RING_OFF, g, S, E);
        }
    }
    SEAM(pb + 3);
    if (IN(pb + 4)) {
        constexpr int NFULL = (F_GU_TAIL ? 40 : 44) * 256;
        { pg8::Gemm g{XB, (const bf16*)(ws + WS_W_GU + L * SZ_W_GU), M, NFULL, DM}; pg8::RsOrder S; S.init(M, NFULL, F.G, (int)blockIdx.x); S.rs = rss + (size_t)(2 * L + 1) * M * 32; S.tab = rtab; S.pend = 0.f; S.nready = 0;
          pg8::EpiSwiglu<false> E{A0, FFN_H, rtab, 0};
          pg8::gemm_phase<pg8::EpiSwiglu<false>, pg8::RsOrder, PG8_ALIGN, PG8_SP2>(F.lds + RING_OFF, g, S, E); }
        if (F_GU_TAIL) { pg8::Gemm g{XB, (const bf16*)(ws + WS_W_GU + L * SZ_W_GU), M, FFN_N2, DM}; pg8::TailOrder S; S.init(M, FFN_N2, F.G, (int)blockIdx.x); S.rs = rss + (size_t)(2 * L + 1) * M * 32; S.tab = rtab; S.pend = 0.f; S.nready = 0; S.pn0 = 40;
          pg8::EpiSwiglu<true> E{A0, FFN_H, rtab, 0};
          pg8::gemm_phase<pg8::EpiSwiglu<true>, pg8::TailOrder, PG8_ALIGN, PG8_SP2, true>(F.lds + RING_OFF, g, S, E); }
    }
    SEAM(pb + 4);
    if (IN(pb + 5)) {
        pg8::Gemm g{A0, (const bf16*)(ws + WS_W_DN + L * SZ_W_DN), M, DM, FFN_H}; pg8::StaticOrder S; S.init(M, DM, F.G, (int)blockIdx.x);
        pg8::EpiResP<L + 1 == DEPTH> E{xo, XB, rss + (size_t)((2 * L + 2) & 7) * M * 32, DM};
        pg8::gemm_phase<pg8::EpiResP<L + 1 == DEPTH>, pg8::StaticOrder, PG8_ALIGN, PG8_SP2>(F.lds + RING_OFF, g, S, E);
    }
    SEAM(pb + 5);
}
__global__ void __launch_bounds__(NWAVES * 64, 2) trunk_fwd(Args args) {
    extern __shared__ __attribute__((aligned(16))) unsigned char lds[];
    Frame F;
    F.lds = (ldsp)lds;
    F.MISC = (volatile LAS unsigned*)(F.lds + MISC_OFF);
    F.tid = threadIdx.x; F.lane = F.tid & 63; F.wave = __builtin_amdgcn_readfirstlane(F.tid >> 6);
    F.G = gridDim.x; { const int bx = blockIdx.x; F.vcu = (F.G % 8 == 0) ? (bx % 8) * (F.G / 8) + bx / 8 : bx; }
    F.ctl = (gu32*)(args.ws + WS_CTL);
    for (int u = F.tid; u < (LDS_BYTES - LDSCTL_OFF) / 4; u += NWAVES * 64) ((LAS unsigned*)(F.lds + LDSCTL_OFF))[u] = 0u;
    __syncthreads();
    XcdBarrier bar; bar.bar = (unsigned*)(F.ctl + CW_BAR); bar.x = 0; bar.st = nullptr;
    if (N_LAUNCHES == 1) bar = xcd_barrier_post((unsigned*)(F.ctl + CW_BAR), F.MISC + 8);
    const int lo = args.ph_lo, hi = args.ph_hi;
    STAMP_AT(999);
    if (IN(0)) for (int rep_ = 0; rep_ < R_PRO; ++rep_) p0_prologue(F, args.in, args.ws);
    SEAM(0);
    layer_body<0>(F, args, bar, lo, hi); layer_body<1>(F, args, bar, lo, hi); layer_body<2>(F, args, bar, lo, hi); layer_body<3>(F, args, bar, lo, hi);
    if (PROBE_A >= 0 && F.tid == 0) {
        const unsigned long long ta = ((unsigned long long)F.MISC[17] << 32) | F.MISC[16], tb = ((unsigned long long)F.MISC[21] << 32) | F.MISC[20];
        const unsigned long long dly = (tb - ta) * (unsigned long long)PROBE_MUL, t0 = __builtin_amdgcn_s_memrealtime();
        if (tb > ta && dly < 400000ull) while (__builtin_amdgcn_s_memrealtime() - t0 < dly) __builtin_amdgcn_s_sleep(16);
    }
}
#undef IN
#undef SEAM

extern "C" void kernel_launch(void* const* d_in, const int* in_sizes, int n_in, void* d_out, int out_size, void* d_ws, size_t ws_size, hipStream_t stream) {
    static int grid = 0;
    if (grid == 0) {
        if (n_in != 21 || in_sizes[0] != M * DM || out_size != M * DM || ws_size < WS_END) { fprintf(stderr, "kernel_launch: unexpected shapes (n_in %d, in0 %d, out %d, ws %zu); nothing launched\n", n_in, n_in > 0 ? in_sizes[0] : -1, out_size, ws_size); grid = -1; return; }
        int dev = 0, cus = 0, per_cu = 0;
        if (hipGetDevice(&dev) != hipSuccess || hipDeviceGetAttribute(&cus, hipDeviceAttributeMultiprocessorCount, dev) != hipSuccess) { grid = -1; return; }
        if (hipFuncSetAttribute((const void*)trunk_fwd, hipFuncAttributeMaxDynamicSharedMemorySize, LDS_BYTES) != hipSuccess) { fprintf(stderr, "kernel_launch: hipFuncSetAttribute failed\n"); grid = -1; return; }
        if (hipOccupancyMaxActiveBlocksPerMultiprocessor(&per_cu, (const void*)trunk_fwd, NWAVES * 64, LDS_BYTES) != hipSuccess || per_cu < 1)
            fprintf(stderr, "kernel_launch: note: occupancy query reports %d workgroups per CU\n", per_cu);
        (void)hipGetLastError();
        grid = cus;
    }
    if (grid < 0) return;
    if (hipMemsetAsync((char*)d_ws + WS_CTL, 0, CTL_ZERO_BYTES, stream) != hipSuccess) return;
    Args a{};
    for (int i = 0; i < 21; ++i) a.in[i] = d_in[i];
    a.out = (float*)d_out; a.ws = (unsigned char*)d_ws;
    for (int li = 0; li < N_LAUNCHES; ++li) {
        a.ph_lo = (N_LAUNCHES == 1) ? 0 : li; a.ph_hi = (N_LAUNCHES == 1) ? N_PHASES : li + 1; a.li = li; a.pad = 0;
        hipLaunchKernelGGL(trunk_fwd, dim3(grid), dim3(NWAVES * 64), LDS_BYTES, stream, a);
        const hipError_t le = hipPeekAtLastError();
        if (le != hipSuccess) { fprintf(stderr, "kernel_launch: launch %d failed: %s\n", li, hipGetErrorName(le)); break; }
    }
}
```

```cpp
#define PG8_WGM 4
#include <hip/hip_runtime.h>
#include <cstdio>
#include <cstdint>
#include <cmath>
namespace pg8 {
#define PG8_LAS __attribute__((address_space(3)))
typedef unsigned short bf16_t;
typedef short bf16x8 __attribute__((ext_vector_type(8)));
typedef float f32x4 __attribute__((ext_vector_type(4)));
typedef unsigned u32x4 __attribute__((ext_vector_type(4)));
constexpr int BM = 256, BK = 64, HALF = 128, HTB = HALF * BK * 2  , STAGE_BYTES = 8 * HTB, NXCD = 8, WGM = PG8_WGM;

__host__ __device__ __forceinline__ int lds_byte(int r, int c) { const int st = (r >> 4) * 2 + (c >> 5), rr = r & 15, cc = c & 31, ob = rr * 64 + cc * 2; return st * 1024 + (ob ^ (((ob >> 9) & 1) << 5)); }
__host__ __device__ __forceinline__ void stage_rc(int b, int& R, int& C) { const int st = b / 1024, sb = b % 1024, swz = sb ^ (((sb >> 9) & 1) << 5); R = (st >> 1) * 16 + swz / 64; C = (st & 1) * 32 + (swz % 64) / 2; }
__host__ __device__ __forceinline__ int perm32(int rho) { const int n = rho >> 4, i = rho & 15; return 8 * (i >> 2) + 4 * n + (i & 3); }

struct Unit { int pm, pn, hf; };
struct Gemm { const bf16_t* A; const bf16_t* Bt; int M, N, K; };

struct StaticOrder {
    int nM, nN, nwg, G, c;
    __host__ __device__ void init(int M, int N, int G_, int c_) { nM = M / BM; nN = N / BM; nwg = nM * nN; G = G_; c = c_; }
    __host__ __device__ bool next(int i, Unit& u) const {
        const long L = (long)i * G + c; if (L >= nwg) return false;
        int wgid = (int)L; { const int q = nwg / NXCD, r = nwg % NXCD, xcd = wgid % NXCD, off = wgid / NXCD; wgid = (xcd < r ? xcd * (q + 1) : r * (q + 1) + (xcd - r) * q) + off; }
        const int nig = WGM * nN, gid = wgid / nig, fm = gid * WGM, gsz = (nM - fm) < WGM ? (nM - fm) : WGM;
        u.pm = fm + ((wgid % nig) % gsz); u.pn = (wgid % nig) / gsz; u.hf = 0; return true;
    }
    __device__ __forceinline__ void a_ready(const Unit&) const {}
    __device__ __forceinline__ void done(const Unit&) const {}
};

__device__ __forceinline__ unsigned cvt_pk_bf16(float lo, float hi) { unsigned r; asm volatile("v_cvt_pk_bf16_f32 %0, %1, %2" : "=v"(r) : "v"(lo), "v"(hi)); return r; }
typedef float f32x2 __attribute__((ext_vector_type(2)));
__device__ __forceinline__ f32x2 gelu_pk(f32x2 v) {
    const f32x2 av = __builtin_elementwise_abs(v), d = av * 0.2316418882f + 1.0f;
    f32x2 t; t.x = __builtin_amdgcn_rcpf(d.x); t.y = __builtin_amdgcn_rcpf(d.y);
    f32x2 q = t * 0.5307027145f + (-0.7265760135f); q = q * t + 0.7107068705f; q = q * t + (-0.142248368f); q = q * t + 0.127414796f; q = q * t;
    const f32x2 s = (v * v) * (-0.72134752044f);
    f32x2 e; e.x = __builtin_amdgcn_exp2f(s.x); e.y = __builtin_amdgcn_exp2f(s.y);
    const f32x2 m = v * (q * e), r = v - m;
    f32x2 o; o.x = v.x < 0.f ? m.x : r.x; o.y = v.y < 0.f ? m.y : r.y; return o;
}

typedef float f32x2v __attribute__((ext_vector_type(2)));
typedef __bf16 bf16x2v __attribute__((ext_vector_type(2)));
__device__ __forceinline__ unsigned cvtpk(float lo, float hi) { f32x2v v = {lo, hi}; bf16x2v b = __builtin_convertvector(v, bf16x2v); return __builtin_bit_cast(unsigned, b); }
__device__ __forceinline__ u32x4 pack8(const f32x4 a, const f32x4 b) { u32x4 w; w.x = cvtpk(a[0], a[1]); w.y = cvtpk(a[2], a[3]); w.z = cvtpk(b[0], b[1]); w.w = cvtpk(b[2], b[3]); return w; }
#ifndef EPI_WT
#define EPI_WT 0
#endif
__device__ __forceinline__ void st16(void* p, const u32x4 v) {
#if EPI_WT
    asm volatile("global_store_dwordx4 %0, %1, off sc1\n\ts_nop 2" :: "v"(p), "v"(v) : "memory");
#else
    *(u32x4*)p = v;
#endif
}
__device__ __forceinline__ float fast_sigmoid(float x) { return __builtin_amdgcn_rcpf(1.0f + __builtin_amdgcn_exp2f(-1.44269504f * x)); }

template <bool BASE_F32, bool OUT_F32> struct EpiRes {
    static constexpr bool PERM = true, AFTER_DRAIN = false, RESID = false;
    const float* base; float* out; bf16_t* xb; float* rs; int ldc;
    __device__ __forceinline__ void operator()(const f32x4 (&acc)[2][2][4][2], const Unit& u, int wr, int wc, int fr, int fq) const {
        const int row0 = u.pm * BM + wr * 64 + fr, col0 = u.pn * BM + wc * 32 + 8 * fq;
#pragma unroll
        for (int ai = 0; ai < 2; ++ai)
#pragma unroll
            for (int m = 0; m < 4; ++m) { const int row = row0 + ai * HALF + m * 16; const size_t off = (size_t)row * ldc + col0; float ss = 0.f;
#pragma unroll
                for (int bj = 0; bj < 2; ++bj) { f32x4 b0, b1;
                    if (BASE_F32) { b0 = *(const f32x4*)(base + off + bj * HALF); b1 = *(const f32x4*)(base + off + bj * HALF + 4); }
                    else { const u32x4 w = *(const u32x4*)(xb + off + bj * HALF);
                        b0 = (f32x4){__uint_as_float(w.x << 16), __uint_as_float(w.x & 0xffff0000u), __uint_as_float(w.y << 16), __uint_as_float(w.y & 0xffff0000u)};
                        b1 = (f32x4){__uint_as_float(w.z << 16), __uint_as_float(w.z & 0xffff0000u), __uint_as_float(w.w << 16), __uint_as_float(w.w & 0xffff0000u)}; }
                    const f32x4 x0 = b0 + acc[ai][bj][m][0], x1 = b1 + acc[ai][bj][m][1];
                    if (OUT_F32) { *(f32x4*)(out + off + bj * HALF) = x0; *(f32x4*)(out + off + bj * HALF + 4) = x1; }
                    else st16(xb + off + bj * HALF, pack8(x0, x1));
                    ss += (x0[0] * x0[0] + x0[1] * x0[1]) + (x0[2] * x0[2] + x0[3] * x0[3]) + (x1[0] * x1[0] + x1[1] * x1[1]) + (x1[2] * x1[2] + x1[3] * x1[3]); }
                if (!OUT_F32) { ss += __shfl_xor(ss, 16); ss += __shfl_xor(ss, 32);
                    if (fq == 0) rs[(size_t)row * 32 + u.pn * 4 + wc] = ss; }
                }
    }
};
template <bool OUT_F32> struct EpiResP {
    static constexpr bool PERM = true, AFTER_DRAIN = true, RESID = true;
    float* out; bf16_t* xb; float* rs; int ldc;
    __device__ __forceinline__ void fused(f32x4 (&acc)[2][2][4][2], const Unit& u, int wr, int wc, int fr, int fq, PG8_LAS unsigned char* lds, int wid, int lane) const {
        const int row0 = u.pm * BM + wr * 64 + fr, col0 = u.pn * BM + wc * 32 + 8 * fq, wh = wc >> 1;
        u32x4 g7[4];
        if (wh) {
#pragma unroll
            for (int m = 0; m < 4; ++m) g7[m] = *(const u32x4*)(xb + (size_t)(row0 + HALF + m * 16) * ldc + col0 + HALF); }
#pragma unroll
        for (int ai = 0; ai < 2; ++ai)
#pragma unroll
            for (int m = 0; m < 4; ++m) { const int row = row0 + ai * HALF + m * 16; const size_t off = (size_t)row * ldc + col0; float ss = 0.f;
                const int lb = lds_byte(wr * 64 + m * 16 + fr, (wc & 1) * 32 + 8 * fq);
#pragma unroll
                for (int bj = 0; bj < 2; ++bj) {
                    const int s0 = (ai == 0 && bj == 0) ? 4 : (ai == 1 && bj == 0) ? 5 : (ai == 0 && bj == 1) ? 6 : 7;
                    const int s1 = (ai == 0 && bj == 0) ? 0 : (ai == 1 && bj == 0) ? 1 : 2;
                    u32x4 w;
                    if (ai == 1 && bj == 1) { if (wh) w = g7[m]; else w = *(const PG8_LAS u32x4*)(lds + s0 * HTB + lb); }
                    else w = *(const PG8_LAS u32x4*)(lds + (wh ? s1 : s0) * HTB + lb);
                    const f32x4 b0 = {__uint_as_float(w.x << 16), __uint_as_float(w.x & 0xffff0000u), __uint_as_float(w.y << 16), __uint_as_float(w.y & 0xffff0000u)};
                    const f32x4 b1 = {__uint_as_float(w.z << 16), __uint_as_float(w.z & 0xffff0000u), __uint_as_float(w.w << 16), __uint_as_float(w.w & 0xffff0000u)};
                    const f32x4 x0 = b0 + acc[ai][bj][m][0], x1 = b1 + acc[ai][bj][m][1];
                    if (OUT_F32) { *(f32x4*)(out + off + bj * HALF) = x0; *(f32x4*)(out + off + bj * HALF + 4) = x1; }
                    else st16(xb + off + bj * HALF, pack8(x0, x1));
                    ss += (x0[0] * x0[0] + x0[1] * x0[1]) + (x0[2] * x0[2] + x0[3] * x0[3]) + (x1[0] * x1[0] + x1[1] * x1[1]) + (x1[2] * x1[2] + x1[3] * x1[3]); }
                if (!OUT_F32) { ss += __shfl_xor(ss, 16); ss += __shfl_xor(ss, 32);
                    if (fq == 0) rs[(size_t)row * 32 + u.pn * 4 + wc] = ss; } }
    }
};
__device__ __forceinline__ float row_sumsq(const float* rs, int row) {
    const f32x4* p = (const f32x4*)(rs + (size_t)row * 32); f32x4 t = p[0];
#pragma unroll
    for (int i = 1; i < 8; ++i) t += p[i];
    return (t[0] + t[1]) + (t[2] + t[3]);
}
__device__ __forceinline__ float row_rstd(const float* rs, int row) { return 1.0f / sqrtf(row_sumsq(rs, row) * (1.0f / 2048.0f) + 1e-6f); }
struct RsOrder : StaticOrder {
    const float* rs; PG8_LAS float* tab; mutable float pend; mutable int nready;
    __device__ __forceinline__ void a_ready(const Unit& u) const {
        if (threadIdx.x < 256) pend = row_sumsq(rs, u.pm * BM + u.hf * HALF + threadIdx.x);
        ++nready;
    }
    __device__ __forceinline__ bool next(int i, Unit& u) const {
        if (i == 1 && threadIdx.x < 256) tab[threadIdx.x] = 1.0f / sqrtf(pend * (1.0f / 2048.0f) + 1e-6f);
        return StaticOrder::next(i, u);
    }
    __device__ __forceinline__ void done(const Unit&) const {
        if (threadIdx.x < 256) tab[((nready - 1) & 1) * 256 + threadIdx.x] = 1.0f / sqrtf(pend * (1.0f / 2048.0f) + 1e-6f);
    }
};
struct TailOrder : RsOrder {
    int pn0;
    __device__ __forceinline__ bool next(int i, Unit& u) const {
        if (i == 1 && threadIdx.x < 256) tab[threadIdx.x] = 1.0f / sqrtf(pend * (1.0f / 2048.0f) + 1e-6f);
        if (i != 0 || G != 256) return false;
        const int x = c & 7, l = c >> 3; u.pm = 4 * x + (l & 3); u.hf = (l >> 2) & 1; u.pn = pn0 + (l >> 3); return true;
    }
};
template <bool HALF_M> struct EpiSwiglu {
    static constexpr bool PERM = true, AFTER_DRAIN = false, RESID = false;
    bf16_t* O; int ldc; const PG8_LAS float* tab; mutable int ui;
    __device__ __forceinline__ void operator()(const f32x4 (&acc)[2][2][4][2], const Unit& u, int wr, int wc, int fr, int fq) const {
        const int row0 = u.pm * BM + (HALF_M ? u.hf * HALF : 0) + wr * 64 + fr, col0 = u.pn * HALF + wc * 32 + 8 * fq;
#pragma unroll
        for (int ai = 0; ai < (HALF_M ? 1 : 2); ++ai)
#pragma unroll
            for (int m = 0; m < 4; ++m) { bf16_t* rowp = O + (size_t)(row0 + ai * HALF + m * 16) * ldc + col0; const float r = tab[(ui & 1) * 256 + wr * 64 + fr + ai * HALF + m * 16];
                f32x4 v0, v1;
#pragma unroll
                for (int j = 0; j < 4; ++j) { const float g0 = acc[ai][0][m][0][j] * r, g1 = acc[ai][0][m][1][j] * r;
                    v0[j] = g0 * fast_sigmoid(g0) * (acc[ai][1][m][0][j] * r); v1[j] = g1 * fast_sigmoid(g1) * (acc[ai][1][m][1][j] * r); }
                st16(rowp, pack8(v0, v1)); }
        ++ui;
    }
};

struct EpiSwigluProbe {
    static constexpr bool PERM = true, AFTER_DRAIN = false, RESID = false;
    bf16_t* O; int never;
    __device__ __forceinline__ void operator()(const f32x4 (&acc)[2][2][4][2], const Unit& u, int wr, int wc, int fr, int fq) const {
        if (never) {
#pragma unroll
        for (int ai = 0; ai < 2; ++ai)
#pragma unroll
            for (int m = 0; m < 4; ++m) { bf16_t* rowp = O + (size_t)(u.pm * BM + wr * 64 + fr + ai * HALF + m * 16) * 5632 + u.pn * HALF + wc * 32 + 8 * fq;
                st16(rowp, pack8(acc[ai][0][m][0] + acc[ai][1][m][0], acc[ai][0][m][1] + acc[ai][1][m][1])); } }
    }
};
struct EpiRetIn {
    static constexpr bool PERM = true, AFTER_DRAIN = false, RESID = false;
    bf16_t *q, *k, *v, *g; const float *cs, *sn; const PG8_LAS float* tab; mutable int ui;
    __device__ __forceinline__ void operator()(const f32x4 (&acc)[2][2][4][2], const Unit& u, int wr, int wc, int fr, int fq) const {
        const int pn = u.pn, ci = wc * 32 + 8 * fq;
#pragma unroll
        for (int ai = 0; ai < 2; ++ai)
#pragma unroll
            for (int m = 0; m < 4; ++m) {
                const int row = u.pm * BM + ai * HALF + wr * 64 + m * 16 + fr, b = row >> 12, s = row & 4095; const float rr = tab[(ui & 1) * 256 + ai * HALF + wr * 64 + m * 16 + fr];
                if (pn < 16) {
                    const int h = pn & 7; const float sc = (pn < 8 ? 1.0f : 0.0625f) * rr;
                    bf16_t* dst = (pn < 8 ? q : k) + ((size_t)((b * 8 + h) * 4096 + s)) * 256 + ci;
                    f32x4 o1[2], o2[2];
#pragma unroll
                    for (int n = 0; n < 2; ++n) { const f32x4 c4 = *(const f32x4*)(cs + (size_t)row * 128 + ci + 4 * n), s4 = *(const f32x4*)(sn + (size_t)row * 128 + ci + 4 * n);
                        const f32x4 x1 = acc[ai][0][m][n], x2 = acc[ai][1][m][n];
                        o1[n] = (x1 * c4 - x2 * s4) * sc; o2[n] = (x2 * c4 + x1 * s4) * sc; }
                    st16(dst, pack8(o1[0], o1[1])); st16(dst + 128, pack8(o2[0], o2[1]));
                } else if (pn < 32) {
                    const int t = pn - 16, h = t >> 1, hf = t & 1;
                    bf16_t* dst = v + ((size_t)((b * 8 + h) * 4096 + s)) * 512 + hf * 256 + ci;
                    st16(dst, pack8(acc[ai][0][m][0] * rr, acc[ai][0][m][1] * rr)); st16(dst + 128, pack8(acc[ai][1][m][0] * rr, acc[ai][1][m][1] * rr));
                } else {
                    bf16_t* dst = g + (size_t)row * 4096 + (pn - 32) * 256 + ci;
                    st16(dst, pack8(acc[ai][0][m][0] * rr, acc[ai][0][m][1] * rr)); st16(dst + 128, pack8(acc[ai][1][m][0] * rr, acc[ai][1][m][1] * rr));
                }
            }
        ++ui;
    }
};
struct EpiGeluUV {
    static constexpr bool PERM = true, AFTER_DRAIN = false, RESID = false;
    bf16_t *uo, *vo; f32x2v* part; const PG8_LAS float* tab; mutable int ui;
    __device__ __forceinline__ void operator()(const f32x4 (&acc)[2][2][4][2], const Unit& u, int wr, int wc, int fr, int fq) const {
        const bool isv = u.pn >= 24; const int ct = isv ? u.pn - 24 : u.pn; bf16_t* dstb = isv ? vo : uo;
#pragma unroll
        for (int ai = 0; ai < 2; ++ai)
#pragma unroll
            for (int m = 0; m < 4; ++m) {
                const int row = u.pm * BM + ai * HALF + wr * 64 + m * 16 + fr;
                bf16_t* dst = dstb + (size_t)row * 6144 + ct * 256 + wc * 32 + 8 * fq;
                float s = 0.f, ss = 0.f; const float rr = tab[(ui & 1) * 256 + ai * HALF + wr * 64 + m * 16 + fr];
#pragma unroll
                for (int bj = 0; bj < 2; ++bj) { const f32x4 v0 = acc[ai][bj][m][0] * rr, v1 = acc[ai][bj][m][1] * rr;
                    const f32x2 a = gelu_pk((f32x2){v0[0], v0[1]}), b = gelu_pk((f32x2){v0[2], v0[3]}), c = gelu_pk((f32x2){v1[0], v1[1]}), d = gelu_pk((f32x2){v1[2], v1[3]});
                    const f32x4 z0 = {a.x, a.y, b.x, b.y}, z1 = {c.x, c.y, d.x, d.y};
                    st16(dst + bj * HALF, pack8(z0, z1));
                    s += (z0[0] + z0[1]) + (z0[2] + z0[3]) + (z1[0] + z1[1]) + (z1[2] + z1[3]);
                    ss += (z0[0] * z0[0] + z0[1] * z0[1]) + (z0[2] * z0[2] + z0[3] * z0[3]) + (z1[0] * z1[0] + z1[1] * z1[1]) + (z1[2] * z1[2] + z1[3] * z1[3]); }
                if (isv) { s += __shfl_xor(s, 16); s += __shfl_xor(s, 32); ss += __shfl_xor(ss, 16); ss += __shfl_xor(ss, 32);
                    if (fq == 0) part[((size_t)row * 24 + ct) * 4 + wc] = (f32x2v){s, ss}; }
            }
        ++ui;
    }
};
struct EpiFoxIn {
    static constexpr bool PERM = true, AFTER_DRAIN = false, RESID = false;
    bf16_t* O; size_t stride; const PG8_LAS float* tab; mutable int ui; PG8_LAS float* qkt; const PG8_LAS float* gains;
    __device__ __forceinline__ void operator()(const f32x4 (&acc)[2][2][4][2], const Unit& u, int wr, int wc, int fr, int fq) const {
        const int t = u.pn >> 3; bf16_t* base = O + (size_t)t * stride + (u.pn & 7) * 256 + wc * 32 + 8 * fq;
        if (t < 2) {
#pragma unroll
            for (int ai = 0; ai < 2; ++ai)
#pragma unroll
                for (int m = 0; m < 4; ++m) { const int rt = ai * HALF + wr * 64 + m * 16 + fr; const float rr = tab[(ui & 1) * 256 + rt];
#pragma unroll
                    for (int bj = 0; bj < 2; ++bj) { const f32x4 v0 = acc[ai][bj][m][0] * rr, v1 = acc[ai][bj][m][1] * rr;
                        float ss = (v0[0] * v0[0] + v0[1] * v0[1]) + (v0[2] * v0[2] + v0[3] * v0[3]) + (v1[0] * v1[0] + v1[1] * v1[1]) + (v1[2] * v1[2] + v1[3] * v1[3]);
                        ss += __shfl_xor(ss, 16); ss += __shfl_xor(ss, 32);
                        if (fq == 0) qkt[(rt * 2 + bj) * 4 + wc] = ss; } }
            asm volatile("s_waitcnt lgkmcnt(0)" ::: "memory"); __builtin_amdgcn_s_barrier(); asm volatile("" ::: "memory");
            const float sc = t == 0 ? 0.08838834764831845f * 1.4426950408889634f : 1.0f;
            const f32x4 g0 = *(const PG8_LAS f32x4*)(gains + t * 128 + wc * 32 + 8 * fq), g1 = *(const PG8_LAS f32x4*)(gains + t * 128 + wc * 32 + 8 * fq + 4);
#pragma unroll
            for (int ai = 0; ai < 2; ++ai)
#pragma unroll
                for (int m = 0; m < 4; ++m) { const int rt = ai * HALF + wr * 64 + m * 16 + fr; const float rr = tab[(ui & 1) * 256 + rt]; bf16_t* dst = base + (size_t)(u.pm * BM + rt) * 2048;
#pragma unroll
                    for (int bj = 0; bj < 2; ++bj) { const f32x4 p = *(const PG8_LAS f32x4*)(qkt + (rt * 2 + bj) * 4);
                        const float rs = rr * sc / sqrtf(((p[0] + p[1]) + (p[2] + p[3])) * (1.0f / 128.0f) + 1e-6f);
                        st16(dst + bj * HALF, pack8(acc[ai][bj][m][0] * rs * g0, acc[ai][bj][m][1] * rs * g1)); } }
        } else {
#pragma unroll
            for (int ai = 0; ai < 2; ++ai)
#pragma unroll
                for (int m = 0; m < 4; ++m) { const int row = u.pm * BM + ai * HALF + wr * 64 + m * 16 + fr; bf16_t* dst = base + (size_t)row * 2048; const float rr = tab[(ui & 1) * 256 + ai * HALF + wr * 64 + m * 16 + fr];
#pragma unroll
                    for (int bj = 0; bj < 2; ++bj) { f32x4 v0 = acc[ai][bj][m][0] * rr, v1 = acc[ai][bj][m][1] * rr;
                        if (t == 3) {
#pragma unroll
                            for (int j = 0; j < 4; ++j) { v0[j] = fast_sigmoid(v0[j]); v1[j] = fast_sigmoid(v1[j]); } }
                        st16(dst + bj * HALF, pack8(v0, v1)); } }
        }
        ++ui;
    }
};

template <class Epi, class Sched, bool ALIGN_EPI = false, bool SP2 = false, bool HALF_M = false>
__device__ __forceinline__ void gemm_phase(PG8_LAS unsigned char* lds, const Gemm g, const Sched& S, const Epi& E) {
    const int tid = threadIdx.x, wid = __builtin_amdgcn_readfirstlane(tid >> 6), lane = tid & 63, wr = wid >> 2, wc = wid & 3, fr = lane & 15, fq = lane >> 4;
    static_assert(!HALF_M || SP2, "HALF_M is written for the SP2 loop");
    const int K = g.K, nt = K / BK;
    unsigned voffA[2], voffB[2];
#pragma unroll
    for (int i = 0; i < 2; ++i) { int R, C; stage_rc(tid * 16 + i * 8192, R, C); const int Rb = Epi::PERM ? ((R & ~31) + perm32(R & 31)) : R;
        voffA[i] = (unsigned)(R * K + C) * 2u; voffB[i] = (unsigned)(Rb * K + C) * 2u; }
    unsigned voffR[2] = {0u, 0u};
    if constexpr (Epi::RESID) {
#pragma unroll
        for (int i = 0; i < 2; ++i) { int R, C; stage_rc(tid * 16 + i * 8192, R, C); voffR[i] = (unsigned)(R * E.ldc + C) * 2u; } }
    const size_t kstep = (size_t)(BK * 2);
    const size_t hstep = (size_t)HALF * K * 2;
    const size_t tstep = 2 * hstep;
    const unsigned ldsw = (unsigned)wid * 1024u;
    const int aoff = lds_byte(wr * 64 + fr, fq * 8), boff = lds_byte(wc * 32 + fr, fq * 8);
#define PG8_SA(b, h) (((b) * 2 + (h)) * HTB)
#define PG8_SB(b, h) ((4 + (b) * 2 + (h)) * HTB)
#define PG8_STAGE(bufoff, gbase, voff) do { _Pragma("unroll") for (int _i = 0; _i < 2; ++_i) \
        __builtin_amdgcn_global_load_lds((const unsigned*)((const char*)(gbase) + (voff)[_i]), (PG8_LAS unsigned*)(lds + (bufoff) + ldsw + _i * 8192), 16, 0, 0); } while (0)
#define PG8_LDA(dst, b, h) do { _Pragma("unroll") for (int m = 0; m < 4; ++m) _Pragma("unroll") for (int k = 0; k < 2; ++k) dst[m][k] = *(const PG8_LAS bf16x8*)(lds + PG8_SA(b, h) + aoff + m * 2048 + k * 1024); } while (0)
#define PG8_LDB(dst, b, h) do { _Pragma("unroll") for (int n = 0; n < 2; ++n) _Pragma("unroll") for (int k = 0; k < 2; ++k) dst[n][k] = *(const PG8_LAS bf16x8*)(lds + PG8_SB(b, h) + boff + n * 2048 + k * 1024); } while (0)
#define PG8_MMA(ai, bj, At, Bt) do { __builtin_amdgcn_s_setprio(1); _Pragma("unroll") for (int m = 0; m < 4; ++m) _Pragma("unroll") for (int n = 0; n < 2; ++n) _Pragma("unroll") for (int k = 0; k < 2; ++k) \
        acc[ai][bj][m][n] = __builtin_amdgcn_mfma_f32_16x16x32_bf16(Bt[n][k], At[m][k], acc[ai][bj][m][n], 0, 0, 0); __builtin_amdgcn_s_setprio(0); } while (0)
#define PG8_WAIT_V(n) asm volatile("s_waitcnt vmcnt(" #n ")" ::: "memory")
#define PG8_WAIT_L(n) asm volatile("s_waitcnt lgkmcnt(" #n ")" ::: "memory")
#define PG8_BAR __builtin_amdgcn_s_barrier()
#define PG8_SCHED __builtin_amdgcn_sched_barrier(0)
    Unit cur, nxt; int ui = 0;
    if (!S.next(0, cur)) return;
    f32x4 acc[2][2][4][2];
#pragma unroll
    for (int a = 0; a < 2; ++a)
#pragma unroll
        for (int b = 0; b < 2; ++b)
#pragma unroll
            for (int m = 0; m < 4; ++m)
#pragma unroll
                for (int n = 0; n < 2; ++n) acc[a][b][m][n] = (f32x4){0.f, 0.f, 0.f, 0.f};
    bf16x8 At[4][2], B0[2][2], B1[2][2];
    const char* cA = (const char*)g.A + (size_t)cur.pm * tstep + (HALF_M ? (size_t)cur.hf * hstep : (size_t)0); const char* cB = (const char*)g.Bt + (size_t)cur.pn * tstep;
    S.a_ready(cur);
    if constexpr (SP2) {
        PG8_STAGE(PG8_SB(0, 0), cB, voffB); PG8_STAGE(PG8_SB(0, 1), cB + hstep, voffB); PG8_STAGE(PG8_SA(0, 0), cA, voffA); PG8_STAGE(PG8_SA(0, 1), cA + hstep, voffA);
        if (wr == 1) PG8_BAR;
        PG8_WAIT_V(2); PG8_BAR;
        PG8_STAGE(PG8_SB(1, 0), cB + kstep, voffB); PG8_STAGE(PG8_SA(1, 0), cA + kstep, voffA); PG8_STAGE(PG8_SB(1, 1), cB + hstep + kstep, voffB);
        PG8_WAIT_V(6); PG8_BAR;
    } else {
        PG8_STAGE(PG8_SB(0, 0), cB, voffB); PG8_STAGE(PG8_SA(0, 0), cA, voffA); PG8_STAGE(PG8_SB(0, 1), cB + hstep, voffB); PG8_STAGE(PG8_SA(0, 1), cA + hstep, voffA);
        if (wr == 1) PG8_BAR;
        PG8_WAIT_V(4); PG8_BAR;
        PG8_STAGE(PG8_SB(1, 0), cB + kstep, voffB); PG8_STAGE(PG8_SA(1, 0), cA + kstep, voffA); PG8_STAGE(PG8_SB(1, 1), cB + hstep + kstep, voffB);
        PG8_WAIT_V(6); PG8_BAR;
    }
    for (;;) {
        const bool has_next = S.next(ui + 1, nxt);
        const char* nA = has_next ? (const char*)g.A + (size_t)nxt.pm * tstep + (HALF_M ? (size_t)nxt.hf * hstep : (size_t)0) : cA; const char* nB = has_next ? (const char*)g.Bt + (size_t)nxt.pn * tstep : cB;
        for (int t = 0; t < nt; t += 2) {
            const bool last = (t == nt - 2);
            const char* a1 = cA + (size_t)(t + 1) * kstep;
            const char* a2 = last ? nA : cA + (size_t)(t + 2) * kstep; const char* b2 = last ? nB : cB + (size_t)(t + 2) * kstep;
            const char* a3 = a2 + kstep; const char* b3 = b2 + kstep;
            if (last && has_next) S.a_ready(nxt);
            bool rp = false; const char* rbase = nullptr; size_t rhstep = 0;
            if constexpr (Epi::RESID) { rp = last && !has_next; rbase = (const char*)E.xb + ((size_t)cur.pm * BM * E.ldc + (size_t)cur.pn * BM) * 2; rhstep = (size_t)HALF * E.ldc * 2; }
#define PG8_STAGE_R(bufoff, gbase, voff, blk) do { if constexpr (Epi::RESID) { const char* g_ = rp ? (rbase + ((blk) & 1) * rhstep + ((blk) >> 1) * 128) : (const char*)(gbase); \
                _Pragma("unroll") for (int _i = 0; _i < 2; ++_i) __builtin_amdgcn_global_load_lds((const unsigned*)(g_ + (rp ? voffR[_i] : (voff)[_i])), (PG8_LAS unsigned*)(lds + (bufoff) + ldsw + _i * 8192), 16, 0, 0); } \
            else { PG8_STAGE(bufoff, gbase, voff); } } while (0)
            if constexpr (SP2) {
            PG8_LDB(B0, 0, 0); PG8_LDB(B1, 0, 1); PG8_SCHED; PG8_LDA(At, 0, 0); PG8_STAGE(PG8_SA(1, 1), a1 + hstep, voffA);
            PG8_WAIT_V(8); PG8_WAIT_L(0); PG8_BAR; PG8_MMA(0, 0, At, B0); PG8_MMA(0, 1, At, B1); PG8_BAR; PG8_SCHED;
            if constexpr (!HALF_M) { PG8_LDA(At, 0, 1); } PG8_STAGE_R(PG8_SB(0, 0), b2, voffB, 0); PG8_STAGE_R(PG8_SB(0, 1), b2 + hstep, voffB, 1); PG8_STAGE_R(PG8_SA(0, 0), a2, voffA, 2);
            PG8_WAIT_V(8); PG8_WAIT_L(0); PG8_BAR; if constexpr (!HALF_M) { PG8_MMA(1, 0, At, B0); PG8_MMA(1, 1, At, B1); } PG8_BAR; PG8_SCHED;
            PG8_LDB(B0, 1, 0); PG8_LDB(B1, 1, 1); PG8_SCHED; PG8_LDA(At, 1, 0); PG8_STAGE_R(PG8_SA(0, 1), a2 + hstep, voffA, 3);
            PG8_WAIT_V(8); PG8_WAIT_L(0); PG8_BAR; PG8_MMA(0, 0, At, B0); PG8_MMA(0, 1, At, B1); PG8_BAR; PG8_SCHED;
            if constexpr (!HALF_M) { PG8_LDA(At, 1, 1); } PG8_STAGE_R(PG8_SB(1, 0), b3, voffB, 4); PG8_STAGE_R(PG8_SB(1, 1), b3 + hstep, voffB, 5); PG8_STAGE_R(PG8_SA(1, 0), a3, voffA, 6);
            PG8_WAIT_V(8); PG8_WAIT_L(0); PG8_BAR; if constexpr (!HALF_M) { PG8_MMA(1, 0, At, B0); PG8_MMA(1, 1, At, B1); } PG8_BAR; PG8_SCHED;
            } else {
            PG8_LDB(B0, 0, 0); PG8_SCHED; PG8_LDA(At, 0, 0); PG8_STAGE(PG8_SA(1, 1), a1 + hstep, voffA);
            PG8_WAIT_L(8); PG8_BAR; PG8_WAIT_L(0); PG8_MMA(0, 0, At, B0); PG8_BAR; PG8_SCHED;
            PG8_LDB(B1, 0, 1); PG8_STAGE(PG8_SB(0, 0), b2, voffB);
            PG8_BAR; PG8_WAIT_L(0); PG8_MMA(0, 1, At, B1); PG8_BAR;
            PG8_LDA(At, 0, 1); PG8_STAGE(PG8_SA(0, 0), a2, voffA);
            PG8_BAR; PG8_WAIT_L(0); PG8_MMA(1, 0, At, B0); PG8_BAR; PG8_SCHED;
            PG8_STAGE(PG8_SB(0, 1), b2 + hstep, voffB);
            PG8_WAIT_V(6); PG8_BAR; PG8_MMA(1, 1, At, B1); PG8_BAR;
            PG8_LDB(B0, 1, 0); PG8_SCHED; PG8_LDA(At, 1, 0); PG8_STAGE(PG8_SA(0, 1), a2 + hstep, voffA);
            PG8_WAIT_L(8); PG8_BAR; PG8_WAIT_L(0); PG8_MMA(0, 0, At, B0); PG8_BAR; PG8_SCHED;
            PG8_LDB(B1, 1, 1); PG8_STAGE(PG8_SB(1, 0), b3, voffB);
            PG8_BAR; PG8_WAIT_L(0); PG8_MMA(0, 1, At, B1); PG8_BAR;
            PG8_LDA(At, 1, 1); PG8_STAGE(PG8_SA(1, 0), a3, voffA);
            PG8_BAR; PG8_WAIT_L(0); PG8_MMA(1, 0, At, B0); PG8_BAR; PG8_SCHED;
            PG8_STAGE(PG8_SB(1, 1), b3 + hstep, voffB);
            PG8_WAIT_V(6); PG8_BAR; PG8_MMA(1, 1, At, B1); PG8_BAR;
            }
        }
        if constexpr (ALIGN_EPI) { if (wr == 0) PG8_BAR; }
        if constexpr (!Epi::AFTER_DRAIN) { E(acc, cur, wr, wc, fr, fq); S.done(cur); }
        if (!has_next) break;
#pragma unroll
        for (int a = 0; a < 2; ++a)
#pragma unroll
            for (int b = 0; b < 2; ++b)
#pragma unroll
                for (int m = 0; m < 4; ++m)
#pragma unroll
                    for (int n = 0; n < 2; ++n) acc[a][b][m][n] = (f32x4){0.f, 0.f, 0.f, 0.f};
        cur = nxt; cA = nA; cB = nB; ++ui;
        if constexpr (ALIGN_EPI) { if (wr == 1) PG8_BAR; }
    }
    PG8_WAIT_V(0);
    if constexpr (!ALIGN_EPI) { if (wr == 0) PG8_BAR; }
    PG8_BAR;
    if constexpr (Epi::AFTER_DRAIN) { E.fused(acc, cur, wr, wc, fr, fq, lds, wid, lane); S.done(cur); }
#undef PG8_SA
#undef PG8_SB
#undef PG8_STAGE
#undef PG8_STAGE_R
#undef PG8_LDA
#undef PG8_LDB
#undef PG8_MMA
#undef PG8_WAIT_V
#undef PG8_WAIT_L
#undef PG8_BAR
#undef PG8_SCHED
}
}

#ifndef PG8_SP2
#define PG8_SP2 true
#endif
#ifndef PG8_ALIGN
#define PG8_ALIGN true
#endif
constexpr int NWAVES = 8, NTHR = 512;
#ifndef MK_N_LAUNCHES
#define MK_N_LAUNCHES 1
#endif
constexpr int N_PHASES = 25;
constexpr int N_LAUNCHES = MK_N_LAUNCHES;
static_assert(N_LAUNCHES == 1, "this build runs as ONE launch (the retention mixer has a grid barrier inside its phase)");

constexpr int BATCH = 2, SEQ = 4096, DM = 2048, M = BATCH * SEQ, DEPTH = 4;
constexpr int RET_N = 12288, GM_N = 12288, GM_HALF = 6144, FOX_LD = 8208, FOX_N = 8192, FFN_H = 5632, FFN_N2 = 2 * FFN_H;
constexpr float EPS = 1e-6f;
constexpr float LOG2E = 1.4426950408889634f;

constexpr size_t MiB = (size_t)1 << 20;
constexpr size_t WS_CTL = 0, CTL_ZERO_BYTES = 1 * MiB;
constexpr size_t WS_W_RET_IN = 1 * MiB, SZ_W_RET_IN = 48 * MiB;
constexpr size_t WS_W_RET_OUT = 97 * MiB, SZ_W_RET_OUT = 16 * MiB;
constexpr size_t WS_W_GM_IN = 129 * MiB, WS_W_GM_OUT = 177 * MiB, WS_W_FOX_IN = 201 * MiB, WS_W_FOX_OUT = 233 * MiB;
constexpr size_t WS_W_GU = 241 * MiB, SZ_W_GU = 44 * MiB;
constexpr size_t WS_W_DN = 417 * MiB, SZ_W_DN = 22 * MiB;
constexpr size_t WS_ROPE_C = 505 * MiB, WS_ROPE_S = 509 * MiB;
constexpr size_t WS_H = 513 * MiB;
constexpr size_t WS_A = 545 * MiB;
constexpr size_t WS_B = 737 * MiB;
constexpr size_t WS_C = 833 * MiB;
constexpr size_t WS_MISC = 897 * MiB, WS_RSP = 913 * MiB, WS_KF = 921 * MiB, WS_QF = 953 * MiB, WS_END = 985 * MiB;
constexpr size_t MISC_PART = 0, MISC_RSTAT = 8 * MiB, MISC_LF = 9 * MiB, MISC_WTRI = 12 * MiB;
constexpr int CW_BAR = 4096;

constexpr int RING_OFF = 0, RING_BYTES = 131072;
constexpr int LDSCTL_OFF = RING_BYTES, MISC_OFF = LDSCTL_OFF + 320;
constexpr int RSTAB_OFF = LDSCTL_OFF + 1024;
constexpr int QKT_OFF = LDSCTL_OFF + 3072, QKG_OFF = QKT_OFF + 8192;
constexpr int LDS_BYTES = 147456;
static_assert(MISC_OFF + 128 <= RSTAB_OFF && RSTAB_OFF + 2048 <= QKT_OFF && QKG_OFF + 1024 <= LDS_BYTES, "LDS map");

#define GAS __attribute__((address_space(1)))
#define LAS __attribute__((address_space(3)))
typedef unsigned short bf16;
typedef unsigned v4u __attribute__((ext_vector_type(4)));
typedef unsigned v2u __attribute__((ext_vector_type(2)));
typedef float f32x4 __attribute__((ext_vector_type(4)));
typedef float f32x2 __attribute__((ext_vector_type(2)));
typedef short bf16x8 __attribute__((ext_vector_type(8)));
typedef short s16x4 __attribute__((ext_vector_type(4)));
typedef GAS unsigned gu32;
typedef LAS unsigned char* ldsp;
#define RLX_AGENT __ATOMIC_RELAXED, __HIP_MEMORY_SCOPE_AGENT
#define LDS_WAIT() asm volatile("s_waitcnt lgkmcnt(0)" ::: "memory")
using pg8::cvtpk;
__device__ __forceinline__ float bflo(unsigned w) { return __uint_as_float(w << 16); }
__device__ __forceinline__ float bfhi(unsigned w) { return __uint_as_float(w & 0xffff0000u); }
#define MFMA16(a, b, c) __builtin_amdgcn_mfma_f32_16x16x32_bf16((a), (b), (c), 0, 0, 0)
__device__ __forceinline__ bf16x8 frag_row(const ldsp tile, int RS, int lane) { return *(const LAS bf16x8*)(tile + (lane & 15) * RS + (lane >> 4) * 16); }
typedef short v4i16_t __attribute__((ext_vector_type(4)));
__device__ __forceinline__ s16x4 vtr(const ldsp p) { return __builtin_bit_cast(s16x4, __builtin_amdgcn_ds_read_tr16_b64_v4i16((LAS v4i16_t*)p)); }
__device__ __forceinline__ bf16x8 frag_tr(const ldsp tile, int RS, int lane) {
    const ldsp a = tile + (8 * (lane >> 4) + ((lane & 15) >> 2)) * RS + 8 * (lane & 3);
    const s16x4 lo = vtr(a), hi = vtr(a + 4 * RS);
    return (bf16x8){lo[0], lo[1], lo[2], lo[3], hi[0], hi[1], hi[2], hi[3]};
}

#define XB_TMO      128
#define XB_XCNT(j)  (256  + 64 * (j))
#define XB_XSUB(j)  (1280 + 64 * (j))
#define XB_XGEN(j)  (2304 + 64 * (j))
#define XB_TOP      3328
#define XB_TOPGEN   3392
#define XCD_BAR_WORDS 3456
#define XB_SPIN_CAP (1u << 18)

__device__ __forceinline__ unsigned xb_ld(unsigned* p)              { return __hip_atomic_load(p, __ATOMIC_RELAXED, __HIP_MEMORY_SCOPE_AGENT); }
__device__ __forceinline__ unsigned xb_add(unsigned* p, unsigned v) { return __hip_atomic_fetch_add(p, v, __ATOMIC_RELAXED, __HIP_MEMORY_SCOPE_AGENT); }
__device__ __forceinline__ unsigned xb_xcc_id() { return (unsigned)__builtin_amdgcn_s_getreg((3 << 11) | 20) & 0xFu; }
#define XB_SPIN(cond, bar) do { unsigned _sp = 0; while (cond) { __builtin_amdgcn_s_sleep(1); \
    if ((++_sp & 255u) == 0u) { if (xb_ld(&(bar)[XB_TMO])) break; if (_sp > XB_SPIN_CAP) { atomicAdd(&(bar)[XB_TMO], 1u); break; } } } } while (0)

struct XcdBarrier {
    unsigned* bar; unsigned x;
    volatile LAS unsigned* st;
};

__device__ __forceinline__ XcdBarrier xcd_barrier_post(unsigned* bar, volatile LAS unsigned* st) {
    XcdBarrier b; b.bar = bar; b.x = xb_xcc_id(); b.st = st;
    if (threadIdx.x == 0) (void)xb_add(&bar[XB_XCNT(b.x)], 1u);
    return b;
}
__device__ __forceinline__ void xcd_barrier_complete(unsigned* bar, unsigned x, unsigned& nloc, unsigned& nx) {
    const unsigned G = gridDim.x * gridDim.y * gridDim.z;
    unsigned sum, cnt, mine, sp = 0u;
    for (;;) {
        sum = 0u; cnt = 0u; mine = 0u;
#pragma unroll
        for (unsigned j = 0; j < 16; ++j) { const unsigned c = xb_ld(&bar[XB_XCNT(j)]); sum += c; cnt += (c > 0u) ? 1u : 0u; mine = (j == x) ? c : mine; }
        if (sum == G) break;
        __builtin_amdgcn_s_sleep(1);
        if ((++sp & 255u) == 0u) { if (xb_ld(&bar[XB_TMO])) break; if (sp > XB_SPIN_CAP) { atomicAdd(&bar[XB_TMO], 1u); break; } }
    }
    nloc = mine > 0u ? mine : 1u; nx = cnt > 0u ? cnt : 1u;
}

__device__ __forceinline__ void xcd_barrier(const XcdBarrier& b) {
    asm volatile("s_waitcnt vmcnt(0)" ::: "memory");
    __syncthreads();
    if (threadIdx.x == 0) {
        unsigned* bar = b.bar;
        __builtin_amdgcn_s_waitcnt(0);
        unsigned nloc = b.st[0], nx = b.st[1];
        if (nloc == 0u) { xcd_barrier_complete(bar, b.x, nloc, nx); b.st[0] = nloc; b.st[1] = nx; }
        const unsigned old = xb_add(&bar[XB_XSUB(b.x)], 1u);
        const unsigned gen = old / nloc;
        if (old + 1u == (gen + 1u) * nloc) {
            __builtin_amdgcn_fence(__ATOMIC_RELEASE, "agent");
            asm volatile("s_waitcnt vmcnt(0)" ::: "memory");
            const unsigned og = xb_add(&bar[XB_TOP], 1u);
            const unsigned tg = og / nx;
            if (og + 1u == (tg + 1u) * nx) xb_add(&bar[XB_TOPGEN], 1u);
            else XB_SPIN(xb_ld(&bar[XB_TOPGEN]) == tg, bar);
            __builtin_amdgcn_fence(__ATOMIC_ACQUIRE, "agent");
            xb_add(&bar[XB_XGEN(b.x)], 1u);
            asm volatile("s_waitcnt vmcnt(0)" ::: "memory");
        } else {
            XB_SPIN(xb_ld(&bar[XB_XGEN(b.x)]) == gen, bar);
            __builtin_amdgcn_fence(__ATOMIC_ACQUIRE, "agent");
            asm volatile("s_waitcnt vmcnt(0)" ::: "memory");
        }
    }
    __syncthreads();
}

struct Frame {
    ldsp lds;
    volatile LAS unsigned* MISC;
    gu32* ctl;
    int tid, lane, wave;
    int vcu, G;
};
__device__ __forceinline__ float wave_sum(float v) {
#pragma unroll
    for (int o = 1; o < 64; o <<= 1) v += __shfl_xor(v, o);
    return v;
}
__device__ __forceinline__ float log_sigmoid(float z) { return fminf(z, 0.f) - log1pf(expf(-fabsf(z))); }

__device__ __forceinline__ void transpose_job(Frame& F, const float* W, int K, int ld, int ncols, bf16* WT, int ilv, const float* gvec) {
    LAS float* scr = (LAS float*)(F.lds + RING_OFF + F.wave * 16384);
    const int gw = F.vcu * NWAVES + F.wave, NGW = F.G * NWAVES, lane = F.lane;
    const int nblk = ncols / 32, nitems = (K / 64) * nblk;
    float wv[32];
#define TJ_LOAD(item) do { const int kb_ = (item) / nblk, nb_ = (item) % nblk; const float* src_ = W + (size_t)(64 * kb_ + (lane >> 5)) * ld + 32 * nb_ + (lane & 31); \
        _Pragma("unroll") for (int i = 0; i < 32; ++i) wv[i] = src_[(size_t)(2 * i) * ld]; } while (0)
    if (gw < nitems) TJ_LOAD(gw);
    for (int it = gw; it < nitems; it += NGW) {
        const int kb = it / nblk, nb = it % nblk, k0 = 64 * kb, n0 = 32 * nb;
        const int drow0 = ilv == 0 ? n0 : ((n0 >> 7) * 256 + (n0 & 127) + (ilv == 2 ? 128 : 0));
#pragma unroll
        for (int i = 0; i < 32; ++i) scr[(2 * i + (lane >> 5)) * 33 + (lane & 31)] = wv[i];
        if (it + NGW < nitems) TJ_LOAD(it + NGW);
        LDS_WAIT(); asm volatile("" ::: "memory");
        const int c = lane & 7;
        f32x4 ga = {1.f, 1.f, 1.f, 1.f}, gb = {1.f, 1.f, 1.f, 1.f};
        if (gvec) { ga = *(const f32x4*)(gvec + k0 + 8 * c); gb = *(const f32x4*)(gvec + k0 + 8 * c + 4); }
#pragma unroll
        for (int j = 0; j < 4; ++j) { const int n = (lane >> 3) + 8 * j; const LAS float* s = scr + (8 * c) * 33 + n;
            v4u o; o.x = cvtpk(s[0 * 33] * ga[0], s[1 * 33] * ga[1]); o.y = cvtpk(s[2 * 33] * ga[2], s[3 * 33] * ga[3]); o.z = cvtpk(s[4 * 33] * gb[0], s[5 * 33] * gb[1]); o.w = cvtpk(s[6 * 33] * gb[2], s[7 * 33] * gb[3]);
            *(GAS v4u*)(WT + (size_t)(drow0 + n) * K + k0 + 8 * c) = o; }
        LDS_WAIT(); asm volatile("" ::: "memory");
    }
#undef TJ_LOAD
}
__device__ __forceinline__ void p0_prologue(Frame& F, const void* const* in, unsigned char* ws) {
    const float* mixg = (const float*)in[2]; const float* ffng = (const float*)in[3];
    for (int j = 0; j < 2; ++j) {
        transpose_job(F, (const float*)in[4] + (size_t)j * DM * RET_N, DM, RET_N, RET_N, (bf16*)(ws + WS_W_RET_IN + j * SZ_W_RET_IN), 0, mixg + (size_t)(3 * j) * DM);
        transpose_job(F, (const float*)in[6] + (size_t)j * 4096 * DM, 4096, DM, DM, (bf16*)(ws + WS_W_RET_OUT + j * SZ_W_RET_OUT), 0, nullptr);
    }
    transpose_job(F, (const float*)in[7], DM, GM_N, GM_N, (bf16*)(ws + WS_W_GM_IN), 0, mixg + DM);
    transpose_job(F, (const float*)in[12], GM_HALF, DM, DM, (bf16*)(ws + WS_W_GM_OUT), 0, nullptr);
    transpose_job(F, (const float*)in[13], DM, FOX_LD, FOX_N, (bf16*)(ws + WS_W_FOX_IN), 0, mixg + 2 * DM);
    transpose_job(F, (const float*)in[17], DM, DM, DM, (bf16*)(ws + WS_W_FOX_OUT), 0, nullptr);
    for (int i = 0; i < DEPTH; ++i) {
        transpose_job(F, (const float*)in[18] + (size_t)i * DM * FFN_H, DM, FFN_H, FFN_H, (bf16*)(ws + WS_W_GU + i * SZ_W_GU), 1, ffng + (size_t)i * DM);
        transpose_job(F, (const float*)in[19] + (size_t)i * DM * FFN_H, DM, FFN_H, FFN_H, (bf16*)(ws + WS_W_GU + i * SZ_W_GU), 2, ffng + (size_t)i * DM);
        transpose_job(F, (const float*)in[20] + (size_t)i * FFN_H * DM, FFN_H, DM, DM, (bf16*)(ws + WS_W_DN + i * SZ_W_DN), 0, nullptr);
    }
    { const float* x = (const float*)in[0]; bf16* xb = (bf16*)(ws + WS_H); float* rss = (float*)(ws + WS_RSP);
      const int gw = F.vcu * NWAVES + F.wave, NGW = F.G * NWAVES, lane = F.lane;
      for (int m = gw; m < M; m += NGW) { const f32x4* xr = (const f32x4*)(x + (size_t)m * DM) + lane; v2u* o8 = (v2u*)(xb + (size_t)m * DM) + lane; float ss = 0.f;
#pragma unroll
          for (int j = 0; j < 8; ++j) { const f32x4 v = xr[64 * j]; ss += (v.x * v.x + v.y * v.y) + (v.z * v.z + v.w * v.w); v2u w; w.x = cvtpk(v.x, v.y); w.y = cvtpk(v.z, v.w); o8[64 * j] = w; }
          ss = wave_sum(ss); if (lane < 32) rss[(size_t)m * 32 + lane] = lane == 0 ? ss : 0.f; } }
    { const float* wsp = (const float*)in[10]; bf16* wtri = (bf16*)(ws + WS_MISC + MISC_WTRI);
      for (int i4 = F.vcu * NTHR + F.tid; i4 < 8 * 128 * 32; i4 += F.G * NTHR) { const int t = (i4 >> 5) & 127, s4 = (i4 & 31) * 4; f32x4 wv = *(const f32x4*)(wsp + (size_t)i4 * 4);
#pragma unroll
          for (int e = 0; e < 4; ++e) if (s4 + e > t) wv[e] = 0.f;
          v2u pk; pk.x = cvtpk(wv[0], wv[1]); pk.y = cvtpk(wv[2], wv[3]); *(v2u*)(wtri + (size_t)i4 * 4) = pk; } }
    { const int* pos = (const int*)in[1]; float* cs = (float*)(ws + WS_ROPE_C); float* sn = (float*)(ws + WS_ROPE_S);
      const int gid = F.vcu * NTHR + F.tid, i = gid & 127, step = (F.G * NTHR) >> 7;
      const double invf = exp2(-(double)i * (13.287712379549449 / 128.0));
      for (int r = gid >> 7; r < M; r += step) { const double ang = (double)pos[r] * invf; const double rr = ang - 6.283185307179586 * rint(ang * 0.15915494309189535);
          const float a = (float)rr; cs[(size_t)r * 128 + i] = cosf(a); sn[(size_t)r * 128 + i] = sinf(a); } }
}

__device__ __forceinline__ void ret_p_phase(Frame& F, const bf16* q, const bf16* k, bf16* PF, bf16* KF, bf16* QF) {
    constexpr int RSQ = 272;
    const ldsp LQ = F.lds, LK = F.lds + 34816;
    const int tid = F.tid, lane = F.lane, w = F.wave, g4 = lane >> 4, l15 = lane & 15;
    for (int unit = F.vcu; unit < 512; unit += F.G) {
        const int bh = unit >> 5, ci = unit & 31, h = bh & 7;
        const float lg2 = log1pf(-exp2f(-5.0f - (float)h)) * LOG2E;
        const size_t rowbase = (size_t)bh * SEQ + ci * 128;
        v4u pq[4], pk[4];
#define RP_LD(dd) do { _Pragma("unroll") for (int ps = 0; ps < 4; ++ps) { const int r_ = ps * 32 + (tid >> 4), c_ = tid & 15; \
            pq[ps] = *(const v4u*)(q + (rowbase + r_) * 256 + (dd) * 128 + c_ * 8); pk[ps] = *(const v4u*)(k + (rowbase + r_) * 256 + (dd) * 128 + c_ * 8); } } while (0)
        RP_LD(0);
        f32x4 S[8];
#pragma unroll
        for (int t = 0; t < 8; ++t) S[t] = (f32x4){0.f, 0.f, 0.f, 0.f};
#pragma unroll
        for (int dh = 0; dh < 2; ++dh) {
            __syncthreads();
#pragma unroll
            for (int ps = 0; ps < 4; ++ps) { const int r_ = ps * 32 + (tid >> 4), c_ = tid & 15; *(LAS v4u*)(LQ + r_ * RSQ + c_ * 16) = pq[ps]; *(LAS v4u*)(LK + r_ * RSQ + c_ * 16) = pk[ps]; }
            if (dh == 0) RP_LD(1);
            __syncthreads();
#pragma unroll
            for (int ks = 0; ks < 4; ++ks) { const bf16x8 a = frag_row(LQ + (16 * w) * RSQ + ks * 64, RSQ, lane);
                *(bf16x8*)(QF + ((((size_t)(bh * 32 + ci) * 8 + w) * 8 + dh * 4 + ks) * 512 + lane * 8)) = a;
#pragma unroll
                for (int t = 0; t < 8; ++t) S[t] = MFMA16(a, frag_row(LK + (16 * t) * RSQ + ks * 64, RSQ, lane), S[t]); }
#pragma unroll
            for (int ks = 0; ks < 4; ++ks) { const bf16x8 f = frag_tr(LK + (32 * ks) * RSQ + (16 * w) * 2, RSQ, lane); const v4u fu = __builtin_bit_cast(v4u, f); v4u o;
                const float k0 = exp2f((float)(127 - 32 * ks - 8 * g4) * lg2), gi = exp2f(-lg2), k1 = k0 * gi, k2 = k1 * gi, k3 = k2 * gi, k4 = k3 * gi, k5 = k4 * gi, k6 = k5 * gi, k7 = k6 * gi;
                o.x = cvtpk(bflo(fu.x) * k0, bfhi(fu.x) * k1); o.y = cvtpk(bflo(fu.y) * k2, bfhi(fu.y) * k3); o.z = cvtpk(bflo(fu.z) * k4, bfhi(fu.z) * k5); o.w = cvtpk(bflo(fu.w) * k6, bfhi(fu.w) * k7);
                *(v4u*)(KF + ((((size_t)(bh * 32 + ci) * 2 + dh) * 8 + w) * 4 + ks) * 512 + lane * 8) = o; }
        }
#undef RP_LD
#pragma unroll
        for (int t = 0; t < 8; ++t)
#pragma unroll
            for (int r = 0; r < 4; ++r) { const int n = 16 * w + 4 * g4 + r, mm = 16 * t + l15;
                const float pv_ = n >= mm ? S[t][r] * exp2f((float)(n - mm) * lg2) : 0.f;
                *(LAS unsigned short*)(LQ + n * RSQ + mm * 2) = (unsigned short)(cvtpk(pv_, 0.f) & 0xffffu); }
#pragma unroll
        for (int ks = 0; ks < 4; ++ks) *(bf16x8*)(PF + ((((size_t)(bh * 32 + ci) * 8 + w) * 4 + ks) * 512 + lane * 8)) = frag_row(LQ + (16 * w) * RSQ + ks * 64, RSQ, lane);
    }
}
__device__ __forceinline__ void ret_core_phase(Frame& F, const bf16* QF, const bf16* v, const bf16* PF, const bf16* KF, bf16* o) {
    constexpr int RSV = 72, RSS = 528;
    const ldsp LV0 = F.lds, LST = F.lds + 18432;
    const ldsp LOw = F.lds + 52224 + F.wave * 1024;
    const int tid = F.tid, lane = F.lane, w = F.wave, g4 = lane >> 4, l15 = lane & 15;
    for (int unit = F.vcu; unit < 256; unit += F.G) {
        const int bh = unit >> 4, es = unit & 15, h = bh & 7, b = bh >> 3, e0 = es * 32;
        const float lg2 = log1pf(-exp2f(-5.0f - (float)h)) * LOG2E;
        const float cd = exp2f(128.0f * lg2);
        const size_t rb0 = (size_t)bh * SEQ;
        f32x4 st[2][2];
#pragma unroll
        for (int a = 0; a < 2; ++a)
#pragma unroll
            for (int t = 0; t < 2; ++t) st[a][t] = (f32x4){0.f, 0.f, 0.f, 0.f};
        __syncthreads();
        for (int i = tid; i < 16896 / 4; i += NTHR) ((LAS unsigned*)LST)[i] = 0u;
        v4u pv, pvn; bf16x8 qf[8], pf[4], kf[8], qn[8], pn[4], kn[8];
#define RC_LD(cc) do { pvn = *(const v4u*)(v + (rb0 + (cc) * 128 + (tid >> 2)) * 512 + e0 + (tid & 3) * 8); \
            _Pragma("unroll") for (int ks = 0; ks < 8; ++ks) qn[ks] = *(const bf16x8*)(QF + ((((size_t)(bh * 32 + (cc)) * 8 + w) * 8 + ks) * 512 + lane * 8)); \
            _Pragma("unroll") for (int ks = 0; ks < 4; ++ks) pn[ks] = *(const bf16x8*)(PF + ((((size_t)(bh * 32 + (cc)) * 8 + w) * 4 + ks) * 512 + lane * 8)); \
            _Pragma("unroll") for (int i_ = 0; i_ < 8; ++i_) kn[i_] = *(const bf16x8*)(KF + ((((size_t)(bh * 32 + (cc)) * 2 + (i_ >> 2)) * 8 + w) * 4 + (i_ & 3)) * 512 + lane * 8); } while (0)
        RC_LD(0);
        for (int ci = 0; ci < 32; ++ci) {
            const ldsp LSc = LST + (ci & 1) * 16896, LSn = LST + ((ci + 1) & 1) * 16896;
            const ldsp LV = LV0 + (ci & 1) * 9216;
            pv = pvn;
#pragma unroll
            for (int i_ = 0; i_ < 8; ++i_) { qf[i_] = qn[i_]; kf[i_] = kn[i_]; }
#pragma unroll
            for (int i_ = 0; i_ < 4; ++i_) pf[i_] = pn[i_];
            *(LAS v4u*)(LV + (tid >> 2) * RSV + (tid & 3) * 16) = pv;
            __syncthreads();
            if (ci + 1 < 32) RC_LD(ci + 1);
            bf16x8 vf[4][2];
#pragma unroll
            for (int ks = 0; ks < 4; ++ks)
#pragma unroll
                for (int t = 0; t < 2; ++t) vf[ks][t] = frag_tr(LV + (32 * ks) * RSV + (16 * t) * 2, RSV, lane);
            f32x4 cr[2], in[2];
            cr[0] = (f32x4){0.f, 0.f, 0.f, 0.f}; cr[1] = (f32x4){0.f, 0.f, 0.f, 0.f}; in[0] = (f32x4){0.f, 0.f, 0.f, 0.f}; in[1] = (f32x4){0.f, 0.f, 0.f, 0.f};
#pragma unroll
            for (int ks = 0; ks < 8; ++ks)
#pragma unroll
                for (int t = 0; t < 2; ++t) cr[t] = MFMA16(qf[ks], frag_row(LSc + (16 * t) * RSS + (ks * 32) * 2, RSS, lane), cr[t]);
#pragma unroll
            for (int ks = 0; ks < 4; ++ks)
#pragma unroll
                for (int t = 0; t < 2; ++t) in[t] = MFMA16(pf[ks], vf[ks][t], in[t]);
#pragma unroll
            for (int dh = 0; dh < 2; ++dh) {
#pragma unroll
                for (int t = 0; t < 2; ++t) st[dh][t] = st[dh][t] * cd;
#pragma unroll
                for (int ks = 0; ks < 4; ++ks)
#pragma unroll
                    for (int t = 0; t < 2; ++t) st[dh][t] = MFMA16(kf[dh * 4 + ks], vf[ks][t], st[dh][t]);
#pragma unroll
                for (int t = 0; t < 2; ++t) { v2u pk2; pk2.x = cvtpk(st[dh][t][0], st[dh][t][1]); pk2.y = cvtpk(st[dh][t][2], st[dh][t][3]);
                    *(LAS v2u*)(LSn + (16 * t + l15) * RSS + (dh * 128 + 16 * w + 4 * g4) * 2) = pk2; }
            }
#pragma unroll
            for (int r = 0; r < 4; ++r) { const int n = 16 * w + 4 * g4 + r; const float qd = exp2f((float)(n + 1) * lg2);
#pragma unroll
                for (int t = 0; t < 2; ++t) *(LAS unsigned short*)(LOw + (4 * g4 + r) * 64 + (16 * t + l15) * 2) = (unsigned short)(cvtpk(in[t][r] + cr[t][r] * qd, 0.f) & 0xffffu); }
            *(v4u*)(o + ((size_t)b * SEQ + ci * 128 + 16 * w + (lane >> 2)) * 4096 + h * 512 + e0 + (lane & 3) * 8) = *(const LAS v4u*)(LOw + (lane >> 2) * 64 + (lane & 3) * 16);
        }
#undef RC_LD
    }
}

__device__ __forceinline__ void ret_gn_phase(Frame& F, const bf16* o, const bf16* g, const float* gn, bf16* y) {
    const int lane = F.lane, gw = F.vcu * NWAVES + F.wave, NGW = F.G * NWAVES;
    for (int it0 = gw; it0 < M * 8; it0 += 4 * NGW) {
        v4u ov[4], gv[4];
#pragma unroll
        for (int u = 0; u < 4; ++u) { const int it = it0 + u * NGW; const size_t off = (size_t)(it >> 3) * 4096 + (it & 7) * 512 + lane * 8;
            if (it < M * 8) { ov[u] = *(const v4u*)(o + off); gv[u] = *(const v4u*)(g + off); } else { ov[u] = (v4u){0u, 0u, 0u, 0u}; gv[u] = ov[u]; } }
#pragma unroll
        for (int u = 0; u < 4; ++u) { const int it = it0 + u * NGW, h = it & 7; const size_t off = (size_t)(it >> 3) * 4096 + h * 512 + lane * 8;
            float x[8] = {bflo(ov[u].x), bfhi(ov[u].x), bflo(ov[u].y), bfhi(ov[u].y), bflo(ov[u].z), bfhi(ov[u].z), bflo(ov[u].w), bfhi(ov[u].w)};
            float gg[8] = {bflo(gv[u].x), bfhi(gv[u].x), bflo(gv[u].y), bfhi(gv[u].y), bflo(gv[u].z), bfhi(gv[u].z), bflo(gv[u].w), bfhi(gv[u].w)};
            float s = 0.f;
#pragma unroll
            for (int e = 0; e < 8; ++e) s += x[e];
            const float mean = wave_sum(s) * (1.0f / 512.0f); float qv = 0.f;
#pragma unroll
            for (int e = 0; e < 8; ++e) { x[e] -= mean; qv += x[e] * x[e]; }
            const float rstd = 1.0f / sqrtf(wave_sum(qv) * (1.0f / 512.0f) + EPS);
            const f32x4 g0 = *(const f32x4*)(gn + h * 512 + lane * 8), g1 = *(const f32x4*)(gn + h * 512 + lane * 8 + 4);
            float r[8];
#pragma unroll
            for (int e = 0; e < 8; ++e) { const float gw_ = e < 4 ? g0[e & 3] : g1[e & 3]; r[e] = x[e] * rstd * gw_ * (gg[e] * pg8::fast_sigmoid(gg[e])); }
            v4u w; w.x = cvtpk(r[0], r[1]); w.y = cvtpk(r[2], r[3]); w.z = cvtpk(r[4], r[5]); w.w = cvtpk(r[6], r[7]);
            if (it < M * 8) *(v4u*)(y + off) = w; }
    }
}

__device__ __forceinline__ void gm_stat_phase(Frame& F, const f32x2* part, f32x2* rstat) {
    const int lane = F.lane, gw = F.vcu * NWAVES + F.wave, NGW = F.G * NWAVES;
    for (int row = gw; row < M; row += NGW) {
        float s = 0.f, ss = 0.f;
        if (lane < 48) { const f32x4 p = *(const f32x4*)(part + (size_t)row * 96 + lane * 2); s = p.x + p.z; ss = p.y + p.w; }
        s = wave_sum(s); ss = wave_sum(ss);
        const float mean = s * (1.0f / GM_HALF), var = fmaxf(ss * (1.0f / GM_HALF) - mean * mean, 0.f);
        if (lane == 0) rstat[row] = (f32x2){mean, 1.0f / sqrtf(var + EPS)};
    }
}
__device__ __forceinline__ void gm_spatial_phase(Frame& F, const bf16* u, const bf16* v, const f32x2* rstat, const float* lng, const float* lnb, const bf16* wtri, const float* bsp, bf16* y) {
    constexpr int RSW = 272, RSN = 528;
    const ldsp LW = F.lds, LN = F.lds + 34816;
    const int tid = F.tid, lane = F.lane, w = F.wave, g4 = lane >> 4, l15 = lane & 15;
    for (int wgi = F.vcu; wgi < 256; wgi += F.G) {
        const int gg = wgi & 7, jj = wgi >> 3;
        __syncthreads();
#pragma unroll
        for (int ps = 0; ps < 4; ++ps) { const int id = ps * NTHR + tid, t = id >> 4, c = id & 15;
            *(LAS v4u*)(LW + t * RSW + c * 16) = *(const v4u*)(wtri + ((size_t)gg * 128 + t) * 128 + c * 8); }
        float bs[8];
#pragma unroll
        for (int tt = 0; tt < 8; ++tt) bs[tt] = bsp[gg * 128 + 16 * tt + l15];
        v4u vr[8], ur[8];
#define GS_ROW0(i_) ((((jj) * 6 + (i_)) / 3) * 128)
#define GS_COL0(i_) (gg * 768 + (((jj) * 6 + (i_)) % 3) * 256)
#define GS_LDV(i_) do { _Pragma("unroll") for (int ps = 0; ps < 8; ++ps) { const int id_ = ps * NTHR + tid; vr[ps] = *(const v4u*)(v + (size_t)(GS_ROW0(i_) + (id_ >> 5)) * GM_HALF + GS_COL0(i_) + (id_ & 31) * 8); } } while (0)
        GS_LDV(0);
        for (int ui = 0; ui < 6; ++ui) {
            const int row0 = GS_ROW0(ui), col0 = GS_COL0(ui);
            __syncthreads();
#pragma unroll
            for (int ps = 0; ps < 8; ++ps) { const int id = ps * NTHR + tid, r = id >> 5, c8 = (id & 31) * 8;
                const v4u vv = vr[ps]; const f32x2 rs = rstat[row0 + r];
                const f32x4 ga = *(const f32x4*)(lng + col0 + c8), gb = *(const f32x4*)(lng + col0 + c8 + 4), ba = *(const f32x4*)(lnb + col0 + c8), bb = *(const f32x4*)(lnb + col0 + c8 + 4);
                v4u o;
                o.x = cvtpk((bflo(vv.x) - rs.x) * rs.y * ga[0] + ba[0], (bfhi(vv.x) - rs.x) * rs.y * ga[1] + ba[1]);
                o.y = cvtpk((bflo(vv.y) - rs.x) * rs.y * ga[2] + ba[2], (bfhi(vv.y) - rs.x) * rs.y * ga[3] + ba[3]);
                o.z = cvtpk((bflo(vv.z) - rs.x) * rs.y * gb[0] + bb[0], (bfhi(vv.z) - rs.x) * rs.y * gb[1] + bb[1]);
                o.w = cvtpk((bflo(vv.w) - rs.x) * rs.y * gb[2] + bb[2], (bfhi(vv.w) - rs.x) * rs.y * gb[3] + bb[3]);
                *(LAS v4u*)(LN + r * RSN + c8 * 2) = o; }
#pragma unroll
            for (int ps = 0; ps < 8; ++ps) { const int id_ = ps * NTHR + tid; ur[ps] = *(const v4u*)(u + (size_t)(row0 + (id_ >> 5)) * GM_HALF + col0 + (id_ & 31) * 8); }
            if (ui + 1 < 6) GS_LDV(ui + 1);
            __syncthreads();
            f32x4 acc[2][8];
#pragma unroll
            for (int ci = 0; ci < 2; ++ci)
#pragma unroll
                for (int tt = 0; tt < 8; ++tt) acc[ci][tt] = (f32x4){0.f, 0.f, 0.f, 0.f};
#pragma unroll
            for (int ks = 0; ks < 4; ++ks) {
                const bf16x8 a0 = frag_tr(LN + (32 * ks) * RSN + (32 * w) * 2, RSN, lane), a1 = frag_tr(LN + (32 * ks) * RSN + (32 * w + 16) * 2, RSN, lane);
#pragma unroll
                for (int tt = 2 * ks; tt < 8; ++tt) { const bf16x8 bfr = frag_row(LW + (16 * tt) * RSW + ks * 64, RSW, lane);
                    acc[0][tt] = MFMA16(a0, bfr, acc[0][tt]); acc[1][tt] = MFMA16(a1, bfr, acc[1][tt]); }
            }
            __syncthreads();
#pragma unroll
            for (int ci = 0; ci < 2; ++ci)
#pragma unroll
                for (int tt = 0; tt < 8; ++tt) { v2u pk; pk.x = cvtpk(acc[ci][tt][0] + bs[tt], acc[ci][tt][1] + bs[tt]); pk.y = cvtpk(acc[ci][tt][2] + bs[tt], acc[ci][tt][3] + bs[tt]);
                    *(LAS v2u*)(LN + (16 * tt + l15) * RSN + (32 * w + 16 * ci + 4 * g4) * 2) = pk; }
            __syncthreads();
#pragma unroll
            for (int ps = 0; ps < 8; ++ps) { const int id = ps * NTHR + tid, r = id >> 5, c8 = (id & 31) * 8;
                const v4u mv = *(const LAS v4u*)(LN + r * RSN + c8 * 2); const size_t off = (size_t)(row0 + r) * GM_HALF + col0 + c8; const v4u uv = ur[ps];
                v4u o; o.x = cvtpk(bflo(uv.x) * bflo(mv.x), bfhi(uv.x) * bfhi(mv.x)); o.y = cvtpk(bflo(uv.y) * bflo(mv.y), bfhi(uv.y) * bfhi(mv.y));
                o.z = cvtpk(bflo(uv.z) * bflo(mv.z), bfhi(uv.z) * bfhi(mv.z)); o.w = cvtpk(bflo(uv.w) * bflo(mv.w), bfhi(uv.w) * bfhi(mv.w));
                *(v4u*)(y + off) = o; }
        }
#undef GS_ROW0
#undef GS_COL0
#undef GS_LDV
    }
}

__device__ __forceinline__ void fox_prep_phase(Frame& F, const bf16* x, const float* rs, const float* gmix, const float* wfox, const float* bfg, float* lf) {
    const int lane = F.lane, gw = F.vcu * NWAVES + F.wave, NGW = F.G * NWAVES;
    for (int idx = F.tid; idx < DM * 4; idx += NTHR) { const int k = idx >> 2, qd = idx & 3; const f32x4 w = *(const f32x4*)(wfox + (size_t)k * FOX_LD + FOX_N + 4 * qd) * gmix[k];
        const int slot = ((k >> 8) * 4 + (k & 3)) * 64 + ((k >> 2) & 63);
        *(LAS f32x4*)(F.lds + qd * 32768 + slot * 16) = w; }
    __syncthreads();
    for (int m = gw; m < M; m += NGW) {
        const v2u* xr = (const v2u*)(x + (size_t)m * DM) + lane;
        f32x4 v[8];
#pragma unroll
        for (int j = 0; j < 8; ++j) { const v2u t = xr[64 * j]; v[j] = (f32x4){bflo(t.x), bfhi(t.x), bflo(t.y), bfhi(t.y)}; }
        f32x4 a[4];
#pragma unroll
        for (int qd = 0; qd < 4; ++qd) a[qd] = (f32x4){0.f, 0.f, 0.f, 0.f};
#pragma unroll
        for (int j = 0; j < 8; ++j)
#pragma unroll
            for (int e = 0; e < 4; ++e) { const float hv = v[j][e];
#pragma unroll
                for (int qd = 0; qd < 4; ++qd) a[qd] += hv * *(const LAS f32x4*)(F.lds + qd * 32768 + ((j * 4 + e) * 64 + lane) * 16);
                asm volatile("" ::: "memory"); }
        float z = 0.f;
#pragma unroll
        for (int qd = 0; qd < 4; ++qd)
#pragma unroll
            for (int i = 0; i < 4; ++i) { const float t = wave_sum(a[qd][i]); z = (lane == qd * 4 + i) ? t : z; }
        if (lane < 16) lf[(size_t)m * 16 + lane] = log_sigmoid(z * pg8::row_rstd(rs, m) + bfg[lane]);
    }
}

typedef float f32x16 __attribute__((ext_vector_type(16)));
#define MFMA32(a, b, c) __builtin_amdgcn_mfma_f32_32x32x16_bf16((a), (b), (c), 0, 0, 0)
__device__ __forceinline__ void fox_attn_phase(Frame& F, const bf16* qn, const bf16* kn, const bf16* vv, const bf16* gs, const float* lf, bf16* y) {
    constexpr int RSK = 272, RSV = 320, KSLOT = 64 * RSK, VSLOT = 64 * RSV;
    const ldsp LK = F.lds, LV = F.lds + 2 * KSLOT;
    LAS float* c2 = (LAS float*)(F.lds + 75776);
    LAS float* red = (LAS float*)(F.lds + 92160);
    const int tid = F.tid, lane = F.lane, w = F.wave, r32 = lane & 31, hi = lane >> 5;
    int bh_have = -1;
    for (int pr = F.vcu; pr < 256; pr += F.G) {
        const int bh = pr >> 3, pi = pr & 7, b = bh >> 4, h = bh & 15;
        const size_t tok0 = (size_t)b * SEQ;
        if (bh != bh_have) {
            bh_have = bh;
            float x8[8]; float run = 0.f;
#pragma unroll
            for (int e = 0; e < 8; ++e) { run += lf[(tok0 + tid * 8 + e) * 16 + h]; x8[e] = run; }
            float inc = run;
#pragma unroll
            for (int o = 1; o < 64; o <<= 1) { const float t = __shfl_up(inc, o); if (lane >= o) inc += t; }
            __syncthreads();
            if (lane == 63) red[w] = inc;
            __syncthreads();
            float pre = inc - run;
#pragma unroll
            for (int wv = 0; wv < 8; ++wv) if (wv < w) pre += red[wv];
#pragma unroll
            for (int e = 0; e < 8; ++e) c2[tid * 8 + e] = (pre + x8[e]) * LOG2E;
        }
        for (int half = 0; half < 2; ++half) {
            const int qb = half ? 15 - pi : pi, q0 = qb * 256, ntile = 4 * qb + 4, qrow = q0 + 32 * w + r32;
            bf16x8 qf[8];
#pragma unroll
            for (int ks = 0; ks < 8; ++ks) qf[ks] = *(const bf16x8*)(qn + (tok0 + qrow) * DM + h * 128 + ks * 16 + 8 * hi);
            v4u kr[2], vr[2];
#define FA_LOAD(tt) do { _Pragma("unroll") for (int pp = 0; pp < 2; ++pp) { const int id_ = tid + NTHR * pp, r_ = id_ >> 4, c_ = id_ & 15; \
                kr[pp] = *(const v4u*)(kn + (tok0 + 64 * (tt) + r_) * DM + h * 128 + c_ * 8); vr[pp] = *(const v4u*)(vv + (tok0 + 64 * (tt) + r_) * DM + h * 128 + c_ * 8); } } while (0)
#define FA_STORE(sl) do { _Pragma("unroll") for (int pp = 0; pp < 2; ++pp) { const int id_ = tid + NTHR * pp, r_ = id_ >> 4, c_ = id_ & 15; \
                *(LAS v4u*)(LK + (sl) * KSLOT + r_ * RSK + c_ * 16) = kr[pp]; *(LAS v4u*)(LV + (sl) * VSLOT + r_ * RSV + c_ * 16) = vr[pp]; } } while (0)
            FA_LOAD(0);
            __syncthreads();
            FA_STORE(0);
            if (ntile > 1) FA_LOAD(1);
            const float cq = c2[qrow];
            float mx = 0.f, ls = 0.f;
            f32x16 O[4];
#pragma unroll
            for (int dt = 0; dt < 4; ++dt)
#pragma unroll
                for (int r = 0; r < 16; ++r) O[dt][r] = 0.f;
            for (int t = 0; t < ntile; ++t) {
                __syncthreads();
                if (t + 1 < ntile) { FA_STORE((t + 1) & 1); if (t + 2 < ntile) FA_LOAD(t + 2); }
                const int key0 = 64 * t;
                if (key0 <= q0 + 32 * w + 31) {
                    const ldsp sk = LK + (t & 1) * KSLOT + r32 * RSK + 16 * hi, sv = LV + (t & 1) * VSLOT;
                    f32x16 S0, S1;
                    const float cbase = cq - mx;
#pragma unroll
                    for (int g = 0; g < 4; ++g) { const f32x4 ck0 = *(const LAS f32x4*)(c2 + key0 + 8 * g + 4 * hi), ck1 = *(const LAS f32x4*)(c2 + key0 + 32 + 8 * g + 4 * hi);
#pragma unroll
                        for (int e = 0; e < 4; ++e) { S0[4 * g + e] = cbase - ck0[e]; S1[4 * g + e] = cbase - ck1[e]; } }
#pragma unroll
                    for (int ks = 0; ks < 8; ++ks) { S0 = MFMA32(*(const LAS bf16x8*)(sk + ks * 32), qf[ks], S0); S1 = MFMA32(*(const LAS bf16x8*)(sk + 32 * RSK + ks * 32), qf[ks], S1); }
                    if (key0 + 63 > q0 + 32 * w) {
#pragma unroll
                        for (int g = 0; g < 4; ++g)
#pragma unroll
                            for (int e = 0; e < 4; ++e) { const int key = key0 + 8 * g + 4 * hi + e; if (key > qrow) S0[4 * g + e] = -INFINITY; if (key + 32 > qrow) S1[4 * g + e] = -INFINITY; } }
                    float mloc = fmaxf(S0[0], S1[0]);
#pragma unroll
                    for (int r = 1; r < 16; ++r) mloc = __builtin_fmaxf(__builtin_fmaxf(mloc, S0[r]), S1[r]);
                    mloc = fmaxf(mloc, __shfl_xor(mloc, 32));
                    if (__any(mloc > 8.0f)) { const float dl = fmaxf(mloc, 0.f), alpha = __builtin_amdgcn_exp2f(-dl); mx += dl; ls *= alpha;
#pragma unroll
                        for (int r = 0; r < 16; ++r) { S0[r] -= dl; S1[r] -= dl; }
#pragma unroll
                        for (int dt = 0; dt < 4; ++dt)
#pragma unroll
                            for (int r = 0; r < 16; ++r) O[dt][r] *= alpha; }
                    float psum = 0.f;
#pragma unroll
                    for (int r = 0; r < 16; ++r) { S0[r] = __builtin_amdgcn_exp2f(S0[r]); S1[r] = __builtin_amdgcn_exp2f(S1[r]); psum += S0[r] + S1[r]; }
                    ls += psum;
                    v4u pf[4];
#pragma unroll
                    for (int s2 = 0; s2 < 2; ++s2) { pf[s2] = (v4u){cvtpk(S0[8 * s2 + 0], S0[8 * s2 + 1]), cvtpk(S0[8 * s2 + 2], S0[8 * s2 + 3]), cvtpk(S0[8 * s2 + 4], S0[8 * s2 + 5]), cvtpk(S0[8 * s2 + 6], S0[8 * s2 + 7])};
                        pf[2 + s2] = (v4u){cvtpk(S1[8 * s2 + 0], S1[8 * s2 + 1]), cvtpk(S1[8 * s2 + 2], S1[8 * s2 + 3]), cvtpk(S1[8 * s2 + 4], S1[8 * s2 + 5]), cvtpk(S1[8 * s2 + 6], S1[8 * s2 + 7])}; }
                    const ldsp vb = sv + (4 * hi + ((lane & 15) >> 2)) * RSV + (16 * ((lane >> 4) & 1) + 4 * (lane & 3)) * 2;
#pragma unroll
                    for (int s4 = 0; s4 < 4; ++s4)
#pragma unroll
                        for (int dt = 0; dt < 4; ++dt) { const ldsp va = vb + (16 * s4) * RSV + dt * 64; const s16x4 lo = vtr(va), hv = vtr(va + 8 * RSV);
                            const bf16x8 af = (bf16x8){lo[0], lo[1], lo[2], lo[3], hv[0], hv[1], hv[2], hv[3]};
                            O[dt] = MFMA32(af, __builtin_bit_cast(bf16x8, pf[s4]), O[dt]); }
                }
            }
            ls += __shfl_xor(ls, 32);
            const float il = 1.0f / ls;
            const size_t yoff = (tok0 + qrow) * DM + h * 128 + 4 * hi;
#pragma unroll
            for (int dt = 0; dt < 4; ++dt)
#pragma unroll
                for (int g = 0; g < 4; ++g) { const v2u gv = *(const v2u*)(gs + yoff + dt * 32 + 8 * g);
                    v2u o; o.x = cvtpk(O[dt][4 * g + 0] * il * bflo(gv.x), O[dt][4 * g + 1] * il * bfhi(gv.x)); o.y = cvtpk(O[dt][4 * g + 2] * il * bflo(gv.y), O[dt][4 * g + 3] * il * bfhi(gv.y));
                    *(v2u*)(y + yoff + dt * 32 + 8 * g) = o; }
        }
    }
#undef FA_LOAD
#undef FA_STORE
}
#ifndef R_RET_CORE
#define R_RET_CORE 1
#endif
#ifndef R_RET_GN
#define R_RET_GN 1
#endif
#ifndef R_GM_SP
#define R_GM_SP 1
#endif
#ifndef R_FOX_ATTN
#define R_FOX_ATTN 1
#endif
#ifndef R_FOX_PREP
#define R_FOX_PREP 1
#endif
#ifndef R_PRO
#define R_PRO 1
#endif
#ifndef F_GU_TAIL
#define F_GU_TAIL 0
#endif

#ifndef PROBE_A
#define PROBE_A -1
#endif
#ifndef PROBE_B
#define PROBE_B -1
#endif
#ifndef PROBE_MUL
#define PROBE_MUL 4
#endif
#define STAMP_AT(id) do { if (PROBE_A >= 0 && ((id) == PROBE_A || (id) == PROBE_B)) { if (F.tid == 0) { const unsigned long long t_ = __builtin_amdgcn_s_memrealtime(); \
        volatile LAS unsigned* m_ = F.MISC + ((id) == PROBE_A ? 16 : 20); m_[0] = (unsigned)t_; m_[1] = (unsigned)(t_ >> 32); } } } while (0)
struct Args { const void* in[21]; float* out; unsigned char* ws; int ph_lo, ph_hi, li, pad; };
#define IN(k) (lo <= (k) && (k) < hi)
#define SEAM(k) do { if (N_LAUNCHES == 1 && IN(k) && IN((k) + 1)) xcd_barrier(bar); STAMP_AT(k); } while (0)
template <int L>
__device__ __forceinline__ void layer_body(Frame& F, const Args& args, const XcdBarrier& bar, const int lo, const int hi) {
    unsigned char* ws = args.ws;
    constexpr int kind = L % 3, j = L / 3, pb = 1 + 6 * L;
    float* xo = args.out;
    bf16* XB = (bf16*)(ws + WS_H);
    bf16* A0 = (bf16*)(ws + WS_A); bf16* B0 = (bf16*)(ws + WS_B); bf16* C0 = (bf16*)(ws + WS_C);
    unsigned char* misc = ws + WS_MISC;
    float* rss = (float*)(ws + WS_RSP);
    PG8_LAS float* rtab = (PG8_LAS float*)(F.lds + RSTAB_OFF);
    if (IN(pb + 0)) {
        if (kind == 0) {
            pg8::Gemm g{XB, (const bf16*)(ws + WS_W_RET_IN + j * SZ_W_RET_IN), M, RET_N, DM}; pg8::RsOrder S; S.init(M, RET_N, F.G, (int)blockIdx.x); S.rs = rss + (size_t)(2 * L) * M * 32; S.tab = rtab; S.pend = 0.f; S.nready = 0;
            pg8::EpiRetIn E{A0, A0 + (size_t)M * 2048, A0 + (size_t)M * 4096, A0 + (size_t)M * 8192, (const float*)(ws + WS_ROPE_C), (const float*)(ws + WS_ROPE_S), rtab, 0};
            pg8::gemm_phase<pg8::EpiRetIn, pg8::RsOrder, PG8_ALIGN, PG8_SP2>(F.lds + RING_OFF, g, S, E);
        } else if (kind == 1) {
            pg8::Gemm g{XB, (const bf16*)(ws + WS_W_GM_IN), M, GM_N, DM}; pg8::RsOrder S; S.init(M, GM_N, F.G, (int)blockIdx.x); S.rs = rss + (size_t)(2 * L) * M * 32; S.tab = rtab; S.pend = 0.f; S.nready = 0;
            pg8::EpiGeluUV E{A0, A0 + (size_t)M * GM_HALF, (pg8::f32x2v*)(misc + MISC_PART), rtab, 0};
            pg8::gemm_phase<pg8::EpiGeluUV, pg8::RsOrder, PG8_ALIGN, PG8_SP2>(F.lds + RING_OFF, g, S, E);
        } else {
            pg8::Gemm g{XB, (const bf16*)(ws + WS_W_FOX_IN), M, FOX_N, DM}; pg8::RsOrder S; S.init(M, FOX_N, F.G, (int)blockIdx.x); S.rs = rss + (size_t)(2 * L) * M * 32; S.tab = rtab; S.pend = 0.f; S.nready = 0;
            PG8_LAS float* qkg = (PG8_LAS float*)(F.lds + QKG_OFF);
            if (F.tid < 256) qkg[F.tid] = F.tid < 128 ? ((const float*)args.in[15])[F.tid] : ((const float*)args.in[16])[F.tid - 128];
            __syncthreads();
            pg8::EpiFoxIn E{A0, (size_t)M * 2048, rtab, 0, (PG8_LAS float*)(F.lds + QKT_OFF), qkg};
            pg8::gemm_phase<pg8::EpiFoxIn, pg8::RsOrder, PG8_ALIGN, PG8_SP2>(F.lds + RING_OFF, g, S, E);
        }
    }
    SEAM(pb + 0);
    if (IN(pb + 1)) {
        if (kind == 0) { bf16* Pb = B0 + (size_t)M * 4096;
            bf16* KFb = (bf16*)(ws + WS_KF);
            bf16* QFb = (bf16*)(ws + WS_QF);
            ret_p_phase(F, A0, A0 + (size_t)M * 2048, Pb, KFb, QFb);
            if (N_LAUNCHES == 1) xcd_barrier(bar);
            STAMP_AT(500 + L);
            for (int rep_ = 0; rep_ < R_RET_CORE; ++rep_) ret_core_phase(F, QFb, A0 + (size_t)M * 4096, Pb, KFb, B0); }
        else if (kind == 1) { gm_stat_phase(F, (const f32x2*)(misc + MISC_PART), (f32x2*)(misc + MISC_RSTAT)); }
        else { for (int rep_ = 0; rep_ < R_FOX_PREP; ++rep_) fox_prep_phase(F,
                              XB, rss + (size_t)(2 * L) * M * 32, (const float*)args.in[2] + (size_t)L * DM, (const float*)args.in[13], (const float*)args.in[14], (float*)(misc + MISC_LF)); }
    }
    SEAM(pb + 1);
    if (IN(pb + 2)) {
        if (kind == 0) { for (int rep_ = 0; rep_ < R_RET_GN; ++rep_) ret_gn_phase(F, B0, A0 + (size_t)M * 8192, (const float*)args.in[5] + (size_t)j * 4096, C0); }
        else if (kind == 1) { for (int rep_ = 0; rep_ < R_GM_SP; ++rep_) gm_spatial_phase(F, A0, A0 + (size_t)M * GM_HALF, (const f32x2*)(misc + MISC_RSTAT), (const float*)args.in[8], (const float*)args.in[9], (const bf16*)(misc + MISC_WTRI), (const float*)args.in[11], B0); }
        else { for (int rep_ = 0; rep_ < R_FOX_ATTN; ++rep_) fox_attn_phase(F, A0, A0 + (size_t)M * 2048, A0 + (size_t)M * 4096, A0 + (size_t)M * 6144, (const float*)(misc + MISC_LF), B0); }
    }
    SEAM(pb + 2);
    if (IN(pb + 3)) {
        const bf16* Ain = kind == 0 ? C0 : B0; constexpr int K = kind == 0 ? 4096 : (kind == 1 ? GM_HALF : DM);
        const bf16* Wt = kind == 0 ? (const bf16*)(ws + WS_W_RET_OUT + j * SZ_W_RET_OUT) : (kind == 1 ? (const bf16*)(ws + WS_W_GM_OUT) : (const bf16*)(ws + WS_W_FOX_OUT));
        pg8::Gemm g{Ain, Wt, M, DM, K}; pg8::StaticOrder S; S.init(M, DM, F.G, (int)blockIdx.x);
        if constexpr (L == 0) {
            pg8::EpiRes<true, false> E{(const float*)args.in[0], nullptr, XB, rss + (size_t)(2 * L + 1) * M * 32, DM};
            pg8::gemm_phase<pg8::EpiRes<true, false>, pg8::StaticOrder, PG8_ALIGN, PG8_SP2>(F.lds + RING_OFF, g, S, E);
        } else {
            pg8::EpiResP<false> E{nullptr, XB, rss + (size_t)(2 * L + 1) * M * 32, DM};
            pg8::gemm_phase<pg8::EpiResP<false>, pg8::StaticOrder, PG8_ALIGN, PG8_SP2>(F.lds + RING_OFF, g, S, E);
        }
    }
    SEAM(pb + 3);
    if (IN(pb + 4)) {
        constexpr int NFULL = (F_GU_TAIL ? 40 : 44) * 256;
        { pg8::Gemm g{XB, (const bf16*)(ws + WS_W_GU + L * SZ_W_GU), M, NFULL, DM}; pg8::RsOrder S; S.init(M, NFULL, F.G, (int)blockIdx.x); S.rs = rss + (size_t)(2 * L + 1) * M * 32; S.tab = rtab; S.pend = 0.f; S.nready = 0;
          pg8::EpiSwiglu<false> E{A0, FFN_H, rtab, 0};
          pg8::gemm_phase<pg8::EpiSwiglu<false>, pg8::RsOrder, PG8_ALIGN, PG8_SP2>(F.lds + RING_OFF, g, S, E); }
        if (F_GU_TAIL) { pg8::Gemm g{XB, (const bf16*)(ws + WS_W_GU + L * SZ_W_GU), M, FFN_N2, DM}; pg8::TailOrder S; S.init(M, FFN_N2, F.G, (int)blockIdx.x); S.rs = rss + (size_t)(2 * L + 1) * M * 32; S.tab = rtab; S.pend = 0.f; S.nready = 0; S.pn0 = 40;
          pg8::EpiSwiglu<true> E{A0, FFN_H, rtab, 0};
          pg8::gemm_phase<pg8::EpiSwiglu<true>, pg8::TailOrder, PG8_ALIGN, PG8_SP2, true>(F.lds + RING_OFF, g, S, E); }
    }
    SEAM(pb + 4);
    if (IN(pb + 5)) {
        pg8::Gemm g{A0, (const bf16*)(ws + WS_W_DN + L * SZ_W_DN), M, DM, FFN_H}; pg8::StaticOrder S; S.init(M, DM, F.G, (int)blockIdx.x);
        pg8::EpiResP<L + 1 == DEPTH> E{xo, XB, rss + (size_t)((2 * L + 2) & 7) * M * 32, DM};
        pg8::gemm_phase<pg8::EpiResP<L + 1 == DEPTH>, pg8::StaticOrder, PG8_ALIGN, PG8_SP2>(F.lds + RING_OFF, g, S, E);
    }
    SEAM(pb + 5);
}
__global__ void __launch_bounds__(NWAVES * 64, 2) trunk_fwd(Args args) {
    extern __shared__ __attribute__((aligned(16))) unsigned char lds[];
    Frame F;
    F.lds = (ldsp)lds;
    F.MISC = (volatile LAS unsigned*)(F.lds + MISC_OFF);
    F.tid = threadIdx.x; F.lane = F.tid & 63; F.wave = __builtin_amdgcn_readfirstlane(F.tid >> 6);
    F.G = gridDim.x; { const int bx = blockIdx.x; F.vcu = (F.G % 8 == 0) ? (bx % 8) * (F.G / 8) + bx / 8 : bx; }
    F.ctl = (gu32*)(args.ws + WS_CTL);
    for (int u = F.tid; u < (LDS_BYTES - LDSCTL_OFF) / 4; u += NWAVES * 64) ((LAS unsigned*)(F.lds + LDSCTL_OFF))[u] = 0u;
    __syncthreads();
    XcdBarrier bar; bar.bar = (unsigned*)(F.ctl + CW_BAR); bar.x = 0; bar.st = nullptr;
    if (N_LAUNCHES == 1) bar = xcd_barrier_post((unsigned*)(F.ctl + CW_BAR), F.MISC + 8);
    const int lo = args.ph_lo, hi = args.ph_hi;
    STAMP_AT(999);
    if (IN(0)) for (int rep_ = 0; rep_ < R_PRO; ++rep_) p0_prologue(F, args.in, args.ws);
    SEAM(0);
    layer_body<0>(F, args, bar, lo, hi); layer_body<1>(F, args, bar, lo, hi); layer_body<2>(F, args, bar, lo, hi); layer_body<3>(F, args, bar, lo, hi);
    if (PROBE_A >= 0 && F.tid == 0) {
        const unsigned long long ta = ((unsigned long long)F.MISC[17] << 32) | F.MISC[16], tb = ((unsigned long long)F.MISC[21] << 32) | F.MISC[20];
        const unsigned long long dly = (tb - ta) * (unsigned long long)PROBE_MUL, t0 = __builtin_amdgcn_s_memrealtime();
        if (tb > ta && dly < 400000ull) while (__builtin_amdgcn_s_memrealtime() - t0 < dly) __builtin_amdgcn_s_sleep(16);
    }
}
#undef IN
#undef SEAM

extern "C" void kernel_launch(void* const* d_in, const int* in_sizes, int n_in, void* d_out, int out_size, void* d_ws, size_t ws_size, hipStream_t stream) {
    static int grid = 0;
    if (grid == 0) {
        if (n_in != 21 || in_sizes[0] != M * DM || out_size != M * DM || ws_size < WS_END) { fprintf(stderr, "kernel_launch: unexpected shapes (n_in %d, in0 %d, out %d, ws %zu); nothing launched\n", n_in, n_in > 0 ? in_sizes[0] : -1, out_size, ws_size); grid = -1; return; }
        int dev = 0, cus = 0, per_cu = 0;
        if (hipGetDevice(&dev) != hipSuccess || hipDeviceGetAttribute(&cus, hipDeviceAttributeMultiprocessorCount, dev) != hipSuccess) { grid = -1; return; }
        if (hipFuncSetAttribute((const void*)trunk_fwd, hipFuncAttributeMaxDynamicSharedMemorySize, LDS_BYTES) != hipSuccess) { fprintf(stderr, "kernel_launch: hipFuncSetAttribute failed\n"); grid = -1; return; }
        if (hipOccupancyMaxActiveBlocksPerMultiprocessor(&per_cu, (const void*)trunk_fwd, NWAVES * 64, LDS_BYTES) != hipSuccess || per_cu < 1)
            fprintf(stderr, "kernel_launch: note: occupancy query reports %d workgroups per CU\n", per_cu);
        (void)hipGetLastError();
        grid = cus;
    }
    if (grid < 0) return;
    if (hipMemsetAsync((char*)d_ws + WS_CTL, 0, CTL_ZERO_BYTES, stream) != hipSuccess) return;
    Args a{};
    for (int i = 0; i < 21; ++i) a.in[i] = d_in[i];
    a.out = (float*)d_out; a.ws = (unsigned char*)d_ws;
    for (int li = 0; li < N_LAUNCHES; ++li) {
        a.ph_lo = (N_LAUNCHES == 1) ? 0 : li; a.ph_hi = (N_LAUNCHES == 1) ? N_PHASES : li + 1; a.li = li; a.pad = 0;
        hipLaunchKernelGGL(trunk_fwd, dim3(grid), dim3(NWAVES * 64), LDS_BYTES, stream, a);
        const hipError_t le = hipPeekAtLastError();
        if (le != hipSuccess) { fprintf(stderr, "kernel_launch: launch %d failed: %s\n", li, hipGetErrorName(le)); break; }
    }
}
```

```cpp
#define PG8_WGM 4
#include <hip/hip_runtime.h>
#include <cstdio>
#include <cstdint>
#include <cmath>
namespace pg8 {
#define PG8_LAS __attribute__((address_space(3)))
typedef unsigned short bf16_t;
typedef short bf16x8 __attribute__((ext_vector_type(8)));
typedef float f32x4 __attribute__((ext_vector_type(4)));
typedef unsigned u32x4 __attribute__((ext_vector_type(4)));
constexpr int BM = 256, BK = 64, HALF = 128, HTB = HALF * BK * 2  , STAGE_BYTES = 8 * HTB, NXCD = 8, WGM = PG8_WGM;

__host__ __device__ __forceinline__ int lds_byte(int r, int c) { const int st = (r >> 4) * 2 + (c >> 5), rr = r & 15, cc = c & 31, ob = rr * 64 + cc * 2; return st * 1024 + (ob ^ (((ob >> 9) & 1) << 5)); }
__host__ __device__ __forceinline__ void stage_rc(int b, int& R, int& C) { const int st = b / 1024, sb = b % 1024, swz = sb ^ (((sb >> 9) & 1) << 5); R = (st >> 1) * 16 + swz / 64; C = (st & 1) * 32 + (swz % 64) / 2; }
__host__ __device__ __forceinline__ int perm32(int rho) { const int n = rho >> 4, i = rho & 15; return 8 * (i >> 2) + 4 * n + (i & 3); }

struct Unit { int pm, pn, hf; };
struct Gemm { const bf16_t* A; const bf16_t* Bt; int M, N, K; };

struct StaticOrder {
    int nM, nN, nwg, G, c;
    __host__ __device__ void init(int M, int N, int G_, int c_) { nM = M / BM; nN = N / BM; nwg = nM * nN; G = G_; c = c_; }
    __host__ __device__ bool next(int i, Unit& u) const {
        const long L = (long)i * G + c; if (L >= nwg) return false;
        int wgid = (int)L; { const int q = nwg / NXCD, r = nwg % NXCD, xcd = wgid % NXCD, off = wgid / NXCD; wgid = (xcd < r ? xcd * (q + 1) : r * (q + 1) + (xcd - r) * q) + off; }
        const int nig = WGM * nN, gid = wgid / nig, fm = gid * WGM, gsz = (nM - fm) < WGM ? (nM - fm) : WGM;
        u.pm = fm + ((wgid % nig) % gsz); u.pn = (wgid % nig) / gsz; u.hf = 0; return true;
    }
    __device__ __forceinline__ void a_ready(const Unit&) const {}
    __device__ __forceinline__ void done(const Unit&) const {}
};

__device__ __forceinline__ unsigned cvt_pk_bf16(float lo, float hi) { unsigned r; asm volatile("v_cvt_pk_bf16_f32 %0, %1, %2" : "=v"(r) : "v"(lo), "v"(hi)); return r; }
typedef float f32x2 __attribute__((ext_vector_type(2)));
__device__ __forceinline__ f32x2 gelu_pk(f32x2 v) {
    const f32x2 av = __builtin_elementwise_abs(v), d = av * 0.2316418882f + 1.0f;
    f32x2 t; t.x = __builtin_amdgcn_rcpf(d.x); t.y = __builtin_amdgcn_rcpf(d.y);
    f32x2 q = t * 0.5307027145f + (-0.7265760135f); q = q * t + 0.7107068705f; q = q * t + (-0.142248368f); q = q * t + 0.127414796f; q = q * t;
    const f32x2 s = (v * v) * (-0.72134752044f);
    f32x2 e; e.x = __builtin_amdgcn_exp2f(s.x); e.y = __builtin_amdgcn_exp2f(s.y);
    const f32x2 m = v * (q * e), r = v - m;
    f32x2 o; o.x = v.x < 0.f ? m.x : r.x; o.y = v.y < 0.f ? m.y : r.y; return o;
}

typedef float f32x2v __attribute__((ext_vector_type(2)));
typedef __bf16 bf16x2v __attribute__((ext_vector_type(2)));
__device__ __forceinline__ unsigned cvtpk(float lo, float hi) { f32x2v v = {lo, hi}; bf16x2v b = __builtin_convertvector(v, bf16x2v); return __builtin_bit_cast(unsigned, b); }
__device__ __forceinline__ u32x4 pack8(const f32x4 a, const f32x4 b) { u32x4 w; w.x = cvtpk(a[0], a[1]); w.y = cvtpk(a[2], a[3]); w.z = cvtpk(b[0], b[1]); w.w = cvtpk(b[2], b[3]); return w; }
#ifndef EPI_WT
#define EPI_WT 0
#endif
__device__ __forceinline__ void st16(void* p, const u32x4 v) {
#if EPI_WT
    asm volatile("global_store_dwordx4 %0, %1, off sc1\n\ts_nop 2" :: "v"(p), "v"(v) : "memory");
#else
    *(u32x4*)p = v;
#endif
}
__device__ __forceinline__ float fast_sigmoid(float x) { return __builtin_amdgcn_rcpf(1.0f + __builtin_amdgcn_exp2f(-1.44269504f * x)); }

template <bool BASE_F32, bool OUT_F32> struct EpiRes {
    static constexpr bool PERM = true, AFTER_DRAIN = false, RESID = false;
    const float* base; float* out; bf16_t* xb; float* rs; int ldc;
    __device__ __forceinline__ void operator()(const f32x4 (&acc)[2][2][4][2], const Unit& u, int wr, int wc, int fr, int fq) const {
        const int row0 = u.pm * BM + wr * 64 + fr, col0 = u.pn * BM + wc * 32 + 8 * fq;
#pragma unroll
        for (int ai = 0; ai < 2; ++ai)
#pragma unroll
            for (int m = 0; m < 4; ++m) { const int row = row0 + ai * HALF + m * 16; const size_t off = (size_t)row * ldc + col0; float ss = 0.f;
#pragma unroll
                for (int bj = 0; bj < 2; ++bj) { f32x4 b0, b1;
                    if (BASE_F32) { b0 = *(const f32x4*)(base + off + bj * HALF); b1 = *(const f32x4*)(base + off + bj * HALF + 4); }
                    else { const u32x4 w = *(const u32x4*)(xb + off + bj * HALF);
                        b0 = (f32x4){__uint_as_float(w.x << 16), __uint_as_float(w.x & 0xffff0000u), __uint_as_float(w.y << 16), __uint_as_float(w.y & 0xffff0000u)};
                        b1 = (f32x4){__uint_as_float(w.z << 16), __uint_as_float(w.z & 0xffff0000u), __uint_as_float(w.w << 16), __uint_as_float(w.w & 0xffff0000u)}; }
                    const f32x4 x0 = b0 + acc[ai][bj][m][0], x1 = b1 + acc[ai][bj][m][1];
                    if (OUT_F32) { *(f32x4*)(out + off + bj * HALF) = x0; *(f32x4*)(out + off + bj * HALF + 4) = x1; }
                    else st16(xb + off + bj * HALF, pack8(x0, x1));
                    ss += (x0[0] * x0[0] + x0[1] * x0[1]) + (x0[2] * x0[2] + x0[3] * x0[3]) + (x1[0] * x1[0] + x1[1] * x1[1]) + (x1[2] * x1[2] + x1[3] * x1[3]); }
                if (!OUT_F32) { ss += __shfl_xor(ss, 16); ss += __shfl_xor(ss, 32);
                    if (fq == 0) rs[(size_t)row * 32 + u.pn * 4 + wc] = ss; }
                }
    }
};
template <bool OUT_F32> struct EpiResP {
    static constexpr bool PERM = true, AFTER_DRAIN = true, RESID = true;
    float* out; bf16_t* xb; float* rs; int ldc;
    __device__ __forceinline__ void fused(f32x4 (&acc)[2][2][4][2], const Unit& u, int wr, int wc, int fr, int fq, PG8_LAS unsigned char* lds, int wid, int lane) const {
        const int row0 = u.pm * BM + wr * 64 + fr, col0 = u.pn * BM + wc * 32 + 8 * fq, wh = wc >> 1;
        u32x4 g7[4];
        if (wh) {
#pragma unroll
            for (int m = 0; m < 4; ++m) g7[m] = *(const u32x4*)(xb + (size_t)(row0 + HALF + m * 16) * ldc + col0 + HALF); }
#pragma unroll
        for (int ai = 0; ai < 2; ++ai)
#pragma unroll
            for (int m = 0; m < 4; ++m) { const int row = row0 + ai * HALF + m * 16; const size_t off = (size_t)row * ldc + col0; float ss = 0.f;
                const int lb = lds_byte(wr * 64 + m * 16 + fr, (wc & 1) * 32 + 8 * fq);
#pragma unroll
                for (int bj = 0; bj < 2; ++bj) {
                    const int s0 = (ai == 0 && bj == 0) ? 4 : (ai == 1 && bj == 0) ? 5 : (ai == 0 && bj == 1) ? 6 : 7;
                    const int s1 = (ai == 0 && bj == 0) ? 0 : (ai == 1 && bj == 0) ? 1 : 2;
                    u32x4 w;
                    if (ai == 1 && bj == 1) { if (wh) w = g7[m]; else w = *(const PG8_LAS u32x4*)(lds + s0 * HTB + lb); }
                    else w = *(const PG8_LAS u32x4*)(lds + (wh ? s1 : s0) * HTB + lb);
                    const f32x4 b0 = {__uint_as_float(w.x << 16), __uint_as_float(w.x & 0xffff0000u), __uint_as_float(w.y << 16), __uint_as_float(w.y & 0xffff0000u)};
                    const f32x4 b1 = {__uint_as_float(w.z << 16), __uint_as_float(w.z & 0xffff0000u), __uint_as_float(w.w << 16), __uint_as_float(w.w & 0xffff0000u)};
                    const f32x4 x0 = b0 + acc[ai][bj][m][0], x1 = b1 + acc[ai][bj][m][1];
                    if (OUT_F32) { *(f32x4*)(out + off + bj * HALF) = x0; *(f32x4*)(out + off + bj * HALF + 4) = x1; }
                    else st16(xb + off + bj * HALF, pack8(x0, x1));
                    ss += (x0[0] * x0[0] + x0[1] * x0[1]) + (x0[2] * x0[2] + x0[3] * x0[3]) + (x1[0] * x1[0] + x1[1] * x1[1]) + (x1[2] * x1[2] + x1[3] * x1[3]); }
                if (!OUT_F32) { ss += __shfl_xor(ss, 16); ss += __shfl_xor(ss, 32);
                    if (fq == 0) rs[(size_t)row * 32 + u.pn * 4 + wc] = ss; } }
    }
};
__device__ __forceinline__ float row_sumsq(const float* rs, int row) {
    const f32x4* p = (const f32x4*)(rs + (size_t)row * 32); f32x4 t = p[0];
#pragma unroll
    for (int i = 1; i < 8; ++i) t += p[i];
    return (t[0] + t[1]) + (t[2] + t[3]);
}
__device__ __forceinline__ float row_rstd(const float* rs, int row) { return 1.0f / sqrtf(row_sumsq(rs, row) * (1.0f / 2048.0f) + 1e-6f); }
struct RsOrder : StaticOrder {
    const float* rs; PG8_LAS float* tab; mutable float pend; mutable int nready;
    __device__ __forceinline__ void a_ready(const Unit& u) const {
        if (threadIdx.x < 256) pend = row_sumsq(rs, u.pm * BM + u.hf * HALF + threadIdx.x);
        ++nready;
    }
    __device__ __forceinline__ bool next(int i, Unit& u) const {
        if (i == 1 && threadIdx.x < 256) tab[threadIdx.x] = 1.0f / sqrtf(pend * (1.0f / 2048.0f) + 1e-6f);
        return StaticOrder::next(i, u);
    }
    __device__ __forceinline__ void done(const Unit&) const {
        if (threadIdx.x < 256) tab[((nready - 1) & 1) * 256 + threadIdx.x] = 1.0f / sqrtf(pend * (1.0f / 2048.0f) + 1e-6f);
    }
};
struct TailOrder : RsOrder {
    int pn0;
    __device__ __forceinline__ bool next(int i, Unit& u) const {
        if (i == 1 && threadIdx.x < 256) tab[threadIdx.x] = 1.0f / sqrtf(pend * (1.0f / 2048.0f) + 1e-6f);
        if (i != 0 || G != 256) return false;
        const int x = c & 7, l = c >> 3; u.pm = 4 * x + (l & 3); u.hf = (l >> 2) & 1; u.pn = pn0 + (l >> 3); return true;
    }
};
template <bool HALF_M> struct EpiSwiglu {
    static constexpr bool PERM = true, AFTER_DRAIN = false, RESID = false;
    bf16_t* O; int ldc; const PG8_LAS float* tab; mutable int ui;
    __device__ __forceinline__ void operator()(const f32x4 (&acc)[2][2][4][2], const Unit& u, int wr, int wc, int fr, int fq) const {
        const int row0 = u.pm * BM + (HALF_M ? u.hf * HALF : 0) + wr * 64 + fr, col0 = u.pn * HALF + wc * 32 + 8 * fq;
#pragma unroll
        for (int ai = 0; ai < (HALF_M ? 1 : 2); ++ai)
#pragma unroll
            for (int m = 0; m < 4; ++m) { bf16_t* rowp = O + (size_t)(row0 + ai * HALF + m * 16) * ldc + col0; const float r = tab[(ui & 1) * 256 + wr * 64 + fr + ai * HALF + m * 16];
                f32x4 v0, v1;
#pragma unroll
                for (int j = 0; j < 4; ++j) { const float g0 = acc[ai][0][m][0][j] * r, g1 = acc[ai][0][m][1][j] * r;
                    v0[j] = g0 * fast_sigmoid(g0) * (acc[ai][1][m][0][j] * r); v1[j] = g1 * fast_sigmoid(g1) * (acc[ai][1][m][1][j] * r); }
                st16(rowp, pack8(v0, v1)); }
        ++ui;
    }
};

struct EpiSwigluProbe {
    static constexpr bool PERM = true, AFTER_DRAIN = false, RESID = false;
    bf16_t* O; int never;
    __device__ __forceinline__ void operator()(const f32x4 (&acc)[2][2][4][2], const Unit& u, int wr, int wc, int fr, int fq) const {
        if (never) {
#pragma unroll
        for (int ai = 0; ai < 2; ++ai)
#pragma unroll
            for (int m = 0; m < 4; ++m) { bf16_t* rowp = O + (size_t)(u.pm * BM + wr * 64 + fr + ai * HALF + m * 16) * 5632 + u.pn * HALF + wc * 32 + 8 * fq;
                st16(rowp, pack8(acc[ai][0][m][0] + acc[ai][1][m][0], acc[ai][0][m][1] + acc[ai][1][m][1])); } }
    }
};
struct EpiRetIn {
    static constexpr bool PERM = true, AFTER_DRAIN = false, RESID = false;
    bf16_t *q, *k, *v, *g; const float *cs, *sn; const PG8_LAS float* tab; mutable int ui;
    __device__ __forceinline__ void operator()(const f32x4 (&acc)[2][2][4][2], const Unit& u, int wr, int wc, int fr, int fq) const {
        const int pn = u.pn, ci = wc * 32 + 8 * fq;
#pragma unroll
        for (int ai = 0; ai < 2; ++ai)
#pragma unroll
            for (int m = 0; m < 4; ++m) {
                const int row = u.pm * BM + ai * HALF + wr * 64 + m * 16 + fr, b = row >> 12, s = row & 4095; const float rr = tab[(ui & 1) * 256 + ai * HALF + wr * 64 + m * 16 + fr];
                if (pn < 16) {
                    const int h = pn & 7; const float sc = (pn < 8 ? 1.0f : 0.0625f) * rr;
                    bf16_t* dst = (pn < 8 ? q : k) + ((size_t)((b * 8 + h) * 4096 + s)) * 256 + ci;
                    f32x4 o1[2], o2[2];
#pragma unroll
                    for (int n = 0; n < 2; ++n) { const f32x4 c4 = *(const f32x4*)(cs + (size_t)row * 128 + ci + 4 * n), s4 = *(const f32x4*)(sn + (size_t)row * 128 + ci + 4 * n);
                        const f32x4 x1 = acc[ai][0][m][n], x2 = acc[ai][1][m][n];
                        o1[n] = (x1 * c4 - x2 * s4) * sc; o2[n] = (x2 * c4 + x1 * s4) * sc; }
                    st16(dst, pack8(o1[0], o1[1])); st16(dst + 128, pack8(o2[0], o2[1]));
                } else if (pn < 32) {
                    const int t = pn - 16, h = t >> 1, hf = t & 1;
                    bf16_t* dst = v + ((size_t)((b * 8 + h) * 4096 + s)) * 512 + hf * 256 + ci;
                    st16(dst, pack8(acc[ai][0][m][0] * rr, acc[ai][0][m][1] * rr)); st16(dst + 128, pack8(acc[ai][1][m][0] * rr, acc[ai][1][m][1] * rr));
                } else {
                    bf16_t* dst = g + (size_t)row * 4096 + (pn - 32) * 256 + ci;
                    st16(dst, pack8(acc[ai][0][m][0] * rr, acc[ai][0][m][1] * rr)); st16(dst + 128, pack8(acc[ai][1][m][0] * rr, acc[ai][1][m][1] * rr));
                }
            }
        ++ui;
    }
};
struct EpiGeluUV {
    static constexpr bool PERM = true, AFTER_DRAIN = false, RESID = false;
    bf16_t *uo, *vo; f32x2v* part; const PG8_LAS float* tab; mutable int ui;
    __device__ __forceinline__ void operator()(const f32x4 (&acc)[2][2][4][2], const Unit& u, int wr, int wc, int fr, int fq) const {
        const bool isv = u.pn >= 24; const int ct = isv ? u.pn - 24 : u.pn; bf16_t* dstb = isv ? vo : uo;
#pragma unroll
        for (int ai = 0; ai < 2; ++ai)
#pragma unroll
            for (int m = 0; m < 4; ++m) {
                const int row = u.pm * BM + ai * HALF + wr * 64 + m * 16 + fr;
                bf16_t* dst = dstb + (size_t)row * 6144 + ct * 256 + wc * 32 + 8 * fq;
                float s = 0.f, ss = 0.f; const float rr = tab[(ui & 1) * 256 + ai * HALF + wr * 64 + m * 16 + fr];
#pragma unroll
                for (int bj = 0; bj < 2; ++bj) { const f32x4 v0 = acc[ai][bj][m][0] * rr, v1 = acc[ai][bj][m][1] * rr;
                    const f32x2 a = gelu_pk((f32x2){v0[0], v0[1]}), b = gelu_pk((f32x2){v0[2], v0[3]}), c = gelu_pk((f32x2){v1[0], v1[1]}), d = gelu_pk((f32x2){v1[2], v1[3]});
                    const f32x4 z0 = {a.x, a.y, b.x, b.y}, z1 = {c.x, c.y, d.x, d.y};
                    st16(dst + bj * HALF, pack8(z0, z1));
                    s += (z0[0] + z0[1]) + (z0[2] + z0[3]) + (z1[0] + z1[1]) + (z1[2] + z1[3]);
                    ss += (z0[0] * z0[0] + z0[1] * z0[1]) + (z0[2] * z0[2] + z0[3] * z0[3]) + (z1[0] * z1[0] + z1[1] * z1[1]) + (z1[2] * z1[2] + z1[3] * z1[3]); }
                if (isv) { s += __shfl_xor(s, 16); s += __shfl_xor(s, 32); ss += __shfl_xor(ss, 16); ss += __shfl_xor(ss, 32);
                    if (fq == 0) part[((size_t)row * 24 + ct) * 4 + wc] = (f32x2v){s, ss}; }
            }
        ++ui;
    }
};
struct EpiFoxIn {
    static constexpr bool PERM = true, AFTER_DRAIN = false, RESID = false;
    bf16_t* O; size_t stride; const PG8_LAS float* tab; mutable int ui; PG8_LAS float* qkt; const PG8_LAS float* gains;
    __device__ __forceinline__ void operator()(const f32x4 (&acc)[2][2][4][2], const Unit& u, int wr, int wc, int fr, int fq) const {
        const int t = u.pn >> 3; bf16_t* base = O + (size_t)t * stride + (u.pn & 7) * 256 + wc * 32 + 8 * fq;
        if (t < 2) {
#pragma unroll
            for (int ai = 0; ai < 2; ++ai)
#pragma unroll
                for (int m = 0; m < 4; ++m) { const int rt = ai * HALF + wr * 64 + m * 16 + fr; const float rr = tab[(ui & 1) * 256 + rt];
#pragma unroll
                    for (int bj = 0; bj < 2; ++bj) { const f32x4 v0 = acc[ai][bj][m][0] * rr, v1 = acc[ai][bj][m][1] * rr;
                        float ss = (v0[0] * v0[0] + v0[1] * v0[1]) + (v0[2] * v0[2] + v0[3] * v0[3]) + (v1[0] * v1[0] + v1[1] * v1[1]) + (v1[2] * v1[2] + v1[3] * v1[3]);
                        ss += __shfl_xor(ss, 16); ss += __shfl_xor(ss, 32);
                        if (fq == 0) qkt[(rt * 2 + bj) * 4 + wc] = ss; } }
            asm volatile("s_waitcnt lgkmcnt(0)" ::: "memory"); __builtin_amdgcn_s_barrier(); asm volatile("" ::: "memory");
            const float sc = t == 0 ? 0.08838834764831845f * 1.4426950408889634f : 1.0f;
            const f32x4 g0 = *(const PG8_LAS f32x4*)(gains + t * 128 + wc * 32 + 8 * fq), g1 = *(const PG8_LAS f32x4*)(gains + t * 128 + wc * 32 + 8 * fq + 4);
#pragma unroll
            for (int ai = 0; ai < 2; ++ai)
#pragma unroll
                for (int m = 0; m < 4; ++m) { const int rt = ai * HALF + wr * 64 + m * 16 + fr; const float rr = tab[(ui & 1) * 256 + rt]; bf16_t* dst = base + (size_t)(u.pm * BM + rt) * 2048;
#pragma unroll
                    for (int bj = 0; bj < 2; ++bj) { const f32x4 p = *(const PG8_LAS f32x4*)(qkt + (rt * 2 + bj) * 4);
                        const float rs = rr * sc / sqrtf(((p[0] + p[1]) + (p[2] + p[3])) * (1.0f / 128.0f) + 1e-6f);
                        st16(dst + bj * HALF, pack8(acc[ai][bj][m][0] * rs * g0, acc[ai][bj][m][1] * rs * g1)); } }
        } else {
#pragma unroll
            for (int ai = 0; ai < 2; ++ai)
#pragma unroll
                for (int m = 0; m < 4; ++m) { const int row = u.pm * BM + ai * HALF + wr * 64 + m * 16 + fr; bf16_t* dst = base + (size_t)row * 2048; const float rr = tab[(ui & 1) * 256 + ai * HALF + wr * 64 + m * 16 + fr];
#pragma unroll
                    for (int bj = 0; bj < 2; ++bj) { f32x4 v0 = acc[ai][bj][m][0] * rr, v1 = acc[ai][bj][m][1] * rr;
                        if (t == 3) {
#pragma unroll
                            for (int j = 0; j < 4; ++j) { v0[j] = fast_sigmoid(v0[j]); v1[j] = fast_sigmoid(v1[j]); } }
                        st16(dst + bj * HALF, pack8(v0, v1)); } }
        }
        ++ui;
    }
};

template <class Epi, class Sched, bool ALIGN_EPI = false, bool SP2 = false, bool HALF_M = false, int ABL = 0>
__device__ __forceinline__ void gemm_phase(PG8_LAS unsigned char* lds, const Gemm g, const Sched& S, const Epi& E) {
    const int tid = threadIdx.x, wid = __builtin_amdgcn_readfirstlane(tid >> 6), lane = tid & 63, wr = wid >> 2, wc = wid & 3, fr = lane & 15, fq = lane >> 4;
    static_assert(!HALF_M || SP2, "HALF_M is written for the SP2 loop");
    const int K = g.K, nt = K / BK;
    unsigned voffA[2], voffB[2];
#pragma unroll
    for (int i = 0; i < 2; ++i) { int R, C; stage_rc(tid * 16 + i * 8192, R, C); const int Rb = Epi::PERM ? ((R & ~31) + perm32(R & 31)) : R;
        voffA[i] = (unsigned)(R * K + C) * 2u; voffB[i] = (unsigned)(Rb * K + C) * 2u; }
    unsigned voffR[2] = {0u, 0u};
    if constexpr (Epi::RESID) {
#pragma unroll
        for (int i = 0; i < 2; ++i) { int R, C; stage_rc(tid * 16 + i * 8192, R, C); voffR[i] = (unsigned)(R * E.ldc + C) * 2u; } }
    const size_t kstep = (size_t)(BK * 2);
    const size_t hstep = (size_t)HALF * K * 2;
    const size_t tstep = 2 * hstep;
    const unsigned ldsw = (unsigned)wid * 1024u;
    const int aoff = lds_byte(wr * 64 + fr, fq * 8), boff = lds_byte(wc * 32 + fr, fq * 8);
#define PG8_SA(b, h) (((b) * 2 + (h)) * HTB)
#define PG8_SB(b, h) ((4 + (b) * 2 + (h)) * HTB)
#define PG8_STAGE(bufoff, gbase, voff) do { if constexpr (!(ABL & 2)) _Pragma("unroll") for (int _i = 0; _i < 2; ++_i) \
        __builtin_amdgcn_global_load_lds((const unsigned*)((const char*)(gbase) + (voff)[_i]), (PG8_LAS unsigned*)(lds + (bufoff) + ldsw + _i * 8192), 16, 0, 0); } while (0)
#define PG8_LDA(dst, b, h) do { if constexpr (!(ABL & 4)) { _Pragma("unroll") for (int m = 0; m < 4; ++m) _Pragma("unroll") for (int k = 0; k < 2; ++k) { dst[m][k] = *(const PG8_LAS bf16x8*)(lds + PG8_SA(b, h) + aoff + m * 2048 + k * 1024); if constexpr (ABL & 1) asm volatile("" :: "v"(dst[m][k])); } } } while (0)
#define PG8_LDB(dst, b, h) do { if constexpr (!(ABL & 4)) { _Pragma("unroll") for (int n = 0; n < 2; ++n) _Pragma("unroll") for (int k = 0; k < 2; ++k) { dst[n][k] = *(const PG8_LAS bf16x8*)(lds + PG8_SB(b, h) + boff + n * 2048 + k * 1024); if constexpr (ABL & 1) asm volatile("" :: "v"(dst[n][k])); } } } while (0)
#define PG8_MMA(ai, bj, At, Bt) do { if constexpr (!(ABL & 1)) { __builtin_amdgcn_s_setprio(1); _Pragma("unroll") for (int m = 0; m < 4; ++m) _Pragma("unroll") for (int n = 0; n < 2; ++n) _Pragma("unroll") for (int k = 0; k < 2; ++k) \
        acc[ai][bj][m][n] = __builtin_amdgcn_mfma_f32_16x16x32_bf16(Bt[n][k], At[m][k], acc[ai][bj][m][n], 0, 0, 0); __builtin_amdgcn_s_setprio(0); } } while (0)
#define PG8_WAIT_V(n) asm volatile("s_waitcnt vmcnt(" #n ")" ::: "memory")
#define PG8_WAIT_L(n) asm volatile("s_waitcnt lgkmcnt(" #n ")" ::: "memory")
#define PG8_BAR __builtin_amdgcn_s_barrier()
#define PG8_SCHED __builtin_amdgcn_sched_barrier(0)
    Unit cur, nxt; int ui = 0;
    if (!S.next(0, cur)) return;
    f32x4 acc[2][2][4][2];
#pragma unroll
    for (int a = 0; a < 2; ++a)
#pragma unroll
        for (int b = 0; b < 2; ++b)
#pragma unroll
            for (int m = 0; m < 4; ++m)
#pragma unroll
                for (int n = 0; n < 2; ++n) acc[a][b][m][n] = (f32x4){0.f, 0.f, 0.f, 0.f};
    bf16x8 At[4][2], B0[2][2], B1[2][2];
    if constexpr (ABL & 4) { _Pragma("unroll") for (int m = 0; m < 4; ++m) _Pragma("unroll") for (int k = 0; k < 2; ++k) At[m][k] = (bf16x8){(short)lane, 1, 2, 3, 4, 5, 6, 7};
        _Pragma("unroll") for (int n = 0; n < 2; ++n) _Pragma("unroll") for (int k = 0; k < 2; ++k) { B0[n][k] = (bf16x8){(short)lane, 1, 2, 3, 4, 5, 6, 7}; B1[n][k] = B0[n][k]; } }
    const char* cA = (const char*)g.A + (size_t)cur.pm * tstep + (HALF_M ? (size_t)cur.hf * hstep : (size_t)0); const char* cB = (const char*)g.Bt + (size_t)cur.pn * tstep;
    S.a_ready(cur);
    if constexpr (SP2) {
        PG8_STAGE(PG8_SB(0, 0), cB, voffB); PG8_STAGE(PG8_SB(0, 1), cB + hstep, voffB); PG8_STAGE(PG8_SA(0, 0), cA, voffA); PG8_STAGE(PG8_SA(0, 1), cA + hstep, voffA);
        if (wr == 1) PG8_BAR;
        PG8_WAIT_V(2); PG8_BAR;
        PG8_STAGE(PG8_SB(1, 0), cB + kstep, voffB); PG8_STAGE(PG8_SA(1, 0), cA + kstep, voffA); PG8_STAGE(PG8_SB(1, 1), cB + hstep + kstep, voffB);
        PG8_WAIT_V(6); PG8_BAR;
    } else {
        PG8_STAGE(PG8_SB(0, 0), cB, voffB); PG8_STAGE(PG8_SA(0, 0), cA, voffA); PG8_STAGE(PG8_SB(0, 1), cB + hstep, voffB); PG8_STAGE(PG8_SA(0, 1), cA + hstep, voffA);
        if (wr == 1) PG8_BAR;
        PG8_WAIT_V(4); PG8_BAR;
        PG8_STAGE(PG8_SB(1, 0), cB + kstep, voffB); PG8_STAGE(PG8_SA(1, 0), cA + kstep, voffA); PG8_STAGE(PG8_SB(1, 1), cB + hstep + kstep, voffB);
        PG8_WAIT_V(6); PG8_BAR;
    }
    for (;;) {
        const bool has_next = S.next(ui + 1, nxt);
        const char* nA = has_next ? (const char*)g.A + (size_t)nxt.pm * tstep + (HALF_M ? (size_t)nxt.hf * hstep : (size_t)0) : cA; const char* nB = has_next ? (const char*)g.Bt + (size_t)nxt.pn * tstep : cB;
        for (int t = 0; t < nt; t += 2) {
            const bool last = (t == nt - 2);
            const char* a1 = cA + (size_t)(t + 1) * kstep;
            const char* a2 = last ? nA : cA + (size_t)(t + 2) * kstep; const char* b2 = last ? nB : cB + (size_t)(t + 2) * kstep;
            const char* a3 = a2 + kstep; const char* b3 = b2 + kstep;
            if (last && has_next) S.a_ready(nxt);
            bool rp = false; const char* rbase = nullptr; size_t rhstep = 0;
            if constexpr (Epi::RESID) { rp = last && !has_next; rbase = (const char*)E.xb + ((size_t)cur.pm * BM * E.ldc + (size_t)cur.pn * BM) * 2; rhstep = (size_t)HALF * E.ldc * 2; }
#define PG8_STAGE_R(bufoff, gbase, voff, blk) do { if constexpr (Epi::RESID) { const char* g_ = rp ? (rbase + ((blk) & 1) * rhstep + ((blk) >> 1) * 128) : (const char*)(gbase); \
                _Pragma("unroll") for (int _i = 0; _i < 2; ++_i) __builtin_amdgcn_global_load_lds((const unsigned*)(g_ + (rp ? voffR[_i] : (voff)[_i])), (PG8_LAS unsigned*)(lds + (bufoff) + ldsw + _i * 8192), 16, 0, 0); } \
            else { PG8_STAGE(bufoff, gbase, voff); } } while (0)
            if constexpr (SP2) {
            PG8_LDB(B0, 0, 0); PG8_LDB(B1, 0, 1); PG8_SCHED; PG8_LDA(At, 0, 0); PG8_STAGE(PG8_SA(1, 1), a1 + hstep, voffA);
            PG8_WAIT_V(8); PG8_WAIT_L(0); PG8_BAR; PG8_MMA(0, 0, At, B0); PG8_MMA(0, 1, At, B1); PG8_BAR; PG8_SCHED;
            if constexpr (!HALF_M) { PG8_LDA(At, 0, 1); } PG8_STAGE_R(PG8_SB(0, 0), b2, voffB, 0); PG8_STAGE_R(PG8_SB(0, 1), b2 + hstep, voffB, 1); PG8_STAGE_R(PG8_SA(0, 0), a2, voffA, 2);
            PG8_WAIT_V(8); PG8_WAIT_L(0); PG8_BAR; if constexpr (!HALF_M) { PG8_MMA(1, 0, At, B0); PG8_MMA(1, 1, At, B1); } PG8_BAR; PG8_SCHED;
            PG8_LDB(B0, 1, 0); PG8_LDB(B1, 1, 1); PG8_SCHED; PG8_LDA(At, 1, 0); PG8_STAGE_R(PG8_SA(0, 1), a2 + hstep, voffA, 3);
            PG8_WAIT_V(8); PG8_WAIT_L(0); PG8_BAR; PG8_MMA(0, 0, At, B0); PG8_MMA(0, 1, At, B1); PG8_BAR; PG8_SCHED;
            if constexpr (!HALF_M) { PG8_LDA(At, 1, 1); } PG8_STAGE_R(PG8_SB(1, 0), b3, voffB, 4); PG8_STAGE_R(PG8_SB(1, 1), b3 + hstep, voffB, 5); PG8_STAGE_R(PG8_SA(1, 0), a3, voffA, 6);
            PG8_WAIT_V(8); PG8_WAIT_L(0); PG8_BAR; if constexpr (!HALF_M) { PG8_MMA(1, 0, At, B0); PG8_MMA(1, 1, At, B1); } PG8_BAR; PG8_SCHED;
            } else {
            PG8_LDB(B0, 0, 0); PG8_SCHED; PG8_LDA(At, 0, 0); PG8_STAGE(PG8_SA(1, 1), a1 + hstep, voffA);
            PG8_WAIT_L(8); PG8_BAR; PG8_WAIT_L(0); PG8_MMA(0, 0, At, B0); PG8_BAR; PG8_SCHED;
            PG8_LDB(B1, 0, 1); PG8_STAGE(PG8_SB(0, 0), b2, voffB);
            PG8_BAR; PG8_WAIT_L(0); PG8_MMA(0, 1, At, B1); PG8_BAR;
            PG8_LDA(At, 0, 1); PG8_STAGE(PG8_SA(0, 0), a2, voffA);
            PG8_BAR; PG8_WAIT_L(0); PG8_MMA(1, 0, At, B0); PG8_BAR; PG8_SCHED;
            PG8_STAGE(PG8_SB(0, 1), b2 + hstep, voffB);
            PG8_WAIT_V(6); PG8_BAR; PG8_MMA(1, 1, At, B1); PG8_BAR;
            PG8_LDB(B0, 1, 0); PG8_SCHED; PG8_LDA(At, 1, 0); PG8_STAGE(PG8_SA(0, 1), a2 + hstep, voffA);
            PG8_WAIT_L(8); PG8_BAR; PG8_WAIT_L(0); PG8_MMA(0, 0, At, B0); PG8_BAR; PG8_SCHED;
            PG8_LDB(B1, 1, 1); PG8_STAGE(PG8_SB(1, 0), b3, voffB);
            PG8_BAR; PG8_WAIT_L(0); PG8_MMA(0, 1, At, B1); PG8_BAR;
            PG8_LDA(At, 1, 1); PG8_STAGE(PG8_SA(1, 0), a3, voffA);
            PG8_BAR; PG8_WAIT_L(0); PG8_MMA(1, 0, At, B0); PG8_BAR; PG8_SCHED;
            PG8_STAGE(PG8_SB(1, 1), b3 + hstep, voffB);
            PG8_WAIT_V(6); PG8_BAR; PG8_MMA(1, 1, At, B1); PG8_BAR;
            }
        }
        if constexpr (ALIGN_EPI) { if (wr == 0) PG8_BAR; }
        if constexpr (!Epi::AFTER_DRAIN) { E(acc, cur, wr, wc, fr, fq); S.done(cur); }
        if (!has_next) break;
#pragma unroll
        for (int a = 0; a < 2; ++a)
#pragma unroll
            for (int b = 0; b < 2; ++b)
#pragma unroll
                for (int m = 0; m < 4; ++m)
#pragma unroll
                    for (int n = 0; n < 2; ++n) acc[a][b][m][n] = (f32x4){0.f, 0.f, 0.f, 0.f};
        cur = nxt; cA = nA; cB = nB; ++ui;
        if constexpr (ALIGN_EPI) { if (wr == 1) PG8_BAR; }
    }
    PG8_WAIT_V(0);
    if constexpr (!ALIGN_EPI) { if (wr == 0) PG8_BAR; }
    PG8_BAR;
    if constexpr (Epi::AFTER_DRAIN) { E.fused(acc, cur, wr, wc, fr, fq, lds, wid, lane); S.done(cur); }
#undef PG8_SA
#undef PG8_SB
#undef PG8_STAGE
#undef PG8_STAGE_R
#undef PG8_LDA
#undef PG8_LDB
#undef PG8_MMA
#undef PG8_WAIT_V
#undef PG8_WAIT_L
#undef PG8_BAR
#undef PG8_SCHED
}
}

#ifndef PG8_SP2
#define PG8_SP2 true
#endif
#ifndef PG8_ALIGN
#define PG8_ALIGN true
#endif
constexpr int NWAVES = 8, NTHR = 512;
#ifndef MK_N_LAUNCHES
#define MK_N_LAUNCHES 1
#endif
constexpr int N_PHASES = 25;
constexpr int N_LAUNCHES = MK_N_LAUNCHES;
static_assert(N_LAUNCHES == 1, "this build runs as ONE launch (the retention mixer has a grid barrier inside its phase)");

constexpr int BATCH = 2, SEQ = 4096, DM = 2048, M = BATCH * SEQ, DEPTH = 4;
constexpr int RET_N = 12288, GM_N = 12288, GM_HALF = 6144, FOX_LD = 8208, FOX_N = 8192, FFN_H = 5632, FFN_N2 = 2 * FFN_H;
constexpr float EPS = 1e-6f;
constexpr float LOG2E = 1.4426950408889634f;

constexpr size_t MiB = (size_t)1 << 20;
constexpr size_t WS_CTL = 0, CTL_ZERO_BYTES = 1 * MiB;
constexpr size_t WS_W_RET_IN = 1 * MiB, SZ_W_RET_IN = 48 * MiB;
constexpr size_t WS_W_RET_OUT = 97 * MiB, SZ_W_RET_OUT = 16 * MiB;
constexpr size_t WS_W_GM_IN = 129 * MiB, WS_W_GM_OUT = 177 * MiB, WS_W_FOX_IN = 201 * MiB, WS_W_FOX_OUT = 233 * MiB;
constexpr size_t WS_W_GU = 241 * MiB, SZ_W_GU = 44 * MiB;
constexpr size_t WS_W_DN = 417 * MiB, SZ_W_DN = 22 * MiB;
constexpr size_t WS_ROPE_C = 505 * MiB, WS_ROPE_S = 509 * MiB;
constexpr size_t WS_H = 513 * MiB;
constexpr size_t WS_A = 545 * MiB;
constexpr size_t WS_B = 737 * MiB;
constexpr size_t WS_C = 833 * MiB;
constexpr size_t WS_MISC = 897 * MiB, WS_RSP = 913 * MiB, WS_KF = 921 * MiB, WS_QF = 953 * MiB, WS_END = 985 * MiB;
constexpr size_t MISC_PART = 0, MISC_RSTAT = 8 * MiB, MISC_LF = 9 * MiB, MISC_WTRI = 12 * MiB;
constexpr int CW_BAR = 4096;

constexpr int RING_OFF = 0, RING_BYTES = 131072;
constexpr int LDSCTL_OFF = RING_BYTES, MISC_OFF = LDSCTL_OFF + 320;
constexpr int RSTAB_OFF = LDSCTL_OFF + 1024;
constexpr int QKT_OFF = LDSCTL_OFF + 3072, QKG_OFF = QKT_OFF + 8192;
constexpr int LDS_BYTES = 147456;
static_assert(MISC_OFF + 128 <= RSTAB_OFF && RSTAB_OFF + 2048 <= QKT_OFF && QKG_OFF + 1024 <= LDS_BYTES, "LDS map");

#define GAS __attribute__((address_space(1)))
#define LAS __attribute__((address_space(3)))
typedef unsigned short bf16;
typedef unsigned v4u __attribute__((ext_vector_type(4)));
typedef unsigned v2u __attribute__((ext_vector_type(2)));
typedef float f32x4 __attribute__((ext_vector_type(4)));
typedef float f32x2 __attribute__((ext_vector_type(2)));
typedef short bf16x8 __attribute__((ext_vector_type(8)));
typedef short s16x4 __attribute__((ext_vector_type(4)));
typedef GAS unsigned gu32;
typedef LAS unsigned char* ldsp;
#define RLX_AGENT __ATOMIC_RELAXED, __HIP_MEMORY_SCOPE_AGENT
#define LDS_WAIT() asm volatile("s_waitcnt lgkmcnt(0)" ::: "memory")
using pg8::cvtpk;
__device__ __forceinline__ float bflo(unsigned w) { return __uint_as_float(w << 16); }
__device__ __forceinline__ float bfhi(unsigned w) { return __uint_as_float(w & 0xffff0000u); }
#define MFMA16(a, b, c) __builtin_amdgcn_mfma_f32_16x16x32_bf16((a), (b), (c), 0, 0, 0)
__device__ __forceinline__ bf16x8 frag_row(const ldsp tile, int RS, int lane) { return *(const LAS bf16x8*)(tile + (lane & 15) * RS + (lane >> 4) * 16); }
typedef short v4i16_t __attribute__((ext_vector_type(4)));
__device__ __forceinline__ s16x4 vtr(const ldsp p) { return __builtin_bit_cast(s16x4, __builtin_amdgcn_ds_read_tr16_b64_v4i16((LAS v4i16_t*)p)); }
__device__ __forceinline__ bf16x8 frag_tr(const ldsp tile, int RS, int lane) {
    const ldsp a = tile + (8 * (lane >> 4) + ((lane & 15) >> 2)) * RS + 8 * (lane & 3);
    const s16x4 lo = vtr(a), hi = vtr(a + 4 * RS);
    return (bf16x8){lo[0], lo[1], lo[2], lo[3], hi[0], hi[1], hi[2], hi[3]};
}

#define XB_TMO      128
#define XB_XCNT(j)  (256  + 64 * (j))
#define XB_XSUB(j)  (1280 + 64 * (j))
#define XB_XGEN(j)  (2304 + 64 * (j))
#define XB_TOP      3328
#define XB_TOPGEN   3392
#define XCD_BAR_WORDS 3456
#define XB_SPIN_CAP (1u << 18)

__device__ __forceinline__ unsigned xb_ld(unsigned* p)              { return __hip_atomic_load(p, __ATOMIC_RELAXED, __HIP_MEMORY_SCOPE_AGENT); }
__device__ __forceinline__ unsigned xb_add(unsigned* p, unsigned v) { return __hip_atomic_fetch_add(p, v, __ATOMIC_RELAXED, __HIP_MEMORY_SCOPE_AGENT); }
__device__ __forceinline__ unsigned xb_xcc_id() { return (unsigned)__builtin_amdgcn_s_getreg((3 << 11) | 20) & 0xFu; }
#define XB_SPIN(cond, bar) do { unsigned _sp = 0; while (cond) { __builtin_amdgcn_s_sleep(1); \
    if ((++_sp & 255u) == 0u) { if (xb_ld(&(bar)[XB_TMO])) break; if (_sp > XB_SPIN_CAP) { atomicAdd(&(bar)[XB_TMO], 1u); break; } } } } while (0)

struct XcdBarrier {
    unsigned* bar; unsigned x;
    volatile LAS unsigned* st;
};

__device__ __forceinline__ XcdBarrier xcd_barrier_post(unsigned* bar, volatile LAS unsigned* st) {
    XcdBarrier b; b.bar = bar; b.x = xb_xcc_id(); b.st = st;
    if (threadIdx.x == 0) (void)xb_add(&bar[XB_XCNT(b.x)], 1u);
    return b;
}
__device__ __forceinline__ void xcd_barrier_complete(unsigned* bar, unsigned x, unsigned& nloc, unsigned& nx) {
    const unsigned G = gridDim.x * gridDim.y * gridDim.z;
    unsigned sum, cnt, mine, sp = 0u;
    for (;;) {
        sum = 0u; cnt = 0u; mine = 0u;
#pragma unroll
        for (unsigned j = 0; j < 16; ++j) { const unsigned c = xb_ld(&bar[XB_XCNT(j)]); sum += c; cnt += (c > 0u) ? 1u : 0u; mine = (j == x) ? c : mine; }
        if (sum == G) break;
        __builtin_amdgcn_s_sleep(1);
        if ((++sp & 255u) == 0u) { if (xb_ld(&bar[XB_TMO])) break; if (sp > XB_SPIN_CAP) { atomicAdd(&bar[XB_TMO], 1u); break; } }
    }
    nloc = mine > 0u ? mine : 1u; nx = cnt > 0u ? cnt : 1u;
}

__device__ __forceinline__ void xcd_barrier(const XcdBarrier& b) {
    asm volatile("s_waitcnt vmcnt(0)" ::: "memory");
    __syncthreads();
    if (threadIdx.x == 0) {
        unsigned* bar = b.bar;
        __builtin_amdgcn_s_waitcnt(0);
        unsigned nloc = b.st[0], nx = b.st[1];
        if (nloc == 0u) { xcd_barrier_complete(bar, b.x, nloc, nx); b.st[0] = nloc; b.st[1] = nx; }
        const unsigned old = xb_add(&bar[XB_XSUB(b.x)], 1u);
        const unsigned gen = old / nloc;
        if (old + 1u == (gen + 1u) * nloc) {
            __builtin_amdgcn_fence(__ATOMIC_RELEASE, "agent");
            asm volatile("s_waitcnt vmcnt(0)" ::: "memory");
            const unsigned og = xb_add(&bar[XB_TOP], 1u);
            const unsigned tg = og / nx;
            if (og + 1u == (tg + 1u) * nx) xb_add(&bar[XB_TOPGEN], 1u);
            else XB_SPIN(xb_ld(&bar[XB_TOPGEN]) == tg, bar);
            __builtin_amdgcn_fence(__ATOMIC_ACQUIRE, "agent");
            xb_add(&bar[XB_XGEN(b.x)], 1u);
            asm volatile("s_waitcnt vmcnt(0)" ::: "memory");
        } else {
            XB_SPIN(xb_ld(&bar[XB_XGEN(b.x)]) == gen, bar);
            __builtin_amdgcn_fence(__ATOMIC_ACQUIRE, "agent");
            asm volatile("s_waitcnt vmcnt(0)" ::: "memory");
        }
    }
    __syncthreads();
}

struct Frame {
    ldsp lds;
    volatile LAS unsigned* MISC;
    gu32* ctl;
    int tid, lane, wave;
    int vcu, G;
};
__device__ __forceinline__ float wave_sum(float v) {
#pragma unroll
    for (int o = 1; o < 64; o <<= 1) v += __shfl_xor(v, o);
    return v;
}
__device__ __forceinline__ float log_sigmoid(float z) { return fminf(z, 0.f) - log1pf(expf(-fabsf(z))); }

__device__ __forceinline__ void transpose_job(Frame& F, const float* W, int K, int ld, int ncols, bf16* WT, int ilv, const float* gvec) {
    LAS float* scr = (LAS float*)(F.lds + RING_OFF + F.wave * 16384);
    const int gw = F.vcu * NWAVES + F.wave, NGW = F.G * NWAVES, lane = F.lane;
    const int nblk = ncols / 32, nitems = (K / 64) * nblk;
    float wv[32];
#define TJ_LOAD(item) do { const int kb_ = (item) / nblk, nb_ = (item) % nblk; const float* src_ = W + (size_t)(64 * kb_ + (lane >> 5)) * ld + 32 * nb_ + (lane & 31); \
        _Pragma("unroll") for (int i = 0; i < 32; ++i) wv[i] = src_[(size_t)(2 * i) * ld]; } while (0)
    if (gw < nitems) TJ_LOAD(gw);
    for (int it = gw; it < nitems; it += NGW) {
        const int kb = it / nblk, nb = it % nblk, k0 = 64 * kb, n0 = 32 * nb;
        const int drow0 = ilv == 0 ? n0 : ((n0 >> 7) * 256 + (n0 & 127) + (ilv == 2 ? 128 : 0));
#pragma unroll
        for (int i = 0; i < 32; ++i) scr[(2 * i + (lane >> 5)) * 33 + (lane & 31)] = wv[i];
        if (it + NGW < nitems) TJ_LOAD(it + NGW);
        LDS_WAIT(); asm volatile("" ::: "memory");
        const int c = lane & 7;
        f32x4 ga = {1.f, 1.f, 1.f, 1.f}, gb = {1.f, 1.f, 1.f, 1.f};
        if (gvec) { ga = *(const f32x4*)(gvec + k0 + 8 * c); gb = *(const f32x4*)(gvec + k0 + 8 * c + 4); }
#pragma unroll
        for (int j = 0; j < 4; ++j) { const int n = (lane >> 3) + 8 * j; const LAS float* s = scr + (8 * c) * 33 + n;
            v4u o; o.x = cvtpk(s[0 * 33] * ga[0], s[1 * 33] * ga[1]); o.y = cvtpk(s[2 * 33] * ga[2], s[3 * 33] * ga[3]); o.z = cvtpk(s[4 * 33] * gb[0], s[5 * 33] * gb[1]); o.w = cvtpk(s[6 * 33] * gb[2], s[7 * 33] * gb[3]);
            *(GAS v4u*)(WT + (size_t)(drow0 + n) * K + k0 + 8 * c) = o; }
        LDS_WAIT(); asm volatile("" ::: "memory");
    }
#undef TJ_LOAD
}
__device__ __forceinline__ void p0_prologue(Frame& F, const void* const* in, unsigned char* ws) {
    const float* mixg = (const float*)in[2]; const float* ffng = (const float*)in[3];
    for (int j = 0; j < 2; ++j) {
        transpose_job(F, (const float*)in[4] + (size_t)j * DM * RET_N, DM, RET_N, RET_N, (bf16*)(ws + WS_W_RET_IN + j * SZ_W_RET_IN), 0, mixg + (size_t)(3 * j) * DM);
        transpose_job(F, (const float*)in[6] + (size_t)j * 4096 * DM, 4096, DM, DM, (bf16*)(ws + WS_W_RET_OUT + j * SZ_W_RET_OUT), 0, nullptr);
    }
    transpose_job(F, (const float*)in[7], DM, GM_N, GM_N, (bf16*)(ws + WS_W_GM_IN), 0, mixg + DM);
    transpose_job(F, (const float*)in[12], GM_HALF, DM, DM, (bf16*)(ws + WS_W_GM_OUT), 0, nullptr);
    transpose_job(F, (const float*)in[13], DM, FOX_LD, FOX_N, (bf16*)(ws + WS_W_FOX_IN), 0, mixg + 2 * DM);
    transpose_job(F, (const float*)in[17], DM, DM, DM, (bf16*)(ws + WS_W_FOX_OUT), 0, nullptr);
    for (int i = 0; i < DEPTH; ++i) {
        transpose_job(F, (const float*)in[18] + (size_t)i * DM * FFN_H, DM, FFN_H, FFN_H, (bf16*)(ws + WS_W_GU + i * SZ_W_GU), 1, ffng + (size_t)i * DM);
        transpose_job(F, (const float*)in[19] + (size_t)i * DM * FFN_H, DM, FFN_H, FFN_H, (bf16*)(ws + WS_W_GU + i * SZ_W_GU), 2, ffng + (size_t)i * DM);
        transpose_job(F, (const float*)in[20] + (size_t)i * FFN_H * DM, FFN_H, DM, DM, (bf16*)(ws + WS_W_DN + i * SZ_W_DN), 0, nullptr);
    }
    { const float* x = (const float*)in[0]; bf16* xb = (bf16*)(ws + WS_H); float* rss = (float*)(ws + WS_RSP);
      const int gw = F.vcu * NWAVES + F.wave, NGW = F.G * NWAVES, lane = F.lane;
      for (int m = gw; m < M; m += NGW) { const f32x4* xr = (const f32x4*)(x + (size_t)m * DM) + lane; v2u* o8 = (v2u*)(xb + (size_t)m * DM) + lane; float ss = 0.f;
#pragma unroll
          for (int j = 0; j < 8; ++j) { const f32x4 v = xr[64 * j]; ss += (v.x * v.x + v.y * v.y) + (v.z * v.z + v.w * v.w); v2u w; w.x = cvtpk(v.x, v.y); w.y = cvtpk(v.z, v.w); o8[64 * j] = w; }
          ss = wave_sum(ss); if (lane < 32) rss[(size_t)m * 32 + lane] = lane == 0 ? ss : 0.f; } }
    { const float* wsp = (const float*)in[10]; bf16* wtri = (bf16*)(ws + WS_MISC + MISC_WTRI);
      for (int i4 = F.vcu * NTHR + F.tid; i4 < 8 * 128 * 32; i4 += F.G * NTHR) { const int t = (i4 >> 5) & 127, s4 = (i4 & 31) * 4; f32x4 wv = *(const f32x4*)(wsp + (size_t)i4 * 4);
#pragma unroll
          for (int e = 0; e < 4; ++e) if (s4 + e > t) wv[e] = 0.f;
          v2u pk; pk.x = cvtpk(wv[0], wv[1]); pk.y = cvtpk(wv[2], wv[3]); *(v2u*)(wtri + (size_t)i4 * 4) = pk; } }
    { const int* pos = (const int*)in[1]; float* cs = (float*)(ws + WS_ROPE_C); float* sn = (float*)(ws + WS_ROPE_S);
      const int gid = F.vcu * NTHR + F.tid, i = gid & 127, step = (F.G * NTHR) >> 7;
      const double invf = exp2(-(double)i * (13.287712379549449 / 128.0));
      for (int r = gid >> 7; r < M; r += step) { const double ang = (double)pos[r] * invf; const double rr = ang - 6.283185307179586 * rint(ang * 0.15915494309189535);
          const float a = (float)rr; cs[(size_t)r * 128 + i] = cosf(a); sn[(size_t)r * 128 + i] = sinf(a); } }
}

__device__ __forceinline__ void ret_p_phase(Frame& F, const bf16* q, const bf16* k, bf16* PF, bf16* KF, bf16* QF) {
    constexpr int RSQ = 272;
    const ldsp LQ = F.lds, LK = F.lds + 34816;
    const int tid = F.tid, lane = F.lane, w = F.wave, g4 = lane >> 4, l15 = lane & 15;
    for (int unit = F.vcu; unit < 512; unit += F.G) {
        const int bh = unit >> 5, ci = unit & 31, h = bh & 7;
        const float lg2 = log1pf(-exp2f(-5.0f - (float)h)) * LOG2E;
        const size_t rowbase = (size_t)bh * SEQ + ci * 128;
        v4u pq[4], pk[4];
#define RP_LD(dd) do { _Pragma("unroll") for (int ps = 0; ps < 4; ++ps) { const int r_ = ps * 32 + (tid >> 4), c_ = tid & 15; \
            pq[ps] = *(const v4u*)(q + (rowbase + r_) * 256 + (dd) * 128 + c_ * 8); pk[ps] = *(const v4u*)(k + (rowbase + r_) * 256 + (dd) * 128 + c_ * 8); } } while (0)
        RP_LD(0);
        f32x4 S[8];
#pragma unroll
        for (int t = 0; t < 8; ++t) S[t] = (f32x4){0.f, 0.f, 0.f, 0.f};
#pragma unroll
        for (int dh = 0; dh < 2; ++dh) {
            __syncthreads();
#pragma unroll
            for (int ps = 0; ps < 4; ++ps) { const int r_ = ps * 32 + (tid >> 4), c_ = tid & 15; *(LAS v4u*)(LQ + r_ * RSQ + c_ * 16) = pq[ps]; *(LAS v4u*)(LK + r_ * RSQ + c_ * 16) = pk[ps]; }
            if (dh == 0) RP_LD(1);
            __syncthreads();
#pragma unroll
            for (int ks = 0; ks < 4; ++ks) { const bf16x8 a = frag_row(LQ + (16 * w) * RSQ + ks * 64, RSQ, lane);
                *(bf16x8*)(QF + ((((size_t)(bh * 32 + ci) * 8 + w) * 8 + dh * 4 + ks) * 512 + lane * 8)) = a;
#pragma unroll
                for (int t = 0; t < 8; ++t) S[t] = MFMA16(a, frag_row(LK + (16 * t) * RSQ + ks * 64, RSQ, lane), S[t]); }
#pragma unroll
            for (int ks = 0; ks < 4; ++ks) { const bf16x8 f = frag_tr(LK + (32 * ks) * RSQ + (16 * w) * 2, RSQ, lane); const v4u fu = __builtin_bit_cast(v4u, f); v4u o;
                const float k0 = exp2f((float)(127 - 32 * ks - 8 * g4) * lg2), gi = exp2f(-lg2), k1 = k0 * gi, k2 = k1 * gi, k3 = k2 * gi, k4 = k3 * gi, k5 = k4 * gi, k6 = k5 * gi, k7 = k6 * gi;
                o.x = cvtpk(bflo(fu.x) * k0, bfhi(fu.x) * k1); o.y = cvtpk(bflo(fu.y) * k2, bfhi(fu.y) * k3); o.z = cvtpk(bflo(fu.z) * k4, bfhi(fu.z) * k5); o.w = cvtpk(bflo(fu.w) * k6, bfhi(fu.w) * k7);
                *(v4u*)(KF + ((((size_t)(bh * 32 + ci) * 2 + dh) * 8 + w) * 4 + ks) * 512 + lane * 8) = o; }
        }
#undef RP_LD
#pragma unroll
        for (int t = 0; t < 8; ++t)
#pragma unroll
            for (int r = 0; r < 4; ++r) { const int n = 16 * w + 4 * g4 + r, mm = 16 * t + l15;
                const float pv_ = n >= mm ? S[t][r] * exp2f((float)(n - mm) * lg2) : 0.f;
                *(LAS unsigned short*)(LQ + n * RSQ + mm * 2) = (unsigned short)(cvtpk(pv_, 0.f) & 0xffffu); }
#pragma unroll
        for (int ks = 0; ks < 4; ++ks) *(bf16x8*)(PF + ((((size_t)(bh * 32 + ci) * 8 + w) * 4 + ks) * 512 + lane * 8)) = frag_row(LQ + (16 * w) * RSQ + ks * 64, RSQ, lane);
    }
}
__device__ __forceinline__ void ret_core_phase(Frame& F, const bf16* QF, const bf16* v, const bf16* PF, const bf16* KF, bf16* o) {
    constexpr int RSV = 72, RSS = 528;
    const ldsp LV0 = F.lds, LST = F.lds + 18432;
    const ldsp LOw = F.lds + 52224 + F.wave * 1024;
    const int tid = F.tid, lane = F.lane, w = F.wave, g4 = lane >> 4, l15 = lane & 15;
    for (int unit = F.vcu; unit < 256; unit += F.G) {
        const int bh = unit >> 4, es = unit & 15, h = bh & 7, b = bh >> 3, e0 = es * 32;
        const float lg2 = log1pf(-exp2f(-5.0f - (float)h)) * LOG2E;
        const float cd = exp2f(128.0f * lg2);
        const size_t rb0 = (size_t)bh * SEQ;
        f32x4 st[2][2];
#pragma unroll
        for (int a = 0; a < 2; ++a)
#pragma unroll
            for (int t = 0; t < 2; ++t) st[a][t] = (f32x4){0.f, 0.f, 0.f, 0.f};
        __syncthreads();
        for (int i = tid; i < 16896 / 4; i += NTHR) ((LAS unsigned*)LST)[i] = 0u;
        v4u pv, pvn; bf16x8 qf[8], pf[4], kf[8], qn[8], pn[4], kn[8];
#define RC_LD(cc) do { pvn = *(const v4u*)(v + (rb0 + (cc) * 128 + (tid >> 2)) * 512 + e0 + (tid & 3) * 8); \
            _Pragma("unroll") for (int ks = 0; ks < 8; ++ks) qn[ks] = *(const bf16x8*)(QF + ((((size_t)(bh * 32 + (cc)) * 8 + w) * 8 + ks) * 512 + lane * 8)); \
            _Pragma("unroll") for (int ks = 0; ks < 4; ++ks) pn[ks] = *(const bf16x8*)(PF + ((((size_t)(bh * 32 + (cc)) * 8 + w) * 4 + ks) * 512 + lane * 8)); \
            _Pragma("unroll") for (int i_ = 0; i_ < 8; ++i_) kn[i_] = *(const bf16x8*)(KF + ((((size_t)(bh * 32 + (cc)) * 2 + (i_ >> 2)) * 8 + w) * 4 + (i_ & 3)) * 512 + lane * 8); } while (0)
        RC_LD(0);
        for (int ci = 0; ci < 32; ++ci) {
            const ldsp LSc = LST + (ci & 1) * 16896, LSn = LST + ((ci + 1) & 1) * 16896;
            const ldsp LV = LV0 + (ci & 1) * 9216;
            pv = pvn;
#pragma unroll
            for (int i_ = 0; i_ < 8; ++i_) { qf[i_] = qn[i_]; kf[i_] = kn[i_]; }
#pragma unroll
            for (int i_ = 0; i_ < 4; ++i_) pf[i_] = pn[i_];
            *(LAS v4u*)(LV + (tid >> 2) * RSV + (tid & 3) * 16) = pv;
            __syncthreads();
            if (ci + 1 < 32) RC_LD(ci + 1);
            bf16x8 vf[4][2];
#pragma unroll
            for (int ks = 0; ks < 4; ++ks)
#pragma unroll
                for (int t = 0; t < 2; ++t) vf[ks][t] = frag_tr(LV + (32 * ks) * RSV + (16 * t) * 2, RSV, lane);
            f32x4 cr[2], in[2];
            cr[0] = (f32x4){0.f, 0.f, 0.f, 0.f}; cr[1] = (f32x4){0.f, 0.f, 0.f, 0.f}; in[0] = (f32x4){0.f, 0.f, 0.f, 0.f}; in[1] = (f32x4){0.f, 0.f, 0.f, 0.f};
#pragma unroll
            for (int ks = 0; ks < 8; ++ks)
#pragma unroll
                for (int t = 0; t < 2; ++t) cr[t] = MFMA16(qf[ks], frag_row(LSc + (16 * t) * RSS + (ks * 32) * 2, RSS, lane), cr[t]);
#pragma unroll
            for (int ks = 0; ks < 4; ++ks)
#pragma unroll
                for (int t = 0; t < 2; ++t) in[t] = MFMA16(pf[ks], vf[ks][t], in[t]);
#pragma unroll
            for (int dh = 0; dh < 2; ++dh) {
#pragma unroll
                for (int t = 0; t < 2; ++t) st[dh][t] = st[dh][t] * cd;
#pragma unroll
                for (int ks = 0; ks < 4; ++ks)
#pragma unroll
                    for (int t = 0; t < 2; ++t) st[dh][t] = MFMA16(kf[dh * 4 + ks], vf[ks][t], st[dh][t]);
#pragma unroll
                for (int t = 0; t < 2; ++t) { v2u pk2; pk2.x = cvtpk(st[dh][t][0], st[dh][t][1]); pk2.y = cvtpk(st[dh][t][2], st[dh][t][3]);
                    *(LAS v2u*)(LSn + (16 * t + l15) * RSS + (dh * 128 + 16 * w + 4 * g4) * 2) = pk2; }
            }
#pragma unroll
            for (int r = 0; r < 4; ++r) { const int n = 16 * w + 4 * g4 + r; const float qd = exp2f((float)(n + 1) * lg2);
#pragma unroll
                for (int t = 0; t < 2; ++t) *(LAS unsigned short*)(LOw + (4 * g4 + r) * 64 + (16 * t + l15) * 2) = (unsigned short)(cvtpk(in[t][r] + cr[t][r] * qd, 0.f) & 0xffffu); }
            *(v4u*)(o + ((size_t)b * SEQ + ci * 128 + 16 * w + (lane >> 2)) * 4096 + h * 512 + e0 + (lane & 3) * 8) = *(const LAS v4u*)(LOw + (lane >> 2) * 64 + (lane & 3) * 16);
        }
#undef RC_LD
    }
}

__device__ __forceinline__ void ret_gn_phase(Frame& F, const bf16* o, const bf16* g, const float* gn, bf16* y) {
    const int lane = F.lane, gw = F.vcu * NWAVES + F.wave, NGW = F.G * NWAVES;
    for (int it0 = gw; it0 < M * 8; it0 += 4 * NGW) {
        v4u ov[4], gv[4];
#pragma unroll
        for (int u = 0; u < 4; ++u) { const int it = it0 + u * NGW; const size_t off = (size_t)(it >> 3) * 4096 + (it & 7) * 512 + lane * 8;
            if (it < M * 8) { ov[u] = *(const v4u*)(o + off); gv[u] = *(const v4u*)(g + off); } else { ov[u] = (v4u){0u, 0u, 0u, 0u}; gv[u] = ov[u]; } }
#pragma unroll
        for (int u = 0; u < 4; ++u) { const int it = it0 + u * NGW, h = it & 7; const size_t off = (size_t)(it >> 3) * 4096 + h * 512 + lane * 8;
            float x[8] = {bflo(ov[u].x), bfhi(ov[u].x), bflo(ov[u].y), bfhi(ov[u].y), bflo(ov[u].z), bfhi(ov[u].z), bflo(ov[u].w), bfhi(ov[u].w)};
            float gg[8] = {bflo(gv[u].x), bfhi(gv[u].x), bflo(gv[u].y), bfhi(gv[u].y), bflo(gv[u].z), bfhi(gv[u].z), bflo(gv[u].w), bfhi(gv[u].w)};
            float s = 0.f;
#pragma unroll
            for (int e = 0; e < 8; ++e) s += x[e];
            const float mean = wave_sum(s) * (1.0f / 512.0f); float qv = 0.f;
#pragma unroll
            for (int e = 0; e < 8; ++e) { x[e] -= mean; qv += x[e] * x[e]; }
            const float rstd = 1.0f / sqrtf(wave_sum(qv) * (1.0f / 512.0f) + EPS);
            const f32x4 g0 = *(const f32x4*)(gn + h * 512 + lane * 8), g1 = *(const f32x4*)(gn + h * 512 + lane * 8 + 4);
            float r[8];
#pragma unroll
            for (int e = 0; e < 8; ++e) { const float gw_ = e < 4 ? g0[e & 3] : g1[e & 3]; r[e] = x[e] * rstd * gw_ * (gg[e] * pg8::fast_sigmoid(gg[e])); }
            v4u w; w.x = cvtpk(r[0], r[1]); w.y = cvtpk(r[2], r[3]); w.z = cvtpk(r[4], r[5]); w.w = cvtpk(r[6], r[7]);
            if (it < M * 8) *(v4u*)(y + off) = w; }
    }
}

__device__ __forceinline__ void gm_stat_phase(Frame& F, const f32x2* part, f32x2* rstat) {
    const int lane = F.lane, gw = F.vcu * NWAVES + F.wave, NGW = F.G * NWAVES;
    for (int row = gw; row < M; row += NGW) {
        float s = 0.f, ss = 0.f;
        if (lane < 48) { const f32x4 p = *(const f32x4*)(part + (size_t)row * 96 + lane * 2); s = p.x + p.z; ss = p.y + p.w; }
        s = wave_sum(s); ss = wave_sum(ss);
        const float mean = s * (1.0f / GM_HALF), var = fmaxf(ss * (1.0f / GM_HALF) - mean * mean, 0.f);
        if (lane == 0) rstat[row] = (f32x2){mean, 1.0f / sqrtf(var + EPS)};
    }
}
__device__ __forceinline__ void gm_spatial_phase(Frame& F, const bf16* u, const bf16* v, const f32x2* rstat, const float* lng, const float* lnb, const bf16* wtri, const float* bsp, bf16* y) {
    constexpr int RSW = 272, RSN = 528;
    const ldsp LW = F.lds, LN = F.lds + 34816;
    const int tid = F.tid, lane = F.lane, w = F.wave, g4 = lane >> 4, l15 = lane & 15;
    for (int wgi = F.vcu; wgi < 256; wgi += F.G) {
        const int gg = wgi & 7, jj = wgi >> 3;
        __syncthreads();
#pragma unroll
        for (int ps = 0; ps < 4; ++ps) { const int id = ps * NTHR + tid, t = id >> 4, c = id & 15;
            *(LAS v4u*)(LW + t * RSW + c * 16) = *(const v4u*)(wtri + ((size_t)gg * 128 + t) * 128 + c * 8); }
        float bs[8];
#pragma unroll
        for (int tt = 0; tt < 8; ++tt) bs[tt] = bsp[gg * 128 + 16 * tt + l15];
        v4u vr[8], ur[8];
#define GS_ROW0(i_) ((((jj) * 6 + (i_)) / 3) * 128)
#define GS_COL0(i_) (gg * 768 + (((jj) * 6 + (i_)) % 3) * 256)
#define GS_LDV(i_) do { _Pragma("unroll") for (int ps = 0; ps < 8; ++ps) { const int id_ = ps * NTHR + tid; vr[ps] = *(const v4u*)(v + (size_t)(GS_ROW0(i_) + (id_ >> 5)) * GM_HALF + GS_COL0(i_) + (id_ & 31) * 8); } } while (0)
        GS_LDV(0);
        for (int ui = 0; ui < 6; ++ui) {
            const int row0 = GS_ROW0(ui), col0 = GS_COL0(ui);
            __syncthreads();
#pragma unroll
            for (int ps = 0; ps < 8; ++ps) { const int id = ps * NTHR + tid, r = id >> 5, c8 = (id & 31) * 8;
                const v4u vv = vr[ps]; const f32x2 rs = rstat[row0 + r];
                const f32x4 ga = *(const f32x4*)(lng + col0 + c8), gb = *(const f32x4*)(lng + col0 + c8 + 4), ba = *(const f32x4*)(lnb + col0 + c8), bb = *(const f32x4*)(lnb + col0 + c8 + 4);
                v4u o;
                o.x = cvtpk((bflo(vv.x) - rs.x) * rs.y * ga[0] + ba[0], (bfhi(vv.x) - rs.x) * rs.y * ga[1] + ba[1]);
                o.y = cvtpk((bflo(vv.y) - rs.x) * rs.y * ga[2] + ba[2], (bfhi(vv.y) - rs.x) * rs.y * ga[3] + ba[3]);
                o.z = cvtpk((bflo(vv.z) - rs.x) * rs.y * gb[0] + bb[0], (bfhi(vv.z) - rs.x) * rs.y * gb[1] + bb[1]);
                o.w = cvtpk((bflo(vv.w) - rs.x) * rs.y * gb[2] + bb[2], (bfhi(vv.w) - rs.x) * rs.y * gb[3] + bb[3]);
                *(LAS v4u*)(LN + r * RSN + c8 * 2) = o; }
#pragma unroll
            for (int ps = 0; ps < 8; ++ps) { const int id_ = ps * NTHR + tid; ur[ps] = *(const v4u*)(u + (size_t)(row0 + (id_ >> 5)) * GM_HALF + col0 + (id_ & 31) * 8); }
            if (ui + 1 < 6) GS_LDV(ui + 1);
            __syncthreads();
            f32x4 acc[2][8];
#pragma unroll
            for (int ci = 0; ci < 2; ++ci)
#pragma unroll
                for (int tt = 0; tt < 8; ++tt) acc[ci][tt] = (f32x4){0.f, 0.f, 0.f, 0.f};
#pragma unroll
            for (int ks = 0; ks < 4; ++ks) {
                const bf16x8 a0 = frag_tr(LN + (32 * ks) * RSN + (32 * w) * 2, RSN, lane), a1 = frag_tr(LN + (32 * ks) * RSN + (32 * w + 16) * 2, RSN, lane);
#pragma unroll
                for (int tt = 2 * ks; tt < 8; ++tt) { const bf16x8 bfr = frag_row(LW + (16 * tt) * RSW + ks * 64, RSW, lane);
                    acc[0][tt] = MFMA16(a0, bfr, acc[0][tt]); acc[1][tt] = MFMA16(a1, bfr, acc[1][tt]); }
            }
            __syncthreads();
#pragma unroll
            for (int ci = 0; ci < 2; ++ci)
#pragma unroll
                for (int tt = 0; tt < 8; ++tt) { v2u pk; pk.x = cvtpk(acc[ci][tt][0] + bs[tt], acc[ci][tt][1] + bs[tt]); pk.y = cvtpk(acc[ci][tt][2] + bs[tt], acc[ci][tt][3] + bs[tt]);
                    *(LAS v2u*)(LN + (16 * tt + l15) * RSN + (32 * w + 16 * ci + 4 * g4) * 2) = pk; }
            __syncthreads();
#pragma unroll
            for (int ps = 0; ps < 8; ++ps) { const int id = ps * NTHR + tid, r = id >> 5, c8 = (id & 31) * 8;
                const v4u mv = *(const LAS v4u*)(LN + r * RSN + c8 * 2); const size_t off = (size_t)(row0 + r) * GM_HALF + col0 + c8; const v4u uv = ur[ps];
                v4u o; o.x = cvtpk(bflo(uv.x) * bflo(mv.x), bfhi(uv.x) * bfhi(mv.x)); o.y = cvtpk(bflo(uv.y) * bflo(mv.y), bfhi(uv.y) * bfhi(mv.y));
                o.z = cvtpk(bflo(uv.z) * bflo(mv.z), bfhi(uv.z) * bfhi(mv.z)); o.w = cvtpk(bflo(uv.w) * bflo(mv.w), bfhi(uv.w) * bfhi(mv.w));
                *(v4u*)(y + off) = o; }
        }
#undef GS_ROW0
#undef GS_COL0
#undef GS_LDV
    }
}

__device__ __forceinline__ void fox_prep_phase(Frame& F, const bf16* x, const float* rs, const float* gmix, const float* wfox, const float* bfg, float* lf) {
    const int lane = F.lane, w = F.wave, fr = lane & 15, fq = lane >> 4, kb = w * 256 + fq * 8;
    LAS float* red = (LAS float*)F.lds;
    bf16x8 wh[8], wl[8];
#pragma unroll
    for (int s = 0; s < 8; ++s) { const int k0 = kb + 32 * s; const f32x4 ga = *(const f32x4*)(gmix + k0), gb = *(const f32x4*)(gmix + k0 + 4);
        float wv[8];
#pragma unroll
        for (int j = 0; j < 8; ++j) wv[j] = wfox[(size_t)(k0 + j) * FOX_LD + FOX_N + fr] * (j < 4 ? ga[j & 3] : gb[j & 3]);
        v4u ph, pl;
#pragma unroll
        for (int p = 0; p < 4; ++p) { const unsigned hp = cvtpk(wv[2 * p], wv[2 * p + 1]); ph[p] = hp; pl[p] = cvtpk(wv[2 * p] - bflo(hp), wv[2 * p + 1] - bfhi(hp)); }
        wh[s] = __builtin_bit_cast(bf16x8, ph); wl[s] = __builtin_bit_cast(bf16x8, pl); }
    for (int blk = F.vcu; blk < M / 32; blk += F.G) {
        const bf16* xa = x + (size_t)(blk * 32 + fr) * DM + kb;
        bf16x8 a0[8], a1[8];
#pragma unroll
        for (int s = 0; s < 8; ++s) { a0[s] = *(const bf16x8*)(xa + 32 * s); a1[s] = *(const bf16x8*)(xa + (size_t)16 * DM + 32 * s); }
        f32x4 c0 = (f32x4){0.f, 0.f, 0.f, 0.f}, c1 = c0;
#pragma unroll
        for (int s = 0; s < 8; ++s) { c0 = MFMA16(a0[s], wh[s], c0); c1 = MFMA16(a1[s], wh[s], c1); c0 = MFMA16(a0[s], wl[s], c0); c1 = MFMA16(a1[s], wl[s], c1); }
#pragma unroll
        for (int r = 0; r < 4; ++r) { red[(w * 32 + 4 * fq + r) * 16 + fr] = c0[r]; red[(w * 32 + 16 + 4 * fq + r) * 16 + fr] = c1[r]; }
        __syncthreads();
        { const int row = F.tid >> 4, col = F.tid & 15, m = blk * 32 + row; float z = 0.f;
#pragma unroll
          for (int ww = 0; ww < 8; ++ww) z += red[(ww * 32 + row) * 16 + col];
          lf[(size_t)m * 16 + col] = log_sigmoid(z * pg8::row_rstd(rs, m) + bfg[col]); }
        __syncthreads();
    }
}

typedef float f32x16 __attribute__((ext_vector_type(16)));
#define MFMA32(a, b, c) __builtin_amdgcn_mfma_f32_32x32x16_bf16((a), (b), (c), 0, 0, 0)
__device__ __forceinline__ void fox_attn_phase(Frame& F, const bf16* qn, const bf16* kn, const bf16* vv, const bf16* gs, const float* lf, bf16* y) {
    constexpr int RSK = 272, RSV = 320, KSLOT = 64 * RSK, VSLOT = 64 * RSV;
    const ldsp LK = F.lds, LV = F.lds + 2 * KSLOT;
    LAS float* c2 = (LAS float*)(F.lds + 75776);
    LAS float* red = (LAS float*)(F.lds + 92160);
    const int tid = F.tid, lane = F.lane, w = F.wave, r32 = lane & 31, hi = lane >> 5;
    int bh_have = -1;
    for (int pr = F.vcu; pr < 256; pr += F.G) {
        const int bh = pr >> 3, pi = pr & 7, b = bh >> 4, h = bh & 15;
        const size_t tok0 = (size_t)b * SEQ;
        if (bh != bh_have) {
            bh_have = bh;
            float x8[8]; float run = 0.f;
#pragma unroll
            for (int e = 0; e < 8; ++e) { run += lf[(tok0 + tid * 8 + e) * 16 + h]; x8[e] = run; }
            float inc = run;
#pragma unroll
            for (int o = 1; o < 64; o <<= 1) { const float t = __shfl_up(inc, o); if (lane >= o) inc += t; }
            __syncthreads();
            if (lane == 63) red[w] = inc;
            __syncthreads();
            float pre = inc - run;
#pragma unroll
            for (int wv = 0; wv < 8; ++wv) if (wv < w) pre += red[wv];
#pragma unroll
            for (int e = 0; e < 8; ++e) c2[tid * 8 + e] = (pre + x8[e]) * LOG2E;
        }
        for (int half = 0; half < 2; ++half) {
            const int qb = half ? 15 - pi : pi, q0 = qb * 256, ntile = 4 * qb + 4, qrow = q0 + 32 * w + r32;
            bf16x8 qf[8];
#pragma unroll
            for (int ks = 0; ks < 8; ++ks) qf[ks] = *(const bf16x8*)(qn + (tok0 + qrow) * DM + h * 128 + ks * 16 + 8 * hi);
            v4u kr[2], vr[2];
#define FA_LOAD(tt) do { _Pragma("unroll") for (int pp = 0; pp < 2; ++pp) { const int id_ = tid + NTHR * pp, r_ = id_ >> 4, c_ = id_ & 15; \
                kr[pp] = *(const v4u*)(kn + (tok0 + 64 * (tt) + r_) * DM + h * 128 + c_ * 8); vr[pp] = *(const v4u*)(vv + (tok0 + 64 * (tt) + r_) * DM + h * 128 + c_ * 8); } } while (0)
#define FA_STORE(sl) do { _Pragma("unroll") for (int pp = 0; pp < 2; ++pp) { const int id_ = tid + NTHR * pp, r_ = id_ >> 4, c_ = id_ & 15; \
                *(LAS v4u*)(LK + (sl) * KSLOT + r_ * RSK + c_ * 16) = kr[pp]; *(LAS v4u*)(LV + (sl) * VSLOT + r_ * RSV + c_ * 16) = vr[pp]; } } while (0)
            FA_LOAD(0);
            __syncthreads();
            FA_STORE(0);
            if (ntile > 1) FA_LOAD(1);
            const float cq = c2[qrow];
            float mx = 0.f, ls = 0.f;
            f32x16 O[4];
#pragma unroll
            for (int dt = 0; dt < 4; ++dt)
#pragma unroll
                for (int r = 0; r < 16; ++r) O[dt][r] = 0.f;
            for (int t = 0; t < ntile; ++t) {
                __syncthreads();
                if (t + 1 < ntile) { FA_STORE((t + 1) & 1); if (t + 2 < ntile) FA_LOAD(t + 2); }
                const int key0 = 64 * t;
                if (key0 <= q0 + 32 * w + 31) {
                    const ldsp sk = LK + (t & 1) * KSLOT + r32 * RSK + 16 * hi, sv = LV + (t & 1) * VSLOT;
                    f32x16 S0, S1;
                    const float cbase = cq - mx;
#pragma unroll
                    for (int g = 0; g < 4; ++g) { const f32x4 ck0 = *(const LAS f32x4*)(c2 + key0 + 8 * g + 4 * hi), ck1 = *(const LAS f32x4*)(c2 + key0 + 32 + 8 * g + 4 * hi);
#pragma unroll
                        for (int e = 0; e < 4; ++e) { S0[4 * g + e] = cbase - ck0[e]; S1[4 * g + e] = cbase - ck1[e]; } }
#pragma unroll
                    for (int ks = 0; ks < 8; ++ks) { S0 = MFMA32(*(const LAS bf16x8*)(sk + ks * 32), qf[ks], S0); S1 = MFMA32(*(const LAS bf16x8*)(sk + 32 * RSK + ks * 32), qf[ks], S1); }
                    if (key0 + 63 > q0 + 32 * w) {
#pragma unroll
                        for (int g = 0; g < 4; ++g)
#pragma unroll
                            for (int e = 0; e < 4; ++e) { const int key = key0 + 8 * g + 4 * hi + e; if (key > qrow) S0[4 * g + e] = -INFINITY; if (key + 32 > qrow) S1[4 * g + e] = -INFINITY; } }
                    float mloc = fmaxf(S0[0], S1[0]);
#pragma unroll
                    for (int r = 1; r < 16; ++r) mloc = __builtin_fmaxf(__builtin_fmaxf(mloc, S0[r]), S1[r]);
                    mloc = fmaxf(mloc, __shfl_xor(mloc, 32));
                    if (__any(mloc > 8.0f)) { const float dl = fmaxf(mloc, 0.f), alpha = __builtin_amdgcn_exp2f(-dl); mx += dl; ls *= alpha;
#pragma unroll
                        for (int r = 0; r < 16; ++r) { S0[r] -= dl; S1[r] -= dl; }
#pragma unroll
                        for (int dt = 0; dt < 4; ++dt)
#pragma unroll
                            for (int r = 0; r < 16; ++r) O[dt][r] *= alpha; }
                    float psum = 0.f;
#pragma unroll
                    for (int r = 0; r < 16; ++r) { S0[r] = __builtin_amdgcn_exp2f(S0[r]); S1[r] = __builtin_amdgcn_exp2f(S1[r]); psum += S0[r] + S1[r]; }
                    ls += psum;
                    v4u pf[4];
#pragma unroll
                    for (int s2 = 0; s2 < 2; ++s2) { pf[s2] = (v4u){cvtpk(S0[8 * s2 + 0], S0[8 * s2 + 1]), cvtpk(S0[8 * s2 + 2], S0[8 * s2 + 3]), cvtpk(S0[8 * s2 + 4], S0[8 * s2 + 5]), cvtpk(S0[8 * s2 + 6], S0[8 * s2 + 7])};
                        pf[2 + s2] = (v4u){cvtpk(S1[8 * s2 + 0], S1[8 * s2 + 1]), cvtpk(S1[8 * s2 + 2], S1[8 * s2 + 3]), cvtpk(S1[8 * s2 + 4], S1[8 * s2 + 5]), cvtpk(S1[8 * s2 + 6], S1[8 * s2 + 7])}; }
                    const ldsp vb = sv + (4 * hi + ((lane & 15) >> 2)) * RSV + (16 * ((lane >> 4) & 1) + 4 * (lane & 3)) * 2;
#pragma unroll
                    for (int s4 = 0; s4 < 4; ++s4)
#pragma unroll
                        for (int dt = 0; dt < 4; ++dt) { const ldsp va = vb + (16 * s4) * RSV + dt * 64; const s16x4 lo = vtr(va), hv = vtr(va + 8 * RSV);
                            const bf16x8 af = (bf16x8){lo[0], lo[1], lo[2], lo[3], hv[0], hv[1], hv[2], hv[3]};
                            O[dt] = MFMA32(af, __builtin_bit_cast(bf16x8, pf[s4]), O[dt]); }
                }
            }
            ls += __shfl_xor(ls, 32);
            const float il = 1.0f / ls;
            const size_t yoff = (tok0 + qrow) * DM + h * 128 + 4 * hi;
#pragma unroll
            for (int dt = 0; dt < 4; ++dt)
#pragma unroll
                for (int g = 0; g < 4; ++g) { const v2u gv = *(const v2u*)(gs + yoff + dt * 32 + 8 * g);
                    v2u o; o.x = cvtpk(O[dt][4 * g + 0] * il * bflo(gv.x), O[dt][4 * g + 1] * il * bfhi(gv.x)); o.y = cvtpk(O[dt][4 * g + 2] * il * bflo(gv.y), O[dt][4 * g + 3] * il * bfhi(gv.y));
                    *(v2u*)(y + yoff + dt * 32 + 8 * g) = o; }
        }
    }
#undef FA_LOAD
#undef FA_STORE
}
#ifndef R_RET_CORE
#define R_RET_CORE 1
#endif
#ifndef R_RET_GN
#define R_RET_GN 1
#endif
#ifndef R_GM_SP
#define R_GM_SP 1
#endif
#ifndef R_FOX_ATTN
#define R_FOX_ATTN 1
#endif
#ifndef R_FOX_PREP
#define R_FOX_PREP 1
#endif
#ifndef R_PRO
#define R_PRO 1
#endif
#ifndef F_GU_TAIL
#define F_GU_TAIL 0
#endif

#ifndef PROBE_A
#define PROBE_A -1
#endif
#ifndef PROBE_B
#define PROBE_B -1
#endif
#ifndef PROBE_MUL
#define PROBE_MUL 4
#endif
#define STAMP_AT(id) do { if (PROBE_A >= 0 && ((id) == PROBE_A || (id) == PROBE_B)) { if (F.tid == 0) { const unsigned long long t_ = __builtin_amdgcn_s_memrealtime(); \
        volatile LAS unsigned* m_ = F.MISC + ((id) == PROBE_A ? 16 : 20); m_[0] = (unsigned)t_; m_[1] = (unsigned)(t_ >> 32); } } } while (0)
struct Args { const void* in[21]; float* out; unsigned char* ws; int ph_lo, ph_hi, li, pad; };
#define IN(k) (lo <= (k) && (k) < hi)
#define SEAM(k) do { if (N_LAUNCHES == 1 && IN(k) && IN((k) + 1)) xcd_barrier(bar); STAMP_AT(k); } while (0)
template <int L>
__device__ __forceinline__ void layer_body(Frame& F, const Args& args, const XcdBarrier& bar, const int lo, const int hi) {
    unsigned char* ws = args.ws;
    constexpr int kind = L % 3, j = L / 3, pb = 1 + 6 * L;
    float* xo = args.out;
    bf16* XB = (bf16*)(ws + WS_H);
    bf16* A0 = (bf16*)(ws + WS_A); bf16* B0 = (bf16*)(ws + WS_B); bf16* C0 = (bf16*)(ws + WS_C);
    unsigned char* misc = ws + WS_MISC;
    float* rss = (float*)(ws + WS_RSP);
    PG8_LAS float* rtab = (PG8_LAS float*)(F.lds + RSTAB_OFF);
    if (IN(pb + 0)) {
        if (kind == 0) {
            pg8::Gemm g{XB, (const bf16*)(ws + WS_W_RET_IN + j * SZ_W_RET_IN), M, RET_N, DM}; pg8::RsOrder S; S.init(M, RET_N, F.G, (int)blockIdx.x); S.rs = rss + (size_t)(2 * L) * M * 32; S.tab = rtab; S.pend = 0.f; S.nready = 0;
            pg8::EpiRetIn E{A0, A0 + (size_t)M * 2048, A0 + (size_t)M * 4096, A0 + (size_t)M * 8192, (const float*)(ws + WS_ROPE_C), (const float*)(ws + WS_ROPE_S), rtab, 0};
            pg8::gemm_phase<pg8::EpiRetIn, pg8::RsOrder, PG8_ALIGN, PG8_SP2>(F.lds + RING_OFF, g, S, E);
        } else if (kind == 1) {
            pg8::Gemm g{XB, (const bf16*)(ws + WS_W_GM_IN), M, GM_N, DM}; pg8::RsOrder S; S.init(M, GM_N, F.G, (int)blockIdx.x); S.rs = rss + (size_t)(2 * L) * M * 32; S.tab = rtab; S.pend = 0.f; S.nready = 0;
            pg8::EpiGeluUV E{A0, A0 + (size_t)M * GM_HALF, (pg8::f32x2v*)(misc + MISC_PART), rtab, 0};
            pg8::gemm_phase<pg8::EpiGeluUV, pg8::RsOrder, PG8_ALIGN, PG8_SP2>(F.lds + RING_OFF, g, S, E);
        } else {
            pg8::Gemm g{XB, (const bf16*)(ws + WS_W_FOX_IN), M, FOX_N, DM}; pg8::RsOrder S; S.init(M, FOX_N, F.G, (int)blockIdx.x); S.rs = rss + (size_t)(2 * L) * M * 32; S.tab = rtab; S.pend = 0.f; S.nready = 0;
            PG8_LAS float* qkg = (PG8_LAS float*)(F.lds + QKG_OFF);
            if (F.tid < 256) qkg[F.tid] = F.tid < 128 ? ((const float*)args.in[15])[F.tid] : ((const float*)args.in[16])[F.tid - 128];
            __syncthreads();
            pg8::EpiFoxIn E{A0, (size_t)M * 2048, rtab, 0, (PG8_LAS float*)(F.lds + QKT_OFF), qkg};
            pg8::gemm_phase<pg8::EpiFoxIn, pg8::RsOrder, PG8_ALIGN, PG8_SP2>(F.lds + RING_OFF, g, S, E);
        }
    }
    SEAM(pb + 0);
    if (IN(pb + 1)) {
        if (kind == 0) { bf16* Pb = B0 + (size_t)M * 4096;
            bf16* KFb = (bf16*)(ws + WS_KF);
            bf16* QFb = (bf16*)(ws + WS_QF);
            ret_p_phase(F, A0, A0 + (size_t)M * 2048, Pb, KFb, QFb);
            if (N_LAUNCHES == 1) xcd_barrier(bar);
            STAMP_AT(500 + L);
            for (int rep_ = 0; rep_ < R_RET_CORE; ++rep_) ret_core_phase(F, QFb, A0 + (size_t)M * 4096, Pb, KFb, B0); }
        else if (kind == 1) { gm_stat_phase(F, (const f32x2*)(misc + MISC_PART), (f32x2*)(misc + MISC_RSTAT)); }
        else { for (int rep_ = 0; rep_ < R_FOX_PREP; ++rep_) fox_prep_phase(F,
                              XB, rss + (size_t)(2 * L) * M * 32, (const float*)args.in[2] + (size_t)L * DM, (const float*)args.in[13], (const float*)args.in[14], (float*)(misc + MISC_LF)); }
    }
    SEAM(pb + 1);
    if (IN(pb + 2)) {
        if (kind == 0) { for (int rep_ = 0; rep_ < R_RET_GN; ++rep_) ret_gn_phase(F, B0, A0 + (size_t)M * 8192, (const float*)args.in[5] + (size_t)j * 4096, C0); }
        else if (kind == 1) { for (int rep_ = 0; rep_ < R_GM_SP; ++rep_) gm_spatial_phase(F, A0, A0 + (size_t)M * GM_HALF, (const f32x2*)(misc + MISC_RSTAT), (const float*)args.in[8], (const float*)args.in[9], (const bf16*)(misc + MISC_WTRI), (const float*)args.in[11], B0); }
        else { for (int rep_ = 0; rep_ < R_FOX_ATTN; ++rep_) fox_attn_phase(F, A0, A0 + (size_t)M * 2048, A0 + (size_t)M * 4096, A0 + (size_t)M * 6144, (const float*)(misc + MISC_LF), B0); }
    }
    SEAM(pb + 2);
    if (IN(pb + 3)) {
        const bf16* Ain = kind == 0 ? C0 : B0; constexpr int K = kind == 0 ? 4096 : (kind == 1 ? GM_HALF : DM);
        const bf16* Wt = kind == 0 ? (const bf16*)(ws + WS_W_RET_OUT + j * SZ_W_RET_OUT) : (kind == 1 ? (const bf16*)(ws + WS_W_GM_OUT) : (const bf16*)(ws + WS_W_FOX_OUT));
        pg8::Gemm g{Ain, Wt, M, DM, K}; pg8::StaticOrder S; S.init(M, DM, F.G, (int)blockIdx.x);
        if constexpr (L == 0) {
            pg8::EpiRes<true, false> E{(const float*)args.in[0], nullptr, XB, rss + (size_t)(2 * L + 1) * M * 32, DM};
            pg8::gemm_phase<pg8::EpiRes<true, false>, pg8::StaticOrder, PG8_ALIGN, PG8_SP2>(F.lds + RING_OFF, g, S, E);
        } else {
            pg8::EpiResP<false> E{nullptr, XB, rss + (size_t)(2 * L + 1) * M * 32, DM};
            pg8::gemm_phase<pg8::EpiResP<false>, pg8::StaticOrder, PG8_ALIGN, PG8_SP2>(F.lds + RING_OFF, g, S, E);
        }
    }
    SEAM(pb + 3);
    if (IN(pb + 4)) {
        constexpr int NFULL = (F_GU_TAIL ? 40 : 44) * 256;
        { pg8::Gemm g{XB, (const bf16*)(ws + WS_W_GU + L * SZ_W_GU), M, NFULL, DM}; pg8::RsOrder S; S.init(M, NFULL, F.G, (int)blockIdx.x); S.rs = rss + (size_t)(2 * L + 1) * M * 32; S.tab = rtab; S.pend = 0.f; S.nready = 0;
          pg8::EpiSwiglu<false> E{A0, FFN_H, rtab, 0};
          pg8::gemm_phase<pg8::EpiSwiglu<false>, pg8::RsOrder, PG8_ALIGN, PG8_SP2>(F.lds + RING_OFF, g, S, E); }
        if (F_GU_TAIL) { pg8::Gemm g{XB, (const bf16*)(ws + WS_W_GU + L * SZ_W_GU), M, FFN_N2, DM}; pg8::TailOrder S; S.init(M, FFN_N2, F.G, (int)blockIdx.x); S.rs = rss + (size_t)(2 * L + 1) * M * 32; S.tab = rtab; S.pend = 0.f; S.nready = 0; S.pn0 = 40;
          pg8::EpiSwiglu<true> E{A0, FFN_H, rtab, 0};
          pg8::gemm_phase<pg8::EpiSwiglu<true>, pg8::TailOrder, PG8_ALIGN, PG8_SP2, true>(F.lds + RING_OFF, g, S, E); }
    }
    SEAM(pb + 4);
    if (IN(pb + 5)) {
        pg8::Gemm g{A0, (const bf16*)(ws + WS_W_DN + L * SZ_W_DN), M, DM, FFN_H}; pg8::StaticOrder S; S.init(M, DM, F.G, (int)blockIdx.x);
        pg8::EpiResP<L + 1 == DEPTH> E{xo, XB, rss + (size_t)((2 * L + 2) & 7) * M * 32, DM};
        pg8::gemm_phase<pg8::EpiResP<L + 1 == DEPTH>, pg8::StaticOrder, PG8_ALIGN, PG8_SP2>(F.lds + RING_OFF, g, S, E);
    }
    SEAM(pb + 5);
}
__global__ void __launch_bounds__(NWAVES * 64, 2) trunk_fwd(Args args) {
    extern __shared__ __attribute__((aligned(16))) unsigned char lds[];
    Frame F;
    F.lds = (ldsp)lds;
    F.MISC = (volatile LAS unsigned*)(F.lds + MISC_OFF);
    F.tid = threadIdx.x; F.lane = F.tid & 63; F.wave = __builtin_amdgcn_readfirstlane(F.tid >> 6);
    F.G = gridDim.x; { const int bx = blockIdx.x; F.vcu = (F.G % 8 == 0) ? (bx % 8) * (F.G / 8) + bx / 8 : bx; }
    F.ctl = (gu32*)(args.ws + WS_CTL);
    for (int u = F.tid; u < (LDS_BYTES - LDSCTL_OFF) / 4; u += NWAVES * 64) ((LAS unsigned*)(F.lds + LDSCTL_OFF))[u] = 0u;
    __syncthreads();
    XcdBarrier bar; bar.bar = (unsigned*)(F.ctl + CW_BAR); bar.x = 0; bar.st = nullptr;
    if (N_LAUNCHES == 1) bar = xcd_barrier_post((unsigned*)(F.ctl + CW_BAR), F.MISC + 8);
    const int lo = args.ph_lo, hi = args.ph_hi;
    STAMP_AT(999);
    if (IN(0)) for (int rep_ = 0; rep_ < R_PRO; ++rep_) p0_prologue(F, args.in, args.ws);
    SEAM(0);
#ifdef IDLE_TEST
#define IDLE_GAP() do { const unsigned long long t0_ = __builtin_amdgcn_s_memrealtime(); while (__builtin_amdgcn_s_memrealtime() - t0_ < (unsigned long long)(IDLE_TEST) * 100ull) __builtin_amdgcn_s_sleep(32); } while (0)
#else
#define IDLE_GAP() do {} while (0)
#endif
    layer_body<0>(F, args, bar, lo, hi); IDLE_GAP(); layer_body<1>(F, args, bar, lo, hi); IDLE_GAP(); layer_body<2>(F, args, bar, lo, hi); IDLE_GAP(); layer_body<3>(F, args, bar, lo, hi);
#ifdef ABL_GEMM
    if (PROBE_A == 700) { unsigned char* ws = args.ws; xcd_barrier(bar); STAMP_AT(700);
        pg8::Gemm g{(const bf16*)(ws + WS_H), (const bf16*)(ws + WS_W_GU), M, 40 * 256, DM}; pg8::RsOrder S; S.init(M, 40 * 256, F.G, (int)blockIdx.x); S.rs = (float*)(ws + WS_RSP); S.tab = (PG8_LAS float*)(F.lds + RSTAB_OFF); S.pend = 0.f; S.nready = 0;
        pg8::EpiSwiglu<false> E{(bf16*)(ws + WS_A), FFN_H, (PG8_LAS float*)(F.lds + RSTAB_OFF), 0};
        pg8::gemm_phase<pg8::EpiSwiglu<false>, pg8::RsOrder, PG8_ALIGN, PG8_SP2, false, ABL_GEMM>(F.lds + RING_OFF, g, S, E);
        xcd_barrier(bar); STAMP_AT(701); }
#endif
    if (PROBE_A >= 0 && F.tid == 0) {
        const unsigned long long ta = ((unsigned long long)F.MISC[17] << 32) | F.MISC[16], tb = ((unsigned long long)F.MISC[21] << 32) | F.MISC[20];
        const unsigned long long dly = (tb - ta) * (unsigned long long)PROBE_MUL, t0 = __builtin_amdgcn_s_memrealtime();
        if (tb > ta && dly < 400000ull) while (__builtin_amdgcn_s_memrealtime() - t0 < dly) __builtin_amdgcn_s_sleep(16);
    }
}
#undef IN
#undef SEAM

extern "C" void kernel_launch(void* const* d_in, const int* in_sizes, int n_in, void* d_out, int out_size, void* d_ws, size_t ws_size, hipStream_t stream) {
    static int grid = 0;
    if (grid == 0) {
        if (n_in != 21 || in_sizes[0] != M * DM || out_size != M * DM || ws_size < WS_END) { fprintf(stderr, "kernel_launch: unexpected shapes (n_in %d, in0 %d, out %d, ws %zu); nothing launched\n", n_in, n_in > 0 ? in_sizes[0] : -1, out_size, ws_size); grid = -1; return; }
        int dev = 0, cus = 0, per_cu = 0;
        if (hipGetDevice(&dev) != hipSuccess || hipDeviceGetAttribute(&cus, hipDeviceAttributeMultiprocessorCount, dev) != hipSuccess) { grid = -1; return; }
        if (hipFuncSetAttribute((const void*)trunk_fwd, hipFuncAttributeMaxDynamicSharedMemorySize, LDS_BYTES) != hipSuccess) { fprintf(stderr, "kernel_launch: hipFuncSetAttribute failed\n"); grid = -1; return; }
        if (hipOccupancyMaxActiveBlocksPerMultiprocessor(&per_cu, (const void*)trunk_fwd, NWAVES * 64, LDS_BYTES) != hipSuccess || per_cu < 1)
            fprintf(stderr, "kernel_launch: note: occupancy query reports %d workgroups per CU\n", per_cu);
        (void)hipGetLastError();
        grid = cus;
    }
    if (grid < 0) return;
    if (hipMemsetAsync((char*)d_ws + WS_CTL, 0, CTL_ZERO_BYTES, stream) != hipSuccess) return;
    Args a{};
    for (int i = 0; i < 21; ++i) a.in[i] = d_in[i];
    a.out = (float*)d_out; a.ws = (unsigned char*)d_ws;
    for (int li = 0; li < N_LAUNCHES; ++li) {
        a.ph_lo = (N_LAUNCHES == 1) ? 0 : li; a.ph_hi = (N_LAUNCHES == 1) ? N_PHASES : li + 1; a.li = li; a.pad = 0;
        hipLaunchKernelGGL(trunk_fwd, dim3(grid), dim3(NWAVES * 64), LDS_BYTES, stream, a);
        const hipError_t le = hipPeekAtLastError();
        if (le != hipSuccess) { fprintf(stderr, "kernel_launch: launch %d failed: %s\n", li, hipGetErrorName(le)); break; }
    }
}
```

```cpp
#define PG8_WGM 4
#include <hip/hip_runtime.h>
#include <cstdio>
#include <cstdint>
#include <cmath>
namespace pg8 {
#define PG8_LAS __attribute__((address_space(3)))
typedef unsigned short bf16_t;
typedef short bf16x8 __attribute__((ext_vector_type(8)));
typedef float f32x4 __attribute__((ext_vector_type(4)));
typedef unsigned u32x4 __attribute__((ext_vector_type(4)));
constexpr int BM = 256, BK = 64, HALF = 128, HTB = HALF * BK * 2  , STAGE_BYTES = 8 * HTB, NXCD = 8, WGM = PG8_WGM;

__host__ __device__ __forceinline__ int lds_byte(int r, int c) { const int st = (r >> 4) * 2 + (c >> 5), rr = r & 15, cc = c & 31, ob = rr * 64 + cc * 2; return st * 1024 + (ob ^ (((ob >> 9) & 1) << 5)); }
__host__ __device__ __forceinline__ void stage_rc(int b, int& R, int& C) { const int st = b / 1024, sb = b % 1024, swz = sb ^ (((sb >> 9) & 1) << 5); R = (st >> 1) * 16 + swz / 64; C = (st & 1) * 32 + (swz % 64) / 2; }
__host__ __device__ __forceinline__ int perm32(int rho) { const int n = rho >> 4, i = rho & 15; return 8 * (i >> 2) + 4 * n + (i & 3); }

struct Unit { int pm, pn, hf; };
struct Gemm { const bf16_t* A; const bf16_t* Bt; int M, N, K; };

struct StaticOrder {
    int nM, nN, nwg, G, c;
    __host__ __device__ void init(int M, int N, int G_, int c_) { nM = M / BM; nN = N / BM; nwg = nM * nN; G = G_; c = c_; }
    __host__ __device__ bool next(int i, Unit& u) const {
        const long L = (long)i * G + c; if (L >= nwg) return false;
        int wgid = (int)L; { const int q = nwg / NXCD, r = nwg % NXCD, xcd = wgid % NXCD, off = wgid / NXCD; wgid = (xcd < r ? xcd * (q + 1) : r * (q + 1) + (xcd - r) * q) + off; }
        const int nig = WGM * nN, gid = wgid / nig, fm = gid * WGM, gsz = (nM - fm) < WGM ? (nM - fm) : WGM;
        u.pm = fm + ((wgid % nig) % gsz); u.pn = (wgid % nig) / gsz; u.hf = 0; return true;
    }
    __device__ __forceinline__ void a_ready(const Unit&) const {}
    __device__ __forceinline__ void done(const Unit&) const {}
};

__device__ __forceinline__ unsigned cvt_pk_bf16(float lo, float hi) { unsigned r; asm volatile("v_cvt_pk_bf16_f32 %0, %1, %2" : "=v"(r) : "v"(lo), "v"(hi)); return r; }
typedef float f32x2 __attribute__((ext_vector_type(2)));
__device__ __forceinline__ f32x2 gelu_pk(f32x2 v) {
    const f32x2 av = __builtin_elementwise_abs(v), d = av * 0.2316418882f + 1.0f;
    f32x2 t; t.x = __builtin_amdgcn_rcpf(d.x); t.y = __builtin_amdgcn_rcpf(d.y);
    f32x2 q = t * 0.5307027145f + (-0.7265760135f); q = q * t + 0.7107068705f; q = q * t + (-0.142248368f); q = q * t + 0.127414796f; q = q * t;
    const f32x2 s = (v * v) * (-0.72134752044f);
    f32x2 e; e.x = __builtin_amdgcn_exp2f(s.x); e.y = __builtin_amdgcn_exp2f(s.y);
    const f32x2 m = v * (q * e), r = v - m;
    f32x2 o; o.x = v.x < 0.f ? m.x : r.x; o.y = v.y < 0.f ? m.y : r.y; return o;
}

typedef float f32x2v __attribute__((ext_vector_type(2)));
typedef __bf16 bf16x2v __attribute__((ext_vector_type(2)));
__device__ __forceinline__ unsigned cvtpk(float lo, float hi) { f32x2v v = {lo, hi}; bf16x2v b = __builtin_convertvector(v, bf16x2v); return __builtin_bit_cast(unsigned, b); }
__device__ __forceinline__ u32x4 pack8(const f32x4 a, const f32x4 b) { u32x4 w; w.x = cvtpk(a[0], a[1]); w.y = cvtpk(a[2], a[3]); w.z = cvtpk(b[0], b[1]); w.w = cvtpk(b[2], b[3]); return w; }
#ifndef EPI_WT
#define EPI_WT 0
#endif
__device__ __forceinline__ void st16(void* p, const u32x4 v) {
#if EPI_WT
    asm volatile("global_store_dwordx4 %0, %1, off sc1\n\ts_nop 2" :: "v"(p), "v"(v) : "memory");
#else
    *(u32x4*)p = v;
#endif
}
__device__ __forceinline__ float fast_sigmoid(float x) { return __builtin_amdgcn_rcpf(1.0f + __builtin_amdgcn_exp2f(-1.44269504f * x)); }

template <bool BASE_F32, bool OUT_F32> struct EpiRes {
    static constexpr bool PERM = true, AFTER_DRAIN = false, RESID = false;
    const float* base; float* out; bf16_t* xb; float* rs; int ldc;
    __device__ __forceinline__ void operator()(const f32x4 (&acc)[2][2][4][2], const Unit& u, int wr, int wc, int fr, int fq) const {
        const int row0 = u.pm * BM + wr * 64 + fr, col0 = u.pn * BM + wc * 32 + 8 * fq;
#pragma unroll
        for (int ai = 0; ai < 2; ++ai)
#pragma unroll
            for (int m = 0; m < 4; ++m) { const int row = row0 + ai * HALF + m * 16; const size_t off = (size_t)row * ldc + col0; float ss = 0.f;
#pragma unroll
                for (int bj = 0; bj < 2; ++bj) { f32x4 b0, b1;
                    if (BASE_F32) { b0 = *(const f32x4*)(base + off + bj * HALF); b1 = *(const f32x4*)(base + off + bj * HALF + 4); }
                    else { const u32x4 w = *(const u32x4*)(xb + off + bj * HALF);
                        b0 = (f32x4){__uint_as_float(w.x << 16), __uint_as_float(w.x & 0xffff0000u), __uint_as_float(w.y << 16), __uint_as_float(w.y & 0xffff0000u)};
                        b1 = (f32x4){__uint_as_float(w.z << 16), __uint_as_float(w.z & 0xffff0000u), __uint_as_float(w.w << 16), __uint_as_float(w.w & 0xffff0000u)}; }
                    const f32x4 x0 = b0 + acc[ai][bj][m][0], x1 = b1 + acc[ai][bj][m][1];
                    if (OUT_F32) { *(f32x4*)(out + off + bj * HALF) = x0; *(f32x4*)(out + off + bj * HALF + 4) = x1; }
                    else st16(xb + off + bj * HALF, pack8(x0, x1));
                    ss += (x0[0] * x0[0] + x0[1] * x0[1]) + (x0[2] * x0[2] + x0[3] * x0[3]) + (x1[0] * x1[0] + x1[1] * x1[1]) + (x1[2] * x1[2] + x1[3] * x1[3]); }
                if (!OUT_F32) { ss += __shfl_xor(ss, 16); ss += __shfl_xor(ss, 32);
                    if (fq == 0) rs[(size_t)row * 32 + u.pn * 4 + wc] = ss; }
                }
    }
};
template <bool OUT_F32> struct EpiResP {
    static constexpr bool PERM = true, AFTER_DRAIN = true, RESID = true;
    float* out; bf16_t* xb; float* rs; int ldc;
    __device__ __forceinline__ void fused(f32x4 (&acc)[2][2][4][2], const Unit& u, int wr, int wc, int fr, int fq, PG8_LAS unsigned char* lds, int wid, int lane) const {
        const int row0 = u.pm * BM + wr * 64 + fr, col0 = u.pn * BM + wc * 32 + 8 * fq, wh = wc >> 1;
        u32x4 g7[4];
        if (wh) {
#pragma unroll
            for (int m = 0; m < 4; ++m) g7[m] = *(const u32x4*)(xb + (size_t)(row0 + HALF + m * 16) * ldc + col0 + HALF); }
#pragma unroll
        for (int ai = 0; ai < 2; ++ai)
#pragma unroll
            for (int m = 0; m < 4; ++m) { const int row = row0 + ai * HALF + m * 16; const size_t off = (size_t)row * ldc + col0; float ss = 0.f;
                const int lb = lds_byte(wr * 64 + m * 16 + fr, (wc & 1) * 32 + 8 * fq);
#pragma unroll
                for (int bj = 0; bj < 2; ++bj) {
                    const int s0 = (ai == 0 && bj == 0) ? 4 : (ai == 1 && bj == 0) ? 5 : (ai == 0 && bj == 1) ? 6 : 7;
                    const int s1 = (ai == 0 && bj == 0) ? 0 : (ai == 1 && bj == 0) ? 1 : 2;
                    u32x4 w;
                    if (ai == 1 && bj == 1) { if (wh) w = g7[m]; else w = *(const PG8_LAS u32x4*)(lds + s0 * HTB + lb); }
                    else w = *(const PG8_LAS u32x4*)(lds + (wh ? s1 : s0) * HTB + lb);
                    const f32x4 b0 = {__uint_as_float(w.x << 16), __uint_as_float(w.x & 0xffff0000u), __uint_as_float(w.y << 16), __uint_as_float(w.y & 0xffff0000u)};
                    const f32x4 b1 = {__uint_as_float(w.z << 16), __uint_as_float(w.z & 0xffff0000u), __uint_as_float(w.w << 16), __uint_as_float(w.w & 0xffff0000u)};
                    const f32x4 x0 = b0 + acc[ai][bj][m][0], x1 = b1 + acc[ai][bj][m][1];
                    if (OUT_F32) { *(f32x4*)(out + off + bj * HALF) = x0; *(f32x4*)(out + off + bj * HALF + 4) = x1; }
                    else st16(xb + off + bj * HALF, pack8(x0, x1));
                    ss += (x0[0] * x0[0] + x0[1] * x0[1]) + (x0[2] * x0[2] + x0[3] * x0[3]) + (x1[0] * x1[0] + x1[1] * x1[1]) + (x1[2] * x1[2] + x1[3] * x1[3]); }
                if (!OUT_F32) { ss += __shfl_xor(ss, 16); ss += __shfl_xor(ss, 32);
                    if (fq == 0) rs[(size_t)row * 32 + u.pn * 4 + wc] = ss; } }
    }
};
__device__ __forceinline__ float row_sumsq(const float* rs, int row) {
    const f32x4* p = (const f32x4*)(rs + (size_t)row * 32); f32x4 t = p[0];
#pragma unroll
    for (int i = 1; i < 8; ++i) t += p[i];
    return (t[0] + t[1]) + (t[2] + t[3]);
}
__device__ __forceinline__ float row_rstd(const float* rs, int row) { return 1.0f / sqrtf(row_sumsq(rs, row) * (1.0f / 2048.0f) + 1e-6f); }
struct RsOrder : StaticOrder {
    const float* rs; PG8_LAS float* tab; mutable float pend; mutable int nready;
    __device__ __forceinline__ void a_ready(const Unit& u) const {
        if (threadIdx.x < 256) pend = row_sumsq(rs, u.pm * BM + u.hf * HALF + threadIdx.x);
        ++nready;
    }
    __device__ __forceinline__ bool next(int i, Unit& u) const {
        if (i == 1 && threadIdx.x < 256) tab[threadIdx.x] = 1.0f / sqrtf(pend * (1.0f / 2048.0f) + 1e-6f);
        return StaticOrder::next(i, u);
    }
    __device__ __forceinline__ void done(const Unit&) const {
        if (threadIdx.x < 256) tab[((nready - 1) & 1) * 256 + threadIdx.x] = 1.0f / sqrtf(pend * (1.0f / 2048.0f) + 1e-6f);
    }
};
struct TailOrder : RsOrder {
    int pn0;
    __device__ __forceinline__ bool next(int i, Unit& u) const {
        if (i == 1 && threadIdx.x < 256) tab[threadIdx.x] = 1.0f / sqrtf(pend * (1.0f / 2048.0f) + 1e-6f);
        if (i != 0 || G != 256) return false;
        const int x = c & 7, l = c >> 3; u.pm = 4 * x + (l & 3); u.hf = (l >> 2) & 1; u.pn = pn0 + (l >> 3); return true;
    }
};
template <bool HALF_M> struct EpiSwiglu {
    static constexpr bool PERM = true, AFTER_DRAIN = false, RESID = false;
    bf16_t* O; int ldc; const PG8_LAS float* tab; mutable int ui;
    __device__ __forceinline__ void operator()(const f32x4 (&acc)[2][2][4][2], const Unit& u, int wr, int wc, int fr, int fq) const {
        const int row0 = u.pm * BM + (HALF_M ? u.hf * HALF : 0) + wr * 64 + fr, col0 = u.pn * HALF + wc * 32 + 8 * fq;
#pragma unroll
        for (int ai = 0; ai < (HALF_M ? 1 : 2); ++ai)
#pragma unroll
            for (int m = 0; m < 4; ++m) { bf16_t* rowp = O + (size_t)(row0 + ai * HALF + m * 16) * ldc + col0; const float r = tab[(ui & 1) * 256 + wr * 64 + fr + ai * HALF + m * 16];
                f32x4 v0, v1;
#pragma unroll
                for (int j = 0; j < 4; ++j) { const float g0 = acc[ai][0][m][0][j] * r, g1 = acc[ai][0][m][1][j] * r;
                    v0[j] = g0 * fast_sigmoid(g0) * (acc[ai][1][m][0][j] * r); v1[j] = g1 * fast_sigmoid(g1) * (acc[ai][1][m][1][j] * r); }
                st16(rowp, pack8(v0, v1)); }
        ++ui;
    }
};

struct EpiSwigluProbe {
    static constexpr bool PERM = true, AFTER_DRAIN = false, RESID = false;
    bf16_t* O; int never;
    __device__ __forceinline__ void operator()(const f32x4 (&acc)[2][2][4][2], const Unit& u, int wr, int wc, int fr, int fq) const {
        if (never) {
#pragma unroll
        for (int ai = 0; ai < 2; ++ai)
#pragma unroll
            for (int m = 0; m < 4; ++m) { bf16_t* rowp = O + (size_t)(u.pm * BM + wr * 64 + fr + ai * HALF + m * 16) * 5632 + u.pn * HALF + wc * 32 + 8 * fq;
                st16(rowp, pack8(acc[ai][0][m][0] + acc[ai][1][m][0], acc[ai][0][m][1] + acc[ai][1][m][1])); } }
    }
};
struct EpiRetIn {
    static constexpr bool PERM = true, AFTER_DRAIN = false, RESID = false;
    bf16_t *q, *k, *v, *g; const float *cs, *sn; const PG8_LAS float* tab; mutable int ui;
    __device__ __forceinline__ void operator()(const f32x4 (&acc)[2][2][4][2], const Unit& u, int wr, int wc, int fr, int fq) const {
        const int pn = u.pn, ci = wc * 32 + 8 * fq;
#pragma unroll
        for (int ai = 0; ai < 2; ++ai)
#pragma unroll
            for (int m = 0; m < 4; ++m) {
                const int row = u.pm * BM + ai * HALF + wr * 64 + m * 16 + fr, b = row >> 12, s = row & 4095; const float rr = tab[(ui & 1) * 256 + ai * HALF + wr * 64 + m * 16 + fr];
                if (pn < 16) {
                    const int h = pn & 7; const float sc = (pn < 8 ? 1.0f : 0.0625f) * rr;
                    bf16_t* dst = (pn < 8 ? q : k) + ((size_t)((b * 8 + h) * 4096 + s)) * 256 + ci;
                    f32x4 o1[2], o2[2];
#pragma unroll
                    for (int n = 0; n < 2; ++n) { const f32x4 c4 = *(const f32x4*)(cs + (size_t)row * 128 + ci + 4 * n), s4 = *(const f32x4*)(sn + (size_t)row * 128 + ci + 4 * n);
                        const f32x4 x1 = acc[ai][0][m][n], x2 = acc[ai][1][m][n];
                        o1[n] = (x1 * c4 - x2 * s4) * sc; o2[n] = (x2 * c4 + x1 * s4) * sc; }
                    st16(dst, pack8(o1[0], o1[1])); st16(dst + 128, pack8(o2[0], o2[1]));
                } else if (pn < 32) {
                    const int t = pn - 16, h = t >> 1, hf = t & 1;
                    bf16_t* dst = v + ((size_t)((b * 8 + h) * 4096 + s)) * 512 + hf * 256 + ci;
                    st16(dst, pack8(acc[ai][0][m][0] * rr, acc[ai][0][m][1] * rr)); st16(dst + 128, pack8(acc[ai][1][m][0] * rr, acc[ai][1][m][1] * rr));
                } else {
                    bf16_t* dst = g + (size_t)row * 4096 + (pn - 32) * 256 + ci;
                    st16(dst, pack8(acc[ai][0][m][0] * rr, acc[ai][0][m][1] * rr)); st16(dst + 128, pack8(acc[ai][1][m][0] * rr, acc[ai][1][m][1] * rr));
                }
            }
        ++ui;
    }
};
struct EpiGeluUV {
    static constexpr bool PERM = true, AFTER_DRAIN = false, RESID = false;
    bf16_t *uo, *vo; f32x2v* part; const PG8_LAS float* tab; mutable int ui;
    __device__ __forceinline__ void operator()(const f32x4 (&acc)[2][2][4][2], const Unit& u, int wr, int wc, int fr, int fq) const {
        const bool isv = u.pn >= 24; const int ct = isv ? u.pn - 24 : u.pn; bf16_t* dstb = isv ? vo : uo;
#pragma unroll
        for (int ai = 0; ai < 2; ++ai)
#pragma unroll
            for (int m = 0; m < 4; ++m) {
                const int row = u.pm * BM + ai * HALF + wr * 64 + m * 16 + fr;
                bf16_t* dst = dstb + (size_t)row * 6144 + ct * 256 + wc * 32 + 8 * fq;
                float s = 0.f, ss = 0.f; const float rr = tab[(ui & 1) * 256 + ai * HALF + wr * 64 + m * 16 + fr];
#pragma unroll
                for (int bj = 0; bj < 2; ++bj) { const f32x4 v0 = acc[ai][bj][m][0] * rr, v1 = acc[ai][bj][m][1] * rr;
                    const f32x2 a = gelu_pk((f32x2){v0[0], v0[1]}), b = gelu_pk((f32x2){v0[2], v0[3]}), c = gelu_pk((f32x2){v1[0], v1[1]}), d = gelu_pk((f32x2){v1[2], v1[3]});
                    const f32x4 z0 = {a.x, a.y, b.x, b.y}, z1 = {c.x, c.y, d.x, d.y};
                    st16(dst + bj * HALF, pack8(z0, z1));
                    s += (z0[0] + z0[1]) + (z0[2] + z0[3]) + (z1[0] + z1[1]) + (z1[2] + z1[3]);
                    ss += (z0[0] * z0[0] + z0[1] * z0[1]) + (z0[2] * z0[2] + z0[3] * z0[3]) + (z1[0] * z1[0] + z1[1] * z1[1]) + (z1[2] * z1[2] + z1[3] * z1[3]); }
                if (isv) { s += __shfl_xor(s, 16); s += __shfl_xor(s, 32); ss += __shfl_xor(ss, 16); ss += __shfl_xor(ss, 32);
                    if (fq == 0) part[((size_t)row * 24 + ct) * 4 + wc] = (f32x2v){s, ss}; }
            }
        ++ui;
    }
};
struct EpiFoxIn {
    static constexpr bool PERM = true, AFTER_DRAIN = false, RESID = false;
    bf16_t* O; size_t stride; const PG8_LAS float* tab; mutable int ui; PG8_LAS float* qkt; const PG8_LAS float* gains;
    __device__ __forceinline__ void operator()(const f32x4 (&acc)[2][2][4][2], const Unit& u, int wr, int wc, int fr, int fq) const {
        const int t = u.pn >> 3; bf16_t* base = O + (size_t)t * stride + (u.pn & 7) * 256 + wc * 32 + 8 * fq;
        if (t < 2) {
#pragma unroll
            for (int ai = 0; ai < 2; ++ai)
#pragma unroll
                for (int m = 0; m < 4; ++m) { const int rt = ai * HALF + wr * 64 + m * 16 + fr; const float rr = tab[(ui & 1) * 256 + rt];
#pragma unroll
                    for (int bj = 0; bj < 2; ++bj) { const f32x4 v0 = acc[ai][bj][m][0] * rr, v1 = acc[ai][bj][m][1] * rr;
                        float ss = (v0[0] * v0[0] + v0[1] * v0[1]) + (v0[2] * v0[2] + v0[3] * v0[3]) + (v1[0] * v1[0] + v1[1] * v1[1]) + (v1[2] * v1[2] + v1[3] * v1[3]);
                        ss += __shfl_xor(ss, 16); ss += __shfl_xor(ss, 32);
                        if (fq == 0) qkt[(rt * 2 + bj) * 4 + wc] = ss; } }
            asm volatile("s_waitcnt lgkmcnt(0)" ::: "memory"); __builtin_amdgcn_s_barrier(); asm volatile("" ::: "memory");
            const float sc = t == 0 ? 0.08838834764831845f * 1.4426950408889634f : 1.0f;
            const f32x4 g0 = *(const PG8_LAS f32x4*)(gains + t * 128 + wc * 32 + 8 * fq), g1 = *(const PG8_LAS f32x4*)(gains + t * 128 + wc * 32 + 8 * fq + 4);
#pragma unroll
            for (int ai = 0; ai < 2; ++ai)
#pragma unroll
                for (int m = 0; m < 4; ++m) { const int rt = ai * HALF + wr * 64 + m * 16 + fr; const float rr = tab[(ui & 1) * 256 + rt]; bf16_t* dst = base + (size_t)(u.pm * BM + rt) * 2048;
#pragma unroll
                    for (int bj = 0; bj < 2; ++bj) { const f32x4 p = *(const PG8_LAS f32x4*)(qkt + (rt * 2 + bj) * 4);
                        const float rs = rr * sc / sqrtf(((p[0] + p[1]) + (p[2] + p[3])) * (1.0f / 128.0f) + 1e-6f);
                        st16(dst + bj * HALF, pack8(acc[ai][bj][m][0] * rs * g0, acc[ai][bj][m][1] * rs * g1)); } }
        } else {
#pragma unroll
            for (int ai = 0; ai < 2; ++ai)
#pragma unroll
                for (int m = 0; m < 4; ++m) { const int row = u.pm * BM + ai * HALF + wr * 64 + m * 16 + fr; bf16_t* dst = base + (size_t)row * 2048; const float rr = tab[(ui & 1) * 256 + ai * HALF + wr * 64 + m * 16 + fr];
#pragma unroll
                    for (int bj = 0; bj < 2; ++bj) { f32x4 v0 = acc[ai][bj][m][0] * rr, v1 = acc[ai][bj][m][1] * rr;
                        if (t == 3) {
#pragma unroll
                            for (int j = 0; j < 4; ++j) { v0[j] = fast_sigmoid(v0[j]); v1[j] = fast_sigmoid(v1[j]); } }
                        st16(dst + bj * HALF, pack8(v0, v1)); } }
        }
        ++ui;
    }
};

template <class Epi, class Sched, bool ALIGN_EPI = false, bool SP2 = false, bool HALF_M = false, int ABL = 0>
__device__ __forceinline__ void gemm_phase(PG8_LAS unsigned char* lds, const Gemm g, const Sched& S, const Epi& E) {
    const int tid = threadIdx.x, wid = __builtin_amdgcn_readfirstlane(tid >> 6), lane = tid & 63, wr = wid >> 2, wc = wid & 3, fr = lane & 15, fq = lane >> 4;
    static_assert(!HALF_M || SP2, "HALF_M is written for the SP2 loop");
    const int K = g.K, nt = K / BK;
    unsigned voffA[2], voffB[2];
#pragma unroll
    for (int i = 0; i < 2; ++i) { int R, C; stage_rc(tid * 16 + i * 8192, R, C); const int Rb = Epi::PERM ? ((R & ~31) + perm32(R & 31)) : R;
        voffA[i] = (unsigned)(R * K + C) * 2u; voffB[i] = (unsigned)(Rb * K + C) * 2u; }
    unsigned voffR[2] = {0u, 0u};
    if constexpr (Epi::RESID) {
#pragma unroll
        for (int i = 0; i < 2; ++i) { int R, C; stage_rc(tid * 16 + i * 8192, R, C); voffR[i] = (unsigned)(R * E.ldc + C) * 2u; } }
    const size_t kstep = (size_t)(BK * 2);
    const size_t hstep = (size_t)HALF * K * 2;
    const size_t tstep = 2 * hstep;
    const unsigned ldsw = (unsigned)wid * 1024u;
    const int aoff = lds_byte(wr * 64 + fr, fq * 8), boff = lds_byte(wc * 32 + fr, fq * 8);
#define PG8_SA(b, h) (((b) * 2 + (h)) * HTB)
#define PG8_SB(b, h) ((4 + (b) * 2 + (h)) * HTB)
#define PG8_STAGE(bufoff, gbase, voff) do { if constexpr (!(ABL & 2)) _Pragma("unroll") for (int _i = 0; _i < 2; ++_i) \
        __builtin_amdgcn_global_load_lds((const unsigned*)((const char*)(gbase) + (voff)[_i]), (PG8_LAS unsigned*)(lds + (bufoff) + ldsw + _i * 8192), 16, 0, 0); } while (0)
#define PG8_LDA(dst, b, h) do { if constexpr (!(ABL & 4)) { _Pragma("unroll") for (int m = 0; m < 4; ++m) _Pragma("unroll") for (int k = 0; k < 2; ++k) { dst[m][k] = *(const PG8_LAS bf16x8*)(lds + PG8_SA(b, h) + aoff + m * 2048 + k * 1024); if constexpr (ABL & 1) asm volatile("" :: "v"(dst[m][k])); } } } while (0)
#define PG8_LDB(dst, b, h) do { if constexpr (!(ABL & 4)) { _Pragma("unroll") for (int n = 0; n < 2; ++n) _Pragma("unroll") for (int k = 0; k < 2; ++k) { dst[n][k] = *(const PG8_LAS bf16x8*)(lds + PG8_SB(b, h) + boff + n * 2048 + k * 1024); if constexpr (ABL & 1) asm volatile("" :: "v"(dst[n][k])); } } } while (0)
#define PG8_MMA(ai, bj, At, Bt) do { if constexpr (!(ABL & 1)) { __builtin_amdgcn_s_setprio(1); _Pragma("unroll") for (int m = 0; m < 4; ++m) _Pragma("unroll") for (int n = 0; n < 2; ++n) _Pragma("unroll") for (int k = 0; k < 2; ++k) \
        acc[ai][bj][m][n] = __builtin_amdgcn_mfma_f32_16x16x32_bf16(Bt[n][k], At[m][k], acc[ai][bj][m][n], 0, 0, 0); __builtin_amdgcn_s_setprio(0); } } while (0)
#define PG8_WAIT_V(n) asm volatile("s_waitcnt vmcnt(" #n ")" ::: "memory")
#define PG8_WAIT_L(n) asm volatile("s_waitcnt lgkmcnt(" #n ")" ::: "memory")
#define PG8_BAR __builtin_amdgcn_s_barrier()
#define PG8_SCHED __builtin_amdgcn_sched_barrier(0)
    Unit cur, nxt; int ui = 0;
    if (!S.next(0, cur)) return;
    f32x4 acc[2][2][4][2];
#pragma unroll
    for (int a = 0; a < 2; ++a)
#pragma unroll
        for (int b = 0; b < 2; ++b)
#pragma unroll
            for (int m = 0; m < 4; ++m)
#pragma unroll
                for (int n = 0; n < 2; ++n) acc[a][b][m][n] = (f32x4){0.f, 0.f, 0.f, 0.f};
    bf16x8 At[4][2], B0[2][2], B1[2][2];
    if constexpr (ABL & 4) { _Pragma("unroll") for (int m = 0; m < 4; ++m) _Pragma("unroll") for (int k = 0; k < 2; ++k) At[m][k] = (bf16x8){(short)lane, 1, 2, 3, 4, 5, 6, 7};
        _Pragma("unroll") for (int n = 0; n < 2; ++n) _Pragma("unroll") for (int k = 0; k < 2; ++k) { B0[n][k] = (bf16x8){(short)lane, 1, 2, 3, 4, 5, 6, 7}; B1[n][k] = B0[n][k]; } }
    const char* cA = (const char*)g.A + (size_t)cur.pm * tstep + (HALF_M ? (size_t)cur.hf * hstep : (size_t)0); const char* cB = (const char*)g.Bt + (size_t)cur.pn * tstep;
    S.a_ready(cur);
    if constexpr (SP2) {
        PG8_STAGE(PG8_SB(0, 0), cB, voffB); PG8_STAGE(PG8_SB(0, 1), cB + hstep, voffB); PG8_STAGE(PG8_SA(0, 0), cA, voffA); PG8_STAGE(PG8_SA(0, 1), cA + hstep, voffA);
        if (wr == 1) PG8_BAR;
        PG8_WAIT_V(2); PG8_BAR;
        PG8_STAGE(PG8_SB(1, 0), cB + kstep, voffB); PG8_STAGE(PG8_SA(1, 0), cA + kstep, voffA); PG8_STAGE(PG8_SB(1, 1), cB + hstep + kstep, voffB);
        PG8_WAIT_V(6); PG8_BAR;
    } else {
        PG8_STAGE(PG8_SB(0, 0), cB, voffB); PG8_STAGE(PG8_SA(0, 0), cA, voffA); PG8_STAGE(PG8_SB(0, 1), cB + hstep, voffB); PG8_STAGE(PG8_SA(0, 1), cA + hstep, voffA);
        if (wr == 1) PG8_BAR;
        PG8_WAIT_V(4); PG8_BAR;
        PG8_STAGE(PG8_SB(1, 0), cB + kstep, voffB); PG8_STAGE(PG8_SA(1, 0), cA + kstep, voffA); PG8_STAGE(PG8_SB(1, 1), cB + hstep + kstep, voffB);
        PG8_WAIT_V(6); PG8_BAR;
    }
    for (;;) {
        const bool has_next = S.next(ui + 1, nxt);
        const char* nA = has_next ? (const char*)g.A + (size_t)nxt.pm * tstep + (HALF_M ? (size_t)nxt.hf * hstep : (size_t)0) : cA; const char* nB = has_next ? (const char*)g.Bt + (size_t)nxt.pn * tstep : cB;
        for (int t = 0; t < nt; t += 2) {
            const bool last = (t == nt - 2);
            const char* a1 = cA + (size_t)(t + 1) * kstep;
            const char* a2 = last ? nA : cA + (size_t)(t + 2) * kstep; const char* b2 = last ? nB : cB + (size_t)(t + 2) * kstep;
            const char* a3 = a2 + kstep; const char* b3 = b2 + kstep;
            if (last && has_next) S.a_ready(nxt);
            bool rp = false; const char* rbase = nullptr; size_t rhstep = 0;
            if constexpr (Epi::RESID) { rp = last && !has_next; rbase = (const char*)E.xb + ((size_t)cur.pm * BM * E.ldc + (size_t)cur.pn * BM) * 2; rhstep = (size_t)HALF * E.ldc * 2; }
#define PG8_STAGE_R(bufoff, gbase, voff, blk) do { if constexpr (Epi::RESID) { const char* g_ = rp ? (rbase + ((blk) & 1) * rhstep + ((blk) >> 1) * 128) : (const char*)(gbase); \
                _Pragma("unroll") for (int _i = 0; _i < 2; ++_i) __builtin_amdgcn_global_load_lds((const unsigned*)(g_ + (rp ? voffR[_i] : (voff)[_i])), (PG8_LAS unsigned*)(lds + (bufoff) + ldsw + _i * 8192), 16, 0, 0); } \
            else { PG8_STAGE(bufoff, gbase, voff); } } while (0)
            if constexpr (SP2) {
            PG8_LDB(B0, 0, 0); PG8_LDB(B1, 0, 1); PG8_SCHED; PG8_LDA(At, 0, 0); PG8_STAGE(PG8_SA(1, 1), a1 + hstep, voffA);
            PG8_WAIT_V(8); PG8_WAIT_L(0); PG8_BAR; PG8_MMA(0, 0, At, B0); PG8_MMA(0, 1, At, B1); PG8_BAR; PG8_SCHED;
            if constexpr (!HALF_M) { PG8_LDA(At, 0, 1); } PG8_STAGE_R(PG8_SB(0, 0), b2, voffB, 0); PG8_STAGE_R(PG8_SB(0, 1), b2 + hstep, voffB, 1); PG8_STAGE_R(PG8_SA(0, 0), a2, voffA, 2);
            PG8_WAIT_V(8); PG8_WAIT_L(0); PG8_BAR; if constexpr (!HALF_M) { PG8_MMA(1, 0, At, B0); PG8_MMA(1, 1, At, B1); } PG8_BAR; PG8_SCHED;
            PG8_LDB(B0, 1, 0); PG8_LDB(B1, 1, 1); PG8_SCHED; PG8_LDA(At, 1, 0); PG8_STAGE_R(PG8_SA(0, 1), a2 + hstep, voffA, 3);
            PG8_WAIT_V(8); PG8_WAIT_L(0); PG8_BAR; PG8_MMA(0, 0, At, B0); PG8_MMA(0, 1, At, B1); PG8_BAR; PG8_SCHED;
            if constexpr (!HALF_M) { PG8_LDA(At, 1, 1); } PG8_STAGE_R(PG8_SB(1, 0), b3, voffB, 4); PG8_STAGE_R(PG8_SB(1, 1), b3 + hstep, voffB, 5); PG8_STAGE_R(PG8_SA(1, 0), a3, voffA, 6);
            PG8_WAIT_V(8); PG8_WAIT_L(0); PG8_BAR; if constexpr (!HALF_M) { PG8_MMA(1, 0, At, B0); PG8_MMA(1, 1, At, B1); } PG8_BAR; PG8_SCHED;
            } else {
            PG8_LDB(B0, 0, 0); PG8_SCHED; PG8_LDA(At, 0, 0); PG8_STAGE(PG8_SA(1, 1), a1 + hstep, voffA);
            PG8_WAIT_L(8); PG8_BAR; PG8_WAIT_L(0); PG8_MMA(0, 0, At, B0); PG8_BAR; PG8_SCHED;
            PG8_LDB(B1, 0, 1); PG8_STAGE(PG8_SB(0, 0), b2, voffB);
            PG8_BAR; PG8_WAIT_L(0); PG8_MMA(0, 1, At, B1); PG8_BAR;
            PG8_LDA(At, 0, 1); PG8_STAGE(PG8_SA(0, 0), a2, voffA);
            PG8_BAR; PG8_WAIT_L(0); PG8_MMA(1, 0, At, B0); PG8_BAR; PG8_SCHED;
            PG8_STAGE(PG8_SB(0, 1), b2 + hstep, voffB);
            PG8_WAIT_V(6); PG8_BAR; PG8_MMA(1, 1, At, B1); PG8_BAR;
            PG8_LDB(B0, 1, 0); PG8_SCHED; PG8_LDA(At, 1, 0); PG8_STAGE(PG8_SA(0, 1), a2 + hstep, voffA);
            PG8_WAIT_L(8); PG8_BAR; PG8_WAIT_L(0); PG8_MMA(0, 0, At, B0); PG8_BAR; PG8_SCHED;
            PG8_LDB(B1, 1, 1); PG8_STAGE(PG8_SB(1, 0), b3, voffB);
            PG8_BAR; PG8_WAIT_L(0); PG8_MMA(0, 1, At, B1); PG8_BAR;
            PG8_LDA(At, 1, 1); PG8_STAGE(PG8_SA(1, 0), a3, voffA);
            PG8_BAR; PG8_WAIT_L(0); PG8_MMA(1, 0, At, B0); PG8_BAR; PG8_SCHED;
            PG8_STAGE(PG8_SB(1, 1), b3 + hstep, voffB);
            PG8_WAIT_V(6); PG8_BAR; PG8_MMA(1, 1, At, B1); PG8_BAR;
            }
        }
        if constexpr (ALIGN_EPI) { if (wr == 0) PG8_BAR; }
        if constexpr (!Epi::AFTER_DRAIN) { E(acc, cur, wr, wc, fr, fq); S.done(cur); }
        if (!has_next) break;
#pragma unroll
        for (int a = 0; a < 2; ++a)
#pragma unroll
            for (int b = 0; b < 2; ++b)
#pragma unroll
                for (int m = 0; m < 4; ++m)
#pragma unroll
                    for (int n = 0; n < 2; ++n) acc[a][b][m][n] = (f32x4){0.f, 0.f, 0.f, 0.f};
        cur = nxt; cA = nA; cB = nB; ++ui;
        if constexpr (ALIGN_EPI) { if (wr == 1) PG8_BAR; }
    }
    PG8_WAIT_V(0);
    if constexpr (!ALIGN_EPI) { if (wr == 0) PG8_BAR; }
    PG8_BAR;
    if constexpr (Epi::AFTER_DRAIN) { E.fused(acc, cur, wr, wc, fr, fq, lds, wid, lane); S.done(cur); }
#undef PG8_SA
#undef PG8_SB
#undef PG8_STAGE
#undef PG8_STAGE_R
#undef PG8_LDA
#undef PG8_LDB
#undef PG8_MMA
#undef PG8_WAIT_V
#undef PG8_WAIT_L
#undef PG8_BAR
#undef PG8_SCHED
}
}

#ifndef PG8_SP2
#define PG8_SP2 true
#endif
#ifndef PG8_ALIGN
#define PG8_ALIGN true
#endif
constexpr int NWAVES = 8, NTHR = 512;
#ifndef MK_N_LAUNCHES
#define MK_N_LAUNCHES 1
#endif
constexpr int N_PHASES = 25;
constexpr int N_LAUNCHES = MK_N_LAUNCHES;
static_assert(N_LAUNCHES == 1, "this build runs as ONE launch (the retention mixer has a grid barrier inside its phase)");

constexpr int BATCH = 2, SEQ = 4096, DM = 2048, M = BATCH * SEQ, DEPTH = 4;
constexpr int RET_N = 12288, GM_N = 12288, GM_HALF = 6144, FOX_LD = 8208, FOX_N = 8192, FFN_H = 5632, FFN_N2 = 2 * FFN_H;
constexpr float EPS = 1e-6f;
constexpr float LOG2E = 1.4426950408889634f;

constexpr size_t MiB = (size_t)1 << 20;
constexpr size_t WS_CTL = 0, CTL_ZERO_BYTES = 1 * MiB;
constexpr size_t WS_W_RET_IN = 1 * MiB, SZ_W_RET_IN = 48 * MiB;
constexpr size_t WS_W_RET_OUT = 97 * MiB, SZ_W_RET_OUT = 16 * MiB;
constexpr size_t WS_W_GM_IN = 129 * MiB, WS_W_GM_OUT = 177 * MiB, WS_W_FOX_IN = 201 * MiB, WS_W_FOX_OUT = 233 * MiB;
constexpr size_t WS_W_GU = 241 * MiB, SZ_W_GU = 44 * MiB;
constexpr size_t WS_W_DN = 417 * MiB, SZ_W_DN = 22 * MiB;
constexpr size_t WS_ROPE_C = 505 * MiB, WS_ROPE_S = 509 * MiB;
constexpr size_t WS_H = 513 * MiB;
constexpr size_t WS_A = 545 * MiB;
constexpr size_t WS_B = 737 * MiB;
constexpr size_t WS_C = 833 * MiB;
constexpr size_t WS_MISC = 897 * MiB, WS_RSP = 913 * MiB, WS_KF = 921 * MiB, WS_QF = 953 * MiB, WS_END = 985 * MiB;
constexpr size_t MISC_PART = 0, MISC_RSTAT = 8 * MiB, MISC_LF = 9 * MiB, MISC_WTRI = 12 * MiB;
constexpr int CW_BAR = 4096;

constexpr int RING_OFF = 0, RING_BYTES = 131072;
constexpr int LDSCTL_OFF = RING_BYTES, MISC_OFF = LDSCTL_OFF + 320;
constexpr int RSTAB_OFF = LDSCTL_OFF + 1024;
constexpr int QKT_OFF = LDSCTL_OFF + 3072, QKG_OFF = QKT_OFF + 8192;
constexpr int LDS_BYTES = 147456;
static_assert(MISC_OFF + 128 <= RSTAB_OFF && RSTAB_OFF + 2048 <= QKT_OFF && QKG_OFF + 1024 <= LDS_BYTES, "LDS map");

#define GAS __attribute__((address_space(1)))
#define LAS __attribute__((address_space(3)))
typedef unsigned short bf16;
typedef unsigned v4u __attribute__((ext_vector_type(4)));
typedef unsigned v2u __attribute__((ext_vector_type(2)));
typedef float f32x4 __attribute__((ext_vector_type(4)));
typedef float f32x2 __attribute__((ext_vector_type(2)));
typedef short bf16x8 __attribute__((ext_vector_type(8)));
typedef short s16x4 __attribute__((ext_vector_type(4)));
typedef GAS unsigned gu32;
typedef LAS unsigned char* ldsp;
#define RLX_AGENT __ATOMIC_RELAXED, __HIP_MEMORY_SCOPE_AGENT
#define LDS_WAIT() asm volatile("s_waitcnt lgkmcnt(0)" ::: "memory")
using pg8::cvtpk;
__device__ __forceinline__ float bflo(unsigned w) { return __uint_as_float(w << 16); }
__device__ __forceinline__ float bfhi(unsigned w) { return __uint_as_float(w & 0xffff0000u); }
#define MFMA16(a, b, c) __builtin_amdgcn_mfma_f32_16x16x32_bf16((a), (b), (c), 0, 0, 0)
__device__ __forceinline__ bf16x8 frag_row(const ldsp tile, int RS, int lane) { return *(const LAS bf16x8*)(tile + (lane & 15) * RS + (lane >> 4) * 16); }
typedef short v4i16_t __attribute__((ext_vector_type(4)));
__device__ __forceinline__ s16x4 vtr(const ldsp p) { return __builtin_bit_cast(s16x4, __builtin_amdgcn_ds_read_tr16_b64_v4i16((LAS v4i16_t*)p)); }
__device__ __forceinline__ bf16x8 frag_tr(const ldsp tile, int RS, int lane) {
    const ldsp a = tile + (8 * (lane >> 4) + ((lane & 15) >> 2)) * RS + 8 * (lane & 3);
    const s16x4 lo = vtr(a), hi = vtr(a + 4 * RS);
    return (bf16x8){lo[0], lo[1], lo[2], lo[3], hi[0], hi[1], hi[2], hi[3]};
}

#define XB_TMO      128
#define XB_XCNT(j)  (256  + 64 * (j))
#define XB_XSUB(j)  (1280 + 64 * (j))
#define XB_XGEN(j)  (2304 + 64 * (j))
#define XB_TOP      3328
#define XB_TOPGEN   3392
#define XCD_BAR_WORDS 3456
#define XB_SPIN_CAP (1u << 18)

__device__ __forceinline__ unsigned xb_ld(unsigned* p)              { return __hip_atomic_load(p, __ATOMIC_RELAXED, __HIP_MEMORY_SCOPE_AGENT); }
__device__ __forceinline__ unsigned xb_add(unsigned* p, unsigned v) { return __hip_atomic_fetch_add(p, v, __ATOMIC_RELAXED, __HIP_MEMORY_SCOPE_AGENT); }
__device__ __forceinline__ unsigned xb_xcc_id() { return (unsigned)__builtin_amdgcn_s_getreg((3 << 11) | 20) & 0xFu; }
#define XB_SPIN(cond, bar) do { unsigned _sp = 0; while (cond) { __builtin_amdgcn_s_sleep(1); \
    if ((++_sp & 255u) == 0u) { if (xb_ld(&(bar)[XB_TMO])) break; if (_sp > XB_SPIN_CAP) { atomicAdd(&(bar)[XB_TMO], 1u); break; } } } } while (0)

struct XcdBarrier {
    unsigned* bar; unsigned x;
    volatile LAS unsigned* st;
};

__device__ __forceinline__ XcdBarrier xcd_barrier_post(unsigned* bar, volatile LAS unsigned* st) {
    XcdBarrier b; b.bar = bar; b.x = xb_xcc_id(); b.st = st;
    if (threadIdx.x == 0) (void)xb_add(&bar[XB_XCNT(b.x)], 1u);
    return b;
}
__device__ __forceinline__ void xcd_barrier_complete(unsigned* bar, unsigned x, unsigned& nloc, unsigned& nx) {
    const unsigned G = gridDim.x * gridDim.y * gridDim.z;
    unsigned sum, cnt, mine, sp = 0u;
    for (;;) {
        sum = 0u; cnt = 0u; mine = 0u;
#pragma unroll
        for (unsigned j = 0; j < 16; ++j) { const unsigned c = xb_ld(&bar[XB_XCNT(j)]); sum += c; cnt += (c > 0u) ? 1u : 0u; mine = (j == x) ? c : mine; }
        if (sum == G) break;
        __builtin_amdgcn_s_sleep(1);
        if ((++sp & 255u) == 0u) { if (xb_ld(&bar[XB_TMO])) break; if (sp > XB_SPIN_CAP) { atomicAdd(&bar[XB_TMO], 1u); break; } }
    }
    nloc = mine > 0u ? mine : 1u; nx = cnt > 0u ? cnt : 1u;
}

__device__ __forceinline__ void xcd_barrier(const XcdBarrier& b) {
    asm volatile("s_waitcnt vmcnt(0)" ::: "memory");
    __syncthreads();
    if (threadIdx.x == 0) {
        unsigned* bar = b.bar;
        __builtin_amdgcn_s_waitcnt(0);
        unsigned nloc = b.st[0], nx = b.st[1];
        if (nloc == 0u) { xcd_barrier_complete(bar, b.x, nloc, nx); b.st[0] = nloc; b.st[1] = nx; }
        const unsigned old = xb_add(&bar[XB_XSUB(b.x)], 1u);
        const unsigned gen = old / nloc;
        if (old + 1u == (gen + 1u) * nloc) {
            __builtin_amdgcn_fence(__ATOMIC_RELEASE, "agent");
            asm volatile("s_waitcnt vmcnt(0)" ::: "memory");
            const unsigned og = xb_add(&bar[XB_TOP], 1u);
            const unsigned tg = og / nx;
            if (og + 1u == (tg + 1u) * nx) xb_add(&bar[XB_TOPGEN], 1u);
            else XB_SPIN(xb_ld(&bar[XB_TOPGEN]) == tg, bar);
            __builtin_amdgcn_fence(__ATOMIC_ACQUIRE, "agent");
            xb_add(&bar[XB_XGEN(b.x)], 1u);
            asm volatile("s_waitcnt vmcnt(0)" ::: "memory");
        } else {
            XB_SPIN(xb_ld(&bar[XB_XGEN(b.x)]) == gen, bar);
            __builtin_amdgcn_fence(__ATOMIC_ACQUIRE, "agent");
            asm volatile("s_waitcnt vmcnt(0)" ::: "memory");
        }
    }
    __syncthreads();
}

struct Frame {
    ldsp lds;
    volatile LAS unsigned* MISC;
    gu32* ctl;
    int tid, lane, wave;
    int vcu, G;
};
__device__ __forceinline__ float wave_sum(float v) {
#pragma unroll
    for (int o = 1; o < 64; o <<= 1) v += __shfl_xor(v, o);
    return v;
}
__device__ __forceinline__ float log_sigmoid(float z) { return fminf(z, 0.f) - log1pf(expf(-fabsf(z))); }

__device__ __forceinline__ void transpose_job(Frame& F, const float* W, int K, int ld, int ncols, bf16* WT, int ilv, const float* gvec) {
    LAS float* scr = (LAS float*)(F.lds + RING_OFF + F.wave * 16384);
    const int gw = F.vcu * NWAVES + F.wave, NGW = F.G * NWAVES, lane = F.lane;
    const int nblk = ncols / 32, nitems = (K / 64) * nblk;
    float wv[32];
#define TJ_LOAD(item) do { const int kb_ = (item) / nblk, nb_ = (item) % nblk; const float* src_ = W + (size_t)(64 * kb_ + (lane >> 5)) * ld + 32 * nb_ + (lane & 31); \
        _Pragma("unroll") for (int i = 0; i < 32; ++i) wv[i] = src_[(size_t)(2 * i) * ld]; } while (0)
    if (gw < nitems) TJ_LOAD(gw);
    for (int it = gw; it < nitems; it += NGW) {
        const int kb = it / nblk, nb = it % nblk, k0 = 64 * kb, n0 = 32 * nb;
        const int drow0 = ilv == 0 ? n0 : ((n0 >> 7) * 256 + (n0 & 127) + (ilv == 2 ? 128 : 0));
#pragma unroll
        for (int i = 0; i < 32; ++i) scr[(2 * i + (lane >> 5)) * 33 + (lane & 31)] = wv[i];
        if (it + NGW < nitems) TJ_LOAD(it + NGW);
        LDS_WAIT(); asm volatile("" ::: "memory");
        const int c = lane & 7;
        f32x4 ga = {1.f, 1.f, 1.f, 1.f}, gb = {1.f, 1.f, 1.f, 1.f};
        if (gvec) { ga = *(const f32x4*)(gvec + k0 + 8 * c); gb = *(const f32x4*)(gvec + k0 + 8 * c + 4); }
#pragma unroll
        for (int j = 0; j < 4; ++j) { const int n = (lane >> 3) + 8 * j; const LAS float* s = scr + (8 * c) * 33 + n;
            v4u o; o.x = cvtpk(s[0 * 33] * ga[0], s[1 * 33] * ga[1]); o.y = cvtpk(s[2 * 33] * ga[2], s[3 * 33] * ga[3]); o.z = cvtpk(s[4 * 33] * gb[0], s[5 * 33] * gb[1]); o.w = cvtpk(s[6 * 33] * gb[2], s[7 * 33] * gb[3]);
            *(GAS v4u*)(WT + (size_t)(drow0 + n) * K + k0 + 8 * c) = o; }
        LDS_WAIT(); asm volatile("" ::: "memory");
    }
#undef TJ_LOAD
}
__device__ __forceinline__ void p0_prologue(Frame& F, const void* const* in, unsigned char* ws) {
    const float* mixg = (const float*)in[2]; const float* ffng = (const float*)in[3];
    for (int j = 0; j < 2; ++j) {
        transpose_job(F, (const float*)in[4] + (size_t)j * DM * RET_N, DM, RET_N, RET_N, (bf16*)(ws + WS_W_RET_IN + j * SZ_W_RET_IN), 0, mixg + (size_t)(3 * j) * DM);
        transpose_job(F, (const float*)in[6] + (size_t)j * 4096 * DM, 4096, DM, DM, (bf16*)(ws + WS_W_RET_OUT + j * SZ_W_RET_OUT), 0, nullptr);
    }
    transpose_job(F, (const float*)in[7], DM, GM_N, GM_N, (bf16*)(ws + WS_W_GM_IN), 0, mixg + DM);
    transpose_job(F, (const float*)in[12], GM_HALF, DM, DM, (bf16*)(ws + WS_W_GM_OUT), 0, nullptr);
    transpose_job(F, (const float*)in[13], DM, FOX_LD, FOX_N, (bf16*)(ws + WS_W_FOX_IN), 0, mixg + 2 * DM);
    transpose_job(F, (const float*)in[17], DM, DM, DM, (bf16*)(ws + WS_W_FOX_OUT), 0, nullptr);
    for (int i = 0; i < DEPTH; ++i) {
        transpose_job(F, (const float*)in[18] + (size_t)i * DM * FFN_H, DM, FFN_H, FFN_H, (bf16*)(ws + WS_W_GU + i * SZ_W_GU), 1, ffng + (size_t)i * DM);
        transpose_job(F, (const float*)in[19] + (size_t)i * DM * FFN_H, DM, FFN_H, FFN_H, (bf16*)(ws + WS_W_GU + i * SZ_W_GU), 2, ffng + (size_t)i * DM);
        transpose_job(F, (const float*)in[20] + (size_t)i * FFN_H * DM, FFN_H, DM, DM, (bf16*)(ws + WS_W_DN + i * SZ_W_DN), 0, nullptr);
    }
    { const float* x = (const float*)in[0]; bf16* xb = (bf16*)(ws + WS_H); float* rss = (float*)(ws + WS_RSP);
      const int gw = F.vcu * NWAVES + F.wave, NGW = F.G * NWAVES, lane = F.lane;
      for (int m = gw; m < M; m += NGW) { const f32x4* xr = (const f32x4*)(x + (size_t)m * DM) + lane; v2u* o8 = (v2u*)(xb + (size_t)m * DM) + lane; float ss = 0.f;
#pragma unroll
          for (int j = 0; j < 8; ++j) { const f32x4 v = xr[64 * j]; ss += (v.x * v.x + v.y * v.y) + (v.z * v.z + v.w * v.w); v2u w; w.x = cvtpk(v.x, v.y); w.y = cvtpk(v.z, v.w); o8[64 * j] = w; }
          ss = wave_sum(ss); if (lane < 32) rss[(size_t)m * 32 + lane] = lane == 0 ? ss : 0.f; } }
    { const float* wsp = (const float*)in[10]; bf16* wtri = (bf16*)(ws + WS_MISC + MISC_WTRI);
      for (int i4 = F.vcu * NTHR + F.tid; i4 < 8 * 128 * 32; i4 += F.G * NTHR) { const int t = (i4 >> 5) & 127, s4 = (i4 & 31) * 4; f32x4 wv = *(const f32x4*)(wsp + (size_t)i4 * 4);
#pragma unroll
          for (int e = 0; e < 4; ++e) if (s4 + e > t) wv[e] = 0.f;
          v2u pk; pk.x = cvtpk(wv[0], wv[1]); pk.y = cvtpk(wv[2], wv[3]); *(v2u*)(wtri + (size_t)i4 * 4) = pk; } }
    { const int* pos = (const int*)in[1]; float* cs = (float*)(ws + WS_ROPE_C); float* sn = (float*)(ws + WS_ROPE_S);
      const int gid = F.vcu * NTHR + F.tid, i = gid & 127, step = (F.G * NTHR) >> 7;
      const double invf = exp2(-(double)i * (13.287712379549449 / 128.0));
      for (int r = gid >> 7; r < M; r += step) { const double ang = (double)pos[r] * invf; const double rr = ang - 6.283185307179586 * rint(ang * 0.15915494309189535);
          const float a = (float)rr; cs[(size_t)r * 128 + i] = cosf(a); sn[(size_t)r * 128 + i] = sinf(a); } }
}

__device__ __forceinline__ void ret_p_phase(Frame& F, const bf16* q, const bf16* k, bf16* PF, bf16* KF, bf16* QF) {
    constexpr int RSQ = 272;
    const ldsp LQ = F.lds, LK = F.lds + 34816;
    const int tid = F.tid, lane = F.lane, w = F.wave, g4 = lane >> 4, l15 = lane & 15;
    for (int unit = F.vcu; unit < 512; unit += F.G) {
        const int bh = unit >> 5, ci = unit & 31, h = bh & 7;
        const float lg2 = log1pf(-exp2f(-5.0f - (float)h)) * LOG2E;
        const size_t rowbase = (size_t)bh * SEQ + ci * 128;
        v4u pq[4], pk[4];
#define RP_LD(dd) do { _Pragma("unroll") for (int ps = 0; ps < 4; ++ps) { const int r_ = ps * 32 + (tid >> 4), c_ = tid & 15; \
            pq[ps] = *(const v4u*)(q + (rowbase + r_) * 256 + (dd) * 128 + c_ * 8); pk[ps] = *(const v4u*)(k + (rowbase + r_) * 256 + (dd) * 128 + c_ * 8); } } while (0)
        RP_LD(0);
        f32x4 S[8];
#pragma unroll
        for (int t = 0; t < 8; ++t) S[t] = (f32x4){0.f, 0.f, 0.f, 0.f};
#pragma unroll
        for (int dh = 0; dh < 2; ++dh) {
            __syncthreads();
#pragma unroll
            for (int ps = 0; ps < 4; ++ps) { const int r_ = ps * 32 + (tid >> 4), c_ = tid & 15; *(LAS v4u*)(LQ + r_ * RSQ + c_ * 16) = pq[ps]; *(LAS v4u*)(LK + r_ * RSQ + c_ * 16) = pk[ps]; }
            if (dh == 0) RP_LD(1);
            __syncthreads();
#pragma unroll
            for (int ks = 0; ks < 4; ++ks) { const bf16x8 a = frag_row(LQ + (16 * w) * RSQ + ks * 64, RSQ, lane);
                *(bf16x8*)(QF + ((((size_t)(bh * 32 + ci) * 8 + w) * 8 + dh * 4 + ks) * 512 + lane * 8)) = a;
#pragma unroll
                for (int t = 0; t < 8; ++t) S[t] = MFMA16(a, frag_row(LK + (16 * t) * RSQ + ks * 64, RSQ, lane), S[t]); }
#pragma unroll
            for (int ks = 0; ks < 4; ++ks) { const bf16x8 f = frag_tr(LK + (32 * ks) * RSQ + (16 * w) * 2, RSQ, lane); const v4u fu = __builtin_bit_cast(v4u, f); v4u o;
                const float k0 = exp2f((float)(127 - 32 * ks - 8 * g4) * lg2), gi = exp2f(-lg2), k1 = k0 * gi, k2 = k1 * gi, k3 = k2 * gi, k4 = k3 * gi, k5 = k4 * gi, k6 = k5 * gi, k7 = k6 * gi;
                o.x = cvtpk(bflo(fu.x) * k0, bfhi(fu.x) * k1); o.y = cvtpk(bflo(fu.y) * k2, bfhi(fu.y) * k3); o.z = cvtpk(bflo(fu.z) * k4, bfhi(fu.z) * k5); o.w = cvtpk(bflo(fu.w) * k6, bfhi(fu.w) * k7);
                *(v4u*)(KF + ((((size_t)(bh * 32 + ci) * 2 + dh) * 8 + w) * 4 + ks) * 512 + lane * 8) = o; }
        }
#undef RP_LD
#pragma unroll
        for (int t = 0; t < 8; ++t)
#pragma unroll
            for (int r = 0; r < 4; ++r) { const int n = 16 * w + 4 * g4 + r, mm = 16 * t + l15;
                const float pv_ = n >= mm ? S[t][r] * exp2f((float)(n - mm) * lg2) : 0.f;
                *(LAS unsigned short*)(LQ + n * RSQ + mm * 2) = (unsigned short)(cvtpk(pv_, 0.f) & 0xffffu); }
#pragma unroll
        for (int ks = 0; ks < 4; ++ks) *(bf16x8*)(PF + ((((size_t)(bh * 32 + ci) * 8 + w) * 4 + ks) * 512 + lane * 8)) = frag_row(LQ + (16 * w) * RSQ + ks * 64, RSQ, lane);
    }
}
#ifndef RC_ILV
#define RC_ILV 1
#endif
__device__ __forceinline__ void ret_core_phase(Frame& F, const bf16* QF, const bf16* v, const bf16* PF, const bf16* KF, bf16* o, const int umask = 0) {
    constexpr int RSV = 72, RSS = 528;
    const ldsp LV0 = F.lds, LST = F.lds + 18432;
    const ldsp LOw = F.lds + 52224 + F.wave * 1024;
    const int tid = F.tid, lane = F.lane, w = F.wave, g4 = lane >> 4, l15 = lane & 15;
    for (int unit = F.vcu; unit < 256; unit += F.G) {
        if (unit & umask) continue;
        const int bh = unit >> 4, es = unit & 15, h = bh & 7, b = bh >> 3, e0 = es * 32;
        const float lg2 = log1pf(-exp2f(-5.0f - (float)h)) * LOG2E;
        const float cd = exp2f(128.0f * lg2);
        const size_t rb0 = (size_t)bh * SEQ;
        f32x4 st[2][2];
#pragma unroll
        for (int a = 0; a < 2; ++a)
#pragma unroll
            for (int t = 0; t < 2; ++t) st[a][t] = (f32x4){0.f, 0.f, 0.f, 0.f};
        __syncthreads();
        for (int i = tid; i < 16896 / 4; i += NTHR) ((LAS unsigned*)LST)[i] = 0u;
        v4u pv, pvn; bf16x8 qf[8], pf[4], kf[8], qn[8], pn[4], kn[8];
#define RC_LD_V(cc) do { pvn = *(const v4u*)(v + (rb0 + (cc) * 128 + (tid >> 2)) * 512 + e0 + (tid & 3) * 8); } while (0)
#define RC_LD_Q(cc, k0_, k1_) do { _Pragma("unroll") for (int ks = (k0_); ks < (k1_); ++ks) qn[ks] = *(const bf16x8*)(QF + ((((size_t)(bh * 32 + (cc)) * 8 + w) * 8 + ks) * 512 + lane * 8)); } while (0)
#define RC_LD_P(cc) do { _Pragma("unroll") for (int ks = 0; ks < 4; ++ks) pn[ks] = *(const bf16x8*)(PF + ((((size_t)(bh * 32 + (cc)) * 8 + w) * 4 + ks) * 512 + lane * 8)); } while (0)
#define RC_LD_K(cc, k0_, k1_) do { _Pragma("unroll") for (int i_ = (k0_); i_ < (k1_); ++i_) kn[i_] = *(const bf16x8*)(KF + ((((size_t)(bh * 32 + (cc)) * 2 + (i_ >> 2)) * 8 + w) * 4 + (i_ & 3)) * 512 + lane * 8); } while (0)
#define RC_LD(cc) do { RC_LD_V(cc); RC_LD_Q(cc, 0, 8); RC_LD_P(cc); RC_LD_K(cc, 0, 8); } while (0)
#define RC_SB __builtin_amdgcn_sched_barrier(0)
        RC_LD(0);
        for (int ci = 0; ci < 32; ++ci) {
            const ldsp LSc = LST + (ci & 1) * 16896, LSn = LST + ((ci + 1) & 1) * 16896;
            const ldsp LV = LV0 + (ci & 1) * 9216;
            pv = pvn;
#pragma unroll
            for (int i_ = 0; i_ < 8; ++i_) { qf[i_] = qn[i_]; kf[i_] = kn[i_]; }
#pragma unroll
            for (int i_ = 0; i_ < 4; ++i_) pf[i_] = pn[i_];
            *(LAS v4u*)(LV + (tid >> 2) * RSV + (tid & 3) * 16) = pv;
            __syncthreads();
#if RC_ILV
            const bool nx = ci + 1 < 32;
            if (nx) { RC_LD_V(ci + 1); RC_LD_Q(ci + 1, 0, 4); } RC_SB;
#else
            if (ci + 1 < 32) RC_LD(ci + 1);
#endif
            bf16x8 vf[4][2];
#pragma unroll
            for (int ks = 0; ks < 4; ++ks)
#pragma unroll
                for (int t = 0; t < 2; ++t) vf[ks][t] = frag_tr(LV + (32 * ks) * RSV + (16 * t) * 2, RSV, lane);
            f32x4 cr[2], in[2];
            cr[0] = (f32x4){0.f, 0.f, 0.f, 0.f}; cr[1] = (f32x4){0.f, 0.f, 0.f, 0.f}; in[0] = (f32x4){0.f, 0.f, 0.f, 0.f}; in[1] = (f32x4){0.f, 0.f, 0.f, 0.f};
#pragma unroll
            for (int ks = 0; ks < 4; ++ks)
#pragma unroll
                for (int t = 0; t < 2; ++t) cr[t] = MFMA16(qf[ks], frag_row(LSc + (16 * t) * RSS + (ks * 32) * 2, RSS, lane), cr[t]);
#if RC_ILV
            RC_SB; if (nx) RC_LD_Q(ci + 1, 4, 8); RC_SB;
#endif
#pragma unroll
            for (int ks = 4; ks < 8; ++ks)
#pragma unroll
                for (int t = 0; t < 2; ++t) cr[t] = MFMA16(qf[ks], frag_row(LSc + (16 * t) * RSS + (ks * 32) * 2, RSS, lane), cr[t]);
#if RC_ILV
            RC_SB; if (nx) RC_LD_P(ci + 1); RC_SB;
#endif
#pragma unroll
            for (int ks = 0; ks < 4; ++ks)
#pragma unroll
                for (int t = 0; t < 2; ++t) in[t] = MFMA16(pf[ks], vf[ks][t], in[t]);
#pragma unroll
            for (int dh = 0; dh < 2; ++dh) {
#if RC_ILV
                RC_SB; if (nx) { if (dh == 0) RC_LD_K(ci + 1, 0, 4); else RC_LD_K(ci + 1, 4, 8); } RC_SB;
#endif
#pragma unroll
                for (int t = 0; t < 2; ++t) st[dh][t] = st[dh][t] * cd;
#pragma unroll
                for (int ks = 0; ks < 4; ++ks)
#pragma unroll
                    for (int t = 0; t < 2; ++t) st[dh][t] = MFMA16(kf[dh * 4 + ks], vf[ks][t], st[dh][t]);
#pragma unroll
                for (int t = 0; t < 2; ++t) { v2u pk2; pk2.x = cvtpk(st[dh][t][0], st[dh][t][1]); pk2.y = cvtpk(st[dh][t][2], st[dh][t][3]);
                    *(LAS v2u*)(LSn + (16 * t + l15) * RSS + (dh * 128 + 16 * w + 4 * g4) * 2) = pk2; }
            }
#pragma unroll
            for (int r = 0; r < 4; ++r) { const int n = 16 * w + 4 * g4 + r; const float qd = exp2f((float)(n + 1) * lg2);
#pragma unroll
                for (int t = 0; t < 2; ++t) *(LAS unsigned short*)(LOw + (4 * g4 + r) * 64 + (16 * t + l15) * 2) = (unsigned short)(cvtpk(in[t][r] + cr[t][r] * qd, 0.f) & 0xffffu); }
            *(v4u*)(o + ((size_t)b * SEQ + ci * 128 + 16 * w + (lane >> 2)) * 4096 + h * 512 + e0 + (lane & 3) * 8) = *(const LAS v4u*)(LOw + (lane >> 2) * 64 + (lane & 3) * 16);
        }
#undef RC_LD
#undef RC_LD_V
#undef RC_LD_Q
#undef RC_LD_P
#undef RC_LD_K
#undef RC_SB
    }
}

__device__ __forceinline__ void ret_gn_phase(Frame& F, const bf16* o, const bf16* g, const float* gn, bf16* y) {
    const int lane = F.lane, gw = F.vcu * NWAVES + F.wave, NGW = F.G * NWAVES;
    for (int it0 = gw; it0 < M * 8; it0 += 4 * NGW) {
        v4u ov[4], gv[4];
#pragma unroll
        for (int u = 0; u < 4; ++u) { const int it = it0 + u * NGW; const size_t off = (size_t)(it >> 3) * 4096 + (it & 7) * 512 + lane * 8;
            if (it < M * 8) { ov[u] = *(const v4u*)(o + off); gv[u] = *(const v4u*)(g + off); } else { ov[u] = (v4u){0u, 0u, 0u, 0u}; gv[u] = ov[u]; } }
#pragma unroll
        for (int u = 0; u < 4; ++u) { const int it = it0 + u * NGW, h = it & 7; const size_t off = (size_t)(it >> 3) * 4096 + h * 512 + lane * 8;
            float x[8] = {bflo(ov[u].x), bfhi(ov[u].x), bflo(ov[u].y), bfhi(ov[u].y), bflo(ov[u].z), bfhi(ov[u].z), bflo(ov[u].w), bfhi(ov[u].w)};
            float gg[8] = {bflo(gv[u].x), bfhi(gv[u].x), bflo(gv[u].y), bfhi(gv[u].y), bflo(gv[u].z), bfhi(gv[u].z), bflo(gv[u].w), bfhi(gv[u].w)};
            float s = 0.f;
#pragma unroll
            for (int e = 0; e < 8; ++e) s += x[e];
            const float mean = wave_sum(s) * (1.0f / 512.0f); float qv = 0.f;
#pragma unroll
            for (int e = 0; e < 8; ++e) { x[e] -= mean; qv += x[e] * x[e]; }
            const float rstd = 1.0f / sqrtf(wave_sum(qv) * (1.0f / 512.0f) + EPS);
            const f32x4 g0 = *(const f32x4*)(gn + h * 512 + lane * 8), g1 = *(const f32x4*)(gn + h * 512 + lane * 8 + 4);
            float r[8];
#pragma unroll
            for (int e = 0; e < 8; ++e) { const float gw_ = e < 4 ? g0[e & 3] : g1[e & 3]; r[e] = x[e] * rstd * gw_ * (gg[e] * pg8::fast_sigmoid(gg[e])); }
            v4u w; w.x = cvtpk(r[0], r[1]); w.y = cvtpk(r[2], r[3]); w.z = cvtpk(r[4], r[5]); w.w = cvtpk(r[6], r[7]);
            if (it < M * 8) *(v4u*)(y + off) = w; }
    }
}

__device__ __forceinline__ void gm_stat_phase(Frame& F, const f32x2* part, f32x2* rstat) {
    const int lane = F.lane, gw = F.vcu * NWAVES + F.wave, NGW = F.G * NWAVES;
    for (int row = gw; row < M; row += NGW) {
        float s = 0.f, ss = 0.f;
        if (lane < 48) { const f32x4 p = *(const f32x4*)(part + (size_t)row * 96 + lane * 2); s = p.x + p.z; ss = p.y + p.w; }
        s = wave_sum(s); ss = wave_sum(ss);
        const float mean = s * (1.0f / GM_HALF), var = fmaxf(ss * (1.0f / GM_HALF) - mean * mean, 0.f);
        if (lane == 0) rstat[row] = (f32x2){mean, 1.0f / sqrtf(var + EPS)};
    }
}
__device__ __forceinline__ void gm_spatial_phase(Frame& F, const bf16* u, const bf16* v, const f32x2* rstat, const float* lng, const float* lnb, const bf16* wtri, const float* bsp, bf16* y) {
    constexpr int RSW = 272, RSN = 528;
    const ldsp LW = F.lds, LN = F.lds + 34816;
    const int tid = F.tid, lane = F.lane, w = F.wave, g4 = lane >> 4, l15 = lane & 15;
    for (int wgi = F.vcu; wgi < 256; wgi += F.G) {
        const int gg = wgi & 7, jj = wgi >> 3;
        __syncthreads();
#pragma unroll
        for (int ps = 0; ps < 4; ++ps) { const int id = ps * NTHR + tid, t = id >> 4, c = id & 15;
            *(LAS v4u*)(LW + t * RSW + c * 16) = *(const v4u*)(wtri + ((size_t)gg * 128 + t) * 128 + c * 8); }
        float bs[8];
#pragma unroll
        for (int tt = 0; tt < 8; ++tt) bs[tt] = bsp[gg * 128 + 16 * tt + l15];
        v4u vr[8], ur[8];
#define GS_ROW0(i_) ((((jj) * 6 + (i_)) / 3) * 128)
#define GS_COL0(i_) (gg * 768 + (((jj) * 6 + (i_)) % 3) * 256)
#define GS_LDV(i_) do { _Pragma("unroll") for (int ps = 0; ps < 8; ++ps) { const int id_ = ps * NTHR + tid; vr[ps] = *(const v4u*)(v + (size_t)(GS_ROW0(i_) + (id_ >> 5)) * GM_HALF + GS_COL0(i_) + (id_ & 31) * 8); } } while (0)
        GS_LDV(0);
        for (int ui = 0; ui < 6; ++ui) {
            const int row0 = GS_ROW0(ui), col0 = GS_COL0(ui);
            __syncthreads();
#pragma unroll
            for (int ps = 0; ps < 8; ++ps) { const int id = ps * NTHR + tid, r = id >> 5, c8 = (id & 31) * 8;
                const v4u vv = vr[ps]; const f32x2 rs = rstat[row0 + r];
                const f32x4 ga = *(const f32x4*)(lng + col0 + c8), gb = *(const f32x4*)(lng + col0 + c8 + 4), ba = *(const f32x4*)(lnb + col0 + c8), bb = *(const f32x4*)(lnb + col0 + c8 + 4);
                v4u o;
                o.x = cvtpk((bflo(vv.x) - rs.x) * rs.y * ga[0] + ba[0], (bfhi(vv.x) - rs.x) * rs.y * ga[1] + ba[1]);
                o.y = cvtpk((bflo(vv.y) - rs.x) * rs.y * ga[2] + ba[2], (bfhi(vv.y) - rs.x) * rs.y * ga[3] + ba[3]);
                o.z = cvtpk((bflo(vv.z) - rs.x) * rs.y * gb[0] + bb[0], (bfhi(vv.z) - rs.x) * rs.y * gb[1] + bb[1]);
                o.w = cvtpk((bflo(vv.w) - rs.x) * rs.y * gb[2] + bb[2], (bfhi(vv.w) - rs.x) * rs.y * gb[3] + bb[3]);
                *(LAS v4u*)(LN + r * RSN + c8 * 2) = o; }
#pragma unroll
            for (int ps = 0; ps < 8; ++ps) { const int id_ = ps * NTHR + tid; ur[ps] = *(const v4u*)(u + (size_t)(row0 + (id_ >> 5)) * GM_HALF + col0 + (id_ & 31) * 8); }
            if (ui + 1 < 6) GS_LDV(ui + 1);
            __syncthreads();
            f32x4 acc[2][8];
#pragma unroll
            for (int ci = 0; ci < 2; ++ci)
#pragma unroll
                for (int tt = 0; tt < 8; ++tt) acc[ci][tt] = (f32x4){0.f, 0.f, 0.f, 0.f};
#pragma unroll
            for (int ks = 0; ks < 4; ++ks) {
                const bf16x8 a0 = frag_tr(LN + (32 * ks) * RSN + (32 * w) * 2, RSN, lane), a1 = frag_tr(LN + (32 * ks) * RSN + (32 * w + 16) * 2, RSN, lane);
#pragma unroll
                for (int tt = 2 * ks; tt < 8; ++tt) { const bf16x8 bfr = frag_row(LW + (16 * tt) * RSW + ks * 64, RSW, lane);
                    acc[0][tt] = MFMA16(a0, bfr, acc[0][tt]); acc[1][tt] = MFMA16(a1, bfr, acc[1][tt]); }
            }
            __syncthreads();
#pragma unroll
            for (int ci = 0; ci < 2; ++ci)
#pragma unroll
                for (int tt = 0; tt < 8; ++tt) { v2u pk; pk.x = cvtpk(acc[ci][tt][0] + bs[tt], acc[ci][tt][1] + bs[tt]); pk.y = cvtpk(acc[ci][tt][2] + bs[tt], acc[ci][tt][3] + bs[tt]);
                    *(LAS v2u*)(LN + (16 * tt + l15) * RSN + (32 * w + 16 * ci + 4 * g4) * 2) = pk; }
            __syncthreads();
#pragma unroll
            for (int ps = 0; ps < 8; ++ps) { const int id = ps * NTHR + tid, r = id >> 5, c8 = (id & 31) * 8;
                const v4u mv = *(const LAS v4u*)(LN + r * RSN + c8 * 2); const size_t off = (size_t)(row0 + r) * GM_HALF + col0 + c8; const v4u uv = ur[ps];
                v4u o; o.x = cvtpk(bflo(uv.x) * bflo(mv.x), bfhi(uv.x) * bfhi(mv.x)); o.y = cvtpk(bflo(uv.y) * bflo(mv.y), bfhi(uv.y) * bfhi(mv.y));
                o.z = cvtpk(bflo(uv.z) * bflo(mv.z), bfhi(uv.z) * bfhi(mv.z)); o.w = cvtpk(bflo(uv.w) * bflo(mv.w), bfhi(uv.w) * bfhi(mv.w));
                *(v4u*)(y + off) = o; }
        }
#undef GS_ROW0
#undef GS_COL0
#undef GS_LDV
    }
}

__device__ __forceinline__ void fox_prep_phase(Frame& F, const bf16* x, const float* rs, const float* gmix, const float* wfox, const float* bfg, float* lf) {
    const int lane = F.lane, w = F.wave, fr = lane & 15, fq = lane >> 4, kb = w * 256 + fq * 8;
    LAS float* red = (LAS float*)F.lds;
    bf16x8 wh[8], wl[8];
#pragma unroll
    for (int s = 0; s < 8; ++s) { const int k0 = kb + 32 * s; const f32x4 ga = *(const f32x4*)(gmix + k0), gb = *(const f32x4*)(gmix + k0 + 4);
        float wv[8];
#pragma unroll
        for (int j = 0; j < 8; ++j) wv[j] = wfox[(size_t)(k0 + j) * FOX_LD + FOX_N + fr] * (j < 4 ? ga[j & 3] : gb[j & 3]);
        v4u ph, pl;
#pragma unroll
        for (int p = 0; p < 4; ++p) { const unsigned hp = cvtpk(wv[2 * p], wv[2 * p + 1]); ph[p] = hp; pl[p] = cvtpk(wv[2 * p] - bflo(hp), wv[2 * p + 1] - bfhi(hp)); }
        wh[s] = __builtin_bit_cast(bf16x8, ph); wl[s] = __builtin_bit_cast(bf16x8, pl); }
    for (int blk = F.vcu; blk < M / 32; blk += F.G) {
        const bf16* xa = x + (size_t)(blk * 32 + fr) * DM + kb;
        bf16x8 a0[8], a1[8];
#pragma unroll
        for (int s = 0; s < 8; ++s) { a0[s] = *(const bf16x8*)(xa + 32 * s); a1[s] = *(const bf16x8*)(xa + (size_t)16 * DM + 32 * s); }
        f32x4 c0 = (f32x4){0.f, 0.f, 0.f, 0.f}, c1 = c0;
#pragma unroll
        for (int s = 0; s < 8; ++s) { c0 = MFMA16(a0[s], wh[s], c0); c1 = MFMA16(a1[s], wh[s], c1); c0 = MFMA16(a0[s], wl[s], c0); c1 = MFMA16(a1[s], wl[s], c1); }
#pragma unroll
        for (int r = 0; r < 4; ++r) { red[(w * 32 + 4 * fq + r) * 16 + fr] = c0[r]; red[(w * 32 + 16 + 4 * fq + r) * 16 + fr] = c1[r]; }
        __syncthreads();
        { const int row = F.tid >> 4, col = F.tid & 15, m = blk * 32 + row; float z = 0.f;
#pragma unroll
          for (int ww = 0; ww < 8; ++ww) z += red[(ww * 32 + row) * 16 + col];
          lf[(size_t)m * 16 + col] = log_sigmoid(z * pg8::row_rstd(rs, m) + bfg[col]); }
        __syncthreads();
    }
}

typedef float f32x16 __attribute__((ext_vector_type(16)));
#define MFMA32(a, b, c) __builtin_amdgcn_mfma_f32_32x32x16_bf16((a), (b), (c), 0, 0, 0)
__device__ __forceinline__ void fox_attn_phase(Frame& F, const bf16* qn, const bf16* kn, const bf16* vv, const bf16* gs, const float* lf, bf16* y) {
    constexpr int RSK = 272, RSV = 320, KSLOT = 64 * RSK, VSLOT = 64 * RSV;
    const ldsp LK = F.lds, LV = F.lds + 2 * KSLOT;
    LAS float* c2 = (LAS float*)(F.lds + 75776);
    LAS float* red = (LAS float*)(F.lds + 92160);
    const int tid = F.tid, lane = F.lane, w = F.wave, r32 = lane & 31, hi = lane >> 5;
    int bh_have = -1;
    for (int pr = F.vcu; pr < 256; pr += F.G) {
        const int bh = pr >> 3, pi = pr & 7, b = bh >> 4, h = bh & 15;
        const size_t tok0 = (size_t)b * SEQ;
        if (bh != bh_have) {
            bh_have = bh;
            float x8[8]; float run = 0.f;
#pragma unroll
            for (int e = 0; e < 8; ++e) { run += lf[(tok0 + tid * 8 + e) * 16 + h]; x8[e] = run; }
            float inc = run;
#pragma unroll
            for (int o = 1; o < 64; o <<= 1) { const float t = __shfl_up(inc, o); if (lane >= o) inc += t; }
            __syncthreads();
            if (lane == 63) red[w] = inc;
            __syncthreads();
            float pre = inc - run;
#pragma unroll
            for (int wv = 0; wv < 8; ++wv) if (wv < w) pre += red[wv];
#pragma unroll
            for (int e = 0; e < 8; ++e) c2[tid * 8 + e] = (pre + x8[e]) * LOG2E;
        }
        for (int half = 0; half < 2; ++half) {
            const int qb = half ? 15 - pi : pi, q0 = qb * 256, ntile = 4 * qb + 4, qrow = q0 + 32 * w + r32;
            bf16x8 qf[8];
#pragma unroll
            for (int ks = 0; ks < 8; ++ks) qf[ks] = *(const bf16x8*)(qn + (tok0 + qrow) * DM + h * 128 + ks * 16 + 8 * hi);
            v4u kr[2], vr[2];
#define FA_LOAD(tt) do { _Pragma("unroll") for (int pp = 0; pp < 2; ++pp) { const int id_ = tid + NTHR * pp, r_ = id_ >> 4, c_ = id_ & 15; \
                kr[pp] = *(const v4u*)(kn + (tok0 + 64 * (tt) + r_) * DM + h * 128 + c_ * 8); vr[pp] = *(const v4u*)(vv + (tok0 + 64 * (tt) + r_) * DM + h * 128 + c_ * 8); } } while (0)
#define FA_STORE(sl) do { _Pragma("unroll") for (int pp = 0; pp < 2; ++pp) { const int id_ = tid + NTHR * pp, r_ = id_ >> 4, c_ = id_ & 15; \
                *(LAS v4u*)(LK + (sl) * KSLOT + r_ * RSK + c_ * 16) = kr[pp]; *(LAS v4u*)(LV + (sl) * VSLOT + r_ * RSV + c_ * 16) = vr[pp]; } } while (0)
            FA_LOAD(0);
            __syncthreads();
            FA_STORE(0);
            if (ntile > 1) FA_LOAD(1);
            const float cq = c2[qrow];
            float mx = 0.f, ls = 0.f;
            f32x16 O[4];
#pragma unroll
            for (int dt = 0; dt < 4; ++dt)
#pragma unroll
                for (int r = 0; r < 16; ++r) O[dt][r] = 0.f;
            for (int t = 0; t < ntile; ++t) {
                __syncthreads();
                if (t + 1 < ntile) { FA_STORE((t + 1) & 1); if (t + 2 < ntile) FA_LOAD(t + 2); }
                const int key0 = 64 * t;
                if (key0 <= q0 + 32 * w + 31) {
                    const ldsp sk = LK + (t & 1) * KSLOT + r32 * RSK + 16 * hi, sv = LV + (t & 1) * VSLOT;
                    f32x16 S0, S1;
                    const float cbase = cq - mx;
#pragma unroll
                    for (int g = 0; g < 4; ++g) { const f32x4 ck0 = *(const LAS f32x4*)(c2 + key0 + 8 * g + 4 * hi), ck1 = *(const LAS f32x4*)(c2 + key0 + 32 + 8 * g + 4 * hi);
#pragma unroll
                        for (int e = 0; e < 4; ++e) { S0[4 * g + e] = cbase - ck0[e]; S1[4 * g + e] = cbase - ck1[e]; } }
#pragma unroll
                    for (int ks = 0; ks < 8; ++ks) { S0 = MFMA32(*(const LAS bf16x8*)(sk + ks * 32), qf[ks], S0); S1 = MFMA32(*(const LAS bf16x8*)(sk + 32 * RSK + ks * 32), qf[ks], S1); }
                    if (key0 + 63 > q0 + 32 * w) {
#pragma unroll
                        for (int g = 0; g < 4; ++g)
#pragma unroll
                            for (int e = 0; e < 4; ++e) { const int key = key0 + 8 * g + 4 * hi + e; if (key > qrow) S0[4 * g + e] = -INFINITY; if (key + 32 > qrow) S1[4 * g + e] = -INFINITY; } }
                    float mloc = fmaxf(S0[0], S1[0]);
#pragma unroll
                    for (int r = 1; r < 16; ++r) mloc = __builtin_fmaxf(__builtin_fmaxf(mloc, S0[r]), S1[r]);
                    mloc = fmaxf(mloc, __shfl_xor(mloc, 32));
                    if (__any(mloc > 8.0f)) { const float dl = fmaxf(mloc, 0.f), alpha = __builtin_amdgcn_exp2f(-dl); mx += dl; ls *= alpha;
#pragma unroll
                        for (int r = 0; r < 16; ++r) { S0[r] -= dl; S1[r] -= dl; }
#pragma unroll
                        for (int dt = 0; dt < 4; ++dt)
#pragma unroll
                            for (int r = 0; r < 16; ++r) O[dt][r] *= alpha; }
                    float psum = 0.f;
#pragma unroll
                    for (int r = 0; r < 16; ++r) { S0[r] = __builtin_amdgcn_exp2f(S0[r]); S1[r] = __builtin_amdgcn_exp2f(S1[r]); psum += S0[r] + S1[r]; }
                    ls += psum;
                    v4u pf[4];
#pragma unroll
                    for (int s2 = 0; s2 < 2; ++s2) { pf[s2] = (v4u){cvtpk(S0[8 * s2 + 0], S0[8 * s2 + 1]), cvtpk(S0[8 * s2 + 2], S0[8 * s2 + 3]), cvtpk(S0[8 * s2 + 4], S0[8 * s2 + 5]), cvtpk(S0[8 * s2 + 6], S0[8 * s2 + 7])};
                        pf[2 + s2] = (v4u){cvtpk(S1[8 * s2 + 0], S1[8 * s2 + 1]), cvtpk(S1[8 * s2 + 2], S1[8 * s2 + 3]), cvtpk(S1[8 * s2 + 4], S1[8 * s2 + 5]), cvtpk(S1[8 * s2 + 6], S1[8 * s2 + 7])}; }
                    const ldsp vb = sv + (4 * hi + ((lane & 15) >> 2)) * RSV + (16 * ((lane >> 4) & 1) + 4 * (lane & 3)) * 2;
#pragma unroll
                    for (int s4 = 0; s4 < 4; ++s4)
#pragma unroll
                        for (int dt = 0; dt < 4; ++dt) { const ldsp va = vb + (16 * s4) * RSV + dt * 64; const s16x4 lo = vtr(va), hv = vtr(va + 8 * RSV);
                            const bf16x8 af = (bf16x8){lo[0], lo[1], lo[2], lo[3], hv[0], hv[1], hv[2], hv[3]};
                            O[dt] = MFMA32(af, __builtin_bit_cast(bf16x8, pf[s4]), O[dt]); }
                }
            }
            ls += __shfl_xor(ls, 32);
            const float il = 1.0f / ls;
            const size_t yoff = (tok0 + qrow) * DM + h * 128 + 4 * hi;
#pragma unroll
            for (int dt = 0; dt < 4; ++dt)
#pragma unroll
                for (int g = 0; g < 4; ++g) { const v2u gv = *(const v2u*)(gs + yoff + dt * 32 + 8 * g);
                    v2u o; o.x = cvtpk(O[dt][4 * g + 0] * il * bflo(gv.x), O[dt][4 * g + 1] * il * bfhi(gv.x)); o.y = cvtpk(O[dt][4 * g + 2] * il * bflo(gv.y), O[dt][4 * g + 3] * il * bfhi(gv.y));
                    *(v2u*)(y + yoff + dt * 32 + 8 * g) = o; }
        }
    }
#undef FA_LOAD
#undef FA_STORE
}
#ifndef R_RET_CORE
#define R_RET_CORE 1
#endif
#ifndef RC_MASK
#define RC_MASK 0
#endif
#ifndef R_RET_GN
#define R_RET_GN 1
#endif
#ifndef R_GM_SP
#define R_GM_SP 1
#endif
#ifndef R_FOX_ATTN
#define R_FOX_ATTN 1
#endif
#ifndef R_FOX_PREP
#define R_FOX_PREP 1
#endif
#ifndef R_PRO
#define R_PRO 1
#endif
#ifndef F_GU_TAIL
#define F_GU_TAIL 0
#endif

#ifndef PROBE_A
#define PROBE_A -1
#endif
#ifndef PROBE_B
#define PROBE_B -1
#endif
#ifndef PROBE_MUL
#define PROBE_MUL 4
#endif
#define STAMP_AT(id) do { if (PROBE_A >= 0 && ((id) == PROBE_A || (id) == PROBE_B)) { if (F.tid == 0) { const unsigned long long t_ = __builtin_amdgcn_s_memrealtime(); \
        volatile LAS unsigned* m_ = F.MISC + ((id) == PROBE_A ? 16 : 20); m_[0] = (unsigned)t_; m_[1] = (unsigned)(t_ >> 32); } } } while (0)
struct Args { const void* in[21]; float* out; unsigned char* ws; int ph_lo, ph_hi, li, pad; };
#define IN(k) (lo <= (k) && (k) < hi)
#define SEAM(k) do { if (N_LAUNCHES == 1 && IN(k) && IN((k) + 1)) xcd_barrier(bar); STAMP_AT(k); } while (0)
template <int L>
__device__ __forceinline__ void layer_body(Frame& F, const Args& args, const XcdBarrier& bar, const int lo, const int hi) {
    unsigned char* ws = args.ws;
    constexpr int kind = L % 3, j = L / 3, pb = 1 + 6 * L;
    float* xo = args.out;
    bf16* XB = (bf16*)(ws + WS_H);
    bf16* A0 = (bf16*)(ws + WS_A); bf16* B0 = (bf16*)(ws + WS_B); bf16* C0 = (bf16*)(ws + WS_C);
    unsigned char* misc = ws + WS_MISC;
    float* rss = (float*)(ws + WS_RSP);
    PG8_LAS float* rtab = (PG8_LAS float*)(F.lds + RSTAB_OFF);
    if (IN(pb + 0)) {
        if (kind == 0) {
            pg8::Gemm g{XB, (const bf16*)(ws + WS_W_RET_IN + j * SZ_W_RET_IN), M, RET_N, DM}; pg8::RsOrder S; S.init(M, RET_N, F.G, (int)blockIdx.x); S.rs = rss + (size_t)(2 * L) * M * 32; S.tab = rtab; S.pend = 0.f; S.nready = 0;
            pg8::EpiRetIn E{A0, A0 + (size_t)M * 2048, A0 + (size_t)M * 4096, A0 + (size_t)M * 8192, (const float*)(ws + WS_ROPE_C), (const float*)(ws + WS_ROPE_S), rtab, 0};
            pg8::gemm_phase<pg8::EpiRetIn, pg8::RsOrder, PG8_ALIGN, PG8_SP2>(F.lds + RING_OFF, g, S, E);
        } else if (kind == 1) {
            pg8::Gemm g{XB, (const bf16*)(ws + WS_W_GM_IN), M, GM_N, DM}; pg8::RsOrder S; S.init(M, GM_N, F.G, (int)blockIdx.x); S.rs = rss + (size_t)(2 * L) * M * 32; S.tab = rtab; S.pend = 0.f; S.nready = 0;
            pg8::EpiGeluUV E{A0, A0 + (size_t)M * GM_HALF, (pg8::f32x2v*)(misc + MISC_PART), rtab, 0};
            pg8::gemm_phase<pg8::EpiGeluUV, pg8::RsOrder, PG8_ALIGN, PG8_SP2>(F.lds + RING_OFF, g, S, E);
        } else {
            pg8::Gemm g{XB, (const bf16*)(ws + WS_W_FOX_IN), M, FOX_N, DM}; pg8::RsOrder S; S.init(M, FOX_N, F.G, (int)blockIdx.x); S.rs = rss + (size_t)(2 * L) * M * 32; S.tab = rtab; S.pend = 0.f; S.nready = 0;
            PG8_LAS float* qkg = (PG8_LAS float*)(F.lds + QKG_OFF);
            if (F.tid < 256) qkg[F.tid] = F.tid < 128 ? ((const float*)args.in[15])[F.tid] : ((const float*)args.in[16])[F.tid - 128];
            __syncthreads();
            pg8::EpiFoxIn E{A0, (size_t)M * 2048, rtab, 0, (PG8_LAS float*)(F.lds + QKT_OFF), qkg};
            pg8::gemm_phase<pg8::EpiFoxIn, pg8::RsOrder, PG8_ALIGN, PG8_SP2>(F.lds + RING_OFF, g, S, E);
        }
    }
    SEAM(pb + 0);
    if (IN(pb + 1)) {
        if (kind == 0) { bf16* Pb = B0 + (size_t)M * 4096;
            bf16* KFb = (bf16*)(ws + WS_KF);
            bf16* QFb = (bf16*)(ws + WS_QF);
            ret_p_phase(F, A0, A0 + (size_t)M * 2048, Pb, KFb, QFb);
            if (N_LAUNCHES == 1) xcd_barrier(bar);
            STAMP_AT(500 + L);
            for (int rep_ = 0; rep_ < R_RET_CORE; ++rep_) ret_core_phase(F, QFb, A0 + (size_t)M * 4096, Pb, KFb, B0, rep_ ? RC_MASK : 0); }
        else if (kind == 1) { gm_stat_phase(F, (const f32x2*)(misc + MISC_PART), (f32x2*)(misc + MISC_RSTAT)); }
        else { for (int rep_ = 0; rep_ < R_FOX_PREP; ++rep_) fox_prep_phase(F,
                              XB, rss + (size_t)(2 * L) * M * 32, (const float*)args.in[2] + (size_t)L * DM, (const float*)args.in[13], (const float*)args.in[14], (float*)(misc + MISC_LF)); }
    }
    SEAM(pb + 1);
    if (IN(pb + 2)) {
        if (kind == 0) { for (int rep_ = 0; rep_ < R_RET_GN; ++rep_) ret_gn_phase(F, B0, A0 + (size_t)M * 8192, (const float*)args.in[5] + (size_t)j * 4096, C0); }
        else if (kind == 1) { for (int rep_ = 0; rep_ < R_GM_SP; ++rep_) gm_spatial_phase(F, A0, A0 + (size_t)M * GM_HALF, (const f32x2*)(misc + MISC_RSTAT), (const float*)args.in[8], (const float*)args.in[9], (const bf16*)(misc + MISC_WTRI), (const float*)args.in[11], B0); }
        else { for (int rep_ = 0; rep_ < R_FOX_ATTN; ++rep_) fox_attn_phase(F, A0, A0 + (size_t)M * 2048, A0 + (size_t)M * 4096, A0 + (size_t)M * 6144, (const float*)(misc + MISC_LF), B0); }
    }
    SEAM(pb + 2);
    if (IN(pb + 3)) {
        const bf16* Ain = kind == 0 ? C0 : B0; constexpr int K = kind == 0 ? 4096 : (kind == 1 ? GM_HALF : DM);
        const bf16* Wt = kind == 0 ? (const bf16*)(ws + WS_W_RET_OUT + j * SZ_W_RET_OUT) : (kind == 1 ? (const bf16*)(ws + WS_W_GM_OUT) : (const bf16*)(ws + WS_W_FOX_OUT));
        pg8::Gemm g{Ain, Wt, M, DM, K}; pg8::StaticOrder S; S.init(M, DM, F.G, (int)blockIdx.x);
        if constexpr (L == 0) {
            pg8::EpiRes<true, false> E{(const float*)args.in[0], nullptr, XB, rss + (size_t)(2 * L + 1) * M * 32, DM};
            pg8::gemm_phase<pg8::EpiRes<true, false>, pg8::StaticOrder, PG8_ALIGN, PG8_SP2>(F.lds + RING_OFF, g, S, E);
        } else {
            pg8::EpiResP<false> E{nullptr, XB, rss + (size_t)(2 * L + 1) * M * 32, DM};
            pg8::gemm_phase<pg8::EpiResP<false>, pg8::StaticOrder, PG8_ALIGN, PG8_SP2>(F.lds + RING_OFF, g, S, E);
        }
    }
    SEAM(pb + 3);
    if (IN(pb + 4)) {
        constexpr int NFULL = (F_GU_TAIL ? 40 : 44) * 256;
        { pg8::Gemm g{XB, (const bf16*)(ws + WS_W_GU + L * SZ_W_GU), M, NFULL, DM}; pg8::RsOrder S; S.init(M, NFULL, F.G, (int)blockIdx.x); S.rs = rss + (size_t)(2 * L + 1) * M * 32; S.tab = rtab; S.pend = 0.f; S.nready = 0;
          pg8::EpiSwiglu<false> E{A0, FFN_H, rtab, 0};
          pg8::gemm_phase<pg8::EpiSwiglu<false>, pg8::RsOrder, PG8_ALIGN, PG8_SP2>(F.lds + RING_OFF, g, S, E); }
        if (F_GU_TAIL) { pg8::Gemm g{XB, (const bf16*)(ws + WS_W_GU + L * SZ_W_GU), M, FFN_N2, DM}; pg8::TailOrder S; S.init(M, FFN_N2, F.G, (int)blockIdx.x); S.rs = rss + (size_t)(2 * L + 1) * M * 32; S.tab = rtab; S.pend = 0.f; S.nready = 0; S.pn0 = 40;
          pg8::EpiSwiglu<true> E{A0, FFN_H, rtab, 0};
          pg8::gemm_phase<pg8::EpiSwiglu<true>, pg8::TailOrder, PG8_ALIGN, PG8_SP2, true>(F.lds + RING_OFF, g, S, E); }
    }
    SEAM(pb + 4);
    if (IN(pb + 5)) {
        pg8::Gemm g{A0, (const bf16*)(ws + WS_W_DN + L * SZ_W_DN), M, DM, FFN_H}; pg8::StaticOrder S; S.init(M, DM, F.G, (int)blockIdx.x);
        pg8::EpiResP<L + 1 == DEPTH> E{xo, XB, rss + (size_t)((2 * L + 2) & 7) * M * 32, DM};
        pg8::gemm_phase<pg8::EpiResP<L + 1 == DEPTH>, pg8::StaticOrder, PG8_ALIGN, PG8_SP2>(F.lds + RING_OFF, g, S, E);
    }
    SEAM(pb + 5);
}
__global__ void __launch_bounds__(NWAVES * 64, 2) trunk_fwd(Args args) {
    extern __shared__ __attribute__((aligned(16))) unsigned char lds[];
    Frame F;
    F.lds = (ldsp)lds;
    F.MISC = (volatile LAS unsigned*)(F.lds + MISC_OFF);
    F.tid = threadIdx.x; F.lane = F.tid & 63; F.wave = __builtin_amdgcn_readfirstlane(F.tid >> 6);
    F.G = gridDim.x; { const int bx = blockIdx.x; F.vcu = (F.G % 8 == 0) ? (bx % 8) * (F.G / 8) + bx / 8 : bx; }
    F.ctl = (gu32*)(args.ws + WS_CTL);
    for (int u = F.tid; u < (LDS_BYTES - LDSCTL_OFF) / 4; u += NWAVES * 64) ((LAS unsigned*)(F.lds + LDSCTL_OFF))[u] = 0u;
    __syncthreads();
    XcdBarrier bar; bar.bar = (unsigned*)(F.ctl + CW_BAR); bar.x = 0; bar.st = nullptr;
    if (N_LAUNCHES == 1) bar = xcd_barrier_post((unsigned*)(F.ctl + CW_BAR), F.MISC + 8);
    const int lo = args.ph_lo, hi = args.ph_hi;
    STAMP_AT(999);
    if (IN(0)) for (int rep_ = 0; rep_ < R_PRO; ++rep_) p0_prologue(F, args.in, args.ws);
    SEAM(0);
#ifdef IDLE_TEST
#define IDLE_GAP() do { const unsigned long long t0_ = __builtin_amdgcn_s_memrealtime(); while (__builtin_amdgcn_s_memrealtime() - t0_ < (unsigned long long)(IDLE_TEST) * 100ull) __builtin_amdgcn_s_sleep(32); } while (0)
#else
#define IDLE_GAP() do {} while (0)
#endif
    layer_body<0>(F, args, bar, lo, hi); IDLE_GAP(); layer_body<1>(F, args, bar, lo, hi); IDLE_GAP(); layer_body<2>(F, args, bar, lo, hi); IDLE_GAP(); layer_body<3>(F, args, bar, lo, hi);
#ifdef ABL_GEMM
    if (PROBE_A == 700) { unsigned char* ws = args.ws; xcd_barrier(bar); STAMP_AT(700);
        pg8::Gemm g{(const bf16*)(ws + WS_H), (const bf16*)(ws + WS_W_GU), M, 40 * 256, DM}; pg8::RsOrder S; S.init(M, 40 * 256, F.G, (int)blockIdx.x); S.rs = (float*)(ws + WS_RSP); S.tab = (PG8_LAS float*)(F.lds + RSTAB_OFF); S.pend = 0.f; S.nready = 0;
        pg8::EpiSwiglu<false> E{(bf16*)(ws + WS_A), FFN_H, (PG8_LAS float*)(F.lds + RSTAB_OFF), 0};
        pg8::gemm_phase<pg8::EpiSwiglu<false>, pg8::RsOrder, PG8_ALIGN, PG8_SP2, false, ABL_GEMM>(F.lds + RING_OFF, g, S, E);
        xcd_barrier(bar); STAMP_AT(701); }
#endif
    if (PROBE_A >= 0 && F.tid == 0) {
        const unsigned long long ta = ((unsigned long long)F.MISC[17] << 32) | F.MISC[16], tb = ((unsigned long long)F.MISC[21] << 32) | F.MISC[20];
        const unsigned long long dly = (tb - ta) * (unsigned long long)PROBE_MUL, t0 = __builtin_amdgcn_s_memrealtime();
        if (tb > ta && dly < 400000ull) while (__builtin_amdgcn_s_memrealtime() - t0 < dly) __builtin_amdgcn_s_sleep(16);
    }
}
#undef IN
#undef SEAM

extern "C" void kernel_launch(void* const* d_in, const int* in_sizes, int n_in, void* d_out, int out_size, void* d_ws, size_t ws_size, hipStream_t stream) {
    static int grid = 0;
    if (grid == 0) {
        if (n_in != 21 || in_sizes[0] != M * DM || out_size != M * DM || ws_size < WS_END) { fprintf(stderr, "kernel_launch: unexpected shapes (n_in %d, in0 %d, out %d, ws %zu); nothing launched\n", n_in, n_in > 0 ? in_sizes[0] : -1, out_size, ws_size); grid = -1; return; }
        int dev = 0, cus = 0, per_cu = 0;
        if (hipGetDevice(&dev) != hipSuccess || hipDeviceGetAttribute(&cus, hipDeviceAttributeMultiprocessorCount, dev) != hipSuccess) { grid = -1; return; }
        if (hipFuncSetAttribute((const void*)trunk_fwd, hipFuncAttributeMaxDynamicSharedMemorySize, LDS_BYTES) != hipSuccess) { fprintf(stderr, "kernel_launch: hipFuncSetAttribute failed\n"); grid = -1; return; }
        if (hipOccupancyMaxActiveBlocksPerMultiprocessor(&per_cu, (const void*)trunk_fwd, NWAVES * 64, LDS_BYTES) != hipSuccess || per_cu < 1)
            fprintf(stderr, "kernel_launch: note: occupancy query reports %d workgroups per CU\n", per_cu);
        (void)hipGetLastError();
        grid = cus;
    }
    if (grid < 0) return;
    if (hipMemsetAsync((char*)d_ws + WS_CTL, 0, CTL_ZERO_BYTES, stream) != hipSuccess) return;
    Args a{};
    for (int i = 0; i < 21; ++i) a.in[i] = d_in[i];
    a.out = (float*)d_out; a.ws = (unsigned char*)d_ws;
    for (int li = 0; li < N_LAUNCHES; ++li) {
        a.ph_lo = (N_LAUNCHES == 1) ? 0 : li; a.ph_hi = (N_LAUNCHES == 1) ? N_PHASES : li + 1; a.li = li; a.pad = 0;
        hipLaunchKernelGGL(trunk_fwd, dim3(grid), dim3(NWAVES * 64), LDS_BYTES, stream, a);
        const hipError_t le = hipPeekAtLastError();
        if (le != hipSuccess) { fprintf(stderr, "kernel_launch: launch %d failed: %s\n", li, hipGetErrorName(le)); break; }
    }
}
```

```cpp
#define PG8_WGM 4
#include <hip/hip_runtime.h>
#include <cstdio>
#include <cstdint>
#include <cmath>
namespace pg8 {
#define PG8_LAS __attribute__((address_space(3)))
typedef unsigned short bf16_t;
typedef short bf16x8 __attribute__((ext_vector_type(8)));
typedef float f32x4 __attribute__((ext_vector_type(4)));
typedef unsigned u32x4 __attribute__((ext_vector_type(4)));
constexpr int BM = 256, BK = 64, HALF = 128, HTB = HALF * BK * 2  , STAGE_BYTES = 8 * HTB, NXCD = 8, WGM = PG8_WGM;

__host__ __device__ __forceinline__ int lds_byte(int r, int c) { const int st = (r >> 4) * 2 + (c >> 5), rr = r & 15, cc = c & 31, ob = rr * 64 + cc * 2; return st * 1024 + (ob ^ (((ob >> 9) & 1) << 5)); }
__host__ __device__ __forceinline__ void stage_rc(int b, int& R, int& C) { const int st = b / 1024, sb = b % 1024, swz = sb ^ (((sb >> 9) & 1) << 5); R = (st >> 1) * 16 + swz / 64; C = (st & 1) * 32 + (swz % 64) / 2; }
__host__ __device__ __forceinline__ int perm32(int rho) { const int n = rho >> 4, i = rho & 15; return 8 * (i >> 2) + 4 * n + (i & 3); }

struct Unit { int pm, pn, hf; };
struct Gemm { const bf16_t* A; const bf16_t* Bt; int M, N, K; };

struct StaticOrder {
    int nM, nN, nwg, G, c;
    __host__ __device__ void init(int M, int N, int G_, int c_) { nM = M / BM; nN = N / BM; nwg = nM * nN; G = G_; c = c_; }
    __host__ __device__ bool next(int i, Unit& u) const {
        const long L = (long)i * G + c; if (L >= nwg) return false;
        int wgid = (int)L; { const int q = nwg / NXCD, r = nwg % NXCD, xcd = wgid % NXCD, off = wgid / NXCD; wgid = (xcd < r ? xcd * (q + 1) : r * (q + 1) + (xcd - r) * q) + off; }
        const int nig = WGM * nN, gid = wgid / nig, fm = gid * WGM, gsz = (nM - fm) < WGM ? (nM - fm) : WGM;
        u.pm = fm + ((wgid % nig) % gsz); u.pn = (wgid % nig) / gsz; u.hf = 0; return true;
    }
    __device__ __forceinline__ void a_ready(const Unit&) const {}
    __device__ __forceinline__ void done(const Unit&) const {}
};

__device__ __forceinline__ unsigned cvt_pk_bf16(float lo, float hi) { unsigned r; asm volatile("v_cvt_pk_bf16_f32 %0, %1, %2" : "=v"(r) : "v"(lo), "v"(hi)); return r; }
typedef float f32x2 __attribute__((ext_vector_type(2)));
__device__ __forceinline__ f32x2 gelu_pk(f32x2 v) {
    const f32x2 av = __builtin_elementwise_abs(v), d = av * 0.2316418882f + 1.0f;
    f32x2 t; t.x = __builtin_amdgcn_rcpf(d.x); t.y = __builtin_amdgcn_rcpf(d.y);
    f32x2 q = t * 0.5307027145f + (-0.7265760135f); q = q * t + 0.7107068705f; q = q * t + (-0.142248368f); q = q * t + 0.127414796f; q = q * t;
    const f32x2 s = (v * v) * (-0.72134752044f);
    f32x2 e; e.x = __builtin_amdgcn_exp2f(s.x); e.y = __builtin_amdgcn_exp2f(s.y);
    const f32x2 m = v * (q * e), r = v - m;
    f32x2 o; o.x = v.x < 0.f ? m.x : r.x; o.y = v.y < 0.f ? m.y : r.y; return o;
}

typedef float f32x2v __attribute__((ext_vector_type(2)));
typedef __bf16 bf16x2v __attribute__((ext_vector_type(2)));
__device__ __forceinline__ unsigned cvtpk(float lo, float hi) { f32x2v v = {lo, hi}; bf16x2v b = __builtin_convertvector(v, bf16x2v); return __builtin_bit_cast(unsigned, b); }
__device__ __forceinline__ u32x4 pack8(const f32x4 a, const f32x4 b) { u32x4 w; w.x = cvtpk(a[0], a[1]); w.y = cvtpk(a[2], a[3]); w.z = cvtpk(b[0], b[1]); w.w = cvtpk(b[2], b[3]); return w; }
#ifndef EPI_WT
#define EPI_WT 0
#endif
__device__ __forceinline__ void st16(void* p, const u32x4 v) {
#if EPI_WT
    asm volatile("global_store_dwordx4 %0, %1, off sc1\n\ts_nop 2" :: "v"(p), "v"(v) : "memory");
#else
    *(u32x4*)p = v;
#endif
}
__device__ __forceinline__ float fast_sigmoid(float x) { return __builtin_amdgcn_rcpf(1.0f + __builtin_amdgcn_exp2f(-1.44269504f * x)); }

template <bool BASE_F32, bool OUT_F32> struct EpiRes {
    static constexpr bool PERM = true, AFTER_DRAIN = false, RESID = false;
    const float* base; float* out; bf16_t* xb; float* rs; int ldc;
    __device__ __forceinline__ void operator()(const f32x4 (&acc)[2][2][4][2], const Unit& u, int wr, int wc, int fr, int fq) const {
        const int row0 = u.pm * BM + wr * 64 + fr, col0 = u.pn * BM + wc * 32 + 8 * fq;
#pragma unroll
        for (int ai = 0; ai < 2; ++ai)
#pragma unroll
            for (int m = 0; m < 4; ++m) { const int row = row0 + ai * HALF + m * 16; const size_t off = (size_t)row * ldc + col0; float ss = 0.f;
#pragma unroll
                for (int bj = 0; bj < 2; ++bj) { f32x4 b0, b1;
                    if (BASE_F32) { b0 = *(const f32x4*)(base + off + bj * HALF); b1 = *(const f32x4*)(base + off + bj * HALF + 4); }
                    else { const u32x4 w = *(const u32x4*)(xb + off + bj * HALF);
                        b0 = (f32x4){__uint_as_float(w.x << 16), __uint_as_float(w.x & 0xffff0000u), __uint_as_float(w.y << 16), __uint_as_float(w.y & 0xffff0000u)};
                        b1 = (f32x4){__uint_as_float(w.z << 16), __uint_as_float(w.z & 0xffff0000u), __uint_as_float(w.w << 16), __uint_as_float(w.w & 0xffff0000u)}; }
                    const f32x4 x0 = b0 + acc[ai][bj][m][0], x1 = b1 + acc[ai][bj][m][1];
                    if (OUT_F32) { *(f32x4*)(out + off + bj * HALF) = x0; *(f32x4*)(out + off + bj * HALF + 4) = x1; }
                    else st16(xb + off + bj * HALF, pack8(x0, x1));
                    ss += (x0[0] * x0[0] + x0[1] * x0[1]) + (x0[2] * x0[2] + x0[3] * x0[3]) + (x1[0] * x1[0] + x1[1] * x1[1]) + (x1[2] * x1[2] + x1[3] * x1[3]); }
                if (!OUT_F32) { ss += __shfl_xor(ss, 16); ss += __shfl_xor(ss, 32);
                    if (fq == 0) rs[(size_t)row * 32 + u.pn * 4 + wc] = ss; }
                }
    }
};
template <bool OUT_F32> struct EpiResP {
    static constexpr bool PERM = true, AFTER_DRAIN = true, RESID = true;
    float* out; bf16_t* xb; float* rs; int ldc;
    __device__ __forceinline__ void fused(f32x4 (&acc)[2][2][4][2], const Unit& u, int wr, int wc, int fr, int fq, PG8_LAS unsigned char* lds, int wid, int lane) const {
        const int row0 = u.pm * BM + wr * 64 + fr, col0 = u.pn * BM + wc * 32 + 8 * fq, wh = wc >> 1;
        u32x4 g7[4];
        if (wh) {
#pragma unroll
            for (int m = 0; m < 4; ++m) g7[m] = *(const u32x4*)(xb + (size_t)(row0 + HALF + m * 16) * ldc + col0 + HALF); }
#pragma unroll
        for (int ai = 0; ai < 2; ++ai)
#pragma unroll
            for (int m = 0; m < 4; ++m) { const int row = row0 + ai * HALF + m * 16; const size_t off = (size_t)row * ldc + col0; float ss = 0.f;
                const int lb = lds_byte(wr * 64 + m * 16 + fr, (wc & 1) * 32 + 8 * fq);
#pragma unroll
                for (int bj = 0; bj < 2; ++bj) {
                    const int s0 = (ai == 0 && bj == 0) ? 4 : (ai == 1 && bj == 0) ? 5 : (ai == 0 && bj == 1) ? 6 : 7;
                    const int s1 = (ai == 0 && bj == 0) ? 0 : (ai == 1 && bj == 0) ? 1 : 2;
                    u32x4 w;
                    if (ai == 1 && bj == 1) { if (wh) w = g7[m]; else w = *(const PG8_LAS u32x4*)(lds + s0 * HTB + lb); }
                    else w = *(const PG8_LAS u32x4*)(lds + (wh ? s1 : s0) * HTB + lb);
                    const f32x4 b0 = {__uint_as_float(w.x << 16), __uint_as_float(w.x & 0xffff0000u), __uint_as_float(w.y << 16), __uint_as_float(w.y & 0xffff0000u)};
                    const f32x4 b1 = {__uint_as_float(w.z << 16), __uint_as_float(w.z & 0xffff0000u), __uint_as_float(w.w << 16), __uint_as_float(w.w & 0xffff0000u)};
                    const f32x4 x0 = b0 + acc[ai][bj][m][0], x1 = b1 + acc[ai][bj][m][1];
                    if (OUT_F32) { *(f32x4*)(out + off + bj * HALF) = x0; *(f32x4*)(out + off + bj * HALF + 4) = x1; }
                    else st16(xb + off + bj * HALF, pack8(x0, x1));
                    ss += (x0[0] * x0[0] + x0[1] * x0[1]) + (x0[2] * x0[2] + x0[3] * x0[3]) + (x1[0] * x1[0] + x1[1] * x1[1]) + (x1[2] * x1[2] + x1[3] * x1[3]); }
                if (!OUT_F32) { ss += __shfl_xor(ss, 16); ss += __shfl_xor(ss, 32);
                    if (fq == 0) rs[(size_t)row * 32 + u.pn * 4 + wc] = ss; } }
    }
};
__device__ __forceinline__ float row_sumsq(const float* rs, int row) {
    const f32x4* p = (const f32x4*)(rs + (size_t)row * 32); f32x4 t = p[0];
#pragma unroll
    for (int i = 1; i < 8; ++i) t += p[i];
    return (t[0] + t[1]) + (t[2] + t[3]);
}
__device__ __forceinline__ float row_rstd(const float* rs, int row) { return 1.0f / sqrtf(row_sumsq(rs, row) * (1.0f / 2048.0f) + 1e-6f); }
struct RsOrder : StaticOrder {
    const float* rs; PG8_LAS float* tab; mutable float pend; mutable int nready;
    __device__ __forceinline__ void a_ready(const Unit& u) const {
        if (threadIdx.x < 256) pend = row_sumsq(rs, u.pm * BM + u.hf * HALF + threadIdx.x);
        ++nready;
    }
    __device__ __forceinline__ bool next(int i, Unit& u) const {
        if (i == 1 && threadIdx.x < 256) tab[threadIdx.x] = 1.0f / sqrtf(pend * (1.0f / 2048.0f) + 1e-6f);
        return StaticOrder::next(i, u);
    }
    __device__ __forceinline__ void done(const Unit&) const {
        if (threadIdx.x < 256) tab[((nready - 1) & 1) * 256 + threadIdx.x] = 1.0f / sqrtf(pend * (1.0f / 2048.0f) + 1e-6f);
    }
};
struct TailOrder : RsOrder {
    int pn0;
    __device__ __forceinline__ bool next(int i, Unit& u) const {
        if (i == 1 && threadIdx.x < 256) tab[threadIdx.x] = 1.0f / sqrtf(pend * (1.0f / 2048.0f) + 1e-6f);
        if (i != 0 || G != 256) return false;
        const int x = c & 7, l = c >> 3; u.pm = 4 * x + (l & 3); u.hf = (l >> 2) & 1; u.pn = pn0 + (l >> 3); return true;
    }
};
template <bool HALF_M> struct EpiSwiglu {
    static constexpr bool PERM = true, AFTER_DRAIN = false, RESID = false;
    bf16_t* O; int ldc; const PG8_LAS float* tab; mutable int ui;
    __device__ __forceinline__ void operator()(const f32x4 (&acc)[2][2][4][2], const Unit& u, int wr, int wc, int fr, int fq) const {
        const int row0 = u.pm * BM + (HALF_M ? u.hf * HALF : 0) + wr * 64 + fr, col0 = u.pn * HALF + wc * 32 + 8 * fq;
#pragma unroll
        for (int ai = 0; ai < (HALF_M ? 1 : 2); ++ai)
#pragma unroll
            for (int m = 0; m < 4; ++m) { bf16_t* rowp = O + (size_t)(row0 + ai * HALF + m * 16) * ldc + col0; const float r = tab[(ui & 1) * 256 + wr * 64 + fr + ai * HALF + m * 16];
                f32x4 v0, v1;
#pragma unroll
                for (int j = 0; j < 4; ++j) { const float g0 = acc[ai][0][m][0][j] * r, g1 = acc[ai][0][m][1][j] * r;
                    v0[j] = g0 * fast_sigmoid(g0) * (acc[ai][1][m][0][j] * r); v1[j] = g1 * fast_sigmoid(g1) * (acc[ai][1][m][1][j] * r); }
                st16(rowp, pack8(v0, v1)); }
        ++ui;
    }
};

struct EpiSwigluProbe {
    static constexpr bool PERM = true, AFTER_DRAIN = false, RESID = false;
    bf16_t* O; int never;
    __device__ __forceinline__ void operator()(const f32x4 (&acc)[2][2][4][2], const Unit& u, int wr, int wc, int fr, int fq) const {
        if (never) {
#pragma unroll
        for (int ai = 0; ai < 2; ++ai)
#pragma unroll
            for (int m = 0; m < 4; ++m) { bf16_t* rowp = O + (size_t)(u.pm * BM + wr * 64 + fr + ai * HALF + m * 16) * 5632 + u.pn * HALF + wc * 32 + 8 * fq;
                st16(rowp, pack8(acc[ai][0][m][0] + acc[ai][1][m][0], acc[ai][0][m][1] + acc[ai][1][m][1])); } }
    }
};
struct EpiRetIn {
    static constexpr bool PERM = true, AFTER_DRAIN = false, RESID = false;
    bf16_t *q, *k, *v, *g; const float *cs, *sn; const PG8_LAS float* tab; mutable int ui;
    __device__ __forceinline__ void operator()(const f32x4 (&acc)[2][2][4][2], const Unit& u, int wr, int wc, int fr, int fq) const {
        const int pn = u.pn, ci = wc * 32 + 8 * fq;
#pragma unroll
        for (int ai = 0; ai < 2; ++ai)
#pragma unroll
            for (int m = 0; m < 4; ++m) {
                const int row = u.pm * BM + ai * HALF + wr * 64 + m * 16 + fr, b = row >> 12, s = row & 4095; const float rr = tab[(ui & 1) * 256 + ai * HALF + wr * 64 + m * 16 + fr];
                if (pn < 16) {
                    const int h = pn & 7; const float sc = (pn < 8 ? 1.0f : 0.0625f) * rr;
                    bf16_t* dst = (pn < 8 ? q : k) + ((size_t)((b * 8 + h) * 4096 + s)) * 256 + ci;
                    f32x4 o1[2], o2[2];
#pragma unroll
                    for (int n = 0; n < 2; ++n) { const f32x4 c4 = *(const f32x4*)(cs + (size_t)row * 128 + ci + 4 * n), s4 = *(const f32x4*)(sn + (size_t)row * 128 + ci + 4 * n);
                        const f32x4 x1 = acc[ai][0][m][n], x2 = acc[ai][1][m][n];
                        o1[n] = (x1 * c4 - x2 * s4) * sc; o2[n] = (x2 * c4 + x1 * s4) * sc; }
                    st16(dst, pack8(o1[0], o1[1])); st16(dst + 128, pack8(o2[0], o2[1]));
                } else if (pn < 32) {
                    const int t = pn - 16, h = t >> 1, hf = t & 1;
                    bf16_t* dst = v + ((size_t)((b * 8 + h) * 4096 + s)) * 512 + hf * 256 + ci;
                    st16(dst, pack8(acc[ai][0][m][0] * rr, acc[ai][0][m][1] * rr)); st16(dst + 128, pack8(acc[ai][1][m][0] * rr, acc[ai][1][m][1] * rr));
                } else {
                    bf16_t* dst = g + (size_t)row * 4096 + (pn - 32) * 256 + ci;
                    st16(dst, pack8(acc[ai][0][m][0] * rr, acc[ai][0][m][1] * rr)); st16(dst + 128, pack8(acc[ai][1][m][0] * rr, acc[ai][1][m][1] * rr));
                }
            }
        ++ui;
    }
};
struct EpiGeluUV {
    static constexpr bool PERM = true, AFTER_DRAIN = false, RESID = false;
    bf16_t *uo, *vo; f32x2v* part; const PG8_LAS float* tab; mutable int ui;
    __device__ __forceinline__ void operator()(const f32x4 (&acc)[2][2][4][2], const Unit& u, int wr, int wc, int fr, int fq) const {
        const bool isv = u.pn >= 24; const int ct = isv ? u.pn - 24 : u.pn; bf16_t* dstb = isv ? vo : uo;
#pragma unroll
        for (int ai = 0; ai < 2; ++ai)
#pragma unroll
            for (int m = 0; m < 4; ++m) {
                const int row = u.pm * BM + ai * HALF + wr * 64 + m * 16 + fr;
                bf16_t* dst = dstb + (size_t)row * 6144 + ct * 256 + wc * 32 + 8 * fq;
                float s = 0.f, ss = 0.f; const float rr = tab[(ui & 1) * 256 + ai * HALF + wr * 64 + m * 16 + fr];
#pragma unroll
                for (int bj = 0; bj < 2; ++bj) { const f32x4 v0 = acc[ai][bj][m][0] * rr, v1 = acc[ai][bj][m][1] * rr;
                    const f32x2 a = gelu_pk((f32x2){v0[0], v0[1]}), b = gelu_pk((f32x2){v0[2], v0[3]}), c = gelu_pk((f32x2){v1[0], v1[1]}), d = gelu_pk((f32x2){v1[2], v1[3]});
                    const f32x4 z0 = {a.x, a.y, b.x, b.y}, z1 = {c.x, c.y, d.x, d.y};
                    st16(dst + bj * HALF, pack8(z0, z1));
                    s += (z0[0] + z0[1]) + (z0[2] + z0[3]) + (z1[0] + z1[1]) + (z1[2] + z1[3]);
                    ss += (z0[0] * z0[0] + z0[1] * z0[1]) + (z0[2] * z0[2] + z0[3] * z0[3]) + (z1[0] * z1[0] + z1[1] * z1[1]) + (z1[2] * z1[2] + z1[3] * z1[3]); }
                if (isv) { s += __shfl_xor(s, 16); s += __shfl_xor(s, 32); ss += __shfl_xor(ss, 16); ss += __shfl_xor(ss, 32);
                    if (fq == 0) part[((size_t)row * 24 + ct) * 4 + wc] = (f32x2v){s, ss}; }
            }
        ++ui;
    }
};
struct EpiFoxIn {
    static constexpr bool PERM = true, AFTER_DRAIN = false, RESID = false;
    bf16_t* O; size_t stride; const PG8_LAS float* tab; mutable int ui; PG8_LAS float* qkt; const PG8_LAS float* gains;
    __device__ __forceinline__ void operator()(const f32x4 (&acc)[2][2][4][2], const Unit& u, int wr, int wc, int fr, int fq) const {
        const int t = u.pn >> 3; bf16_t* base = O + (size_t)t * stride + (u.pn & 7) * 256 + wc * 32 + 8 * fq;
        if (t < 2) {
#pragma unroll
            for (int ai = 0; ai < 2; ++ai)
#pragma unroll
                for (int m = 0; m < 4; ++m) { const int rt = ai * HALF + wr * 64 + m * 16 + fr; const float rr = tab[(ui & 1) * 256 + rt];
#pragma unroll
                    for (int bj = 0; bj < 2; ++bj) { const f32x4 v0 = acc[ai][bj][m][0] * rr, v1 = acc[ai][bj][m][1] * rr;
                        float ss = (v0[0] * v0[0] + v0[1] * v0[1]) + (v0[2] * v0[2] + v0[3] * v0[3]) + (v1[0] * v1[0] + v1[1] * v1[1]) + (v1[2] * v1[2] + v1[3] * v1[3]);
                        ss += __shfl_xor(ss, 16); ss += __shfl_xor(ss, 32);
                        if (fq == 0) qkt[(rt * 2 + bj) * 4 + wc] = ss; } }
            asm volatile("s_waitcnt lgkmcnt(0)" ::: "memory"); __builtin_amdgcn_s_barrier(); asm volatile("" ::: "memory");
            const float sc = t == 0 ? 0.08838834764831845f * 1.4426950408889634f : 1.0f;
            const f32x4 g0 = *(const PG8_LAS f32x4*)(gains + t * 128 + wc * 32 + 8 * fq), g1 = *(const PG8_LAS f32x4*)(gains + t * 128 + wc * 32 + 8 * fq + 4);
#pragma unroll
            for (int ai = 0; ai < 2; ++ai)
#pragma unroll
                for (int m = 0; m < 4; ++m) { const int rt = ai * HALF + wr * 64 + m * 16 + fr; const float rr = tab[(ui & 1) * 256 + rt]; bf16_t* dst = base + (size_t)(u.pm * BM + rt) * 2048;
#pragma unroll
                    for (int bj = 0; bj < 2; ++bj) { const f32x4 p = *(const PG8_LAS f32x4*)(qkt + (rt * 2 + bj) * 4);
                        const float rs = rr * sc / sqrtf(((p[0] + p[1]) + (p[2] + p[3])) * (1.0f / 128.0f) + 1e-6f);
                        st16(dst + bj * HALF, pack8(acc[ai][bj][m][0] * rs * g0, acc[ai][bj][m][1] * rs * g1)); } }
        } else {
#pragma unroll
            for (int ai = 0; ai < 2; ++ai)
#pragma unroll
                for (int m = 0; m < 4; ++m) { const int row = u.pm * BM + ai * HALF + wr * 64 + m * 16 + fr; bf16_t* dst = base + (size_t)row * 2048; const float rr = tab[(ui & 1) * 256 + ai * HALF + wr * 64 + m * 16 + fr];
#pragma unroll
                    for (int bj = 0; bj < 2; ++bj) { f32x4 v0 = acc[ai][bj][m][0] * rr, v1 = acc[ai][bj][m][1] * rr;
                        if (t == 3) {
#pragma unroll
                            for (int j = 0; j < 4; ++j) { v0[j] = fast_sigmoid(v0[j]); v1[j] = fast_sigmoid(v1[j]); } }
                        st16(dst + bj * HALF, pack8(v0, v1)); } }
        }
        ++ui;
    }
};

template <class Epi, class Sched, bool ALIGN_EPI = false, bool SP2 = false, bool HALF_M = false, int ABL = 0>
__device__ __forceinline__ void gemm_phase(PG8_LAS unsigned char* lds, const Gemm g, const Sched& S, const Epi& E) {
    const int tid = threadIdx.x, wid = __builtin_amdgcn_readfirstlane(tid >> 6), lane = tid & 63, wr = wid >> 2, wc = wid & 3, fr = lane & 15, fq = lane >> 4;
    static_assert(!HALF_M || SP2, "HALF_M is written for the SP2 loop");
    const int K = g.K, nt = K / BK;
    unsigned voffA[2], voffB[2];
#pragma unroll
    for (int i = 0; i < 2; ++i) { int R, C; stage_rc(tid * 16 + i * 8192, R, C); const int Rb = Epi::PERM ? ((R & ~31) + perm32(R & 31)) : R;
        voffA[i] = (unsigned)(R * K + C) * 2u; voffB[i] = (unsigned)(Rb * K + C) * 2u; }
    unsigned voffR[2] = {0u, 0u};
    if constexpr (Epi::RESID) {
#pragma unroll
        for (int i = 0; i < 2; ++i) { int R, C; stage_rc(tid * 16 + i * 8192, R, C); voffR[i] = (unsigned)(R * E.ldc + C) * 2u; } }
    const size_t kstep = (size_t)(BK * 2);
    const size_t hstep = (size_t)HALF * K * 2;
    const size_t tstep = 2 * hstep;
    const unsigned ldsw = (unsigned)wid * 1024u;
    const int aoff = lds_byte(wr * 64 + fr, fq * 8), boff = lds_byte(wc * 32 + fr, fq * 8);
#define PG8_SA(b, h) (((b) * 2 + (h)) * HTB)
#define PG8_SB(b, h) ((4 + (b) * 2 + (h)) * HTB)
#define PG8_STAGE(bufoff, gbase, voff) do { if constexpr (!(ABL & 2)) _Pragma("unroll") for (int _i = 0; _i < 2; ++_i) \
        __builtin_amdgcn_global_load_lds((const unsigned*)((const char*)(gbase) + (voff)[_i]), (PG8_LAS unsigned*)(lds + (bufoff) + ldsw + _i * 8192), 16, 0, 0); } while (0)
#define PG8_LDA(dst, b, h) do { if constexpr (!(ABL & 4)) { _Pragma("unroll") for (int m = 0; m < 4; ++m) _Pragma("unroll") for (int k = 0; k < 2; ++k) { dst[m][k] = *(const PG8_LAS bf16x8*)(lds + PG8_SA(b, h) + aoff + m * 2048 + k * 1024); if constexpr (ABL & 1) asm volatile("" :: "v"(dst[m][k])); } } } while (0)
#define PG8_LDB(dst, b, h) do { if constexpr (!(ABL & 4)) { _Pragma("unroll") for (int n = 0; n < 2; ++n) _Pragma("unroll") for (int k = 0; k < 2; ++k) { dst[n][k] = *(const PG8_LAS bf16x8*)(lds + PG8_SB(b, h) + boff + n * 2048 + k * 1024); if constexpr (ABL & 1) asm volatile("" :: "v"(dst[n][k])); } } } while (0)
#define PG8_MMA(ai, bj, At, Bt) do { if constexpr (!(ABL & 1)) { __builtin_amdgcn_s_setprio(1); _Pragma("unroll") for (int m = 0; m < 4; ++m) _Pragma("unroll") for (int n = 0; n < 2; ++n) _Pragma("unroll") for (int k = 0; k < 2; ++k) \
        acc[ai][bj][m][n] = __builtin_amdgcn_mfma_f32_16x16x32_bf16(Bt[n][k], At[m][k], acc[ai][bj][m][n], 0, 0, 0); __builtin_amdgcn_s_setprio(0); } } while (0)
#define PG8_WAIT_V(n) asm volatile("s_waitcnt vmcnt(" #n ")" ::: "memory")
#define PG8_WAIT_L(n) asm volatile("s_waitcnt lgkmcnt(" #n ")" ::: "memory")
#define PG8_BAR __builtin_amdgcn_s_barrier()
#define PG8_SCHED __builtin_amdgcn_sched_barrier(0)
    Unit cur, nxt; int ui = 0;
    if (!S.next(0, cur)) return;
    f32x4 acc[2][2][4][2];
#pragma unroll
    for (int a = 0; a < 2; ++a)
#pragma unroll
        for (int b = 0; b < 2; ++b)
#pragma unroll
            for (int m = 0; m < 4; ++m)
#pragma unroll
                for (int n = 0; n < 2; ++n) acc[a][b][m][n] = (f32x4){0.f, 0.f, 0.f, 0.f};
    bf16x8 At[4][2], B0[2][2], B1[2][2];
    if constexpr (ABL & 4) { _Pragma("unroll") for (int m = 0; m < 4; ++m) _Pragma("unroll") for (int k = 0; k < 2; ++k) At[m][k] = (bf16x8){(short)lane, 1, 2, 3, 4, 5, 6, 7};
        _Pragma("unroll") for (int n = 0; n < 2; ++n) _Pragma("unroll") for (int k = 0; k < 2; ++k) { B0[n][k] = (bf16x8){(short)lane, 1, 2, 3, 4, 5, 6, 7}; B1[n][k] = B0[n][k]; } }
    const char* cA = (const char*)g.A + (size_t)cur.pm * tstep + (HALF_M ? (size_t)cur.hf * hstep : (size_t)0); const char* cB = (const char*)g.Bt + (size_t)cur.pn * tstep;
    S.a_ready(cur);
    if constexpr (SP2) {
        PG8_STAGE(PG8_SB(0, 0), cB, voffB); PG8_STAGE(PG8_SB(0, 1), cB + hstep, voffB); PG8_STAGE(PG8_SA(0, 0), cA, voffA); PG8_STAGE(PG8_SA(0, 1), cA + hstep, voffA);
        if (wr == 1) PG8_BAR;
        PG8_WAIT_V(2); PG8_BAR;
        PG8_STAGE(PG8_SB(1, 0), cB + kstep, voffB); PG8_STAGE(PG8_SA(1, 0), cA + kstep, voffA); PG8_STAGE(PG8_SB(1, 1), cB + hstep + kstep, voffB);
        PG8_WAIT_V(6); PG8_BAR;
    } else {
        PG8_STAGE(PG8_SB(0, 0), cB, voffB); PG8_STAGE(PG8_SA(0, 0), cA, voffA); PG8_STAGE(PG8_SB(0, 1), cB + hstep, voffB); PG8_STAGE(PG8_SA(0, 1), cA + hstep, voffA);
        if (wr == 1) PG8_BAR;
        PG8_WAIT_V(4); PG8_BAR;
        PG8_STAGE(PG8_SB(1, 0), cB + kstep, voffB); PG8_STAGE(PG8_SA(1, 0), cA + kstep, voffA); PG8_STAGE(PG8_SB(1, 1), cB + hstep + kstep, voffB);
        PG8_WAIT_V(6); PG8_BAR;
    }
    for (;;) {
        const bool has_next = S.next(ui + 1, nxt);
        const char* nA = has_next ? (const char*)g.A + (size_t)nxt.pm * tstep + (HALF_M ? (size_t)nxt.hf * hstep : (size_t)0) : cA; const char* nB = has_next ? (const char*)g.Bt + (size_t)nxt.pn * tstep : cB;
        for (int t = 0; t < nt; t += 2) {
            const bool last = (t == nt - 2);
            const char* a1 = cA + (size_t)(t + 1) * kstep;
            const char* a2 = last ? nA : cA + (size_t)(t + 2) * kstep; const char* b2 = last ? nB : cB + (size_t)(t + 2) * kstep;
            const char* a3 = a2 + kstep; const char* b3 = b2 + kstep;
            if (last && has_next) S.a_ready(nxt);
            bool rp = false; const char* rbase = nullptr; size_t rhstep = 0;
            if constexpr (Epi::RESID) { rp = last && !has_next; rbase = (const char*)E.xb + ((size_t)cur.pm * BM * E.ldc + (size_t)cur.pn * BM) * 2; rhstep = (size_t)HALF * E.ldc * 2; }
#define PG8_STAGE_R(bufoff, gbase, voff, blk) do { if constexpr (Epi::RESID) { const char* g_ = rp ? (rbase + ((blk) & 1) * rhstep + ((blk) >> 1) * 128) : (const char*)(gbase); \
                _Pragma("unroll") for (int _i = 0; _i < 2; ++_i) __builtin_amdgcn_global_load_lds((const unsigned*)(g_ + (rp ? voffR[_i] : (voff)[_i])), (PG8_LAS unsigned*)(lds + (bufoff) + ldsw + _i * 8192), 16, 0, 0); } \
            else { PG8_STAGE(bufoff, gbase, voff); } } while (0)
            if constexpr (SP2) {
            PG8_LDB(B0, 0, 0); PG8_LDB(B1, 0, 1); PG8_SCHED; PG8_LDA(At, 0, 0); PG8_STAGE(PG8_SA(1, 1), a1 + hstep, voffA);
            PG8_WAIT_V(8); PG8_WAIT_L(0); PG8_BAR; PG8_MMA(0, 0, At, B0); PG8_MMA(0, 1, At, B1); PG8_BAR; if constexpr (ABL & 8) __builtin_amdgcn_s_sleep(2); PG8_SCHED;
            if constexpr (!HALF_M) { PG8_LDA(At, 0, 1); } PG8_STAGE_R(PG8_SB(0, 0), b2, voffB, 0); PG8_STAGE_R(PG8_SB(0, 1), b2 + hstep, voffB, 1); PG8_STAGE_R(PG8_SA(0, 0), a2, voffA, 2);
            PG8_WAIT_V(8); PG8_WAIT_L(0); PG8_BAR; if constexpr (!HALF_M) { PG8_MMA(1, 0, At, B0); PG8_MMA(1, 1, At, B1); } PG8_BAR; if constexpr (ABL & 8) __builtin_amdgcn_s_sleep(2); PG8_SCHED;
            PG8_LDB(B0, 1, 0); PG8_LDB(B1, 1, 1); PG8_SCHED; PG8_LDA(At, 1, 0); PG8_STAGE_R(PG8_SA(0, 1), a2 + hstep, voffA, 3);
            PG8_WAIT_V(8); PG8_WAIT_L(0); PG8_BAR; PG8_MMA(0, 0, At, B0); PG8_MMA(0, 1, At, B1); PG8_BAR; if constexpr (ABL & 8) __builtin_amdgcn_s_sleep(2); PG8_SCHED;
            if constexpr (!HALF_M) { PG8_LDA(At, 1, 1); } PG8_STAGE_R(PG8_SB(1, 0), b3, voffB, 4); PG8_STAGE_R(PG8_SB(1, 1), b3 + hstep, voffB, 5); PG8_STAGE_R(PG8_SA(1, 0), a3, voffA, 6);
            PG8_WAIT_V(8); PG8_WAIT_L(0); PG8_BAR; if constexpr (!HALF_M) { PG8_MMA(1, 0, At, B0); PG8_MMA(1, 1, At, B1); } PG8_BAR; if constexpr (ABL & 8) __builtin_amdgcn_s_sleep(2); PG8_SCHED;
            } else {
            PG8_LDB(B0, 0, 0); PG8_SCHED; PG8_LDA(At, 0, 0); PG8_STAGE(PG8_SA(1, 1), a1 + hstep, voffA);
            PG8_WAIT_L(8); PG8_BAR; PG8_WAIT_L(0); PG8_MMA(0, 0, At, B0); PG8_BAR; PG8_SCHED;
            PG8_LDB(B1, 0, 1); PG8_STAGE(PG8_SB(0, 0), b2, voffB);
            PG8_BAR; PG8_WAIT_L(0); PG8_MMA(0, 1, At, B1); PG8_BAR;
            PG8_LDA(At, 0, 1); PG8_STAGE(PG8_SA(0, 0), a2, voffA);
            PG8_BAR; PG8_WAIT_L(0); PG8_MMA(1, 0, At, B0); PG8_BAR; PG8_SCHED;
            PG8_STAGE(PG8_SB(0, 1), b2 + hstep, voffB);
            PG8_WAIT_V(6); PG8_BAR; PG8_MMA(1, 1, At, B1); PG8_BAR;
            PG8_LDB(B0, 1, 0); PG8_SCHED; PG8_LDA(At, 1, 0); PG8_STAGE(PG8_SA(0, 1), a2 + hstep, voffA);
            PG8_WAIT_L(8); PG8_BAR; PG8_WAIT_L(0); PG8_MMA(0, 0, At, B0); PG8_BAR; PG8_SCHED;
            PG8_LDB(B1, 1, 1); PG8_STAGE(PG8_SB(1, 0), b3, voffB);
            PG8_BAR; PG8_WAIT_L(0); PG8_MMA(0, 1, At, B1); PG8_BAR;
            PG8_LDA(At, 1, 1); PG8_STAGE(PG8_SA(1, 0), a3, voffA);
            PG8_BAR; PG8_WAIT_L(0); PG8_MMA(1, 0, At, B0); PG8_BAR; PG8_SCHED;
            PG8_STAGE(PG8_SB(1, 1), b3 + hstep, voffB);
            PG8_WAIT_V(6); PG8_BAR; PG8_MMA(1, 1, At, B1); PG8_BAR;
            }
        }
        if constexpr (ALIGN_EPI) { if (wr == 0) PG8_BAR; }
        if constexpr (!Epi::AFTER_DRAIN) { E(acc, cur, wr, wc, fr, fq); S.done(cur); }
        if (!has_next) break;
#pragma unroll
        for (int a = 0; a < 2; ++a)
#pragma unroll
            for (int b = 0; b < 2; ++b)
#pragma unroll
                for (int m = 0; m < 4; ++m)
#pragma unroll
                    for (int n = 0; n < 2; ++n) acc[a][b][m][n] = (f32x4){0.f, 0.f, 0.f, 0.f};
        cur = nxt; cA = nA; cB = nB; ++ui;
        if constexpr (ALIGN_EPI) { if (wr == 1) PG8_BAR; }
    }
    PG8_WAIT_V(0);
    if constexpr (!ALIGN_EPI) { if (wr == 0) PG8_BAR; }
    PG8_BAR;
    if constexpr (Epi::AFTER_DRAIN) { E.fused(acc, cur, wr, wc, fr, fq, lds, wid, lane); S.done(cur); }
#undef PG8_SA
#undef PG8_SB
#undef PG8_STAGE
#undef PG8_STAGE_R
#undef PG8_LDA
#undef PG8_LDB
#undef PG8_MMA
#undef PG8_WAIT_V
#undef PG8_WAIT_L
#undef PG8_BAR
#undef PG8_SCHED
}
}

#ifndef PG8_SP2
#define PG8_SP2 true
#endif
#ifndef PG8_ALIGN
#define PG8_ALIGN true
#endif
constexpr int NWAVES = 8, NTHR = 512;
#ifndef MK_N_LAUNCHES
#define MK_N_LAUNCHES 1
#endif
constexpr int N_PHASES = 25;
constexpr int N_LAUNCHES = MK_N_LAUNCHES;
static_assert(N_LAUNCHES == 1, "this build runs as ONE launch (the retention mixer has a grid barrier inside its phase)");

constexpr int BATCH = 2, SEQ = 4096, DM = 2048, M = BATCH * SEQ, DEPTH = 4;
constexpr int RET_N = 12288, GM_N = 12288, GM_HALF = 6144, FOX_LD = 8208, FOX_N = 8192, FFN_H = 5632, FFN_N2 = 2 * FFN_H;
constexpr float EPS = 1e-6f;
constexpr float LOG2E = 1.4426950408889634f;

constexpr size_t MiB = (size_t)1 << 20;
constexpr size_t WS_CTL = 0, CTL_ZERO_BYTES = 1 * MiB;
constexpr size_t WS_W_RET_IN = 1 * MiB, SZ_W_RET_IN = 48 * MiB;
constexpr size_t WS_W_RET_OUT = 97 * MiB, SZ_W_RET_OUT = 16 * MiB;
constexpr size_t WS_W_GM_IN = 129 * MiB, WS_W_GM_OUT = 177 * MiB, WS_W_FOX_IN = 201 * MiB, WS_W_FOX_OUT = 233 * MiB;
constexpr size_t WS_W_GU = 241 * MiB, SZ_W_GU = 44 * MiB;
constexpr size_t WS_W_DN = 417 * MiB, SZ_W_DN = 22 * MiB;
constexpr size_t WS_ROPE_C = 505 * MiB, WS_ROPE_S = 509 * MiB;
constexpr size_t WS_H = 513 * MiB;
constexpr size_t WS_A = 545 * MiB;
constexpr size_t WS_B = 737 * MiB;
constexpr size_t WS_C = 833 * MiB;
constexpr size_t WS_MISC = 897 * MiB, WS_RSP = 913 * MiB, WS_KF = 921 * MiB, WS_QF = 953 * MiB, WS_END = 985 * MiB;
constexpr size_t MISC_PART = 0, MISC_RSTAT = 8 * MiB, MISC_LF = 9 * MiB, MISC_WTRI = 12 * MiB;
constexpr int CW_BAR = 4096;

constexpr int RING_OFF = 0, RING_BYTES = 131072;
constexpr int LDSCTL_OFF = RING_BYTES, MISC_OFF = LDSCTL_OFF + 320;
constexpr int RSTAB_OFF = LDSCTL_OFF + 1024;
constexpr int QKT_OFF = LDSCTL_OFF + 3072, QKG_OFF = QKT_OFF + 8192;
constexpr int LDS_BYTES = 147456;
static_assert(MISC_OFF + 128 <= RSTAB_OFF && RSTAB_OFF + 2048 <= QKT_OFF && QKG_OFF + 1024 <= LDS_BYTES, "LDS map");

#define GAS __attribute__((address_space(1)))
#define LAS __attribute__((address_space(3)))
typedef unsigned short bf16;
typedef unsigned v4u __attribute__((ext_vector_type(4)));
typedef unsigned v2u __attribute__((ext_vector_type(2)));
typedef float f32x4 __attribute__((ext_vector_type(4)));
typedef float f32x2 __attribute__((ext_vector_type(2)));
typedef short bf16x8 __attribute__((ext_vector_type(8)));
typedef short s16x4 __attribute__((ext_vector_type(4)));
typedef GAS unsigned gu32;
typedef LAS unsigned char* ldsp;
#define RLX_AGENT __ATOMIC_RELAXED, __HIP_MEMORY_SCOPE_AGENT
#define LDS_WAIT() asm volatile("s_waitcnt lgkmcnt(0)" ::: "memory")
using pg8::cvtpk;
__device__ __forceinline__ float bflo(unsigned w) { return __uint_as_float(w << 16); }
__device__ __forceinline__ float bfhi(unsigned w) { return __uint_as_float(w & 0xffff0000u); }
#define MFMA16(a, b, c) __builtin_amdgcn_mfma_f32_16x16x32_bf16((a), (b), (c), 0, 0, 0)
__device__ __forceinline__ bf16x8 frag_row(const ldsp tile, int RS, int lane) { return *(const LAS bf16x8*)(tile + (lane & 15) * RS + (lane >> 4) * 16); }
typedef short v4i16_t __attribute__((ext_vector_type(4)));
__device__ __forceinline__ s16x4 vtr(const ldsp p) { return __builtin_bit_cast(s16x4, __builtin_amdgcn_ds_read_tr16_b64_v4i16((LAS v4i16_t*)p)); }
__device__ __forceinline__ bf16x8 frag_tr(const ldsp tile, int RS, int lane) {
    const ldsp a = tile + (8 * (lane >> 4) + ((lane & 15) >> 2)) * RS + 8 * (lane & 3);
    const s16x4 lo = vtr(a), hi = vtr(a + 4 * RS);
    return (bf16x8){lo[0], lo[1], lo[2], lo[3], hi[0], hi[1], hi[2], hi[3]};
}

#define XB_TMO      128
#define XB_XCNT(j)  (256  + 64 * (j))
#define XB_XSUB(j)  (1280 + 64 * (j))
#define XB_XGEN(j)  (2304 + 64 * (j))
#define XB_TOP      3328
#define XB_TOPGEN   3392
#define XCD_BAR_WORDS 3456
#define XB_SPIN_CAP (1u << 18)

__device__ __forceinline__ unsigned xb_ld(unsigned* p)              { return __hip_atomic_load(p, __ATOMIC_RELAXED, __HIP_MEMORY_SCOPE_AGENT); }
__device__ __forceinline__ unsigned xb_add(unsigned* p, unsigned v) { return __hip_atomic_fetch_add(p, v, __ATOMIC_RELAXED, __HIP_MEMORY_SCOPE_AGENT); }
__device__ __forceinline__ unsigned xb_xcc_id() { return (unsigned)__builtin_amdgcn_s_getreg((3 << 11) | 20) & 0xFu; }
#define XB_SPIN(cond, bar) do { unsigned _sp = 0; while (cond) { __builtin_amdgcn_s_sleep(1); \
    if ((++_sp & 255u) == 0u) { if (xb_ld(&(bar)[XB_TMO])) break; if (_sp > XB_SPIN_CAP) { atomicAdd(&(bar)[XB_TMO], 1u); break; } } } } while (0)

struct XcdBarrier {
    unsigned* bar; unsigned x;
    volatile LAS unsigned* st;
};

__device__ __forceinline__ XcdBarrier xcd_barrier_post(unsigned* bar, volatile LAS unsigned* st) {
    XcdBarrier b; b.bar = bar; b.x = xb_xcc_id(); b.st = st;
    if (threadIdx.x == 0) (void)xb_add(&bar[XB_XCNT(b.x)], 1u);
    return b;
}
__device__ __forceinline__ void xcd_barrier_complete(unsigned* bar, unsigned x, unsigned& nloc, unsigned& nx) {
    const unsigned G = gridDim.x * gridDim.y * gridDim.z;
    unsigned sum, cnt, mine, sp = 0u;
    for (;;) {
        sum = 0u; cnt = 0u; mine = 0u;
#pragma unroll
        for (unsigned j = 0; j < 16; ++j) { const unsigned c = xb_ld(&bar[XB_XCNT(j)]); sum += c; cnt += (c > 0u) ? 1u : 0u; mine = (j == x) ? c : mine; }
        if (sum == G) break;
        __builtin_amdgcn_s_sleep(1);
        if ((++sp & 255u) == 0u) { if (xb_ld(&bar[XB_TMO])) break; if (sp > XB_SPIN_CAP) { atomicAdd(&bar[XB_TMO], 1u); break; } }
    }
    nloc = mine > 0u ? mine : 1u; nx = cnt > 0u ? cnt : 1u;
}

__device__ __forceinline__ void xcd_barrier(const XcdBarrier& b) {
    asm volatile("s_waitcnt vmcnt(0)" ::: "memory");
    __syncthreads();
    if (threadIdx.x == 0) {
        unsigned* bar = b.bar;
        __builtin_amdgcn_s_waitcnt(0);
        unsigned nloc = b.st[0], nx = b.st[1];
        if (nloc == 0u) { xcd_barrier_complete(bar, b.x, nloc, nx); b.st[0] = nloc; b.st[1] = nx; }
        const unsigned old = xb_add(&bar[XB_XSUB(b.x)], 1u);
        const unsigned gen = old / nloc;
        if (old + 1u == (gen + 1u) * nloc) {
            __builtin_amdgcn_fence(__ATOMIC_RELEASE, "agent");
            asm volatile("s_waitcnt vmcnt(0)" ::: "memory");
            const unsigned og = xb_add(&bar[XB_TOP], 1u);
            const unsigned tg = og / nx;
            if (og + 1u == (tg + 1u) * nx) xb_add(&bar[XB_TOPGEN], 1u);
            else XB_SPIN(xb_ld(&bar[XB_TOPGEN]) == tg, bar);
            __builtin_amdgcn_fence(__ATOMIC_ACQUIRE, "agent");
            xb_add(&bar[XB_XGEN(b.x)], 1u);
            asm volatile("s_waitcnt vmcnt(0)" ::: "memory");
        } else {
            XB_SPIN(xb_ld(&bar[XB_XGEN(b.x)]) == gen, bar);
            __builtin_amdgcn_fence(__ATOMIC_ACQUIRE, "agent");
            asm volatile("s_waitcnt vmcnt(0)" ::: "memory");
        }
    }
    __syncthreads();
}

struct Frame {
    ldsp lds;
    volatile LAS unsigned* MISC;
    gu32* ctl;
    int tid, lane, wave;
    int vcu, G;
};
__device__ __forceinline__ float wave_sum(float v) {
#pragma unroll
    for (int o = 1; o < 64; o <<= 1) v += __shfl_xor(v, o);
    return v;
}
__device__ __forceinline__ float log_sigmoid(float z) { return fminf(z, 0.f) - log1pf(expf(-fabsf(z))); }

__device__ __forceinline__ void transpose_job(Frame& F, const float* W, int K, int ld, int ncols, bf16* WT, int ilv, const float* gvec) {
    LAS float* scr = (LAS float*)(F.lds + RING_OFF + F.wave * 16384);
    const int gw = F.vcu * NWAVES + F.wave, NGW = F.G * NWAVES, lane = F.lane;
    const int nblk = ncols / 32, nitems = (K / 64) * nblk;
    float wv[32];
#define TJ_LOAD(item) do { const int kb_ = (item) / nblk, nb_ = (item) % nblk; const float* src_ = W + (size_t)(64 * kb_ + (lane >> 5)) * ld + 32 * nb_ + (lane & 31); \
        _Pragma("unroll") for (int i = 0; i < 32; ++i) wv[i] = src_[(size_t)(2 * i) * ld]; } while (0)
    if (gw < nitems) TJ_LOAD(gw);
    for (int it = gw; it < nitems; it += NGW) {
        const int kb = it / nblk, nb = it % nblk, k0 = 64 * kb, n0 = 32 * nb;
        const int drow0 = ilv == 0 ? n0 : ((n0 >> 7) * 256 + (n0 & 127) + (ilv == 2 ? 128 : 0));
#pragma unroll
        for (int i = 0; i < 32; ++i) scr[(2 * i + (lane >> 5)) * 33 + (lane & 31)] = wv[i];
        if (it + NGW < nitems) TJ_LOAD(it + NGW);
        LDS_WAIT(); asm volatile("" ::: "memory");
        const int c = lane & 7;
        f32x4 ga = {1.f, 1.f, 1.f, 1.f}, gb = {1.f, 1.f, 1.f, 1.f};
        if (gvec) { ga = *(const f32x4*)(gvec + k0 + 8 * c); gb = *(const f32x4*)(gvec + k0 + 8 * c + 4); }
#pragma unroll
        for (int j = 0; j < 4; ++j) { const int n = (lane >> 3) + 8 * j; const LAS float* s = scr + (8 * c) * 33 + n;
            v4u o; o.x = cvtpk(s[0 * 33] * ga[0], s[1 * 33] * ga[1]); o.y = cvtpk(s[2 * 33] * ga[2], s[3 * 33] * ga[3]); o.z = cvtpk(s[4 * 33] * gb[0], s[5 * 33] * gb[1]); o.w = cvtpk(s[6 * 33] * gb[2], s[7 * 33] * gb[3]);
            *(GAS v4u*)(WT + (size_t)(drow0 + n) * K + k0 + 8 * c) = o; }
        LDS_WAIT(); asm volatile("" ::: "memory");
    }
#undef TJ_LOAD
}
__device__ __forceinline__ void p0_prologue(Frame& F, const void* const* in, unsigned char* ws) {
    const float* mixg = (const float*)in[2]; const float* ffng = (const float*)in[3];
    for (int j = 0; j < 2; ++j) {
        transpose_job(F, (const float*)in[4] + (size_t)j * DM * RET_N, DM, RET_N, RET_N, (bf16*)(ws + WS_W_RET_IN + j * SZ_W_RET_IN), 0, mixg + (size_t)(3 * j) * DM);
        transpose_job(F, (const float*)in[6] + (size_t)j * 4096 * DM, 4096, DM, DM, (bf16*)(ws + WS_W_RET_OUT + j * SZ_W_RET_OUT), 0, nullptr);
    }
    transpose_job(F, (const float*)in[7], DM, GM_N, GM_N, (bf16*)(ws + WS_W_GM_IN), 0, mixg + DM);
    transpose_job(F, (const float*)in[12], GM_HALF, DM, DM, (bf16*)(ws + WS_W_GM_OUT), 0, nullptr);
    transpose_job(F, (const float*)in[13], DM, FOX_LD, FOX_N, (bf16*)(ws + WS_W_FOX_IN), 0, mixg + 2 * DM);
    transpose_job(F, (const float*)in[17], DM, DM, DM, (bf16*)(ws + WS_W_FOX_OUT), 0, nullptr);
    for (int i = 0; i < DEPTH; ++i) {
        transpose_job(F, (const float*)in[18] + (size_t)i * DM * FFN_H, DM, FFN_H, FFN_H, (bf16*)(ws + WS_W_GU + i * SZ_W_GU), 1, ffng + (size_t)i * DM);
        transpose_job(F, (const float*)in[19] + (size_t)i * DM * FFN_H, DM, FFN_H, FFN_H, (bf16*)(ws + WS_W_GU + i * SZ_W_GU), 2, ffng + (size_t)i * DM);
        transpose_job(F, (const float*)in[20] + (size_t)i * FFN_H * DM, FFN_H, DM, DM, (bf16*)(ws + WS_W_DN + i * SZ_W_DN), 0, nullptr);
    }
    { const float* x = (const float*)in[0]; bf16* xb = (bf16*)(ws + WS_H); float* rss = (float*)(ws + WS_RSP);
      const int gw = F.vcu * NWAVES + F.wave, NGW = F.G * NWAVES, lane = F.lane;
      for (int m = gw; m < M; m += NGW) { const f32x4* xr = (const f32x4*)(x + (size_t)m * DM) + lane; v2u* o8 = (v2u*)(xb + (size_t)m * DM) + lane; float ss = 0.f;
#pragma unroll
          for (int j = 0; j < 8; ++j) { const f32x4 v = xr[64 * j]; ss += (v.x * v.x + v.y * v.y) + (v.z * v.z + v.w * v.w); v2u w; w.x = cvtpk(v.x, v.y); w.y = cvtpk(v.z, v.w); o8[64 * j] = w; }
          ss = wave_sum(ss); if (lane < 32) rss[(size_t)m * 32 + lane] = lane == 0 ? ss : 0.f; } }
    { const float* wsp = (const float*)in[10]; bf16* wtri = (bf16*)(ws + WS_MISC + MISC_WTRI);
      for (int i4 = F.vcu * NTHR + F.tid; i4 < 8 * 128 * 32; i4 += F.G * NTHR) { const int t = (i4 >> 5) & 127, s4 = (i4 & 31) * 4; f32x4 wv = *(const f32x4*)(wsp + (size_t)i4 * 4);
#pragma unroll
          for (int e = 0; e < 4; ++e) if (s4 + e > t) wv[e] = 0.f;
          v2u pk; pk.x = cvtpk(wv[0], wv[1]); pk.y = cvtpk(wv[2], wv[3]); *(v2u*)(wtri + (size_t)i4 * 4) = pk; } }
    { const int* pos = (const int*)in[1]; float* cs = (float*)(ws + WS_ROPE_C); float* sn = (float*)(ws + WS_ROPE_S);
      const int gid = F.vcu * NTHR + F.tid, i = gid & 127, step = (F.G * NTHR) >> 7;
      const double invf = exp2(-(double)i * (13.287712379549449 / 128.0));
      for (int r = gid >> 7; r < M; r += step) { const double ang = (double)pos[r] * invf; const double rr = ang - 6.283185307179586 * rint(ang * 0.15915494309189535);
          const float a = (float)rr; cs[(size_t)r * 128 + i] = cosf(a); sn[(size_t)r * 128 + i] = sinf(a); } }
}

__device__ __forceinline__ void ret_p_phase(Frame& F, const bf16* q, const bf16* k, bf16* PF, bf16* KF, bf16* QF) {
    constexpr int RSQ = 272;
    const ldsp LQ = F.lds, LK = F.lds + 34816;
    const int tid = F.tid, lane = F.lane, w = F.wave, g4 = lane >> 4, l15 = lane & 15;
    for (int unit = F.vcu; unit < 512; unit += F.G) {
        const int bh = unit >> 5, ci = unit & 31, h = bh & 7;
        const float lg2 = log1pf(-exp2f(-5.0f - (float)h)) * LOG2E;
        const size_t rowbase = (size_t)bh * SEQ + ci * 128;
        v4u pq[4], pk[4];
#define RP_LD(dd) do { _Pragma("unroll") for (int ps = 0; ps < 4; ++ps) { const int r_ = ps * 32 + (tid >> 4), c_ = tid & 15; \
            pq[ps] = *(const v4u*)(q + (rowbase + r_) * 256 + (dd) * 128 + c_ * 8); pk[ps] = *(const v4u*)(k + (rowbase + r_) * 256 + (dd) * 128 + c_ * 8); } } while (0)
        RP_LD(0);
        f32x4 S[8];
#pragma unroll
        for (int t = 0; t < 8; ++t) S[t] = (f32x4){0.f, 0.f, 0.f, 0.f};
#pragma unroll
        for (int dh = 0; dh < 2; ++dh) {
            __syncthreads();
#pragma unroll
            for (int ps = 0; ps < 4; ++ps) { const int r_ = ps * 32 + (tid >> 4), c_ = tid & 15; *(LAS v4u*)(LQ + r_ * RSQ + c_ * 16) = pq[ps]; *(LAS v4u*)(LK + r_ * RSQ + c_ * 16) = pk[ps]; }
            if (dh == 0) RP_LD(1);
            __syncthreads();
#pragma unroll
            for (int ks = 0; ks < 4; ++ks) { const bf16x8 a = frag_row(LQ + (16 * w) * RSQ + ks * 64, RSQ, lane);
                *(bf16x8*)(QF + ((((size_t)(bh * 32 + ci) * 8 + w) * 8 + dh * 4 + ks) * 512 + lane * 8)) = a;
#pragma unroll
                for (int t = 0; t < 8; ++t) S[t] = MFMA16(a, frag_row(LK + (16 * t) * RSQ + ks * 64, RSQ, lane), S[t]); }
#pragma unroll
            for (int ks = 0; ks < 4; ++ks) { const bf16x8 f = frag_tr(LK + (32 * ks) * RSQ + (16 * w) * 2, RSQ, lane); const v4u fu = __builtin_bit_cast(v4u, f); v4u o;
                const float k0 = exp2f((float)(127 - 32 * ks - 8 * g4) * lg2), gi = exp2f(-lg2), k1 = k0 * gi, k2 = k1 * gi, k3 = k2 * gi, k4 = k3 * gi, k5 = k4 * gi, k6 = k5 * gi, k7 = k6 * gi;
                o.x = cvtpk(bflo(fu.x) * k0, bfhi(fu.x) * k1); o.y = cvtpk(bflo(fu.y) * k2, bfhi(fu.y) * k3); o.z = cvtpk(bflo(fu.z) * k4, bfhi(fu.z) * k5); o.w = cvtpk(bflo(fu.w) * k6, bfhi(fu.w) * k7);
                *(v4u*)(KF + ((((size_t)(bh * 32 + ci) * 2 + dh) * 8 + w) * 4 + ks) * 512 + lane * 8) = o; }
        }
#undef RP_LD
#pragma unroll
        for (int t = 0; t < 8; ++t)
#pragma unroll
            for (int r = 0; r < 4; ++r) { const int n = 16 * w + 4 * g4 + r, mm = 16 * t + l15;
                const float pv_ = n >= mm ? S[t][r] * exp2f((float)(n - mm) * lg2) : 0.f;
                *(LAS unsigned short*)(LQ + n * RSQ + mm * 2) = (unsigned short)(cvtpk(pv_, 0.f) & 0xffffu); }
#pragma unroll
        for (int ks = 0; ks < 4; ++ks) *(bf16x8*)(PF + ((((size_t)(bh * 32 + ci) * 8 + w) * 4 + ks) * 512 + lane * 8)) = frag_row(LQ + (16 * w) * RSQ + ks * 64, RSQ, lane);
    }
}
#ifndef RC_ILV
#define RC_ILV 1
#endif
__device__ __forceinline__ void ret_core_phase(Frame& F, const bf16* QF, const bf16* v, const bf16* PF, const bf16* KF, bf16* o, const int umask = 0) {
    constexpr int RSV = 72, RSS = 528;
    const ldsp LV0 = F.lds, LST = F.lds + 18432;
    const ldsp LOw = F.lds + 52224 + F.wave * 1024;
    const int tid = F.tid, lane = F.lane, w = F.wave, g4 = lane >> 4, l15 = lane & 15;
    for (int unit = F.vcu; unit < 256; unit += F.G) {
        if (unit & umask) continue;
        const int bh = unit >> 4, es = unit & 15, h = bh & 7, b = bh >> 3, e0 = es * 32;
        const float lg2 = log1pf(-exp2f(-5.0f - (float)h)) * LOG2E;
        const float cd = exp2f(128.0f * lg2);
        const size_t rb0 = (size_t)bh * SEQ;
        f32x4 st[2][2];
#pragma unroll
        for (int a = 0; a < 2; ++a)
#pragma unroll
            for (int t = 0; t < 2; ++t) st[a][t] = (f32x4){0.f, 0.f, 0.f, 0.f};
        __syncthreads();
        for (int i = tid; i < 16896 / 4; i += NTHR) ((LAS unsigned*)LST)[i] = 0u;
        v4u pv, pvn; bf16x8 qf[8], pf[4], kf[8], qn[8], pn[4], kn[8];
#define RC_LD_V(cc) do { pvn = *(const v4u*)(v + (rb0 + (cc) * 128 + (tid >> 2)) * 512 + e0 + (tid & 3) * 8); } while (0)
#define RC_LD_Q(cc, k0_, k1_) do { _Pragma("unroll") for (int ks = (k0_); ks < (k1_); ++ks) qn[ks] = *(const bf16x8*)(QF + ((((size_t)(bh * 32 + (cc)) * 8 + w) * 8 + ks) * 512 + lane * 8)); } while (0)
#define RC_LD_P(cc) do { _Pragma("unroll") for (int ks = 0; ks < 4; ++ks) pn[ks] = *(const bf16x8*)(PF + ((((size_t)(bh * 32 + (cc)) * 8 + w) * 4 + ks) * 512 + lane * 8)); } while (0)
#define RC_LD_K(cc, k0_, k1_) do { _Pragma("unroll") for (int i_ = (k0_); i_ < (k1_); ++i_) kn[i_] = *(const bf16x8*)(KF + ((((size_t)(bh * 32 + (cc)) * 2 + (i_ >> 2)) * 8 + w) * 4 + (i_ & 3)) * 512 + lane * 8); } while (0)
#define RC_LD(cc) do { RC_LD_V(cc); RC_LD_Q(cc, 0, 8); RC_LD_P(cc); RC_LD_K(cc, 0, 8); } while (0)
#define RC_SB __builtin_amdgcn_sched_barrier(0)
        RC_LD(0);
        for (int ci = 0; ci < 32; ++ci) {
            const ldsp LSc = LST + (ci & 1) * 16896, LSn = LST + ((ci + 1) & 1) * 16896;
            const ldsp LV = LV0 + (ci & 1) * 9216;
            pv = pvn;
#pragma unroll
            for (int i_ = 0; i_ < 8; ++i_) { qf[i_] = qn[i_]; kf[i_] = kn[i_]; }
#pragma unroll
            for (int i_ = 0; i_ < 4; ++i_) pf[i_] = pn[i_];
            *(LAS v4u*)(LV + (tid >> 2) * RSV + (tid & 3) * 16) = pv;
            __syncthreads();
#if RC_ILV
            const bool nx = ci + 1 < 32;
            if (nx) { RC_LD_V(ci + 1); RC_LD_Q(ci + 1, 0, 4); } RC_SB;
#else
            if (ci + 1 < 32) RC_LD(ci + 1);
#endif
            bf16x8 vf[4][2];
#pragma unroll
            for (int ks = 0; ks < 4; ++ks)
#pragma unroll
                for (int t = 0; t < 2; ++t) vf[ks][t] = frag_tr(LV + (32 * ks) * RSV + (16 * t) * 2, RSV, lane);
            f32x4 cr[2], in[2];
            cr[0] = (f32x4){0.f, 0.f, 0.f, 0.f}; cr[1] = (f32x4){0.f, 0.f, 0.f, 0.f}; in[0] = (f32x4){0.f, 0.f, 0.f, 0.f}; in[1] = (f32x4){0.f, 0.f, 0.f, 0.f};
#pragma unroll
            for (int ks = 0; ks < 4; ++ks)
#pragma unroll
                for (int t = 0; t < 2; ++t) cr[t] = MFMA16(qf[ks], frag_row(LSc + (16 * t) * RSS + (ks * 32) * 2, RSS, lane), cr[t]);
#if RC_ILV
            RC_SB; if (nx) RC_LD_Q(ci + 1, 4, 8); RC_SB;
#endif
#pragma unroll
            for (int ks = 4; ks < 8; ++ks)
#pragma unroll
                for (int t = 0; t < 2; ++t) cr[t] = MFMA16(qf[ks], frag_row(LSc + (16 * t) * RSS + (ks * 32) * 2, RSS, lane), cr[t]);
#if RC_ILV
            RC_SB; if (nx) RC_LD_P(ci + 1); RC_SB;
#endif
#pragma unroll
            for (int ks = 0; ks < 4; ++ks)
#pragma unroll
                for (int t = 0; t < 2; ++t) in[t] = MFMA16(pf[ks], vf[ks][t], in[t]);
#pragma unroll
            for (int dh = 0; dh < 2; ++dh) {
#if RC_ILV
                RC_SB; if (nx) { if (dh == 0) RC_LD_K(ci + 1, 0, 4); else RC_LD_K(ci + 1, 4, 8); } RC_SB;
#endif
#pragma unroll
                for (int t = 0; t < 2; ++t) st[dh][t] = st[dh][t] * cd;
#pragma unroll
                for (int ks = 0; ks < 4; ++ks)
#pragma unroll
                    for (int t = 0; t < 2; ++t) st[dh][t] = MFMA16(kf[dh * 4 + ks], vf[ks][t], st[dh][t]);
#pragma unroll
                for (int t = 0; t < 2; ++t) { v2u pk2; pk2.x = cvtpk(st[dh][t][0], st[dh][t][1]); pk2.y = cvtpk(st[dh][t][2], st[dh][t][3]);
                    *(LAS v2u*)(LSn + (16 * t + l15) * RSS + (dh * 128 + 16 * w + 4 * g4) * 2) = pk2; }
            }
#pragma unroll
            for (int r = 0; r < 4; ++r) { const int n = 16 * w + 4 * g4 + r; const float qd = exp2f((float)(n + 1) * lg2);
#pragma unroll
                for (int t = 0; t < 2; ++t) *(LAS unsigned short*)(LOw + (4 * g4 + r) * 64 + (16 * t + l15) * 2) = (unsigned short)(cvtpk(in[t][r] + cr[t][r] * qd, 0.f) & 0xffffu); }
            *(v4u*)(o + ((size_t)b * SEQ + ci * 128 + 16 * w + (lane >> 2)) * 4096 + h * 512 + e0 + (lane & 3) * 8) = *(const LAS v4u*)(LOw + (lane >> 2) * 64 + (lane & 3) * 16);
        }
#undef RC_LD
#undef RC_LD_V
#undef RC_LD_Q
#undef RC_LD_P
#undef RC_LD_K
#undef RC_SB
    }
}

__device__ __forceinline__ void ret_gn_phase(Frame& F, const bf16* o, const bf16* g, const float* gn, bf16* y) {
    const int lane = F.lane, gw = F.vcu * NWAVES + F.wave, NGW = F.G * NWAVES;
    for (int it0 = gw; it0 < M * 8; it0 += 4 * NGW) {
        v4u ov[4], gv[4];
#pragma unroll
        for (int u = 0; u < 4; ++u) { const int it = it0 + u * NGW; const size_t off = (size_t)(it >> 3) * 4096 + (it & 7) * 512 + lane * 8;
            if (it < M * 8) { ov[u] = *(const v4u*)(o + off); gv[u] = *(const v4u*)(g + off); } else { ov[u] = (v4u){0u, 0u, 0u, 0u}; gv[u] = ov[u]; } }
#pragma unroll
        for (int u = 0; u < 4; ++u) { const int it = it0 + u * NGW, h = it & 7; const size_t off = (size_t)(it >> 3) * 4096 + h * 512 + lane * 8;
            float x[8] = {bflo(ov[u].x), bfhi(ov[u].x), bflo(ov[u].y), bfhi(ov[u].y), bflo(ov[u].z), bfhi(ov[u].z), bflo(ov[u].w), bfhi(ov[u].w)};
            float gg[8] = {bflo(gv[u].x), bfhi(gv[u].x), bflo(gv[u].y), bfhi(gv[u].y), bflo(gv[u].z), bfhi(gv[u].z), bflo(gv[u].w), bfhi(gv[u].w)};
            float s = 0.f;
#pragma unroll
            for (int e = 0; e < 8; ++e) s += x[e];
            const float mean = wave_sum(s) * (1.0f / 512.0f); float qv = 0.f;
#pragma unroll
            for (int e = 0; e < 8; ++e) { x[e] -= mean; qv += x[e] * x[e]; }
            const float rstd = 1.0f / sqrtf(wave_sum(qv) * (1.0f / 512.0f) + EPS);
            const f32x4 g0 = *(const f32x4*)(gn + h * 512 + lane * 8), g1 = *(const f32x4*)(gn + h * 512 + lane * 8 + 4);
            float r[8];
#pragma unroll
            for (int e = 0; e < 8; ++e) { const float gw_ = e < 4 ? g0[e & 3] : g1[e & 3]; r[e] = x[e] * rstd * gw_ * (gg[e] * pg8::fast_sigmoid(gg[e])); }
            v4u w; w.x = cvtpk(r[0], r[1]); w.y = cvtpk(r[2], r[3]); w.z = cvtpk(r[4], r[5]); w.w = cvtpk(r[6], r[7]);
            if (it < M * 8) *(v4u*)(y + off) = w; }
    }
}

__device__ __forceinline__ void gm_stat_phase(Frame& F, const f32x2* part, f32x2* rstat) {
    const int lane = F.lane, gw = F.vcu * NWAVES + F.wave, NGW = F.G * NWAVES;
    for (int row = gw; row < M; row += NGW) {
        float s = 0.f, ss = 0.f;
        if (lane < 48) { const f32x4 p = *(const f32x4*)(part + (size_t)row * 96 + lane * 2); s = p.x + p.z; ss = p.y + p.w; }
        s = wave_sum(s); ss = wave_sum(ss);
        const float mean = s * (1.0f / GM_HALF), var = fmaxf(ss * (1.0f / GM_HALF) - mean * mean, 0.f);
        if (lane == 0) rstat[row] = (f32x2){mean, 1.0f / sqrtf(var + EPS)};
    }
}
__device__ __forceinline__ void gm_spatial_phase(Frame& F, const bf16* u, const bf16* v, const f32x2* rstat, const float* lng, const float* lnb, const bf16* wtri, const float* bsp, bf16* y) {
    constexpr int RSW = 272, RSN = 528;
    const ldsp LW = F.lds, LN = F.lds + 34816;
    const int tid = F.tid, lane = F.lane, w = F.wave, g4 = lane >> 4, l15 = lane & 15;
    for (int wgi = F.vcu; wgi < 256; wgi += F.G) {
        const int gg = wgi & 7, jj = wgi >> 3;
        __syncthreads();
#pragma unroll
        for (int ps = 0; ps < 4; ++ps) { const int id = ps * NTHR + tid, t = id >> 4, c = id & 15;
            *(LAS v4u*)(LW + t * RSW + c * 16) = *(const v4u*)(wtri + ((size_t)gg * 128 + t) * 128 + c * 8); }
        float bs[8];
#pragma unroll
        for (int tt = 0; tt < 8; ++tt) bs[tt] = bsp[gg * 128 + 16 * tt + l15];
        v4u vr[8], ur[8];
#define GS_ROW0(i_) ((((jj) * 6 + (i_)) / 3) * 128)
#define GS_COL0(i_) (gg * 768 + (((jj) * 6 + (i_)) % 3) * 256)
#define GS_LDV(i_) do { _Pragma("unroll") for (int ps = 0; ps < 8; ++ps) { const int id_ = ps * NTHR + tid; vr[ps] = *(const v4u*)(v + (size_t)(GS_ROW0(i_) + (id_ >> 5)) * GM_HALF + GS_COL0(i_) + (id_ & 31) * 8); } } while (0)
        GS_LDV(0);
        for (int ui = 0; ui < 6; ++ui) {
            const int row0 = GS_ROW0(ui), col0 = GS_COL0(ui);
            __syncthreads();
#pragma unroll
            for (int ps = 0; ps < 8; ++ps) { const int id = ps * NTHR + tid, r = id >> 5, c8 = (id & 31) * 8;
                const v4u vv = vr[ps]; const f32x2 rs = rstat[row0 + r];
                const f32x4 ga = *(const f32x4*)(lng + col0 + c8), gb = *(const f32x4*)(lng + col0 + c8 + 4), ba = *(const f32x4*)(lnb + col0 + c8), bb = *(const f32x4*)(lnb + col0 + c8 + 4);
                v4u o;
                o.x = cvtpk((bflo(vv.x) - rs.x) * rs.y * ga[0] + ba[0], (bfhi(vv.x) - rs.x) * rs.y * ga[1] + ba[1]);
                o.y = cvtpk((bflo(vv.y) - rs.x) * rs.y * ga[2] + ba[2], (bfhi(vv.y) - rs.x) * rs.y * ga[3] + ba[3]);
                o.z = cvtpk((bflo(vv.z) - rs.x) * rs.y * gb[0] + bb[0], (bfhi(vv.z) - rs.x) * rs.y * gb[1] + bb[1]);
                o.w = cvtpk((bflo(vv.w) - rs.x) * rs.y * gb[2] + bb[2], (bfhi(vv.w) - rs.x) * rs.y * gb[3] + bb[3]);
                *(LAS v4u*)(LN + r * RSN + c8 * 2) = o; }
#pragma unroll
            for (int ps = 0; ps < 8; ++ps) { const int id_ = ps * NTHR + tid; ur[ps] = *(const v4u*)(u + (size_t)(row0 + (id_ >> 5)) * GM_HALF + col0 + (id_ & 31) * 8); }
            if (ui + 1 < 6) GS_LDV(ui + 1);
            __syncthreads();
            f32x4 acc[2][8];
#pragma unroll
            for (int ci = 0; ci < 2; ++ci)
#pragma unroll
                for (int tt = 0; tt < 8; ++tt) acc[ci][tt] = (f32x4){0.f, 0.f, 0.f, 0.f};
#pragma unroll
            for (int ks = 0; ks < 4; ++ks) {
                const bf16x8 a0 = frag_tr(LN + (32 * ks) * RSN + (32 * w) * 2, RSN, lane), a1 = frag_tr(LN + (32 * ks) * RSN + (32 * w + 16) * 2, RSN, lane);
#pragma unroll
                for (int tt = 2 * ks; tt < 8; ++tt) { const bf16x8 bfr = frag_row(LW + (16 * tt) * RSW + ks * 64, RSW, lane);
                    acc[0][tt] = MFMA16(a0, bfr, acc[0][tt]); acc[1][tt] = MFMA16(a1, bfr, acc[1][tt]); }
            }
            __syncthreads();
#pragma unroll
            for (int ci = 0; ci < 2; ++ci)
#pragma unroll
                for (int tt = 0; tt < 8; ++tt) { v2u pk; pk.x = cvtpk(acc[ci][tt][0] + bs[tt], acc[ci][tt][1] + bs[tt]); pk.y = cvtpk(acc[ci][tt][2] + bs[tt], acc[ci][tt][3] + bs[tt]);
                    *(LAS v2u*)(LN + (16 * tt + l15) * RSN + (32 * w + 16 * ci + 4 * g4) * 2) = pk; }
            __syncthreads();
#pragma unroll
            for (int ps = 0; ps < 8; ++ps) { const int id = ps * NTHR + tid, r = id >> 5, c8 = (id & 31) * 8;
                const v4u mv = *(const LAS v4u*)(LN + r * RSN + c8 * 2); const size_t off = (size_t)(row0 + r) * GM_HALF + col0 + c8; const v4u uv = ur[ps];
                v4u o; o.x = cvtpk(bflo(uv.x) * bflo(mv.x), bfhi(uv.x) * bfhi(mv.x)); o.y = cvtpk(bflo(uv.y) * bflo(mv.y), bfhi(uv.y) * bfhi(mv.y));
                o.z = cvtpk(bflo(uv.z) * bflo(mv.z), bfhi(uv.z) * bfhi(mv.z)); o.w = cvtpk(bflo(uv.w) * bflo(mv.w), bfhi(uv.w) * bfhi(mv.w));
                *(v4u*)(y + off) = o; }
        }
#undef GS_ROW0
#undef GS_COL0
#undef GS_LDV
    }
}

__device__ __forceinline__ void fox_prep_phase(Frame& F, const bf16* x, const float* rs, const float* gmix, const float* wfox, const float* bfg, float* lf) {
    const int lane = F.lane, w = F.wave, fr = lane & 15, fq = lane >> 4, kb = w * 256 + fq * 8;
    LAS float* red = (LAS float*)F.lds;
    bf16x8 wh[8], wl[8];
#pragma unroll
    for (int s = 0; s < 8; ++s) { const int k0 = kb + 32 * s; const f32x4 ga = *(const f32x4*)(gmix + k0), gb = *(const f32x4*)(gmix + k0 + 4);
        float wv[8];
#pragma unroll
        for (int j = 0; j < 8; ++j) wv[j] = wfox[(size_t)(k0 + j) * FOX_LD + FOX_N + fr] * (j < 4 ? ga[j & 3] : gb[j & 3]);
        v4u ph, pl;
#pragma unroll
        for (int p = 0; p < 4; ++p) { const unsigned hp = cvtpk(wv[2 * p], wv[2 * p + 1]); ph[p] = hp; pl[p] = cvtpk(wv[2 * p] - bflo(hp), wv[2 * p + 1] - bfhi(hp)); }
        wh[s] = __builtin_bit_cast(bf16x8, ph); wl[s] = __builtin_bit_cast(bf16x8, pl); }
    for (int blk = F.vcu; blk < M / 32; blk += F.G) {
        const bf16* xa = x + (size_t)(blk * 32 + fr) * DM + kb;
        bf16x8 a0[8], a1[8];
#pragma unroll
        for (int s = 0; s < 8; ++s) { a0[s] = *(const bf16x8*)(xa + 32 * s); a1[s] = *(const bf16x8*)(xa + (size_t)16 * DM + 32 * s); }
        f32x4 c0 = (f32x4){0.f, 0.f, 0.f, 0.f}, c1 = c0;
#pragma unroll
        for (int s = 0; s < 8; ++s) { c0 = MFMA16(a0[s], wh[s], c0); c1 = MFMA16(a1[s], wh[s], c1); c0 = MFMA16(a0[s], wl[s], c0); c1 = MFMA16(a1[s], wl[s], c1); }
#pragma unroll
        for (int r = 0; r < 4; ++r) { red[(w * 32 + 4 * fq + r) * 16 + fr] = c0[r]; red[(w * 32 + 16 + 4 * fq + r) * 16 + fr] = c1[r]; }
        __syncthreads();
        { const int row = F.tid >> 4, col = F.tid & 15, m = blk * 32 + row; float z = 0.f;
#pragma unroll
          for (int ww = 0; ww < 8; ++ww) z += red[(ww * 32 + row) * 16 + col];
          lf[(size_t)m * 16 + col] = log_sigmoid(z * pg8::row_rstd(rs, m) + bfg[col]); }
        __syncthreads();
    }
}

typedef float f32x16 __attribute__((ext_vector_type(16)));
#define MFMA32(a, b, c) __builtin_amdgcn_mfma_f32_32x32x16_bf16((a), (b), (c), 0, 0, 0)
__device__ __forceinline__ void fox_attn_phase(Frame& F, const bf16* qn, const bf16* kn, const bf16* vv, const bf16* gs, const float* lf, bf16* y) {
    constexpr int RSK = 272, RSV = 320, KSLOT = 64 * RSK, VSLOT = 64 * RSV;
    const ldsp LK = F.lds, LV = F.lds + 2 * KSLOT;
    LAS float* c2 = (LAS float*)(F.lds + 75776);
    LAS float* red = (LAS float*)(F.lds + 92160);
    const int tid = F.tid, lane = F.lane, w = F.wave, r32 = lane & 31, hi = lane >> 5;
    int bh_have = -1;
    for (int pr = F.vcu; pr < 256; pr += F.G) {
        const int bh = pr >> 3, pi = pr & 7, b = bh >> 4, h = bh & 15;
        const size_t tok0 = (size_t)b * SEQ;
        if (bh != bh_have) {
            bh_have = bh;
            float x8[8]; float run = 0.f;
#pragma unroll
            for (int e = 0; e < 8; ++e) { run += lf[(tok0 + tid * 8 + e) * 16 + h]; x8[e] = run; }
            float inc = run;
#pragma unroll
            for (int o = 1; o < 64; o <<= 1) { const float t = __shfl_up(inc, o); if (lane >= o) inc += t; }
            __syncthreads();
            if (lane == 63) red[w] = inc;
            __syncthreads();
            float pre = inc - run;
#pragma unroll
            for (int wv = 0; wv < 8; ++wv) if (wv < w) pre += red[wv];
#pragma unroll
            for (int e = 0; e < 8; ++e) c2[tid * 8 + e] = (pre + x8[e]) * LOG2E;
        }
        for (int half = 0; half < 2; ++half) {
            const int qb = half ? 15 - pi : pi, q0 = qb * 256, ntile = 4 * qb + 4, qrow = q0 + 32 * w + r32;
            bf16x8 qf[8];
#pragma unroll
            for (int ks = 0; ks < 8; ++ks) qf[ks] = *(const bf16x8*)(qn + (tok0 + qrow) * DM + h * 128 + ks * 16 + 8 * hi);
            v4u kr[2], vr[2];
#define FA_LOAD(tt) do { _Pragma("unroll") for (int pp = 0; pp < 2; ++pp) { const int id_ = tid + NTHR * pp, r_ = id_ >> 4, c_ = id_ & 15; \
                kr[pp] = *(const v4u*)(kn + (tok0 + 64 * (tt) + r_) * DM + h * 128 + c_ * 8); vr[pp] = *(const v4u*)(vv + (tok0 + 64 * (tt) + r_) * DM + h * 128 + c_ * 8); } } while (0)
#define FA_STORE(sl) do { _Pragma("unroll") for (int pp = 0; pp < 2; ++pp) { const int id_ = tid + NTHR * pp, r_ = id_ >> 4, c_ = id_ & 15; \
                *(LAS v4u*)(LK + (sl) * KSLOT + r_ * RSK + c_ * 16) = kr[pp]; *(LAS v4u*)(LV + (sl) * VSLOT + r_ * RSV + c_ * 16) = vr[pp]; } } while (0)
            FA_LOAD(0);
            __syncthreads();
            FA_STORE(0);
            if (ntile > 1) FA_LOAD(1);
            const float cq = c2[qrow];
            float mx = 0.f, ls = 0.f;
            f32x16 O[4];
#pragma unroll
            for (int dt = 0; dt < 4; ++dt)
#pragma unroll
                for (int r = 0; r < 16; ++r) O[dt][r] = 0.f;
            for (int t = 0; t < ntile; ++t) {
                __syncthreads();
                if (t + 1 < ntile) { FA_STORE((t + 1) & 1); if (t + 2 < ntile) FA_LOAD(t + 2); }
                const int key0 = 64 * t;
                if (key0 <= q0 + 32 * w + 31) {
                    const ldsp sk = LK + (t & 1) * KSLOT + r32 * RSK + 16 * hi, sv = LV + (t & 1) * VSLOT;
                    f32x16 S0, S1;
                    const float cbase = cq - mx;
#pragma unroll
                    for (int g = 0; g < 4; ++g) { const f32x4 ck0 = *(const LAS f32x4*)(c2 + key0 + 8 * g + 4 * hi), ck1 = *(const LAS f32x4*)(c2 + key0 + 32 + 8 * g + 4 * hi);
#pragma unroll
                        for (int e = 0; e < 4; ++e) { S0[4 * g + e] = cbase - ck0[e]; S1[4 * g + e] = cbase - ck1[e]; } }
#pragma unroll
                    for (int ks = 0; ks < 8; ++ks) { S0 = MFMA32(*(const LAS bf16x8*)(sk + ks * 32), qf[ks], S0); S1 = MFMA32(*(const LAS bf16x8*)(sk + 32 * RSK + ks * 32), qf[ks], S1); }
                    if (key0 + 63 > q0 + 32 * w) {
#pragma unroll
                        for (int g = 0; g < 4; ++g)
#pragma unroll
                            for (int e = 0; e < 4; ++e) { const int key = key0 + 8 * g + 4 * hi + e; if (key > qrow) S0[4 * g + e] = -INFINITY; if (key + 32 > qrow) S1[4 * g + e] = -INFINITY; } }
                    float mloc = fmaxf(S0[0], S1[0]);
#pragma unroll
                    for (int r = 1; r < 16; ++r) mloc = __builtin_fmaxf(__builtin_fmaxf(mloc, S0[r]), S1[r]);
                    mloc = fmaxf(mloc, __shfl_xor(mloc, 32));
                    if (__any(mloc > 8.0f)) { const float dl = fmaxf(mloc, 0.f), alpha = __builtin_amdgcn_exp2f(-dl); mx += dl; ls *= alpha;
#pragma unroll
                        for (int r = 0; r < 16; ++r) { S0[r] -= dl; S1[r] -= dl; }
#pragma unroll
                        for (int dt = 0; dt < 4; ++dt)
#pragma unroll
                            for (int r = 0; r < 16; ++r) O[dt][r] *= alpha; }
                    float psum = 0.f;
#pragma unroll
                    for (int r = 0; r < 16; ++r) { S0[r] = __builtin_amdgcn_exp2f(S0[r]); S1[r] = __builtin_amdgcn_exp2f(S1[r]); psum += S0[r] + S1[r]; }
                    ls += psum;
                    v4u pf[4];
#pragma unroll
                    for (int s2 = 0; s2 < 2; ++s2) { pf[s2] = (v4u){cvtpk(S0[8 * s2 + 0], S0[8 * s2 + 1]), cvtpk(S0[8 * s2 + 2], S0[8 * s2 + 3]), cvtpk(S0[8 * s2 + 4], S0[8 * s2 + 5]), cvtpk(S0[8 * s2 + 6], S0[8 * s2 + 7])};
                        pf[2 + s2] = (v4u){cvtpk(S1[8 * s2 + 0], S1[8 * s2 + 1]), cvtpk(S1[8 * s2 + 2], S1[8 * s2 + 3]), cvtpk(S1[8 * s2 + 4], S1[8 * s2 + 5]), cvtpk(S1[8 * s2 + 6], S1[8 * s2 + 7])}; }
                    const ldsp vb = sv + (4 * hi + ((lane & 15) >> 2)) * RSV + (16 * ((lane >> 4) & 1) + 4 * (lane & 3)) * 2;
#pragma unroll
                    for (int s4 = 0; s4 < 4; ++s4)
#pragma unroll
                        for (int dt = 0; dt < 4; ++dt) { const ldsp va = vb + (16 * s4) * RSV + dt * 64; const s16x4 lo = vtr(va), hv = vtr(va + 8 * RSV);
                            const bf16x8 af = (bf16x8){lo[0], lo[1], lo[2], lo[3], hv[0], hv[1], hv[2], hv[3]};
                            O[dt] = MFMA32(af, __builtin_bit_cast(bf16x8, pf[s4]), O[dt]); }
                }
            }
            ls += __shfl_xor(ls, 32);
            const float il = 1.0f / ls;
            const size_t yoff = (tok0 + qrow) * DM + h * 128 + 4 * hi;
#pragma unroll
            for (int dt = 0; dt < 4; ++dt)
#pragma unroll
                for (int g = 0; g < 4; ++g) { const v2u gv = *(const v2u*)(gs + yoff + dt * 32 + 8 * g);
                    v2u o; o.x = cvtpk(O[dt][4 * g + 0] * il * bflo(gv.x), O[dt][4 * g + 1] * il * bfhi(gv.x)); o.y = cvtpk(O[dt][4 * g + 2] * il * bflo(gv.y), O[dt][4 * g + 3] * il * bfhi(gv.y));
                    *(v2u*)(y + yoff + dt * 32 + 8 * g) = o; }
        }
    }
#undef FA_LOAD
#undef FA_STORE
}
#ifndef R_RET_CORE
#define R_RET_CORE 1
#endif
#ifndef RC_MASK
#define RC_MASK 0
#endif
#ifndef R_RET_GN
#define R_RET_GN 1
#endif
#ifndef R_GM_SP
#define R_GM_SP 1
#endif
#ifndef R_FOX_ATTN
#define R_FOX_ATTN 1
#endif
#ifndef R_FOX_PREP
#define R_FOX_PREP 1
#endif
#ifndef R_PRO
#define R_PRO 1
#endif
#ifndef F_GU_TAIL
#define F_GU_TAIL 0
#endif

#ifndef PROBE_A
#define PROBE_A -1
#endif
#ifndef PROBE_B
#define PROBE_B -1
#endif
#ifndef PROBE_MUL
#define PROBE_MUL 4
#endif
#define STAMP_AT(id) do { if (PROBE_A >= 0 && ((id) == PROBE_A || (id) == PROBE_B)) { if (F.tid == 0) { const unsigned long long t_ = __builtin_amdgcn_s_memrealtime(); \
        volatile LAS unsigned* m_ = F.MISC + ((id) == PROBE_A ? 16 : 20); m_[0] = (unsigned)t_; m_[1] = (unsigned)(t_ >> 32); const unsigned long long c_ = __builtin_amdgcn_s_memtime(); volatile LAS unsigned* n_ = F.MISC + ((id) == PROBE_A ? 26 : 28); n_[0] = (unsigned)c_; n_[1] = (unsigned)(c_ >> 32); } } } while (0)
struct Args { const void* in[21]; float* out; unsigned char* ws; int ph_lo, ph_hi, li, pad; };
#define IN(k) (lo <= (k) && (k) < hi)
#ifndef PROBE_SKEW
#define PROBE_SKEW -1
#endif
#define SKEW_PRE(k) do { if (PROBE_SKEW >= 0 && (k) == PROBE_SKEW && F.tid == 0) __hip_atomic_store((unsigned long long*)(args.ws + WS_CTL + 524288) + blockIdx.x, (unsigned long long)__builtin_amdgcn_s_memrealtime(), __ATOMIC_RELAXED, __HIP_MEMORY_SCOPE_AGENT); } while (0)
#define SKEW_POST(k) do { if (PROBE_SKEW >= 0 && (k) == PROBE_SKEW && F.tid == 0) { unsigned long long mx_ = 0ull, sm_ = 0ull, mn_ = ~0ull; for (int i_ = 0; i_ < F.G; ++i_) { const unsigned long long t_ = __hip_atomic_load((unsigned long long*)(args.ws + WS_CTL + 524288) + i_, __ATOMIC_RELAXED, __HIP_MEMORY_SCOPE_AGENT); mx_ = t_ > mx_ ? t_ : mx_; mn_ = t_ < mn_ ? t_ : mn_; sm_ += t_ - 1ull; } \
        const unsigned long long mean_ = sm_ / (unsigned long long)F.G + 1ull; F.MISC[24] = (unsigned)(PROBE_SKEW_MINMAX ? (mx_ - mn_) : (mx_ - mean_)); } } while (0)
#ifndef PROBE_SKEW_MINMAX
#define PROBE_SKEW_MINMAX 0
#endif
#define SEAM(k) do { SKEW_PRE(k); if (N_LAUNCHES == 1 && IN(k) && IN((k) + 1)) xcd_barrier(bar); STAMP_AT(k); SKEW_POST(k); } while (0)
template <int L>
__device__ __forceinline__ void layer_body(Frame& F, const Args& args, const XcdBarrier& bar, const int lo, const int hi) {
    unsigned char* ws = args.ws;
    constexpr int kind = L % 3, j = L / 3, pb = 1 + 6 * L;
    float* xo = args.out;
    bf16* XB = (bf16*)(ws + WS_H);
    bf16* A0 = (bf16*)(ws + WS_A); bf16* B0 = (bf16*)(ws + WS_B); bf16* C0 = (bf16*)(ws + WS_C);
    unsigned char* misc = ws + WS_MISC;
    float* rss = (float*)(ws + WS_RSP);
    PG8_LAS float* rtab = (PG8_LAS float*)(F.lds + RSTAB_OFF);
    if (IN(pb + 0)) {
        if (kind == 0) {
            pg8::Gemm g{XB, (const bf16*)(ws + WS_W_RET_IN + j * SZ_W_RET_IN), M, RET_N, DM}; pg8::RsOrder S; S.init(M, RET_N, F.G, (int)blockIdx.x); S.rs = rss + (size_t)(2 * L) * M * 32; S.tab = rtab; S.pend = 0.f; S.nready = 0;
            pg8::EpiRetIn E{A0, A0 + (size_t)M * 2048, A0 + (size_t)M * 4096, A0 + (size_t)M * 8192, (const float*)(ws + WS_ROPE_C), (const float*)(ws + WS_ROPE_S), rtab, 0};
            pg8::gemm_phase<pg8::EpiRetIn, pg8::RsOrder, PG8_ALIGN, PG8_SP2>(F.lds + RING_OFF, g, S, E);
        } else if (kind == 1) {
            pg8::Gemm g{XB, (const bf16*)(ws + WS_W_GM_IN), M, GM_N, DM}; pg8::RsOrder S; S.init(M, GM_N, F.G, (int)blockIdx.x); S.rs = rss + (size_t)(2 * L) * M * 32; S.tab = rtab; S.pend = 0.f; S.nready = 0;
            pg8::EpiGeluUV E{A0, A0 + (size_t)M * GM_HALF, (pg8::f32x2v*)(misc + MISC_PART), rtab, 0};
            pg8::gemm_phase<pg8::EpiGeluUV, pg8::RsOrder, PG8_ALIGN, PG8_SP2>(F.lds + RING_OFF, g, S, E);
        } else {
            pg8::Gemm g{XB, (const bf16*)(ws + WS_W_FOX_IN), M, FOX_N, DM}; pg8::RsOrder S; S.init(M, FOX_N, F.G, (int)blockIdx.x); S.rs = rss + (size_t)(2 * L) * M * 32; S.tab = rtab; S.pend = 0.f; S.nready = 0;
            for (int rep_ = 0; rep_ < R_FOX_PREP; ++rep_) fox_prep_phase(F, XB, rss + (size_t)(2 * L) * M * 32, (const float*)args.in[2] + (size_t)L * DM, (const float*)args.in[13], (const float*)args.in[14], (float*)(misc + MISC_LF));
            PG8_LAS float* qkg = (PG8_LAS float*)(F.lds + QKG_OFF);
            if (F.tid < 256) qkg[F.tid] = F.tid < 128 ? ((const float*)args.in[15])[F.tid] : ((const float*)args.in[16])[F.tid - 128];
            __syncthreads();
            pg8::EpiFoxIn E{A0, (size_t)M * 2048, rtab, 0, (PG8_LAS float*)(F.lds + QKT_OFF), qkg};
            pg8::gemm_phase<pg8::EpiFoxIn, pg8::RsOrder, PG8_ALIGN, PG8_SP2>(F.lds + RING_OFF, g, S, E);
        }
    }
    SEAM(pb + 0);
    if (IN(pb + 1)) {
        if (kind == 0) { bf16* Pb = B0 + (size_t)M * 4096;
            bf16* KFb = (bf16*)(ws + WS_KF);
            bf16* QFb = (bf16*)(ws + WS_QF);
            ret_p_phase(F, A0, A0 + (size_t)M * 2048, Pb, KFb, QFb);
            if (N_LAUNCHES == 1) xcd_barrier(bar);
            STAMP_AT(500 + L);
            for (int rep_ = 0; rep_ < R_RET_CORE; ++rep_) ret_core_phase(F, QFb, A0 + (size_t)M * 4096, Pb, KFb, B0, rep_ ? RC_MASK : 0); }
        else if (kind == 1) { gm_stat_phase(F, (const f32x2*)(misc + MISC_PART), (f32x2*)(misc + MISC_RSTAT)); }
        else { }
    }
    if (kind != 2) SEAM(pb + 1); else STAMP_AT(pb + 1);
    if (IN(pb + 2)) {
        if (kind == 0) { for (int rep_ = 0; rep_ < R_RET_GN; ++rep_) ret_gn_phase(F, B0, A0 + (size_t)M * 8192, (const float*)args.in[5] + (size_t)j * 4096, C0); }
        else if (kind == 1) { for (int rep_ = 0; rep_ < R_GM_SP; ++rep_) gm_spatial_phase(F, A0, A0 + (size_t)M * GM_HALF, (const f32x2*)(misc + MISC_RSTAT), (const float*)args.in[8], (const float*)args.in[9], (const bf16*)(misc + MISC_WTRI), (const float*)args.in[11], B0); }
        else { for (int rep_ = 0; rep_ < R_FOX_ATTN; ++rep_) fox_attn_phase(F, A0, A0 + (size_t)M * 2048, A0 + (size_t)M * 4096, A0 + (size_t)M * 6144, (const float*)(misc + MISC_LF), B0); }
    }
    SEAM(pb + 2);
    if (IN(pb + 3)) {
        const bf16* Ain = kind == 0 ? C0 : B0; constexpr int K = kind == 0 ? 4096 : (kind == 1 ? GM_HALF : DM);
        const bf16* Wt = kind == 0 ? (const bf16*)(ws + WS_W_RET_OUT + j * SZ_W_RET_OUT) : (kind == 1 ? (const bf16*)(ws + WS_W_GM_OUT) : (const bf16*)(ws + WS_W_FOX_OUT));
        pg8::Gemm g{Ain, Wt, M, DM, K}; pg8::StaticOrder S; S.init(M, DM, F.G, (int)blockIdx.x);
        if constexpr (L == 0) {
            pg8::EpiRes<true, false> E{(const float*)args.in[0], nullptr, XB, rss + (size_t)(2 * L + 1) * M * 32, DM};
            pg8::gemm_phase<pg8::EpiRes<true, false>, pg8::StaticOrder, PG8_ALIGN, PG8_SP2>(F.lds + RING_OFF, g, S, E);
        } else {
            pg8::EpiResP<false> E{nullptr, XB, rss + (size_t)(2 * L + 1) * M * 32, DM};
            pg8::gemm_phase<pg8::EpiResP<false>, pg8::StaticOrder, PG8_ALIGN, PG8_SP2>(F.lds + RING_OFF, g, S, E);
        }
    }
    SEAM(pb + 3);
    if (IN(pb + 4)) {
        constexpr int NFULL = (F_GU_TAIL ? 40 : 44) * 256;
        { pg8::Gemm g{XB, (const bf16*)(ws + WS_W_GU + L * SZ_W_GU), M, NFULL, DM}; pg8::RsOrder S; S.init(M, NFULL, F.G, (int)blockIdx.x); S.rs = rss + (size_t)(2 * L + 1) * M * 32; S.tab = rtab; S.pend = 0.f; S.nready = 0;
          pg8::EpiSwiglu<false> E{A0, FFN_H, rtab, 0};
          pg8::gemm_phase<pg8::EpiSwiglu<false>, pg8::RsOrder, PG8_ALIGN, PG8_SP2>(F.lds + RING_OFF, g, S, E); }
        if (F_GU_TAIL) { pg8::Gemm g{XB, (const bf16*)(ws + WS_W_GU + L * SZ_W_GU), M, FFN_N2, DM}; pg8::TailOrder S; S.init(M, FFN_N2, F.G, (int)blockIdx.x); S.rs = rss + (size_t)(2 * L + 1) * M * 32; S.tab = rtab; S.pend = 0.f; S.nready = 0; S.pn0 = 40;
          pg8::EpiSwiglu<true> E{A0, FFN_H, rtab, 0};
          pg8::gemm_phase<pg8::EpiSwiglu<true>, pg8::TailOrder, PG8_ALIGN, PG8_SP2, true>(F.lds + RING_OFF, g, S, E); }
    }
    SEAM(pb + 4);
    if (IN(pb + 5)) {
        pg8::Gemm g{A0, (const bf16*)(ws + WS_W_DN + L * SZ_W_DN), M, DM, FFN_H}; pg8::StaticOrder S; S.init(M, DM, F.G, (int)blockIdx.x);
        pg8::EpiResP<L + 1 == DEPTH> E{xo, XB, rss + (size_t)((2 * L + 2) & 7) * M * 32, DM};
        pg8::gemm_phase<pg8::EpiResP<L + 1 == DEPTH>, pg8::StaticOrder, PG8_ALIGN, PG8_SP2>(F.lds + RING_OFF, g, S, E);
    }
    SEAM(pb + 5);
}
__global__ void __launch_bounds__(NWAVES * 64, 2) trunk_fwd(Args args) {
    extern __shared__ __attribute__((aligned(16))) unsigned char lds[];
    Frame F;
    F.lds = (ldsp)lds;
    F.MISC = (volatile LAS unsigned*)(F.lds + MISC_OFF);
    F.tid = threadIdx.x; F.lane = F.tid & 63; F.wave = __builtin_amdgcn_readfirstlane(F.tid >> 6);
    F.G = gridDim.x; { const int bx = blockIdx.x; F.vcu = (F.G % 8 == 0) ? (bx % 8) * (F.G / 8) + bx / 8 : bx; }
    F.ctl = (gu32*)(args.ws + WS_CTL);
    for (int u = F.tid; u < (LDS_BYTES - LDSCTL_OFF) / 4; u += NWAVES * 64) ((LAS unsigned*)(F.lds + LDSCTL_OFF))[u] = 0u;
    __syncthreads();
    XcdBarrier bar; bar.bar = (unsigned*)(F.ctl + CW_BAR); bar.x = 0; bar.st = nullptr;
    if (N_LAUNCHES == 1) bar = xcd_barrier_post((unsigned*)(F.ctl + CW_BAR), F.MISC + 8);
    const int lo = args.ph_lo, hi = args.ph_hi;
    STAMP_AT(999);
    if (IN(0)) for (int rep_ = 0; rep_ < R_PRO; ++rep_) p0_prologue(F, args.in, args.ws);
    SEAM(0);
#ifdef IDLE_TEST
#define IDLE_GAP() do { const unsigned long long t0_ = __builtin_amdgcn_s_memrealtime(); while (__builtin_amdgcn_s_memrealtime() - t0_ < (unsigned long long)(IDLE_TEST) * 100ull) __builtin_amdgcn_s_sleep(32); } while (0)
#else
#define IDLE_GAP() do {} while (0)
#endif
    layer_body<0>(F, args, bar, lo, hi); IDLE_GAP(); layer_body<1>(F, args, bar, lo, hi); IDLE_GAP(); layer_body<2>(F, args, bar, lo, hi); IDLE_GAP(); layer_body<3>(F, args, bar, lo, hi);
#ifdef ABL_GEMM
    if (PROBE_A == 700) { unsigned char* ws = args.ws; xcd_barrier(bar); STAMP_AT(700);
        pg8::Gemm g{(const bf16*)(ws + WS_H), (const bf16*)(ws + WS_W_GU), M, 40 * 256, DM}; pg8::RsOrder S; S.init(M, 40 * 256, F.G, (int)blockIdx.x); S.rs = (float*)(ws + WS_RSP); S.tab = (PG8_LAS float*)(F.lds + RSTAB_OFF); S.pend = 0.f; S.nready = 0;
        pg8::EpiSwiglu<false> E{(bf16*)(ws + WS_A), FFN_H, (PG8_LAS float*)(F.lds + RSTAB_OFF), 0};
        pg8::gemm_phase<pg8::EpiSwiglu<false>, pg8::RsOrder, PG8_ALIGN, PG8_SP2, false, ABL_GEMM>(F.lds + RING_OFF, g, S, E);
        xcd_barrier(bar); STAMP_AT(701); }
#endif
    if (PROBE_SKEW >= 0 && F.tid == 0) { const unsigned long long dly = (unsigned long long)F.MISC[24] * (unsigned long long)PROBE_MUL, t0 = __builtin_amdgcn_s_memrealtime();
        if (dly < 400000ull) while (__builtin_amdgcn_s_memrealtime() - t0 < dly) __builtin_amdgcn_s_sleep(16); }
    if (PROBE_A >= 0 && F.tid == 0) {
        const unsigned long long ta = ((unsigned long long)F.MISC[17] << 32) | F.MISC[16], tb = ((unsigned long long)F.MISC[21] << 32) | F.MISC[20];
        const unsigned long long dly = (tb - ta) * (unsigned long long)PROBE_MUL, t0 = __builtin_amdgcn_s_memrealtime();
        if (tb > ta && dly < 400000ull) while (__builtin_amdgcn_s_memrealtime() - t0 < dly) __builtin_amdgcn_s_sleep(16);
#ifdef CLK_PROBE
        { const unsigned long long ca = ((unsigned long long)F.MISC[27] << 32) | F.MISC[26], cb = ((unsigned long long)F.MISC[29] << 32) | F.MISC[28];
          const unsigned long long mhz = tb > ta ? (cb - ca) * 100ull / (tb - ta) : 0ull, dl2 = mhz * 25ull, t1 = __builtin_amdgcn_s_memrealtime();
          if (dl2 < 400000ull) while (__builtin_amdgcn_s_memrealtime() - t1 < dl2) __builtin_amdgcn_s_sleep(16); }
#endif
    }
}
#undef IN
#undef SEAM

extern "C" void kernel_launch(void* const* d_in, const int* in_sizes, int n_in, void* d_out, int out_size, void* d_ws, size_t ws_size, hipStream_t stream) {
    static int grid = 0;
    if (grid == 0) {
        if (n_in != 21 || in_sizes[0] != M * DM || out_size != M * DM || ws_size < WS_END) { fprintf(stderr, "kernel_launch: unexpected shapes (n_in %d, in0 %d, out %d, ws %zu); nothing launched\n", n_in, n_in > 0 ? in_sizes[0] : -1, out_size, ws_size); grid = -1; return; }
        int dev = 0, cus = 0, per_cu = 0;
        if (hipGetDevice(&dev) != hipSuccess || hipDeviceGetAttribute(&cus, hipDeviceAttributeMultiprocessorCount, dev) != hipSuccess) { grid = -1; return; }
        if (hipFuncSetAttribute((const void*)trunk_fwd, hipFuncAttributeMaxDynamicSharedMemorySize, LDS_BYTES) != hipSuccess) { fprintf(stderr, "kernel_launch: hipFuncSetAttribute failed\n"); grid = -1; return; }
        if (hipOccupancyMaxActiveBlocksPerMultiprocessor(&per_cu, (const void*)trunk_fwd, NWAVES * 64, LDS_BYTES) != hipSuccess || per_cu < 1)
            fprintf(stderr, "kernel_launch: note: occupancy query reports %d workgroups per CU\n", per_cu);
        (void)hipGetLastError();
        grid = cus;
    }
    if (grid < 0) return;
    if (hipMemsetAsync((char*)d_ws + WS_CTL, 0, CTL_ZERO_BYTES, stream) != hipSuccess) return;
    Args a{};
    for (int i = 0; i < 21; ++i) a.in[i] = d_in[i];
    a.out = (float*)d_out; a.ws = (unsigned char*)d_ws;
    for (int li = 0; li < N_LAUNCHES; ++li) {
        a.ph_lo = (N_LAUNCHES == 1) ? 0 : li; a.ph_hi = (N_LAUNCHES == 1) ? N_PHASES : li + 1; a.li = li; a.pad = 0;
        hipLaunchKernelGGL(trunk_fwd, dim3(grid), dim3(NWAVES * 64), LDS_BYTES, stream, a);
        const hipError_t le = hipPeekAtLastError();
        if (le != hipSuccess) { fprintf(stderr, "kernel_launch: launch %d failed: %s\n", li, hipGetErrorName(le)); break; }
    }
}
```

```cpp
#define PG8_WGM 4
#define GU_CUT 32
#include <hip/hip_runtime.h>
#include <cstdio>
#include <cstdint>
#include <cmath>
namespace pg8 {
#define PG8_LAS __attribute__((address_space(3)))
typedef unsigned short bf16_t;
typedef short bf16x8 __attribute__((ext_vector_type(8)));
typedef float f32x4 __attribute__((ext_vector_type(4)));
typedef unsigned u32x4 __attribute__((ext_vector_type(4)));
constexpr int BM = 256, BK = 64, HALF = 128, HTB = HALF * BK * 2  , STAGE_BYTES = 8 * HTB, NXCD = 8, WGM = PG8_WGM;

__host__ __device__ __forceinline__ int lds_byte(int r, int c) { const int st = (r >> 4) * 2 + (c >> 5), rr = r & 15, cc = c & 31, ob = rr * 64 + cc * 2; return st * 1024 + (ob ^ (((ob >> 9) & 1) << 5)); }
__host__ __device__ __forceinline__ void stage_rc(int b, int& R, int& C) { const int st = b / 1024, sb = b % 1024, swz = sb ^ (((sb >> 9) & 1) << 5); R = (st >> 1) * 16 + swz / 64; C = (st & 1) * 32 + (swz % 64) / 2; }
__host__ __device__ __forceinline__ int perm32(int rho) { const int n = rho >> 4, i = rho & 15; return 8 * (i >> 2) + 4 * n + (i & 3); }

struct Unit { int pm, pn, hf; };
struct Gemm { const bf16_t* A; const bf16_t* Bt; int M, N, K; };

struct StaticOrder {
    int nM, nN, nwg, G, c;
    __host__ __device__ void init(int M, int N, int G_, int c_) { nM = M / BM; nN = N / BM; nwg = nM * nN; G = G_; c = c_; }
    __host__ __device__ bool next(int i, Unit& u) const {
        const long L = (long)i * G + c; if (L >= nwg) return false;
        int wgid = (int)L; { const int q = nwg / NXCD, r = nwg % NXCD, xcd = wgid % NXCD, off = wgid / NXCD; wgid = (xcd < r ? xcd * (q + 1) : r * (q + 1) + (xcd - r) * q) + off; }
        const int nig = WGM * nN, gid = wgid / nig, fm = gid * WGM, gsz = (nM - fm) < WGM ? (nM - fm) : WGM;
        u.pm = fm + ((wgid % nig) % gsz); u.pn = (wgid % nig) / gsz; u.hf = 0; return true;
    }
    __device__ __forceinline__ void a_ready(const Unit&) const {}
    __device__ __forceinline__ void done(const Unit&) const {}
};

__device__ __forceinline__ unsigned cvt_pk_bf16(float lo, float hi) { unsigned r; asm volatile("v_cvt_pk_bf16_f32 %0, %1, %2" : "=v"(r) : "v"(lo), "v"(hi)); return r; }
typedef float f32x2 __attribute__((ext_vector_type(2)));
__device__ __forceinline__ f32x2 gelu_pk(f32x2 v) {
    const f32x2 av = __builtin_elementwise_abs(v), d = av * 0.2316418882f + 1.0f;
    f32x2 t; t.x = __builtin_amdgcn_rcpf(d.x); t.y = __builtin_amdgcn_rcpf(d.y);
    f32x2 q = t * 0.5307027145f + (-0.7265760135f); q = q * t + 0.7107068705f; q = q * t + (-0.142248368f); q = q * t + 0.127414796f; q = q * t;
    const f32x2 s = (v * v) * (-0.72134752044f);
    f32x2 e; e.x = __builtin_amdgcn_exp2f(s.x); e.y = __builtin_amdgcn_exp2f(s.y);
    const f32x2 m = v * (q * e), r = v - m;
    f32x2 o; o.x = v.x < 0.f ? m.x : r.x; o.y = v.y < 0.f ? m.y : r.y; return o;
}

typedef float f32x2v __attribute__((ext_vector_type(2)));
typedef __bf16 bf16x2v __attribute__((ext_vector_type(2)));
__device__ __forceinline__ unsigned cvtpk(float lo, float hi) { f32x2v v = {lo, hi}; bf16x2v b = __builtin_convertvector(v, bf16x2v); return __builtin_bit_cast(unsigned, b); }
__device__ __forceinline__ u32x4 pack8(const f32x4 a, const f32x4 b) { u32x4 w; w.x = cvtpk(a[0], a[1]); w.y = cvtpk(a[2], a[3]); w.z = cvtpk(b[0], b[1]); w.w = cvtpk(b[2], b[3]); return w; }
#ifndef EPI_WT
#define EPI_WT 0
#endif
__device__ __forceinline__ void st16(void* p, const u32x4 v) {
#if EPI_WT
    asm volatile("global_store_dwordx4 %0, %1, off sc1\n\ts_nop 2" :: "v"(p), "v"(v) : "memory");
#else
    *(u32x4*)p = v;
#endif
}
__device__ __forceinline__ float fast_sigmoid(float x) { return __builtin_amdgcn_rcpf(1.0f + __builtin_amdgcn_exp2f(-1.44269504f * x)); }

template <bool BASE_F32, bool OUT_F32> struct EpiRes {
    static constexpr bool PERM = true, AFTER_DRAIN = false, RESID = false;
    const float* base; float* out; bf16_t* xb; float* rs; int ldc;
    __device__ __forceinline__ void operator()(const f32x4 (&acc)[2][2][4][2], const Unit& u, int wr, int wc, int fr, int fq) const {
        const int row0 = u.pm * BM + wr * 64 + fr, col0 = u.pn * BM + wc * 32 + 8 * fq;
#pragma unroll
        for (int ai = 0; ai < 2; ++ai)
#pragma unroll
            for (int m = 0; m < 4; ++m) { const int row = row0 + ai * HALF + m * 16; const size_t off = (size_t)row * ldc + col0; float ss = 0.f;
#pragma unroll
                for (int bj = 0; bj < 2; ++bj) { f32x4 b0, b1;
                    if (BASE_F32) { b0 = *(const f32x4*)(base + off + bj * HALF); b1 = *(const f32x4*)(base + off + bj * HALF + 4); }
                    else { const u32x4 w = *(const u32x4*)(xb + off + bj * HALF);
                        b0 = (f32x4){__uint_as_float(w.x << 16), __uint_as_float(w.x & 0xffff0000u), __uint_as_float(w.y << 16), __uint_as_float(w.y & 0xffff0000u)};
                        b1 = (f32x4){__uint_as_float(w.z << 16), __uint_as_float(w.z & 0xffff0000u), __uint_as_float(w.w << 16), __uint_as_float(w.w & 0xffff0000u)}; }
                    const f32x4 x0 = b0 + acc[ai][bj][m][0], x1 = b1 + acc[ai][bj][m][1];
                    if (OUT_F32) { *(f32x4*)(out + off + bj * HALF) = x0; *(f32x4*)(out + off + bj * HALF + 4) = x1; }
                    else st16(xb + off + bj * HALF, pack8(x0, x1));
                    ss += (x0[0] * x0[0] + x0[1] * x0[1]) + (x0[2] * x0[2] + x0[3] * x0[3]) + (x1[0] * x1[0] + x1[1] * x1[1]) + (x1[2] * x1[2] + x1[3] * x1[3]); }
                if (!OUT_F32) { ss += __shfl_xor(ss, 16); ss += __shfl_xor(ss, 32);
                    if (fq == 0) rs[(size_t)row * 32 + u.pn * 4 + wc] = ss; }
                }
    }
};
template <bool OUT_F32> struct EpiResP {
    static constexpr bool PERM = true, AFTER_DRAIN = true, RESID = true;
    float* out; bf16_t* xb; float* rs; int ldc;
    __device__ __forceinline__ void fused(f32x4 (&acc)[2][2][4][2], const Unit& u, int wr, int wc, int fr, int fq, PG8_LAS unsigned char* lds, int wid, int lane) const {
        const int row0 = u.pm * BM + wr * 64 + fr, col0 = u.pn * BM + wc * 32 + 8 * fq, wh = wc >> 1;
        u32x4 g7[4];
        if (wh) {
#pragma unroll
            for (int m = 0; m < 4; ++m) g7[m] = *(const u32x4*)(xb + (size_t)(row0 + HALF + m * 16) * ldc + col0 + HALF); }
#pragma unroll
        for (int ai = 0; ai < 2; ++ai)
#pragma unroll
            for (int m = 0; m < 4; ++m) { const int row = row0 + ai * HALF + m * 16; const size_t off = (size_t)row * ldc + col0; float ss = 0.f;
                const int lb = lds_byte(wr * 64 + m * 16 + fr, (wc & 1) * 32 + 8 * fq);
#pragma unroll
                for (int bj = 0; bj < 2; ++bj) {
                    const int s0 = (ai == 0 && bj == 0) ? 4 : (ai == 1 && bj == 0) ? 5 : (ai == 0 && bj == 1) ? 6 : 7;
                    const int s1 = (ai == 0 && bj == 0) ? 0 : (ai == 1 && bj == 0) ? 1 : 2;
                    u32x4 w;
                    if (ai == 1 && bj == 1) { if (wh) w = g7[m]; else w = *(const PG8_LAS u32x4*)(lds + s0 * HTB + lb); }
                    else w = *(const PG8_LAS u32x4*)(lds + (wh ? s1 : s0) * HTB + lb);
                    const f32x4 b0 = {__uint_as_float(w.x << 16), __uint_as_float(w.x & 0xffff0000u), __uint_as_float(w.y << 16), __uint_as_float(w.y & 0xffff0000u)};
                    const f32x4 b1 = {__uint_as_float(w.z << 16), __uint_as_float(w.z & 0xffff0000u), __uint_as_float(w.w << 16), __uint_as_float(w.w & 0xffff0000u)};
                    const f32x4 x0 = b0 + acc[ai][bj][m][0], x1 = b1 + acc[ai][bj][m][1];
                    if (OUT_F32) { *(f32x4*)(out + off + bj * HALF) = x0; *(f32x4*)(out + off + bj * HALF + 4) = x1; }
                    else st16(xb + off + bj * HALF, pack8(x0, x1));
                    ss += (x0[0] * x0[0] + x0[1] * x0[1]) + (x0[2] * x0[2] + x0[3] * x0[3]) + (x1[0] * x1[0] + x1[1] * x1[1]) + (x1[2] * x1[2] + x1[3] * x1[3]); }
                if (!OUT_F32) { ss += __shfl_xor(ss, 16); ss += __shfl_xor(ss, 32);
                    if (fq == 0) rs[(size_t)row * 32 + u.pn * 4 + wc] = ss; } }
    }
};
__device__ __forceinline__ float row_sumsq(const float* rs, int row) {
    const f32x4* p = (const f32x4*)(rs + (size_t)row * 32); f32x4 t = p[0];
#pragma unroll
    for (int i = 1; i < 8; ++i) t += p[i];
    return (t[0] + t[1]) + (t[2] + t[3]);
}
__device__ __forceinline__ float row_rstd(const float* rs, int row) { return 1.0f / sqrtf(row_sumsq(rs, row) * (1.0f / 2048.0f) + 1e-6f); }
struct RsOrder : StaticOrder {
    const float* rs; PG8_LAS float* tab; mutable float pend; mutable int nready;
    __device__ __forceinline__ void a_ready(const Unit& u) const {
        if (threadIdx.x < 256) pend = row_sumsq(rs, u.pm * BM + u.hf * HALF + threadIdx.x);
        ++nready;
    }
    __device__ __forceinline__ bool next(int i, Unit& u) const {
        if (i == 1 && threadIdx.x < 256) tab[threadIdx.x] = 1.0f / sqrtf(pend * (1.0f / 2048.0f) + 1e-6f);
        return StaticOrder::next(i, u);
    }
    __device__ __forceinline__ void done(const Unit&) const {
        if (threadIdx.x < 256) tab[((nready - 1) & 1) * 256 + threadIdx.x] = 1.0f / sqrtf(pend * (1.0f / 2048.0f) + 1e-6f);
    }
};
struct TailOrder : RsOrder {
    int pn0;
    __device__ __forceinline__ bool next(int i, Unit& u) const {
        if (i == 1 && threadIdx.x < 256) tab[threadIdx.x] = 1.0f / sqrtf(pend * (1.0f / 2048.0f) + 1e-6f);
        if (i != 0 || G != 256) return false;
        const int x = c & 7, l = c >> 3; u.pm = 4 * x + (l & 3); u.hf = (l >> 2) & 1; u.pn = pn0 + (l >> 3); return true;
    }
};
template <bool HALF_M> struct EpiSwiglu {
    static constexpr bool PERM = true, AFTER_DRAIN = false, RESID = false;
    bf16_t* O; int ldc; const PG8_LAS float* tab; mutable int ui;
    __device__ __forceinline__ void operator()(const f32x4 (&acc)[2][2][4][2], const Unit& u, int wr, int wc, int fr, int fq) const {
        const int row0 = u.pm * BM + (HALF_M ? u.hf * HALF : 0) + wr * 64 + fr, col0 = u.pn * HALF + wc * 32 + 8 * fq;
#pragma unroll
        for (int ai = 0; ai < (HALF_M ? 1 : 2); ++ai)
#pragma unroll
            for (int m = 0; m < 4; ++m) { bf16_t* rowp = O + (size_t)(row0 + ai * HALF + m * 16) * ldc + col0; const float r = tab[(ui & 1) * 256 + wr * 64 + fr + ai * HALF + m * 16];
                f32x4 v0, v1;
#pragma unroll
                for (int j = 0; j < 4; ++j) { const float g0 = acc[ai][0][m][0][j] * r, g1 = acc[ai][0][m][1][j] * r;
                    v0[j] = g0 * fast_sigmoid(g0) * (acc[ai][1][m][0][j] * r); v1[j] = g1 * fast_sigmoid(g1) * (acc[ai][1][m][1][j] * r); }
                st16(rowp, pack8(v0, v1)); }
        ++ui;
    }
};

struct EpiSwigluProbe {
    static constexpr bool PERM = true, AFTER_DRAIN = false, RESID = false;
    bf16_t* O; int never;
    __device__ __forceinline__ void operator()(const f32x4 (&acc)[2][2][4][2], const Unit& u, int wr, int wc, int fr, int fq) const {
        if (never) {
#pragma unroll
        for (int ai = 0; ai < 2; ++ai)
#pragma unroll
            for (int m = 0; m < 4; ++m) { bf16_t* rowp = O + (size_t)(u.pm * BM + wr * 64 + fr + ai * HALF + m * 16) * 5632 + u.pn * HALF + wc * 32 + 8 * fq;
                st16(rowp, pack8(acc[ai][0][m][0] + acc[ai][1][m][0], acc[ai][0][m][1] + acc[ai][1][m][1])); } }
    }
};
struct EpiRetIn {
    static constexpr bool PERM = true, AFTER_DRAIN = false, RESID = false;
    bf16_t *q, *k, *v, *g; const float *cs, *sn; const PG8_LAS float* tab; mutable int ui;
    __device__ __forceinline__ void operator()(const f32x4 (&acc)[2][2][4][2], const Unit& u, int wr, int wc, int fr, int fq) const {
        const int pn = u.pn, ci = wc * 32 + 8 * fq;
#pragma unroll
        for (int ai = 0; ai < 2; ++ai)
#pragma unroll
            for (int m = 0; m < 4; ++m) {
                const int row = u.pm * BM + ai * HALF + wr * 64 + m * 16 + fr, b = row >> 12, s = row & 4095; const float rr = tab[(ui & 1) * 256 + ai * HALF + wr * 64 + m * 16 + fr];
                if (pn < 16) {
                    const int h = pn & 7; const float sc = (pn < 8 ? 1.0f : 0.0625f) * rr;
                    bf16_t* dst = (pn < 8 ? q : k) + ((size_t)((b * 8 + h) * 4096 + s)) * 256 + ci;
                    f32x4 o1[2], o2[2];
#pragma unroll
                    for (int n = 0; n < 2; ++n) { const f32x4 c4 = *(const f32x4*)(cs + (size_t)row * 128 + ci + 4 * n), s4 = *(const f32x4*)(sn + (size_t)row * 128 + ci + 4 * n);
                        const f32x4 x1 = acc[ai][0][m][n], x2 = acc[ai][1][m][n];
                        o1[n] = (x1 * c4 - x2 * s4) * sc; o2[n] = (x2 * c4 + x1 * s4) * sc; }
                    st16(dst, pack8(o1[0], o1[1])); st16(dst + 128, pack8(o2[0], o2[1]));
                } else if (pn < 32) {
                    const int t = pn - 16, h = t >> 1, hf = t & 1;
                    bf16_t* dst = v + ((size_t)((b * 8 + h) * 4096 + s)) * 512 + hf * 256 + ci;
                    st16(dst, pack8(acc[ai][0][m][0] * rr, acc[ai][0][m][1] * rr)); st16(dst + 128, pack8(acc[ai][1][m][0] * rr, acc[ai][1][m][1] * rr));
                } else {
                    bf16_t* dst = g + (size_t)row * 4096 + (pn - 32) * 256 + ci;
                    st16(dst, pack8(acc[ai][0][m][0] * rr, acc[ai][0][m][1] * rr)); st16(dst + 128, pack8(acc[ai][1][m][0] * rr, acc[ai][1][m][1] * rr));
                }
            }
        ++ui;
    }
};
struct EpiGeluUV {
    static constexpr bool PERM = true, AFTER_DRAIN = false, RESID = false;
    bf16_t *uo, *vo; f32x2v* part; const PG8_LAS float* tab; mutable int ui;
    __device__ __forceinline__ void operator()(const f32x4 (&acc)[2][2][4][2], const Unit& u, int wr, int wc, int fr, int fq) const {
        const bool isv = u.pn >= 24; const int ct = isv ? u.pn - 24 : u.pn; bf16_t* dstb = isv ? vo : uo;
#pragma unroll
        for (int ai = 0; ai < 2; ++ai)
#pragma unroll
            for (int m = 0; m < 4; ++m) {
                const int row = u.pm * BM + ai * HALF + wr * 64 + m * 16 + fr;
                bf16_t* dst = dstb + (size_t)row * 6144 + ct * 256 + wc * 32 + 8 * fq;
                float s = 0.f, ss = 0.f; const float rr = tab[(ui & 1) * 256 + ai * HALF + wr * 64 + m * 16 + fr];
#pragma unroll
                for (int bj = 0; bj < 2; ++bj) { const f32x4 v0 = acc[ai][bj][m][0] * rr, v1 = acc[ai][bj][m][1] * rr;
                    const f32x2 a = gelu_pk((f32x2){v0[0], v0[1]}), b = gelu_pk((f32x2){v0[2], v0[3]}), c = gelu_pk((f32x2){v1[0], v1[1]}), d = gelu_pk((f32x2){v1[2], v1[3]});
                    const f32x4 z0 = {a.x, a.y, b.x, b.y}, z1 = {c.x, c.y, d.x, d.y};
                    st16(dst + bj * HALF, pack8(z0, z1));
                    s += (z0[0] + z0[1]) + (z0[2] + z0[3]) + (z1[0] + z1[1]) + (z1[2] + z1[3]);
                    ss += (z0[0] * z0[0] + z0[1] * z0[1]) + (z0[2] * z0[2] + z0[3] * z0[3]) + (z1[0] * z1[0] + z1[1] * z1[1]) + (z1[2] * z1[2] + z1[3] * z1[3]); }
                if (isv) { s += __shfl_xor(s, 16); s += __shfl_xor(s, 32); ss += __shfl_xor(ss, 16); ss += __shfl_xor(ss, 32);
                    if (fq == 0) part[((size_t)row * 24 + ct) * 4 + wc] = (f32x2v){s, ss}; }
            }
        ++ui;
    }
};
struct EpiFoxIn {
    static constexpr bool PERM = true, AFTER_DRAIN = false, RESID = false;
    bf16_t* O; size_t stride; const PG8_LAS float* tab; mutable int ui; PG8_LAS float* qkt; const PG8_LAS float* gains;
    __device__ __forceinline__ void operator()(const f32x4 (&acc)[2][2][4][2], const Unit& u, int wr, int wc, int fr, int fq) const {
        const int t = u.pn >> 3; bf16_t* base = O + (size_t)t * stride + (u.pn & 7) * 256 + wc * 32 + 8 * fq;
        if (t < 2) {
#pragma unroll
            for (int ai = 0; ai < 2; ++ai)
#pragma unroll
                for (int m = 0; m < 4; ++m) { const int rt = ai * HALF + wr * 64 + m * 16 + fr; const float rr = tab[(ui & 1) * 256 + rt];
#pragma unroll
                    for (int bj = 0; bj < 2; ++bj) { const f32x4 v0 = acc[ai][bj][m][0] * rr, v1 = acc[ai][bj][m][1] * rr;
                        float ss = (v0[0] * v0[0] + v0[1] * v0[1]) + (v0[2] * v0[2] + v0[3] * v0[3]) + (v1[0] * v1[0] + v1[1] * v1[1]) + (v1[2] * v1[2] + v1[3] * v1[3]);
                        ss += __shfl_xor(ss, 16); ss += __shfl_xor(ss, 32);
                        if (fq == 0) qkt[(rt * 2 + bj) * 4 + wc] = ss; } }
            asm volatile("s_waitcnt lgkmcnt(0)" ::: "memory"); __builtin_amdgcn_s_barrier(); asm volatile("" ::: "memory");
            const float sc = t == 0 ? 0.08838834764831845f * 1.4426950408889634f : 1.0f;
            const f32x4 g0 = *(const PG8_LAS f32x4*)(gains + t * 128 + wc * 32 + 8 * fq), g1 = *(const PG8_LAS f32x4*)(gains + t * 128 + wc * 32 + 8 * fq + 4);
#pragma unroll
            for (int ai = 0; ai < 2; ++ai)
#pragma unroll
                for (int m = 0; m < 4; ++m) { const int rt = ai * HALF + wr * 64 + m * 16 + fr; const float rr = tab[(ui & 1) * 256 + rt]; bf16_t* dst = base + (size_t)(u.pm * BM + rt) * 2048;
#pragma unroll
                    for (int bj = 0; bj < 2; ++bj) { const f32x4 p = *(const PG8_LAS f32x4*)(qkt + (rt * 2 + bj) * 4);
                        const float rs = rr * sc / sqrtf(((p[0] + p[1]) + (p[2] + p[3])) * (1.0f / 128.0f) + 1e-6f);
                        st16(dst + bj * HALF, pack8(acc[ai][bj][m][0] * rs * g0, acc[ai][bj][m][1] * rs * g1)); } }
        } else {
#pragma unroll
            for (int ai = 0; ai < 2; ++ai)
#pragma unroll
                for (int m = 0; m < 4; ++m) { const int row = u.pm * BM + ai * HALF + wr * 64 + m * 16 + fr; bf16_t* dst = base + (size_t)row * 2048; const float rr = tab[(ui & 1) * 256 + ai * HALF + wr * 64 + m * 16 + fr];
#pragma unroll
                    for (int bj = 0; bj < 2; ++bj) { f32x4 v0 = acc[ai][bj][m][0] * rr, v1 = acc[ai][bj][m][1] * rr;
                        if (t == 3) {
#pragma unroll
                            for (int j = 0; j < 4; ++j) { v0[j] = fast_sigmoid(v0[j]); v1[j] = fast_sigmoid(v1[j]); } }
                        st16(dst + bj * HALF, pack8(v0, v1)); } }
        }
        ++ui;
    }
};

template <class Epi, class Sched, bool ALIGN_EPI = false, bool SP2 = false, bool HALF_M = false, int ABL = 0>
__device__ __forceinline__ void gemm_phase(PG8_LAS unsigned char* lds, const Gemm g, const Sched& S, const Epi& E) {
    const int tid = threadIdx.x, wid = __builtin_amdgcn_readfirstlane(tid >> 6), lane = tid & 63, wr = wid >> 2, wc = wid & 3, fr = lane & 15, fq = lane >> 4;
    static_assert(!HALF_M || SP2, "HALF_M is written for the SP2 loop");
    const int K = g.K, nt = K / BK;
    unsigned voffA[2], voffB[2];
#pragma unroll
    for (int i = 0; i < 2; ++i) { int R, C; stage_rc(tid * 16 + i * 8192, R, C); const int Rb = Epi::PERM ? ((R & ~31) + perm32(R & 31)) : R;
        voffA[i] = (unsigned)(R * K + C) * 2u; voffB[i] = (unsigned)(Rb * K + C) * 2u; }
    unsigned voffR[2] = {0u, 0u};
    if constexpr (Epi::RESID) {
#pragma unroll
        for (int i = 0; i < 2; ++i) { int R, C; stage_rc(tid * 16 + i * 8192, R, C); voffR[i] = (unsigned)(R * E.ldc + C) * 2u; } }
    const size_t kstep = (size_t)(BK * 2);
    const size_t hstep = (size_t)HALF * K * 2;
    const size_t tstep = 2 * hstep;
    const unsigned ldsw = (unsigned)wid * 1024u;
    const int aoff = lds_byte(wr * 64 + fr, fq * 8), boff = lds_byte(wc * 32 + fr, fq * 8);
#define PG8_SA(b, h) (((b) * 2 + (h)) * HTB)
#define PG8_SB(b, h) ((4 + (b) * 2 + (h)) * HTB)
#define PG8_STAGE(bufoff, gbase, voff) do { if constexpr (!(ABL & 2)) _Pragma("unroll") for (int _i = 0; _i < 2; ++_i) \
        __builtin_amdgcn_global_load_lds((const unsigned*)((const char*)(gbase) + (voff)[_i]), (PG8_LAS unsigned*)(lds + (bufoff) + ldsw + _i * 8192), 16, 0, 0); } while (0)
#define PG8_LDA(dst, b, h) do { if constexpr (!(ABL & 4)) { _Pragma("unroll") for (int m = 0; m < 4; ++m) _Pragma("unroll") for (int k = 0; k < 2; ++k) { dst[m][k] = *(const PG8_LAS bf16x8*)(lds + PG8_SA(b, h) + aoff + m * 2048 + k * 1024); if constexpr (ABL & 1) asm volatile("" :: "v"(dst[m][k])); } } } while (0)
#define PG8_LDB(dst, b, h) do { if constexpr (!(ABL & 4)) { _Pragma("unroll") for (int n = 0; n < 2; ++n) _Pragma("unroll") for (int k = 0; k < 2; ++k) { dst[n][k] = *(const PG8_LAS bf16x8*)(lds + PG8_SB(b, h) + boff + n * 2048 + k * 1024); if constexpr (ABL & 1) asm volatile("" :: "v"(dst[n][k])); } } } while (0)
#define PG8_MMA(ai, bj, At, Bt) do { if constexpr (!(ABL & 1)) { __builtin_amdgcn_s_setprio(1); _Pragma("unroll") for (int m = 0; m < 4; ++m) _Pragma("unroll") for (int n = 0; n < 2; ++n) _Pragma("unroll") for (int k = 0; k < 2; ++k) \
        acc[ai][bj][m][n] = __builtin_amdgcn_mfma_f32_16x16x32_bf16(Bt[n][k], At[m][k], acc[ai][bj][m][n], 0, 0, 0); __builtin_amdgcn_s_setprio(0); } } while (0)
#define PG8_WAIT_V(n) asm volatile("s_waitcnt vmcnt(" #n ")" ::: "memory")
#define PG8_WAIT_L(n) asm volatile("s_waitcnt lgkmcnt(" #n ")" ::: "memory")
#define PG8_BAR __builtin_amdgcn_s_barrier()
#define PG8_SCHED __builtin_amdgcn_sched_barrier(0)
    Unit cur, nxt; int ui = 0;
    if (!S.next(0, cur)) return;
    f32x4 acc[2][2][4][2];
#pragma unroll
    for (int a = 0; a < 2; ++a)
#pragma unroll
        for (int b = 0; b < 2; ++b)
#pragma unroll
            for (int m = 0; m < 4; ++m)
#pragma unroll
                for (int n = 0; n < 2; ++n) acc[a][b][m][n] = (f32x4){0.f, 0.f, 0.f, 0.f};
    bf16x8 At[4][2], B0[2][2], B1[2][2];
    if constexpr (ABL & 4) { _Pragma("unroll") for (int m = 0; m < 4; ++m) _Pragma("unroll") for (int k = 0; k < 2; ++k) At[m][k] = (bf16x8){(short)lane, 1, 2, 3, 4, 5, 6, 7};
        _Pragma("unroll") for (int n = 0; n < 2; ++n) _Pragma("unroll") for (int k = 0; k < 2; ++k) { B0[n][k] = (bf16x8){(short)lane, 1, 2, 3, 4, 5, 6, 7}; B1[n][k] = B0[n][k]; } }
    const char* cA = (const char*)g.A + (size_t)cur.pm * tstep + (HALF_M ? (size_t)cur.hf * hstep : (size_t)0); const char* cB = (const char*)g.Bt + (size_t)cur.pn * tstep;
    S.a_ready(cur);
    if constexpr (SP2) {
        PG8_STAGE(PG8_SB(0, 0), cB, voffB); PG8_STAGE(PG8_SB(0, 1), cB + hstep, voffB); PG8_STAGE(PG8_SA(0, 0), cA, voffA); PG8_STAGE(PG8_SA(0, 1), cA + hstep, voffA);
        if (wr == 1) PG8_BAR;
        PG8_WAIT_V(2); PG8_BAR;
        PG8_STAGE(PG8_SB(1, 0), cB + kstep, voffB); PG8_STAGE(PG8_SA(1, 0), cA + kstep, voffA); PG8_STAGE(PG8_SB(1, 1), cB + hstep + kstep, voffB);
        PG8_WAIT_V(6); PG8_BAR;
    } else {
        PG8_STAGE(PG8_SB(0, 0), cB, voffB); PG8_STAGE(PG8_SA(0, 0), cA, voffA); PG8_STAGE(PG8_SB(0, 1), cB + hstep, voffB); PG8_STAGE(PG8_SA(0, 1), cA + hstep, voffA);
        if (wr == 1) PG8_BAR;
        PG8_WAIT_V(4); PG8_BAR;
        PG8_STAGE(PG8_SB(1, 0), cB + kstep, voffB); PG8_STAGE(PG8_SA(1, 0), cA + kstep, voffA); PG8_STAGE(PG8_SB(1, 1), cB + hstep + kstep, voffB);
        PG8_WAIT_V(6); PG8_BAR;
    }
    for (;;) {
        const bool has_next = S.next(ui + 1, nxt);
        const char* nA = has_next ? (const char*)g.A + (size_t)nxt.pm * tstep + (HALF_M ? (size_t)nxt.hf * hstep : (size_t)0) : cA; const char* nB = has_next ? (const char*)g.Bt + (size_t)nxt.pn * tstep : cB;
        for (int t = 0; t < nt; t += 2) {
            const bool last = (t == nt - 2);
            const char* a1 = cA + (size_t)(t + 1) * kstep;
            const char* a2 = last ? nA : cA + (size_t)(t + 2) * kstep; const char* b2 = last ? nB : cB + (size_t)(t + 2) * kstep;
            const char* a3 = a2 + kstep; const char* b3 = b2 + kstep;
            if (last && has_next) S.a_ready(nxt);
            bool rp = false; const char* rbase = nullptr; size_t rhstep = 0;
            if constexpr (Epi::RESID) { rp = last && !has_next; rbase = (const char*)E.xb + ((size_t)cur.pm * BM * E.ldc + (size_t)cur.pn * BM) * 2; rhstep = (size_t)HALF * E.ldc * 2; }
#define PG8_STAGE_R(bufoff, gbase, voff, blk) do { if constexpr (Epi::RESID) { const char* g_ = rp ? (rbase + ((blk) & 1) * rhstep + ((blk) >> 1) * 128) : (const char*)(gbase); \
                _Pragma("unroll") for (int _i = 0; _i < 2; ++_i) __builtin_amdgcn_global_load_lds((const unsigned*)(g_ + (rp ? voffR[_i] : (voff)[_i])), (PG8_LAS unsigned*)(lds + (bufoff) + ldsw + _i * 8192), 16, 0, 0); } \
            else { PG8_STAGE(bufoff, gbase, voff); } } while (0)
            if constexpr (SP2) {
            PG8_LDB(B0, 0, 0); PG8_LDB(B1, 0, 1); PG8_SCHED; PG8_LDA(At, 0, 0); PG8_STAGE(PG8_SA(1, 1), a1 + hstep, voffA);
            PG8_WAIT_V(8); PG8_WAIT_L(0); PG8_BAR; PG8_MMA(0, 0, At, B0); PG8_MMA(0, 1, At, B1); PG8_BAR; if constexpr (ABL & 8) __builtin_amdgcn_s_sleep(2); PG8_SCHED;
            if constexpr (!HALF_M) { PG8_LDA(At, 0, 1); } PG8_STAGE_R(PG8_SB(0, 0), b2, voffB, 0); PG8_STAGE_R(PG8_SB(0, 1), b2 + hstep, voffB, 1); PG8_STAGE_R(PG8_SA(0, 0), a2, voffA, 2);
            PG8_WAIT_V(8); PG8_WAIT_L(0); PG8_BAR; if constexpr (!HALF_M) { PG8_MMA(1, 0, At, B0); PG8_MMA(1, 1, At, B1); } PG8_BAR; if constexpr (ABL & 8) __builtin_amdgcn_s_sleep(2); PG8_SCHED;
            PG8_LDB(B0, 1, 0); PG8_LDB(B1, 1, 1); PG8_SCHED; PG8_LDA(At, 1, 0); PG8_STAGE_R(PG8_SA(0, 1), a2 + hstep, voffA, 3);
            PG8_WAIT_V(8); PG8_WAIT_L(0); PG8_BAR; PG8_MMA(0, 0, At, B0); PG8_MMA(0, 1, At, B1); PG8_BAR; if constexpr (ABL & 8) __builtin_amdgcn_s_sleep(2); PG8_SCHED;
            if constexpr (!HALF_M) { PG8_LDA(At, 1, 1); } PG8_STAGE_R(PG8_SB(1, 0), b3, voffB, 4); PG8_STAGE_R(PG8_SB(1, 1), b3 + hstep, voffB, 5); PG8_STAGE_R(PG8_SA(1, 0), a3, voffA, 6);
            PG8_WAIT_V(8); PG8_WAIT_L(0); PG8_BAR; if constexpr (!HALF_M) { PG8_MMA(1, 0, At, B0); PG8_MMA(1, 1, At, B1); } PG8_BAR; if constexpr (ABL & 8) __builtin_amdgcn_s_sleep(2); PG8_SCHED;
            } else {
            PG8_LDB(B0, 0, 0); PG8_SCHED; PG8_LDA(At, 0, 0); PG8_STAGE(PG8_SA(1, 1), a1 + hstep, voffA);
            PG8_WAIT_L(8); PG8_BAR; PG8_WAIT_L(0); PG8_MMA(0, 0, At, B0); PG8_BAR; PG8_SCHED;
            PG8_LDB(B1, 0, 1); PG8_STAGE(PG8_SB(0, 0), b2, voffB);
            PG8_BAR; PG8_WAIT_L(0); PG8_MMA(0, 1, At, B1); PG8_BAR;
            PG8_LDA(At, 0, 1); PG8_STAGE(PG8_SA(0, 0), a2, voffA);
            PG8_BAR; PG8_WAIT_L(0); PG8_MMA(1, 0, At, B0); PG8_BAR; PG8_SCHED;
            PG8_STAGE(PG8_SB(0, 1), b2 + hstep, voffB);
            PG8_WAIT_V(6); PG8_BAR; PG8_MMA(1, 1, At, B1); PG8_BAR;
            PG8_LDB(B0, 1, 0); PG8_SCHED; PG8_LDA(At, 1, 0); PG8_STAGE(PG8_SA(0, 1), a2 + hstep, voffA);
            PG8_WAIT_L(8); PG8_BAR; PG8_WAIT_L(0); PG8_MMA(0, 0, At, B0); PG8_BAR; PG8_SCHED;
            PG8_LDB(B1, 1, 1); PG8_STAGE(PG8_SB(1, 0), b3, voffB);
            PG8_BAR; PG8_WAIT_L(0); PG8_MMA(0, 1, At, B1); PG8_BAR;
            PG8_LDA(At, 1, 1); PG8_STAGE(PG8_SA(1, 0), a3, voffA);
            PG8_BAR; PG8_WAIT_L(0); PG8_MMA(1, 0, At, B0); PG8_BAR; PG8_SCHED;
            PG8_STAGE(PG8_SB(1, 1), b3 + hstep, voffB);
            PG8_WAIT_V(6); PG8_BAR; PG8_MMA(1, 1, At, B1); PG8_BAR;
            }
        }
        if constexpr (ALIGN_EPI) { if (wr == 0) PG8_BAR; }
        if constexpr (!Epi::AFTER_DRAIN) { E(acc, cur, wr, wc, fr, fq); S.done(cur); }
        if (!has_next) break;
#pragma unroll
        for (int a = 0; a < 2; ++a)
#pragma unroll
            for (int b = 0; b < 2; ++b)
#pragma unroll
                for (int m = 0; m < 4; ++m)
#pragma unroll
                    for (int n = 0; n < 2; ++n) acc[a][b][m][n] = (f32x4){0.f, 0.f, 0.f, 0.f};
        cur = nxt; cA = nA; cB = nB; ++ui;
        if constexpr (ALIGN_EPI) { if (wr == 1) PG8_BAR; }
    }
    PG8_WAIT_V(0);
    if constexpr (!ALIGN_EPI) { if (wr == 0) PG8_BAR; }
    PG8_BAR;
    if constexpr (Epi::AFTER_DRAIN) { E.fused(acc, cur, wr, wc, fr, fq, lds, wid, lane); S.done(cur); }
#undef PG8_SA
#undef PG8_SB
#undef PG8_STAGE
#undef PG8_STAGE_R
#undef PG8_LDA
#undef PG8_LDB
#undef PG8_MMA
#undef PG8_WAIT_V
#undef PG8_WAIT_L
#undef PG8_BAR
#undef PG8_SCHED
}
}

#ifndef PG8_SP2
#define PG8_SP2 true
#endif
#ifndef PG8_ALIGN
#define PG8_ALIGN true
#endif
constexpr int NWAVES = 8, NTHR = 512;
#ifndef MK_N_LAUNCHES
#define MK_N_LAUNCHES 1
#endif
constexpr int N_PHASES = 25;
constexpr int N_LAUNCHES = MK_N_LAUNCHES;
static_assert(N_LAUNCHES == 1, "this build runs as ONE launch (the retention mixer has a grid barrier inside its phase)");

constexpr int BATCH = 2, SEQ = 4096, DM = 2048, M = BATCH * SEQ, DEPTH = 4;
constexpr int RET_N = 12288, GM_N = 12288, GM_HALF = 6144, FOX_LD = 8208, FOX_N = 8192, FFN_H = 5632, FFN_N2 = 2 * FFN_H;
constexpr float EPS = 1e-6f;
constexpr float LOG2E = 1.4426950408889634f;

constexpr size_t MiB = (size_t)1 << 20;
constexpr size_t WS_CTL = 0, CTL_ZERO_BYTES = 1 * MiB;
constexpr size_t WS_W_RET_IN = 1 * MiB, SZ_W_RET_IN = 48 * MiB;
constexpr size_t WS_W_RET_OUT = 97 * MiB, SZ_W_RET_OUT = 16 * MiB;
constexpr size_t WS_W_GM_IN = 129 * MiB, WS_W_GM_OUT = 177 * MiB, WS_W_FOX_IN = 201 * MiB, WS_W_FOX_OUT = 233 * MiB;
constexpr size_t WS_W_GU = 241 * MiB, SZ_W_GU = 44 * MiB;
constexpr size_t WS_W_DN = 417 * MiB, SZ_W_DN = 22 * MiB;
constexpr size_t WS_ROPE_C = 505 * MiB, WS_ROPE_S = 509 * MiB;
constexpr size_t WS_H = 513 * MiB;
constexpr size_t WS_A = 545 * MiB;
constexpr size_t WS_B = 737 * MiB;
constexpr size_t WS_C = 833 * MiB;
constexpr size_t WS_MISC = 897 * MiB, WS_RSP = 913 * MiB, WS_KF = 921 * MiB, WS_QF = 953 * MiB, WS_END = 985 * MiB;
constexpr size_t MISC_PART = 0, MISC_RSTAT = 8 * MiB, MISC_LF = 9 * MiB, MISC_WTRI = 12 * MiB;
constexpr int CW_BAR = 4096;

constexpr int RING_OFF = 0, RING_BYTES = 131072;
constexpr int LDSCTL_OFF = RING_BYTES, MISC_OFF = LDSCTL_OFF + 320;
constexpr int RSTAB_OFF = LDSCTL_OFF + 1024;
constexpr int QKT_OFF = LDSCTL_OFF + 3072, QKG_OFF = QKT_OFF + 8192;
constexpr int LDS_BYTES = 147456;
static_assert(MISC_OFF + 128 <= RSTAB_OFF && RSTAB_OFF + 2048 <= QKT_OFF && QKG_OFF + 1024 <= LDS_BYTES, "LDS map");

#define GAS __attribute__((address_space(1)))
#define LAS __attribute__((address_space(3)))
typedef unsigned short bf16;
typedef unsigned v4u __attribute__((ext_vector_type(4)));
typedef unsigned v2u __attribute__((ext_vector_type(2)));
typedef float f32x4 __attribute__((ext_vector_type(4)));
typedef float f32x2 __attribute__((ext_vector_type(2)));
typedef short bf16x8 __attribute__((ext_vector_type(8)));
typedef short s16x4 __attribute__((ext_vector_type(4)));
typedef GAS unsigned gu32;
typedef LAS unsigned char* ldsp;
#define RLX_AGENT __ATOMIC_RELAXED, __HIP_MEMORY_SCOPE_AGENT
#define LDS_WAIT() asm volatile("s_waitcnt lgkmcnt(0)" ::: "memory")
using pg8::cvtpk;
__device__ __forceinline__ float bflo(unsigned w) { return __uint_as_float(w << 16); }
__device__ __forceinline__ float bfhi(unsigned w) { return __uint_as_float(w & 0xffff0000u); }
#define MFMA16(a, b, c) __builtin_amdgcn_mfma_f32_16x16x32_bf16((a), (b), (c), 0, 0, 0)
__device__ __forceinline__ bf16x8 frag_row(const ldsp tile, int RS, int lane) { return *(const LAS bf16x8*)(tile + (lane & 15) * RS + (lane >> 4) * 16); }
typedef short v4i16_t __attribute__((ext_vector_type(4)));
__device__ __forceinline__ s16x4 vtr(const ldsp p) { return __builtin_bit_cast(s16x4, __builtin_amdgcn_ds_read_tr16_b64_v4i16((LAS v4i16_t*)p)); }
__device__ __forceinline__ bf16x8 frag_tr(const ldsp tile, int RS, int lane) {
    const ldsp a = tile + (8 * (lane >> 4) + ((lane & 15) >> 2)) * RS + 8 * (lane & 3);
    const s16x4 lo = vtr(a), hi = vtr(a + 4 * RS);
    return (bf16x8){lo[0], lo[1], lo[2], lo[3], hi[0], hi[1], hi[2], hi[3]};
}

#define XB_TMO      128
#define XB_XCNT(j)  (256  + 64 * (j))
#define XB_XSUB(j)  (1280 + 64 * (j))
#define XB_XGEN(j)  (2304 + 64 * (j))
#define XB_TOP      3328
#define XB_TOPGEN   3392
#define XCD_BAR_WORDS 3456
#define XB_SPIN_CAP (1u << 18)

__device__ __forceinline__ unsigned xb_ld(unsigned* p)              { return __hip_atomic_load(p, __ATOMIC_RELAXED, __HIP_MEMORY_SCOPE_AGENT); }
__device__ __forceinline__ unsigned xb_add(unsigned* p, unsigned v) { return __hip_atomic_fetch_add(p, v, __ATOMIC_RELAXED, __HIP_MEMORY_SCOPE_AGENT); }
__device__ __forceinline__ unsigned xb_xcc_id() { return (unsigned)__builtin_amdgcn_s_getreg((3 << 11) | 20) & 0xFu; }
#define XB_SPIN(cond, bar) do { unsigned _sp = 0; while (cond) { __builtin_amdgcn_s_sleep(1); \
    if ((++_sp & 255u) == 0u) { if (xb_ld(&(bar)[XB_TMO])) break; if (_sp > XB_SPIN_CAP) { atomicAdd(&(bar)[XB_TMO], 1u); break; } } } } while (0)

struct XcdBarrier {
    unsigned* bar; unsigned x;
    volatile LAS unsigned* st;
};

__device__ __forceinline__ XcdBarrier xcd_barrier_post(unsigned* bar, volatile LAS unsigned* st) {
    XcdBarrier b; b.bar = bar; b.x = xb_xcc_id(); b.st = st;
    if (threadIdx.x == 0) (void)xb_add(&bar[XB_XCNT(b.x)], 1u);
    return b;
}
__device__ __forceinline__ void xcd_barrier_complete(unsigned* bar, unsigned x, unsigned& nloc, unsigned& nx) {
    const unsigned G = gridDim.x * gridDim.y * gridDim.z;
    unsigned sum, cnt, mine, sp = 0u;
    for (;;) {
        sum = 0u; cnt = 0u; mine = 0u;
#pragma unroll
        for (unsigned j = 0; j < 16; ++j) { const unsigned c = xb_ld(&bar[XB_XCNT(j)]); sum += c; cnt += (c > 0u) ? 1u : 0u; mine = (j == x) ? c : mine; }
        if (sum == G) break;
        __builtin_amdgcn_s_sleep(1);
        if ((++sp & 255u) == 0u) { if (xb_ld(&bar[XB_TMO])) break; if (sp > XB_SPIN_CAP) { atomicAdd(&bar[XB_TMO], 1u); break; } }
    }
    nloc = mine > 0u ? mine : 1u; nx = cnt > 0u ? cnt : 1u;
}

__device__ __forceinline__ void xcd_barrier(const XcdBarrier& b) {
    asm volatile("s_waitcnt vmcnt(0)" ::: "memory");
    __syncthreads();
    if (threadIdx.x == 0) {
        unsigned* bar = b.bar;
        __builtin_amdgcn_s_waitcnt(0);
        unsigned nloc = b.st[0], nx = b.st[1];
        if (nloc == 0u) { xcd_barrier_complete(bar, b.x, nloc, nx); b.st[0] = nloc; b.st[1] = nx; }
        const unsigned old = xb_add(&bar[XB_XSUB(b.x)], 1u);
        const unsigned gen = old / nloc;
        if (old + 1u == (gen + 1u) * nloc) {
            __builtin_amdgcn_fence(__ATOMIC_RELEASE, "agent");
            asm volatile("s_waitcnt vmcnt(0)" ::: "memory");
            const unsigned og = xb_add(&bar[XB_TOP], 1u);
            const unsigned tg = og / nx;
            if (og + 1u == (tg + 1u) * nx) xb_add(&bar[XB_TOPGEN], 1u);
            else XB_SPIN(xb_ld(&bar[XB_TOPGEN]) == tg, bar);
            __builtin_amdgcn_fence(__ATOMIC_ACQUIRE, "agent");
            xb_add(&bar[XB_XGEN(b.x)], 1u);
            asm volatile("s_waitcnt vmcnt(0)" ::: "memory");
        } else {
            XB_SPIN(xb_ld(&bar[XB_XGEN(b.x)]) == gen, bar);
            __builtin_amdgcn_fence(__ATOMIC_ACQUIRE, "agent");
            asm volatile("s_waitcnt vmcnt(0)" ::: "memory");
        }
    }
    __syncthreads();
}

struct Frame {
    ldsp lds;
    volatile LAS unsigned* MISC;
    gu32* ctl;
    int tid, lane, wave;
    int vcu, G;
};
__device__ __forceinline__ float wave_sum(float v) {
#pragma unroll
    for (int o = 1; o < 64; o <<= 1) v += __shfl_xor(v, o);
    return v;
}
__device__ __forceinline__ float log_sigmoid(float z) { return fminf(z, 0.f) - log1pf(expf(-fabsf(z))); }

#ifndef GU_CUT
#define GU_CUT 24
#endif
__device__ __forceinline__ void transpose_job(Frame& F, const float* W, int K, int ld, int ncols, bf16* WT, int ilv, const float* gvec, int rank = -1, int cnt = 0, int it_lo = 0, int it_hi = -1) {
    LAS float* scr = (LAS float*)(F.lds + RING_OFF + F.wave * 16384);
    const int gw = it_lo + (rank < 0 ? F.vcu : rank) * NWAVES + F.wave, NGW = (rank < 0 ? F.G : cnt) * NWAVES, lane = F.lane;
    const int nblk = ncols / 32, nitems = it_hi < 0 ? (K / 64) * nblk : it_hi;
    float wv[32];
#define TJ_LOAD(item) do { const int kb_ = (item) / nblk, nb_ = (item) % nblk; const float* src_ = W + (size_t)(64 * kb_ + (lane >> 5)) * ld + 32 * nb_ + (lane & 31); \
        _Pragma("unroll") for (int i = 0; i < 32; ++i) wv[i] = src_[(size_t)(2 * i) * ld]; } while (0)
    if (gw < nitems) TJ_LOAD(gw);
    for (int it = gw; it < nitems; it += NGW) {
        const int kb = it / nblk, nb = it % nblk, k0 = 64 * kb, n0 = 32 * nb;
        const int drow0 = ilv == 0 ? n0 : ((n0 >> 7) * 256 + (n0 & 127) + (ilv == 2 ? 128 : 0));
#pragma unroll
        for (int i = 0; i < 32; ++i) scr[(2 * i + (lane >> 5)) * 33 + (lane & 31)] = wv[i];
        if (it + NGW < nitems) TJ_LOAD(it + NGW);
        LDS_WAIT(); asm volatile("" ::: "memory");
        const int c = lane & 7;
        f32x4 ga = {1.f, 1.f, 1.f, 1.f}, gb = {1.f, 1.f, 1.f, 1.f};
        if (gvec) { ga = *(const f32x4*)(gvec + k0 + 8 * c); gb = *(const f32x4*)(gvec + k0 + 8 * c + 4); }
#pragma unroll
        for (int j = 0; j < 4; ++j) { const int n = (lane >> 3) + 8 * j; const LAS float* s = scr + (8 * c) * 33 + n;
            v4u o; o.x = cvtpk(s[0 * 33] * ga[0], s[1 * 33] * ga[1]); o.y = cvtpk(s[2 * 33] * ga[2], s[3 * 33] * ga[3]); o.z = cvtpk(s[4 * 33] * gb[0], s[5 * 33] * gb[1]); o.w = cvtpk(s[6 * 33] * gb[2], s[7 * 33] * gb[3]);
            *(GAS v4u*)(WT + (size_t)(drow0 + n) * K + k0 + 8 * c) = o; }
        LDS_WAIT(); asm volatile("" ::: "memory");
    }
#undef TJ_LOAD
}
__device__ __forceinline__ void transpose_job2(Frame& F, const float* W, int K, int ld, int ncols, bf16* WT, int ilv, const float* gvec, int rank, int cnt, int it_lo, int it_hi) {
    LAS float* scr = (LAS float*)(F.lds + RING_OFF + F.wave * 16384);
    const int gw = it_lo + rank * NWAVES + F.wave, NGW = cnt * NWAVES, lane = F.lane;
    const int nblk = ncols / 32, nitems = it_hi;
    float wa[32], wb[32];
#define TJ2_LOAD(arr, item) do { const int kb_ = (item) / nblk, nb_ = (item) % nblk; const float* src_ = W + (size_t)(64 * kb_ + (lane >> 5)) * ld + 32 * nb_ + (lane & 31); \
        _Pragma("unroll") for (int i = 0; i < 32; ++i) arr[i] = src_[(size_t)(2 * i) * ld]; } while (0)
#define TJ2_PROC(arr, it_) do { const int kb = (it_) / nblk, nb = (it_) % nblk, k0 = 64 * kb, n0 = 32 * nb; \
        const int drow0 = ilv == 0 ? n0 : ((n0 >> 7) * 256 + (n0 & 127) + (ilv == 2 ? 128 : 0)); \
        _Pragma("unroll") for (int i = 0; i < 32; ++i) scr[(2 * i + (lane >> 5)) * 33 + (lane & 31)] = arr[i]; \
        if ((it_) + 2 * NGW < nitems) TJ2_LOAD(arr, (it_) + 2 * NGW); \
        LDS_WAIT(); asm volatile("" ::: "memory"); \
        const int c = lane & 7; \
        f32x4 ga = {1.f, 1.f, 1.f, 1.f}, gb = {1.f, 1.f, 1.f, 1.f}; \
        if (gvec) { ga = *(const f32x4*)(gvec + k0 + 8 * c); gb = *(const f32x4*)(gvec + k0 + 8 * c + 4); } \
        _Pragma("unroll") for (int j = 0; j < 4; ++j) { const int n = (lane >> 3) + 8 * j; const LAS float* s = scr + (8 * c) * 33 + n; \
            v4u o; o.x = cvtpk(s[0 * 33] * ga[0], s[1 * 33] * ga[1]); o.y = cvtpk(s[2 * 33] * ga[2], s[3 * 33] * ga[3]); o.z = cvtpk(s[4 * 33] * gb[0], s[5 * 33] * gb[1]); o.w = cvtpk(s[6 * 33] * gb[2], s[7 * 33] * gb[3]); \
            *(GAS v4u*)(WT + (size_t)(drow0 + n) * K + k0 + 8 * c) = o; } \
        LDS_WAIT(); asm volatile("" ::: "memory"); } while (0)
    if (gw < nitems) TJ2_LOAD(wa, gw);
    if (gw + NGW < nitems) TJ2_LOAD(wb, gw + NGW);
    for (int it = gw; it < nitems; it += 2 * NGW) {
        TJ2_PROC(wa, it);
        if (it + NGW < nitems) TJ2_PROC(wb, it + NGW);
    }
#undef TJ2_LOAD
#undef TJ2_PROC
}
__device__ __forceinline__ void p0_prologue(Frame& F, const void* const* in, unsigned char* ws) {
    const float* mixg = (const float*)in[2]; const float* ffng = (const float*)in[3];
    {
        struct TJob { const float* W; bf16* WT; const float* gv; int K, ld, nblk, ilv, lo, n; };
        constexpr int NJ = 20;
        auto job = [&](int k) -> TJob {
            TJob J; J.gv = nullptr; J.ilv = 0; J.lo = 0;
            if (k < 4) { const int j = k >> 1;
                if ((k & 1) == 0) { J.W = (const float*)in[4] + (size_t)j * DM * RET_N; J.K = DM; J.ld = RET_N; J.nblk = RET_N / 32; J.WT = (bf16*)(ws + WS_W_RET_IN + j * SZ_W_RET_IN); J.gv = mixg + (size_t)(3 * j) * DM; }
                else { J.W = (const float*)in[6] + (size_t)j * 4096 * DM; J.K = 4096; J.ld = DM; J.nblk = DM / 32; J.WT = (bf16*)(ws + WS_W_RET_OUT + j * SZ_W_RET_OUT); } }
            else if (k == 4) { J.W = (const float*)in[7]; J.K = DM; J.ld = GM_N; J.nblk = GM_N / 32; J.WT = (bf16*)(ws + WS_W_GM_IN); J.gv = mixg + DM; }
            else if (k == 5) { J.W = (const float*)in[12]; J.K = GM_HALF; J.ld = DM; J.nblk = DM / 32; J.WT = (bf16*)(ws + WS_W_GM_OUT); }
            else if (k == 6) { J.W = (const float*)in[13]; J.K = DM; J.ld = FOX_LD; J.nblk = FOX_N / 32; J.WT = (bf16*)(ws + WS_W_FOX_IN); J.gv = mixg + 2 * DM; }
            else if (k == 7) { J.W = (const float*)in[17]; J.K = DM; J.ld = DM; J.nblk = DM / 32; J.WT = (bf16*)(ws + WS_W_FOX_OUT); }
            else { const int i = (k - 8) / 3, t = (k - 8) % 3;
                if (t < 2) { J.W = (const float*)in[18 + t] + (size_t)i * DM * FFN_H; J.K = DM; J.ld = FFN_H; J.nblk = FFN_H / 32; J.WT = (bf16*)(ws + WS_W_GU + i * SZ_W_GU); J.ilv = 1 + t; J.gv = ffng + (size_t)i * DM;
                    J.lo = (i > 0 && F.G == 256) ? GU_CUT * (FFN_H / 32) : 0; }
                else { J.W = (const float*)in[20] + (size_t)i * FFN_H * DM; J.K = FFN_H; J.ld = DM; J.nblk = DM / 32; J.WT = (bf16*)(ws + WS_W_DN + i * SZ_W_DN); } }
            J.n = (J.K / 64) * J.nblk - J.lo; if (J.n < 0) J.n = 0;
            return J; };
        LAS float* scr = (LAS float*)(F.lds + RING_OFF + F.wave * 16384);
        const int lane = F.lane, NGW = F.G * NWAVES;
        int g = F.vcu * NWAVES + F.wave, jk = 0, base = 0; TJob J = job(NJ - 1);
        float wv[32]; bf16* dstN = nullptr; const float* gpN = nullptr; int KN = 0;
#define PJ_LOCATE() do { while (jk < NJ && g >= base + J.n) { base += J.n; ++jk; if (jk < NJ) J = job(NJ - 1 - jk); } } while (0)
#define PJ_LOAD() do { const int it_ = J.lo + (g - base), kb_ = it_ / J.nblk, nb_ = it_ % J.nblk, n0_ = 32 * nb_; const float* src_ = J.W + (size_t)(64 * kb_ + (lane >> 5)) * J.ld + n0_ + (lane & 31); \
            _Pragma("unroll") for (int i = 0; i < 32; ++i) wv[i] = src_[(size_t)(2 * i) * J.ld]; \
            const int drow0_ = J.ilv == 0 ? n0_ : ((n0_ >> 7) * 256 + (n0_ & 127) + (J.ilv == 2 ? 128 : 0)); \
            dstN = J.WT + (size_t)drow0_ * J.K + 64 * kb_; KN = J.K; gpN = J.gv ? J.gv + 64 * kb_ : nullptr; } while (0)
        PJ_LOCATE(); if (jk < NJ) PJ_LOAD();
        while (jk < NJ) {
            bf16* dst = dstN; const float* gp = gpN; const int Kc = KN;
#pragma unroll
            for (int i = 0; i < 32; ++i) scr[(2 * i + (lane >> 5)) * 33 + (lane & 31)] = wv[i];
            g += NGW; PJ_LOCATE(); if (jk < NJ) PJ_LOAD();
            LDS_WAIT(); asm volatile("" ::: "memory");
            const int c8 = lane & 7;
            f32x4 ga = {1.f, 1.f, 1.f, 1.f}, gb = {1.f, 1.f, 1.f, 1.f};
            if (gp) { ga = *(const f32x4*)(gp + 8 * c8); gb = *(const f32x4*)(gp + 8 * c8 + 4); }
#pragma unroll
            for (int j = 0; j < 4; ++j) { const int n = (lane >> 3) + 8 * j; const LAS float* sp = scr + (8 * c8) * 33 + n;
                v4u o; o.x = cvtpk(sp[0 * 33] * ga[0], sp[1 * 33] * ga[1]); o.y = cvtpk(sp[2 * 33] * ga[2], sp[3 * 33] * ga[3]); o.z = cvtpk(sp[4 * 33] * gb[0], sp[5 * 33] * gb[1]); o.w = cvtpk(sp[6 * 33] * gb[2], sp[7 * 33] * gb[3]);
                *(GAS v4u*)(dst + (size_t)n * Kc + 8 * c8) = o; }
            LDS_WAIT(); asm volatile("" ::: "memory");
        }
#undef PJ_LOCATE
#undef PJ_LOAD
    }
    { const float* x = (const float*)in[0]; bf16* xb = (bf16*)(ws + WS_H); float* rss = (float*)(ws + WS_RSP);
      const int gw = F.vcu * NWAVES + F.wave, NGW = F.G * NWAVES, lane = F.lane;
      for (int m0 = gw; m0 < M; m0 += 4 * NGW) {
          f32x4 v[4][8];
#pragma unroll
          for (int r = 0; r < 4; ++r) { const int m = m0 + r * NGW; if (m < M) { const f32x4* xr = (const f32x4*)(x + (size_t)m * DM) + lane;
#pragma unroll
              for (int j = 0; j < 8; ++j) v[r][j] = xr[64 * j]; } }
#pragma unroll
          for (int r = 0; r < 4; ++r) { const int m = m0 + r * NGW; if (m < M) { v2u* o8 = (v2u*)(xb + (size_t)m * DM) + lane; float ss = 0.f;
#pragma unroll
              for (int j = 0; j < 8; ++j) { const f32x4 t = v[r][j]; ss += (t.x * t.x + t.y * t.y) + (t.z * t.z + t.w * t.w); v2u w; w.x = cvtpk(t.x, t.y); w.y = cvtpk(t.z, t.w); o8[64 * j] = w; }
              ss = wave_sum(ss); if (lane < 32) rss[(size_t)m * 32 + lane] = lane == 0 ? ss : 0.f; } } } }
    { const float* wsp = (const float*)in[10]; bf16* wtri = (bf16*)(ws + WS_MISC + MISC_WTRI);
      for (int i4 = F.vcu * NTHR + F.tid; i4 < 8 * 128 * 32; i4 += F.G * NTHR) { const int t = (i4 >> 5) & 127, s4 = (i4 & 31) * 4; f32x4 wv = *(const f32x4*)(wsp + (size_t)i4 * 4);
#pragma unroll
          for (int e = 0; e < 4; ++e) if (s4 + e > t) wv[e] = 0.f;
          v2u pk; pk.x = cvtpk(wv[0], wv[1]); pk.y = cvtpk(wv[2], wv[3]); *(v2u*)(wtri + (size_t)i4 * 4) = pk; } }
    { const int* pos = (const int*)in[1]; float* cs = (float*)(ws + WS_ROPE_C); float* sn = (float*)(ws + WS_ROPE_S);
      const int gid = F.vcu * NTHR + F.tid, i = gid & 127, step = (F.G * NTHR) >> 7;
      const double invf = exp2(-(double)i * (13.287712379549449 / 128.0));
      for (int r0 = gid >> 7; r0 < M; r0 += 8 * step) {
          int pp[8];
#pragma unroll
          for (int u = 0; u < 8; ++u) { const int r = r0 + u * step; pp[u] = r < M ? pos[r] : 0; }
#pragma unroll
          for (int u = 0; u < 8; ++u) { const int r = r0 + u * step; if (r < M) { const double ang = (double)pp[u] * invf; const double rr = ang - 6.283185307179586 * rint(ang * 0.15915494309189535);
              const float a = (float)rr; cs[(size_t)r * 128 + i] = cosf(a); sn[(size_t)r * 128 + i] = sinf(a); } } } }
}

__device__ __forceinline__ void ret_p_phase(Frame& F, const bf16* q, const bf16* k, bf16* PF, bf16* KF, bf16* QF) {
    constexpr int RSQ = 272;
    const ldsp LQ = F.lds, LK = F.lds + 34816;
    const int tid = F.tid, lane = F.lane, w = F.wave, g4 = lane >> 4, l15 = lane & 15;
    v4u pq[4], pk[4];
    for (int unit = F.vcu; unit < 512; unit += F.G) {
        const int bh = unit >> 5, ci = unit & 31, h = bh & 7;
        const float lg2 = log1pf(-exp2f(-5.0f - (float)h)) * LOG2E;
        const size_t rowbase = (size_t)bh * SEQ + ci * 128;
#define RP_LD(rb_, dd) do { _Pragma("unroll") for (int ps = 0; ps < 4; ++ps) { const int r_ = ps * 32 + (tid >> 4), c_ = tid & 15; \
            pq[ps] = *(const v4u*)(q + ((rb_) + r_) * 256 + (dd) * 128 + c_ * 8); pk[ps] = *(const v4u*)(k + ((rb_) + r_) * 256 + (dd) * 128 + c_ * 8); } } while (0)
        if (unit == F.vcu) RP_LD(rowbase, 0);
        f32x4 S[8];
#pragma unroll
        for (int t = 0; t < 8; ++t) S[t] = (f32x4){0.f, 0.f, 0.f, 0.f};
#pragma unroll
        for (int dh = 0; dh < 2; ++dh) {
            __syncthreads();
#pragma unroll
            for (int ps = 0; ps < 4; ++ps) { const int r_ = ps * 32 + (tid >> 4), c_ = tid & 15; *(LAS v4u*)(LQ + r_ * RSQ + c_ * 16) = pq[ps]; *(LAS v4u*)(LK + r_ * RSQ + c_ * 16) = pk[ps]; }
            if (dh == 0) RP_LD(rowbase, 1);
            else if (unit + F.G < 512) { const int un_ = unit + F.G; RP_LD((size_t)(un_ >> 5) * SEQ + (un_ & 31) * 128, 0); }
            __syncthreads();
#pragma unroll
            for (int ks = 0; ks < 4; ++ks) { const bf16x8 a = frag_row(LQ + (16 * w) * RSQ + ks * 64, RSQ, lane);
                *(bf16x8*)(QF + ((((size_t)(bh * 32 + ci) * 8 + w) * 8 + dh * 4 + ks) * 512 + lane * 8)) = a;
#pragma unroll
                for (int t = 0; t < 8; ++t) S[t] = MFMA16(a, frag_row(LK + (16 * t) * RSQ + ks * 64, RSQ, lane), S[t]); }
#pragma unroll
            for (int ks = 0; ks < 4; ++ks) { const bf16x8 f = frag_tr(LK + (32 * ks) * RSQ + (16 * w) * 2, RSQ, lane); const v4u fu = __builtin_bit_cast(v4u, f); v4u o;
                const float k0 = exp2f((float)(127 - 32 * ks - 8 * g4) * lg2), gi = exp2f(-lg2), k1 = k0 * gi, k2 = k1 * gi, k3 = k2 * gi, k4 = k3 * gi, k5 = k4 * gi, k6 = k5 * gi, k7 = k6 * gi;
                o.x = cvtpk(bflo(fu.x) * k0, bfhi(fu.x) * k1); o.y = cvtpk(bflo(fu.y) * k2, bfhi(fu.y) * k3); o.z = cvtpk(bflo(fu.z) * k4, bfhi(fu.z) * k5); o.w = cvtpk(bflo(fu.w) * k6, bfhi(fu.w) * k7);
                *(v4u*)(KF + ((((size_t)(bh * 32 + ci) * 2 + dh) * 8 + w) * 4 + ks) * 512 + lane * 8) = o; }
        }
#undef RP_LD
#pragma unroll
        for (int t = 0; t < 8; ++t)
#pragma unroll
            for (int r = 0; r < 4; ++r) { const int n = 16 * w + 4 * g4 + r, mm = 16 * t + l15;
                const float pv_ = n >= mm ? S[t][r] * exp2f((float)(n - mm) * lg2) : 0.f;
                *(LAS unsigned short*)(LQ + n * RSQ + mm * 2) = (unsigned short)(cvtpk(pv_, 0.f) & 0xffffu); }
#pragma unroll
        for (int ks = 0; ks < 4; ++ks) *(bf16x8*)(PF + ((((size_t)(bh * 32 + ci) * 8 + w) * 4 + ks) * 512 + lane * 8)) = frag_row(LQ + (16 * w) * RSQ + ks * 64, RSQ, lane);
    }
}
#ifndef RC_ILV
#define RC_ILV 1
#endif
__device__ __forceinline__ void ret_core_phase(Frame& F, const bf16* QF, const bf16* v, const bf16* PF, const bf16* KF, bf16* o, const int umask = 0) {
    constexpr int RSV = 72, RSS = 528;
    const ldsp LV0 = F.lds, LST = F.lds + 18432;
    const ldsp LOw = F.lds + 52224 + F.wave * 1024;
    const int tid = F.tid, lane = F.lane, w = F.wave, g4 = lane >> 4, l15 = lane & 15;
    for (int unit = F.vcu; unit < 256; unit += F.G) {
        if (unit & umask) continue;
        const int bh = unit >> 4, es = unit & 15, h = bh & 7, b = bh >> 3, e0 = es * 32;
        const float lg2 = log1pf(-exp2f(-5.0f - (float)h)) * LOG2E;
        const float cd = exp2f(128.0f * lg2);
        const size_t rb0 = (size_t)bh * SEQ;
        f32x4 st[2][2];
#pragma unroll
        for (int a = 0; a < 2; ++a)
#pragma unroll
            for (int t = 0; t < 2; ++t) st[a][t] = (f32x4){0.f, 0.f, 0.f, 0.f};
        __syncthreads();
        for (int i = tid; i < 16896 / 4; i += NTHR) ((LAS unsigned*)LST)[i] = 0u;
        v4u pv, pvn; bf16x8 qf[8], pf[4], kf[8], qn[8], pn[4], kn[8];
#define RC_LD_V(cc) do { pvn = *(const v4u*)(v + (rb0 + (cc) * 128 + (tid >> 2)) * 512 + e0 + (tid & 3) * 8); } while (0)
#define RC_LD_Q(cc, k0_, k1_) do { _Pragma("unroll") for (int ks = (k0_); ks < (k1_); ++ks) qn[ks] = *(const bf16x8*)(QF + ((((size_t)(bh * 32 + (cc)) * 8 + w) * 8 + ks) * 512 + lane * 8)); } while (0)
#define RC_LD_P(cc) do { _Pragma("unroll") for (int ks = 0; ks < 4; ++ks) pn[ks] = *(const bf16x8*)(PF + ((((size_t)(bh * 32 + (cc)) * 8 + w) * 4 + ks) * 512 + lane * 8)); } while (0)
#define RC_LD_K(cc, k0_, k1_) do { _Pragma("unroll") for (int i_ = (k0_); i_ < (k1_); ++i_) kn[i_] = *(const bf16x8*)(KF + ((((size_t)(bh * 32 + (cc)) * 2 + (i_ >> 2)) * 8 + w) * 4 + (i_ & 3)) * 512 + lane * 8); } while (0)
#define RC_LD(cc) do { RC_LD_V(cc); RC_LD_Q(cc, 0, 8); RC_LD_P(cc); RC_LD_K(cc, 0, 8); } while (0)
#define RC_SB __builtin_amdgcn_sched_barrier(0)
        RC_LD(0);
        for (int ci = 0; ci < 32; ++ci) {
            const ldsp LSc = LST + (ci & 1) * 16896, LSn = LST + ((ci + 1) & 1) * 16896;
            const ldsp LV = LV0 + (ci & 1) * 9216;
            pv = pvn;
#pragma unroll
            for (int i_ = 0; i_ < 8; ++i_) { qf[i_] = qn[i_]; kf[i_] = kn[i_]; }
#pragma unroll
            for (int i_ = 0; i_ < 4; ++i_) pf[i_] = pn[i_];
            *(LAS v4u*)(LV + (tid >> 2) * RSV + (tid & 3) * 16) = pv;
            __syncthreads();
#if RC_ILV
            const bool nx = ci + 1 < 32;
            if (nx) { RC_LD_V(ci + 1); RC_LD_Q(ci + 1, 0, 4); } RC_SB;
#else
            if (ci + 1 < 32) RC_LD(ci + 1);
#endif
            bf16x8 vf[4][2];
#pragma unroll
            for (int ks = 0; ks < 4; ++ks)
#pragma unroll
                for (int t = 0; t < 2; ++t) vf[ks][t] = frag_tr(LV + (32 * ks) * RSV + (16 * t) * 2, RSV, lane);
            f32x4 cr[2], in[2];
            cr[0] = (f32x4){0.f, 0.f, 0.f, 0.f}; cr[1] = (f32x4){0.f, 0.f, 0.f, 0.f}; in[0] = (f32x4){0.f, 0.f, 0.f, 0.f}; in[1] = (f32x4){0.f, 0.f, 0.f, 0.f};
#pragma unroll
            for (int ks = 0; ks < 4; ++ks)
#pragma unroll
                for (int t = 0; t < 2; ++t) cr[t] = MFMA16(qf[ks], frag_row(LSc + (16 * t) * RSS + (ks * 32) * 2, RSS, lane), cr[t]);
#if RC_ILV
            RC_SB; if (nx) RC_LD_Q(ci + 1, 4, 8); RC_SB;
#endif
#pragma unroll
            for (int ks = 4; ks < 8; ++ks)
#pragma unroll
                for (int t = 0; t < 2; ++t) cr[t] = MFMA16(qf[ks], frag_row(LSc + (16 * t) * RSS + (ks * 32) * 2, RSS, lane), cr[t]);
#if RC_ILV
            RC_SB; if (nx) RC_LD_P(ci + 1); RC_SB;
#endif
#pragma unroll
            for (int ks = 0; ks < 4; ++ks)
#pragma unroll
                for (int t = 0; t < 2; ++t) in[t] = MFMA16(pf[ks], vf[ks][t], in[t]);
#pragma unroll
            for (int dh = 0; dh < 2; ++dh) {
#if RC_ILV
                RC_SB; if (nx) { if (dh == 0) RC_LD_K(ci + 1, 0, 4); else RC_LD_K(ci + 1, 4, 8); } RC_SB;
#endif
#pragma unroll
                for (int t = 0; t < 2; ++t) st[dh][t] = st[dh][t] * cd;
#pragma unroll
                for (int ks = 0; ks < 4; ++ks)
#pragma unroll
                    for (int t = 0; t < 2; ++t) st[dh][t] = MFMA16(kf[dh * 4 + ks], vf[ks][t], st[dh][t]);
#pragma unroll
                for (int t = 0; t < 2; ++t) { v2u pk2; pk2.x = cvtpk(st[dh][t][0], st[dh][t][1]); pk2.y = cvtpk(st[dh][t][2], st[dh][t][3]);
                    *(LAS v2u*)(LSn + (16 * t + l15) * RSS + (dh * 128 + 16 * w + 4 * g4) * 2) = pk2; }
            }
#pragma unroll
            for (int r = 0; r < 4; ++r) { const int n = 16 * w + 4 * g4 + r; const float qd = exp2f((float)(n + 1) * lg2);
#pragma unroll
                for (int t = 0; t < 2; ++t) *(LAS unsigned short*)(LOw + (4 * g4 + r) * 64 + (16 * t + l15) * 2) = (unsigned short)(cvtpk(in[t][r] + cr[t][r] * qd, 0.f) & 0xffffu); }
            *(v4u*)(o + ((size_t)b * SEQ + ci * 128 + 16 * w + (lane >> 2)) * 4096 + h * 512 + e0 + (lane & 3) * 8) = *(const LAS v4u*)(LOw + (lane >> 2) * 64 + (lane & 3) * 16);
        }
#undef RC_LD
#undef RC_LD_V
#undef RC_LD_Q
#undef RC_LD_P
#undef RC_LD_K
#undef RC_SB
    }
}

__device__ __forceinline__ void ret_gn_phase(Frame& F, const bf16* o, const bf16* g, const float* gn, bf16* y) {
    const int lane = F.lane, gw = F.vcu * NWAVES + F.wave, NGW = F.G * NWAVES, h = gw & 7;
    const f32x4 g0 = *(const f32x4*)(gn + h * 512 + lane * 8), g1 = *(const f32x4*)(gn + h * 512 + lane * 8 + 4);
    auto load4 = [&](int it0, v4u (&ov)[4], v4u (&gv)[4]) {
#pragma unroll
        for (int u = 0; u < 4; ++u) { const int it = it0 + u * NGW; const size_t off = (size_t)(it >> 3) * 4096 + (it & 7) * 512 + lane * 8;
            if (it < M * 8) { ov[u] = *(const v4u*)(o + off); gv[u] = *(const v4u*)(g + off); } else { ov[u] = (v4u){0u, 0u, 0u, 0u}; gv[u] = ov[u]; } } };
    auto proc4 = [&](int it0, const v4u (&ov)[4], const v4u (&gv)[4]) {
#pragma unroll
        for (int u = 0; u < 4; ++u) { const int it = it0 + u * NGW; const size_t off = (size_t)(it >> 3) * 4096 + (it & 7) * 512 + lane * 8;
            float x[8] = {bflo(ov[u].x), bfhi(ov[u].x), bflo(ov[u].y), bfhi(ov[u].y), bflo(ov[u].z), bfhi(ov[u].z), bflo(ov[u].w), bfhi(ov[u].w)};
            float gg[8] = {bflo(gv[u].x), bfhi(gv[u].x), bflo(gv[u].y), bfhi(gv[u].y), bflo(gv[u].z), bfhi(gv[u].z), bflo(gv[u].w), bfhi(gv[u].w)};
            float s = 0.f;
#pragma unroll
            for (int e = 0; e < 8; ++e) s += x[e];
            const float mean = wave_sum(s) * (1.0f / 512.0f); float qv = 0.f;
#pragma unroll
            for (int e = 0; e < 8; ++e) { x[e] -= mean; qv += x[e] * x[e]; }
            const float rstd = 1.0f / sqrtf(wave_sum(qv) * (1.0f / 512.0f) + EPS);
            float r[8];
#pragma unroll
            for (int e = 0; e < 8; ++e) { const float gw_ = e < 4 ? g0[e & 3] : g1[e & 3]; r[e] = x[e] * rstd * gw_ * (gg[e] * pg8::fast_sigmoid(gg[e])); }
            v4u w; w.x = cvtpk(r[0], r[1]); w.y = cvtpk(r[2], r[3]); w.z = cvtpk(r[4], r[5]); w.w = cvtpk(r[6], r[7]);
            if (it < M * 8) *(v4u*)(y + off) = w; } };
    v4u oa[4], ga[4], ob[4], gb[4];
    const int step = 4 * NGW;
    if (gw < M * 8) load4(gw, oa, ga);
    for (int it0 = gw; it0 < M * 8; it0 += 2 * step) {
        if (it0 + step < M * 8) load4(it0 + step, ob, gb);
        proc4(it0, oa, ga);
        if (it0 + step < M * 8) { if (it0 + 2 * step < M * 8) load4(it0 + 2 * step, oa, ga); proc4(it0 + step, ob, gb); }
    }
}

__device__ __forceinline__ void gm_stat_phase(Frame& F, const f32x2* part, f32x2* rstat) {
    const int lane = F.lane, gw = F.vcu * NWAVES + F.wave, NGW = F.G * NWAVES;
    for (int row = gw; row < M; row += NGW) {
        float s = 0.f, ss = 0.f;
        if (lane < 48) { const f32x4 p = *(const f32x4*)(part + (size_t)row * 96 + lane * 2); s = p.x + p.z; ss = p.y + p.w; }
        s = wave_sum(s); ss = wave_sum(ss);
        const float mean = s * (1.0f / GM_HALF), var = fmaxf(ss * (1.0f / GM_HALF) - mean * mean, 0.f);
        if (lane == 0) rstat[row] = (f32x2){mean, 1.0f / sqrtf(var + EPS)};
    }
}
__device__ __forceinline__ void gm_spatial_phase(Frame& F, const bf16* u, const bf16* v, const f32x2* rstat, const float* lng, const float* lnb, const bf16* wtri, const float* bsp, bf16* y) {
    constexpr int RSW = 272, RSN = 528;
    const ldsp LW = F.lds, LN = F.lds + 34816;
    const int tid = F.tid, lane = F.lane, w = F.wave, g4 = lane >> 4, l15 = lane & 15;
    for (int wgi = F.vcu; wgi < 256; wgi += F.G) {
        const int gg = wgi & 7, jj = wgi >> 3;
        __syncthreads();
#pragma unroll
        for (int ps = 0; ps < 4; ++ps) { const int id = ps * NTHR + tid, t = id >> 4, c = id & 15;
            *(LAS v4u*)(LW + t * RSW + c * 16) = *(const v4u*)(wtri + ((size_t)gg * 128 + t) * 128 + c * 8); }
        float bs[8];
#pragma unroll
        for (int tt = 0; tt < 8; ++tt) bs[tt] = bsp[gg * 128 + 16 * tt + l15];
        v4u vr[8], ur[8];
#define GS_ROW0(i_) ((((jj) * 6 + (i_)) / 3) * 128)
#define GS_COL0(i_) (gg * 768 + (((jj) * 6 + (i_)) % 3) * 256)
#define GS_LDV(i_) do { _Pragma("unroll") for (int ps = 0; ps < 8; ++ps) { const int id_ = ps * NTHR + tid; vr[ps] = *(const v4u*)(v + (size_t)(GS_ROW0(i_) + (id_ >> 5)) * GM_HALF + GS_COL0(i_) + (id_ & 31) * 8); } } while (0)
        GS_LDV(0);
        for (int ui = 0; ui < 6; ++ui) {
            const int row0 = GS_ROW0(ui), col0 = GS_COL0(ui);
            __syncthreads();
#pragma unroll
            for (int ps = 0; ps < 8; ++ps) { const int id = ps * NTHR + tid, r = id >> 5, c8 = (id & 31) * 8;
                const v4u vv = vr[ps]; const f32x2 rs = rstat[row0 + r];
                const f32x4 ga = *(const f32x4*)(lng + col0 + c8), gb = *(const f32x4*)(lng + col0 + c8 + 4), ba = *(const f32x4*)(lnb + col0 + c8), bb = *(const f32x4*)(lnb + col0 + c8 + 4);
                v4u o;
                o.x = cvtpk((bflo(vv.x) - rs.x) * rs.y * ga[0] + ba[0], (bfhi(vv.x) - rs.x) * rs.y * ga[1] + ba[1]);
                o.y = cvtpk((bflo(vv.y) - rs.x) * rs.y * ga[2] + ba[2], (bfhi(vv.y) - rs.x) * rs.y * ga[3] + ba[3]);
                o.z = cvtpk((bflo(vv.z) - rs.x) * rs.y * gb[0] + bb[0], (bfhi(vv.z) - rs.x) * rs.y * gb[1] + bb[1]);
                o.w = cvtpk((bflo(vv.w) - rs.x) * rs.y * gb[2] + bb[2], (bfhi(vv.w) - rs.x) * rs.y * gb[3] + bb[3]);
                *(LAS v4u*)(LN + r * RSN + c8 * 2) = o; }
#pragma unroll
            for (int ps = 0; ps < 8; ++ps) { const int id_ = ps * NTHR + tid; ur[ps] = *(const v4u*)(u + (size_t)(row0 + (id_ >> 5)) * GM_HALF + col0 + (id_ & 31) * 8); }
            if (ui + 1 < 6) GS_LDV(ui + 1);
            __syncthreads();
            f32x4 acc[2][8];
#pragma unroll
            for (int ci = 0; ci < 2; ++ci)
#pragma unroll
                for (int tt = 0; tt < 8; ++tt) acc[ci][tt] = (f32x4){0.f, 0.f, 0.f, 0.f};
#pragma unroll
            for (int ks = 0; ks < 4; ++ks) {
                const bf16x8 a0 = frag_tr(LN + (32 * ks) * RSN + (32 * w) * 2, RSN, lane), a1 = frag_tr(LN + (32 * ks) * RSN + (32 * w + 16) * 2, RSN, lane);
#pragma unroll
                for (int tt = 2 * ks; tt < 8; ++tt) { const bf16x8 bfr = frag_row(LW + (16 * tt) * RSW + ks * 64, RSW, lane);
                    acc[0][tt] = MFMA16(a0, bfr, acc[0][tt]); acc[1][tt] = MFMA16(a1, bfr, acc[1][tt]); }
            }
            __syncthreads();
#pragma unroll
            for (int ci = 0; ci < 2; ++ci)
#pragma unroll
                for (int tt = 0; tt < 8; ++tt) { v2u pk; pk.x = cvtpk(acc[ci][tt][0] + bs[tt], acc[ci][tt][1] + bs[tt]); pk.y = cvtpk(acc[ci][tt][2] + bs[tt], acc[ci][tt][3] + bs[tt]);
                    *(LAS v2u*)(LN + (16 * tt + l15) * RSN + (32 * w + 16 * ci + 4 * g4) * 2) = pk; }
            __syncthreads();
#pragma unroll
            for (int ps = 0; ps < 8; ++ps) { const int id = ps * NTHR + tid, r = id >> 5, c8 = (id & 31) * 8;
                const v4u mv = *(const LAS v4u*)(LN + r * RSN + c8 * 2); const size_t off = (size_t)(row0 + r) * GM_HALF + col0 + c8; const v4u uv = ur[ps];
                v4u o; o.x = cvtpk(bflo(uv.x) * bflo(mv.x), bfhi(uv.x) * bfhi(mv.x)); o.y = cvtpk(bflo(uv.y) * bflo(mv.y), bfhi(uv.y) * bfhi(mv.y));
                o.z = cvtpk(bflo(uv.z) * bflo(mv.z), bfhi(uv.z) * bfhi(mv.z)); o.w = cvtpk(bflo(uv.w) * bflo(mv.w), bfhi(uv.w) * bfhi(mv.w));
                *(v4u*)(y + off) = o; }
        }
#undef GS_ROW0
#undef GS_COL0
#undef GS_LDV
    }
}

__device__ __forceinline__ void fox_prep_phase(Frame& F, const bf16* x, const float* rs, const float* gmix, const float* wfox, const float* bfg, float* lf) {
    const int lane = F.lane, w = F.wave, fr = lane & 15, fq = lane >> 4, kb = w * 256 + fq * 8;
    LAS float* red = (LAS float*)F.lds;
    bf16x8 wh[8], wl[8];
#pragma unroll
    for (int s = 0; s < 8; ++s) { const int k0 = kb + 32 * s; const f32x4 ga = *(const f32x4*)(gmix + k0), gb = *(const f32x4*)(gmix + k0 + 4);
        float wv[8];
#pragma unroll
        for (int j = 0; j < 8; ++j) wv[j] = wfox[(size_t)(k0 + j) * FOX_LD + FOX_N + fr] * (j < 4 ? ga[j & 3] : gb[j & 3]);
        v4u ph, pl;
#pragma unroll
        for (int p = 0; p < 4; ++p) { const unsigned hp = cvtpk(wv[2 * p], wv[2 * p + 1]); ph[p] = hp; pl[p] = cvtpk(wv[2 * p] - bflo(hp), wv[2 * p + 1] - bfhi(hp)); }
        wh[s] = __builtin_bit_cast(bf16x8, ph); wl[s] = __builtin_bit_cast(bf16x8, pl); }
    for (int blk = F.vcu; blk < M / 32; blk += F.G) {
        const bf16* xa = x + (size_t)(blk * 32 + fr) * DM + kb;
        bf16x8 a0[8], a1[8];
#pragma unroll
        for (int s = 0; s < 8; ++s) { a0[s] = *(const bf16x8*)(xa + 32 * s); a1[s] = *(const bf16x8*)(xa + (size_t)16 * DM + 32 * s); }
        f32x4 c0 = (f32x4){0.f, 0.f, 0.f, 0.f}, c1 = c0;
#pragma unroll
        for (int s = 0; s < 8; ++s) { c0 = MFMA16(a0[s], wh[s], c0); c1 = MFMA16(a1[s], wh[s], c1); c0 = MFMA16(a0[s], wl[s], c0); c1 = MFMA16(a1[s], wl[s], c1); }
#pragma unroll
        for (int r = 0; r < 4; ++r) { red[(w * 32 + 4 * fq + r) * 16 + fr] = c0[r]; red[(w * 32 + 16 + 4 * fq + r) * 16 + fr] = c1[r]; }
        __syncthreads();
        { const int row = F.tid >> 4, col = F.tid & 15, m = blk * 32 + row; float z = 0.f;
#pragma unroll
          for (int ww = 0; ww < 8; ++ww) z += red[(ww * 32 + row) * 16 + col];
          lf[(size_t)m * 16 + col] = log_sigmoid(z * pg8::row_rstd(rs, m) + bfg[col]); }
        __syncthreads();
    }
}

typedef float f32x16 __attribute__((ext_vector_type(16)));
#define MFMA32(a, b, c) __builtin_amdgcn_mfma_f32_32x32x16_bf16((a), (b), (c), 0, 0, 0)
__device__ __forceinline__ void fox_attn_phase(Frame& F, const bf16* qn, const bf16* kn, const bf16* vv, const bf16* gs, const float* lf, bf16* y) {
    constexpr int RSK = 272, RSV = 320, KSLOT = 64 * RSK, VSLOT = 64 * RSV;
    const ldsp LK = F.lds, LV = F.lds + 2 * KSLOT;
    LAS float* c2 = (LAS float*)(F.lds + 75776);
    LAS float* red = (LAS float*)(F.lds + 92160);
    const int tid = F.tid, lane = F.lane, w = F.wave, r32 = lane & 31, hi = lane >> 5;
    int bh_have = -1;
    for (int pr = F.vcu; pr < 256; pr += F.G) {
        const int bh = pr >> 3, pi = pr & 7, b = bh >> 4, h = bh & 15;
        const size_t tok0 = (size_t)b * SEQ;
        if (bh != bh_have) {
            bh_have = bh;
            float x8[8]; float run = 0.f;
#pragma unroll
            for (int e = 0; e < 8; ++e) { run += lf[(tok0 + tid * 8 + e) * 16 + h]; x8[e] = run; }
            float inc = run;
#pragma unroll
            for (int o = 1; o < 64; o <<= 1) { const float t = __shfl_up(inc, o); if (lane >= o) inc += t; }
            __syncthreads();
            if (lane == 63) red[w] = inc;
            __syncthreads();
            float pre = inc - run;
#pragma unroll
            for (int wv = 0; wv < 8; ++wv) if (wv < w) pre += red[wv];
#pragma unroll
            for (int e = 0; e < 8; ++e) c2[tid * 8 + e] = (pre + x8[e]) * LOG2E;
        }
        for (int half = 0; half < 2; ++half) {
            const int qb = half ? 15 - pi : pi, q0 = qb * 256, ntile = 4 * qb + 4, qrow = q0 + 32 * w + r32;
            bf16x8 qf[8];
#pragma unroll
            for (int ks = 0; ks < 8; ++ks) qf[ks] = *(const bf16x8*)(qn + (tok0 + qrow) * DM + h * 128 + ks * 16 + 8 * hi);
            v4u kr[2], vr[2];
#define FA_LOAD(tt) do { _Pragma("unroll") for (int pp = 0; pp < 2; ++pp) { const int id_ = tid + NTHR * pp, r_ = id_ >> 4, c_ = id_ & 15; \
                kr[pp] = *(const v4u*)(kn + (tok0 + 64 * (tt) + r_) * DM + h * 128 + c_ * 8); vr[pp] = *(const v4u*)(vv + (tok0 + 64 * (tt) + r_) * DM + h * 128 + c_ * 8); } } while (0)
#define FA_STORE(sl) do { _Pragma("unroll") for (int pp = 0; pp < 2; ++pp) { const int id_ = tid + NTHR * pp, r_ = id_ >> 4, c_ = id_ & 15; \
                *(LAS v4u*)(LK + (sl) * KSLOT + r_ * RSK + c_ * 16) = kr[pp]; *(LAS v4u*)(LV + (sl) * VSLOT + r_ * RSV + c_ * 16) = vr[pp]; } } while (0)
            FA_LOAD(0);
            __syncthreads();
            FA_STORE(0);
            if (ntile > 1) FA_LOAD(1);
            const float cq = c2[qrow];
            float mx = 0.f, ls = 0.f;
            f32x16 O[4];
#pragma unroll
            for (int dt = 0; dt < 4; ++dt)
#pragma unroll
                for (int r = 0; r < 16; ++r) O[dt][r] = 0.f;
            for (int t = 0; t < ntile; ++t) {
                __syncthreads();
                if (t + 1 < ntile) { FA_STORE((t + 1) & 1); if (t + 2 < ntile) FA_LOAD(t + 2); }
                const int key0 = 64 * t;
                if (key0 <= q0 + 32 * w + 31) {
                    const ldsp sk = LK + (t & 1) * KSLOT + r32 * RSK + 16 * hi, sv = LV + (t & 1) * VSLOT;
                    f32x16 S0, S1;
                    const float cbase = cq - mx;
#pragma unroll
                    for (int g = 0; g < 4; ++g) { const f32x4 ck0 = *(const LAS f32x4*)(c2 + key0 + 8 * g + 4 * hi), ck1 = *(const LAS f32x4*)(c2 + key0 + 32 + 8 * g + 4 * hi);
#pragma unroll
                        for (int e = 0; e < 4; ++e) { S0[4 * g + e] = cbase - ck0[e]; S1[4 * g + e] = cbase - ck1[e]; } }
#pragma unroll
                    for (int ks = 0; ks < 8; ++ks) { S0 = MFMA32(*(const LAS bf16x8*)(sk + ks * 32), qf[ks], S0); S1 = MFMA32(*(const LAS bf16x8*)(sk + 32 * RSK + ks * 32), qf[ks], S1); }
                    if (key0 + 63 > q0 + 32 * w) {
#pragma unroll
                        for (int g = 0; g < 4; ++g)
#pragma unroll
                            for (int e = 0; e < 4; ++e) { const int key = key0 + 8 * g + 4 * hi + e; if (key > qrow) S0[4 * g + e] = -INFINITY; if (key + 32 > qrow) S1[4 * g + e] = -INFINITY; } }
                    float mloc = fmaxf(S0[0], S1[0]);
#pragma unroll
                    for (int r = 1; r < 16; ++r) mloc = __builtin_fmaxf(__builtin_fmaxf(mloc, S0[r]), S1[r]);
                    mloc = fmaxf(mloc, __shfl_xor(mloc, 32));
                    if (__any(mloc > 8.0f)) { const float dl = fmaxf(mloc, 0.f), alpha = __builtin_amdgcn_exp2f(-dl); mx += dl; ls *= alpha;
#pragma unroll
                        for (int r = 0; r < 16; ++r) { S0[r] -= dl; S1[r] -= dl; }
#pragma unroll
                        for (int dt = 0; dt < 4; ++dt)
#pragma unroll
                            for (int r = 0; r < 16; ++r) O[dt][r] *= alpha; }
                    float psum = 0.f;
#pragma unroll
                    for (int r = 0; r < 16; ++r) { S0[r] = __builtin_amdgcn_exp2f(S0[r]); S1[r] = __builtin_amdgcn_exp2f(S1[r]); psum += S0[r] + S1[r]; }
                    ls += psum;
                    v4u pf[4];
#pragma unroll
                    for (int s2 = 0; s2 < 2; ++s2) { pf[s2] = (v4u){cvtpk(S0[8 * s2 + 0], S0[8 * s2 + 1]), cvtpk(S0[8 * s2 + 2], S0[8 * s2 + 3]), cvtpk(S0[8 * s2 + 4], S0[8 * s2 + 5]), cvtpk(S0[8 * s2 + 6], S0[8 * s2 + 7])};
                        pf[2 + s2] = (v4u){cvtpk(S1[8 * s2 + 0], S1[8 * s2 + 1]), cvtpk(S1[8 * s2 + 2], S1[8 * s2 + 3]), cvtpk(S1[8 * s2 + 4], S1[8 * s2 + 5]), cvtpk(S1[8 * s2 + 6], S1[8 * s2 + 7])}; }
                    const ldsp vb = sv + (4 * hi + ((lane & 15) >> 2)) * RSV + (16 * ((lane >> 4) & 1) + 4 * (lane & 3)) * 2;
#pragma unroll
                    for (int s4 = 0; s4 < 4; ++s4)
#pragma unroll
                        for (int dt = 0; dt < 4; ++dt) { const ldsp va = vb + (16 * s4) * RSV + dt * 64; const s16x4 lo = vtr(va), hv = vtr(va + 8 * RSV);
                            const bf16x8 af = (bf16x8){lo[0], lo[1], lo[2], lo[3], hv[0], hv[1], hv[2], hv[3]};
                            O[dt] = MFMA32(af, __builtin_bit_cast(bf16x8, pf[s4]), O[dt]); }
                }
            }
            ls += __shfl_xor(ls, 32);
            const float il = 1.0f / ls;
            const size_t yoff = (tok0 + qrow) * DM + h * 128 + 4 * hi;
#pragma unroll
            for (int dt = 0; dt < 4; ++dt)
#pragma unroll
                for (int g = 0; g < 4; ++g) { const v2u gv = *(const v2u*)(gs + yoff + dt * 32 + 8 * g);
                    v2u o; o.x = cvtpk(O[dt][4 * g + 0] * il * bflo(gv.x), O[dt][4 * g + 1] * il * bfhi(gv.x)); o.y = cvtpk(O[dt][4 * g + 2] * il * bflo(gv.y), O[dt][4 * g + 3] * il * bfhi(gv.y));
                    *(v2u*)(y + yoff + dt * 32 + 8 * g) = o; }
        }
    }
#undef FA_LOAD
#undef FA_STORE
}
#ifndef R_RET_CORE
#define R_RET_CORE 1
#endif
#ifndef RC_MASK
#define RC_MASK 0
#endif
#ifndef R_RET_GN
#define R_RET_GN 1
#endif
#ifndef R_GM_SP
#define R_GM_SP 1
#endif
#ifndef R_FOX_ATTN
#define R_FOX_ATTN 1
#endif
#ifndef R_FOX_PREP
#define R_FOX_PREP 1
#endif
#ifndef R_PRO
#define R_PRO 1
#endif
#ifndef F_GU_TAIL
#define F_GU_TAIL 0
#endif

#ifndef PROBE_A
#define PROBE_A -1
#endif
#ifndef PROBE_B
#define PROBE_B -1
#endif
#ifndef PROBE_MUL
#define PROBE_MUL 4
#endif
#define STAMP_AT(id) do { if (PROBE_A >= 0 && ((id) == PROBE_A || (id) == PROBE_B)) { if (F.tid == 0) { const unsigned long long t_ = __builtin_amdgcn_s_memrealtime(); \
        volatile LAS unsigned* m_ = F.MISC + ((id) == PROBE_A ? 16 : 20); m_[0] = (unsigned)t_; m_[1] = (unsigned)(t_ >> 32); const unsigned long long c_ = __builtin_amdgcn_s_memtime(); volatile LAS unsigned* n_ = F.MISC + ((id) == PROBE_A ? 26 : 28); n_[0] = (unsigned)c_; n_[1] = (unsigned)(c_ >> 32); } } } while (0)
struct Args { const void* in[21]; float* out; unsigned char* ws; int ph_lo, ph_hi, li, pad; };
#define IN(k) (lo <= (k) && (k) < hi)
#ifndef PROBE_SKEW
#define PROBE_SKEW -1
#endif
#define SKEW_PRE(k) do { if (PROBE_SKEW >= 0 && (k) == PROBE_SKEW && F.tid == 0) __hip_atomic_store((unsigned long long*)(args.ws + WS_CTL + 524288) + blockIdx.x, (unsigned long long)__builtin_amdgcn_s_memrealtime(), __ATOMIC_RELAXED, __HIP_MEMORY_SCOPE_AGENT); } while (0)
#define SKEW_POST(k) do { if (PROBE_SKEW >= 0 && (k) == PROBE_SKEW && F.tid == 0) { unsigned long long mx_ = 0ull, sm_ = 0ull, mn_ = ~0ull; for (int i_ = 0; i_ < F.G; ++i_) { const unsigned long long t_ = __hip_atomic_load((unsigned long long*)(args.ws + WS_CTL + 524288) + i_, __ATOMIC_RELAXED, __HIP_MEMORY_SCOPE_AGENT); mx_ = t_ > mx_ ? t_ : mx_; mn_ = t_ < mn_ ? t_ : mn_; sm_ += t_ - 1ull; } \
        const unsigned long long mean_ = sm_ / (unsigned long long)F.G + 1ull; F.MISC[24] = (unsigned)(PROBE_SKEW_MINMAX ? (mx_ - mn_) : (mx_ - mean_)); } } while (0)
#ifndef PROBE_SKEW_MINMAX
#define PROBE_SKEW_MINMAX 0
#endif
#define SEAM(k) do { SKEW_PRE(k); if (N_LAUNCHES == 1 && IN(k) && IN((k) + 1)) xcd_barrier(bar); STAMP_AT(k); SKEW_POST(k); } while (0)
template <int L>
__device__ __forceinline__ void layer_body(Frame& F, const Args& args, const XcdBarrier& bar, const int lo, const int hi) {
    unsigned char* ws = args.ws;
    constexpr int kind = L % 3, j = L / 3, pb = 1 + 6 * L;
    float* xo = args.out;
    bf16* XB = (bf16*)(ws + WS_H);
    bf16* A0 = (bf16*)(ws + WS_A); bf16* B0 = (bf16*)(ws + WS_B); bf16* C0 = (bf16*)(ws + WS_C);
    unsigned char* misc = ws + WS_MISC;
    float* rss = (float*)(ws + WS_RSP);
    PG8_LAS float* rtab = (PG8_LAS float*)(F.lds + RSTAB_OFF);
    if (IN(pb + 0)) {
        if (kind == 0) {
            pg8::Gemm g{XB, (const bf16*)(ws + WS_W_RET_IN + j * SZ_W_RET_IN), M, RET_N, DM}; pg8::RsOrder S; S.init(M, RET_N, F.G, (int)blockIdx.x); S.rs = rss + (size_t)(2 * L) * M * 32; S.tab = rtab; S.pend = 0.f; S.nready = 0;
            pg8::EpiRetIn E{A0, A0 + (size_t)M * 2048, A0 + (size_t)M * 4096, A0 + (size_t)M * 8192, (const float*)(ws + WS_ROPE_C), (const float*)(ws + WS_ROPE_S), rtab, 0};
            pg8::gemm_phase<pg8::EpiRetIn, pg8::RsOrder, PG8_ALIGN, PG8_SP2>(F.lds + RING_OFF, g, S, E);
        } else if (kind == 1) {
            pg8::Gemm g{XB, (const bf16*)(ws + WS_W_GM_IN), M, GM_N, DM}; pg8::RsOrder S; S.init(M, GM_N, F.G, (int)blockIdx.x); S.rs = rss + (size_t)(2 * L) * M * 32; S.tab = rtab; S.pend = 0.f; S.nready = 0;
            pg8::EpiGeluUV E{A0, A0 + (size_t)M * GM_HALF, (pg8::f32x2v*)(misc + MISC_PART), rtab, 0};
            pg8::gemm_phase<pg8::EpiGeluUV, pg8::RsOrder, PG8_ALIGN, PG8_SP2>(F.lds + RING_OFF, g, S, E);
        } else {
            pg8::Gemm g{XB, (const bf16*)(ws + WS_W_FOX_IN), M, FOX_N, DM}; pg8::RsOrder S; S.init(M, FOX_N, F.G, (int)blockIdx.x); S.rs = rss + (size_t)(2 * L) * M * 32; S.tab = rtab; S.pend = 0.f; S.nready = 0;
            for (int rep_ = 0; rep_ < R_FOX_PREP; ++rep_) fox_prep_phase(F, XB, rss + (size_t)(2 * L) * M * 32, (const float*)args.in[2] + (size_t)L * DM, (const float*)args.in[13], (const float*)args.in[14], (float*)(misc + MISC_LF));
            PG8_LAS float* qkg = (PG8_LAS float*)(F.lds + QKG_OFF);
            if (F.tid < 256) qkg[F.tid] = F.tid < 128 ? ((const float*)args.in[15])[F.tid] : ((const float*)args.in[16])[F.tid - 128];
            __syncthreads();
            pg8::EpiFoxIn E{A0, (size_t)M * 2048, rtab, 0, (PG8_LAS float*)(F.lds + QKT_OFF), qkg};
            pg8::gemm_phase<pg8::EpiFoxIn, pg8::RsOrder, PG8_ALIGN, PG8_SP2>(F.lds + RING_OFF, g, S, E);
        }
    }
    SEAM(pb + 0);
    if (IN(pb + 1)) {
        if (kind == 0) { bf16* Pb = B0 + (size_t)M * 4096;
            bf16* KFb = (bf16*)(ws + WS_KF);
            bf16* QFb = (bf16*)(ws + WS_QF);
            ret_p_phase(F, A0, A0 + (size_t)M * 2048, Pb, KFb, QFb);
            if (N_LAUNCHES == 1) xcd_barrier(bar);
            STAMP_AT(500 + L);
            for (int rep_ = 0; rep_ < R_RET_CORE; ++rep_) ret_core_phase(F, QFb, A0 + (size_t)M * 4096, Pb, KFb, B0, rep_ ? RC_MASK : 0); }
        else if (kind == 1) { gm_stat_phase(F, (const f32x2*)(misc + MISC_PART), (f32x2*)(misc + MISC_RSTAT)); }
        else { }
    }
    if (kind != 2) SEAM(pb + 1); else STAMP_AT(pb + 1);
    if (IN(pb + 2)) {
        if (kind == 0) { for (int rep_ = 0; rep_ < R_RET_GN; ++rep_) ret_gn_phase(F, B0, A0 + (size_t)M * 8192, (const float*)args.in[5] + (size_t)j * 4096, C0); }
        else if (kind == 1) { for (int rep_ = 0; rep_ < R_GM_SP; ++rep_) gm_spatial_phase(F, A0, A0 + (size_t)M * GM_HALF, (const f32x2*)(misc + MISC_RSTAT), (const float*)args.in[8], (const float*)args.in[9], (const bf16*)(misc + MISC_WTRI), (const float*)args.in[11], B0); }
        else { for (int rep_ = 0; rep_ < R_FOX_ATTN; ++rep_) fox_attn_phase(F, A0, A0 + (size_t)M * 2048, A0 + (size_t)M * 4096, A0 + (size_t)M * 6144, (const float*)(misc + MISC_LF), B0); }
    }
    SEAM(pb + 2);
    if (IN(pb + 3)) {
        const bf16* Ain = kind == 0 ? C0 : B0; constexpr int K = kind == 0 ? 4096 : (kind == 1 ? GM_HALF : DM);
        const bf16* Wt = kind == 0 ? (const bf16*)(ws + WS_W_RET_OUT + j * SZ_W_RET_OUT) : (kind == 1 ? (const bf16*)(ws + WS_W_GM_OUT) : (const bf16*)(ws + WS_W_FOX_OUT));
        pg8::Gemm g{Ain, Wt, M, DM, K}; pg8::StaticOrder S; S.init(M, DM, F.G, (int)blockIdx.x);
        if constexpr (L == 0) {
            pg8::EpiRes<true, false> E{(const float*)args.in[0], nullptr, XB, rss + (size_t)(2 * L + 1) * M * 32, DM};
            pg8::gemm_phase<pg8::EpiRes<true, false>, pg8::StaticOrder, PG8_ALIGN, PG8_SP2>(F.lds + RING_OFF, g, S, E);
        } else {
            pg8::EpiResP<false> E{nullptr, XB, rss + (size_t)(2 * L + 1) * M * 32, DM};
            pg8::gemm_phase<pg8::EpiResP<false>, pg8::StaticOrder, PG8_ALIGN, PG8_SP2>(F.lds + RING_OFF, g, S, E);
        }
    }
    SEAM(pb + 3);
    if (IN(pb + 4)) {
        constexpr int NFULL = (F_GU_TAIL ? 40 : 44) * 256;
        { pg8::Gemm g{XB, (const bf16*)(ws + WS_W_GU + L * SZ_W_GU), M, NFULL, DM}; pg8::RsOrder S; S.init(M, NFULL, F.G, (int)blockIdx.x); S.rs = rss + (size_t)(2 * L + 1) * M * 32; S.tab = rtab; S.pend = 0.f; S.nready = 0;
          pg8::EpiSwiglu<false> E{A0, FFN_H, rtab, 0};
          pg8::gemm_phase<pg8::EpiSwiglu<false>, pg8::RsOrder, PG8_ALIGN, PG8_SP2>(F.lds + RING_OFF, g, S, E); }
        if (F_GU_TAIL) { pg8::Gemm g{XB, (const bf16*)(ws + WS_W_GU + L * SZ_W_GU), M, FFN_N2, DM}; pg8::TailOrder S; S.init(M, FFN_N2, F.G, (int)blockIdx.x); S.rs = rss + (size_t)(2 * L + 1) * M * 32; S.tab = rtab; S.pend = 0.f; S.nready = 0; S.pn0 = 40;
          pg8::EpiSwiglu<true> E{A0, FFN_H, rtab, 0};
          pg8::gemm_phase<pg8::EpiSwiglu<true>, pg8::TailOrder, PG8_ALIGN, PG8_SP2, true>(F.lds + RING_OFF, g, S, E); }
        if constexpr (L + 1 < DEPTH && GU_CUT > 0) { if (F.G == 256 && (int)blockIdx.x >= 128) { const float* ffng = (const float*)args.in[3] + (size_t)(L + 1) * DM; bf16* wt = (bf16*)(ws + WS_W_GU + (L + 1) * SZ_W_GU);
            __syncthreads();
            transpose_job2(F, (const float*)args.in[18] + (size_t)(L + 1) * DM * FFN_H, DM, FFN_H, FFN_H, wt, 1, ffng, (int)blockIdx.x - 128, 128, 0, GU_CUT * (FFN_H / 32));
            transpose_job2(F, (const float*)args.in[19] + (size_t)(L + 1) * DM * FFN_H, DM, FFN_H, FFN_H, wt, 2, ffng, (int)blockIdx.x - 128, 128, 0, GU_CUT * (FFN_H / 32)); } }
    }
    SEAM(pb + 4);
    if (IN(pb + 5)) {
        pg8::Gemm g{A0, (const bf16*)(ws + WS_W_DN + L * SZ_W_DN), M, DM, FFN_H}; pg8::StaticOrder S; S.init(M, DM, F.G, (int)blockIdx.x);
        pg8::EpiResP<L + 1 == DEPTH> E{xo, XB, rss + (size_t)((2 * L + 2) & 7) * M * 32, DM};
        pg8::gemm_phase<pg8::EpiResP<L + 1 == DEPTH>, pg8::StaticOrder, PG8_ALIGN, PG8_SP2>(F.lds + RING_OFF, g, S, E);
    }
    SEAM(pb + 5);
}
__global__ void __launch_bounds__(NWAVES * 64, 2) trunk_fwd(Args args) {
    extern __shared__ __attribute__((aligned(16))) unsigned char lds[];
    Frame F;
    F.lds = (ldsp)lds;
    F.MISC = (volatile LAS unsigned*)(F.lds + MISC_OFF);
    F.tid = threadIdx.x; F.lane = F.tid & 63; F.wave = __builtin_amdgcn_readfirstlane(F.tid >> 6);
    F.G = gridDim.x; { const int bx = blockIdx.x; F.vcu = (F.G % 8 == 0) ? (bx % 8) * (F.G / 8) + bx / 8 : bx; }
    F.ctl = (gu32*)(args.ws + WS_CTL);
    for (int u = F.tid; u < (LDS_BYTES - LDSCTL_OFF) / 4; u += NWAVES * 64) ((LAS unsigned*)(F.lds + LDSCTL_OFF))[u] = 0u;
    __syncthreads();
    XcdBarrier bar; bar.bar = (unsigned*)(F.ctl + CW_BAR); bar.x = 0; bar.st = nullptr;
    if (N_LAUNCHES == 1) bar = xcd_barrier_post((unsigned*)(F.ctl + CW_BAR), F.MISC + 8);
    const int lo = args.ph_lo, hi = args.ph_hi;
    STAMP_AT(999);
    if (IN(0)) for (int rep_ = 0; rep_ < R_PRO; ++rep_) p0_prologue(F, args.in, args.ws);
    SEAM(0);
#ifdef IDLE_TEST
#define IDLE_GAP() do { const unsigned long long t0_ = __builtin_amdgcn_s_memrealtime(); while (__builtin_amdgcn_s_memrealtime() - t0_ < (unsigned long long)(IDLE_TEST) * 100ull) __builtin_amdgcn_s_sleep(32); } while (0)
#else
#define IDLE_GAP() do {} while (0)
#endif
    layer_body<0>(F, args, bar, lo, hi); IDLE_GAP(); layer_body<1>(F, args, bar, lo, hi); IDLE_GAP(); layer_body<2>(F, args, bar, lo, hi); IDLE_GAP(); layer_body<3>(F, args, bar, lo, hi);
#ifdef ABL_GEMM
    if (PROBE_A == 700) { unsigned char* ws = args.ws; xcd_barrier(bar); STAMP_AT(700);
        pg8::Gemm g{(const bf16*)(ws + WS_H), (const bf16*)(ws + WS_W_GU), M, 40 * 256, DM}; pg8::RsOrder S; S.init(M, 40 * 256, F.G, (int)blockIdx.x); S.rs = (float*)(ws + WS_RSP); S.tab = (PG8_LAS float*)(F.lds + RSTAB_OFF); S.pend = 0.f; S.nready = 0;
        pg8::EpiSwiglu<false> E{(bf16*)(ws + WS_A), FFN_H, (PG8_LAS float*)(F.lds + RSTAB_OFF), 0};
        pg8::gemm_phase<pg8::EpiSwiglu<false>, pg8::RsOrder, PG8_ALIGN, PG8_SP2, false, ABL_GEMM>(F.lds + RING_OFF, g, S, E);
        xcd_barrier(bar); STAMP_AT(701); }
#endif
    if (PROBE_SKEW >= 0 && F.tid == 0) { const unsigned long long dly = (unsigned long long)F.MISC[24] * (unsigned long long)PROBE_MUL, t0 = __builtin_amdgcn_s_memrealtime();
        if (dly < 400000ull) while (__builtin_amdgcn_s_memrealtime() - t0 < dly) __builtin_amdgcn_s_sleep(16); }
    if (PROBE_A >= 0 && F.tid == 0) {
        const unsigned long long ta = ((unsigned long long)F.MISC[17] << 32) | F.MISC[16], tb = ((unsigned long long)F.MISC[21] << 32) | F.MISC[20];
        const unsigned long long dly = (tb - ta) * (unsigned long long)PROBE_MUL, t0 = __builtin_amdgcn_s_memrealtime();
        if (tb > ta && dly < 400000ull) while (__builtin_amdgcn_s_memrealtime() - t0 < dly) __builtin_amdgcn_s_sleep(16);
#ifdef CLK_PROBE
        { const unsigned long long ca = ((unsigned long long)F.MISC[27] << 32) | F.MISC[26], cb = ((unsigned long long)F.MISC[29] << 32) | F.MISC[28];
          const unsigned long long mhz = tb > ta ? (cb - ca) * 100ull / (tb - ta) : 0ull, dl2 = mhz * 25ull, t1 = __builtin_amdgcn_s_memrealtime();
          if (dl2 < 400000ull) while (__builtin_amdgcn_s_memrealtime() - t1 < dl2) __builtin_amdgcn_s_sleep(16); }
#endif
    }
}
#undef IN
#undef SEAM

extern "C" void kernel_launch(void* const* d_in, const int* in_sizes, int n_in, void* d_out, int out_size, void* d_ws, size_t ws_size, hipStream_t stream) {
    static int grid = 0;
    if (grid == 0) {
        if (n_in != 21 || in_sizes[0] != M * DM || out_size != M * DM || ws_size < WS_END) { fprintf(stderr, "kernel_launch: unexpected shapes (n_in %d, in0 %d, out %d, ws %zu); nothing launched\n", n_in, n_in > 0 ? in_sizes[0] : -1, out_size, ws_size); grid = -1; return; }
        int dev = 0, cus = 0, per_cu = 0;
        if (hipGetDevice(&dev) != hipSuccess || hipDeviceGetAttribute(&cus, hipDeviceAttributeMultiprocessorCount, dev) != hipSuccess) { grid = -1; return; }
        if (hipFuncSetAttribute((const void*)trunk_fwd, hipFuncAttributeMaxDynamicSharedMemorySize, LDS_BYTES) != hipSuccess) { fprintf(stderr, "kernel_launch: hipFuncSetAttribute failed\n"); grid = -1; return; }
        if (hipOccupancyMaxActiveBlocksPerMultiprocessor(&per_cu, (const void*)trunk_fwd, NWAVES * 64, LDS_BYTES) != hipSuccess || per_cu < 1)
            fprintf(stderr, "kernel_launch: note: occupancy query reports %d workgroups per CU\n", per_cu);
        (void)hipGetLastError();
        grid = cus;
    }
    if (grid < 0) return;
    if (hipMemsetAsync((char*)d_ws + WS_CTL, 0, CTL_ZERO_BYTES, stream) != hipSuccess) return;
    Args a{};
    for (int i = 0; i < 21; ++i) a.in[i] = d_in[i];
    a.out = (float*)d_out; a.ws = (unsigned char*)d_ws;
    for (int li = 0; li < N_LAUNCHES; ++li) {
        a.ph_lo = (N_LAUNCHES == 1) ? 0 : li; a.ph_hi = (N_LAUNCHES == 1) ? N_PHASES : li + 1; a.li = li; a.pad = 0;
        hipLaunchKernelGGL(trunk_fwd, dim3(grid), dim3(NWAVES * 64), LDS_BYTES, stream, a);
        const hipError_t le = hipPeekAtLastError();
        if (le != hipSuccess) { fprintf(stderr, "kernel_launch: launch %d failed: %s\n", li, hipGetErrorName(le)); break; }
    }
}
```
